# Optimizing an MI355X kernel written in HIP

```python
import math
import jax, jax.numpy as jnp
from jax import lax
import numpy as np

D_MODEL = 1024
BATCH = 8
SEQ = 4096
DEPTH = 1

GRID_W = 64
CTX_LEN = 256
EPS = 1e-6
N_MOD = 6

HG_WIDTH = 512
HG_HEADS = 4
HG_DK = HG_WIDTH // HG_HEADS
HG_DV = HG_WIDTH // HG_HEADS
CHUNK = 64

HY_WIDTH = 512
HY_SHORT = 3
HY_EMB = 33
HY_BANDS = (HY_EMB - 1) // 2
HY_FILTER_HIDDEN = 64
HY_DECAY_TARGET = 1e-2
HY_FAST_PCT = 0.3
HY_SLOW_PCT = 1.5

D_FF = 4 * D_MODEL

HY_OFF = 5 * HG_WIDTH
GATE_OFF = HY_OFF + 3 * HY_WIDTH
IN_COLS = GATE_OFF + 2 * D_MODEL

kernel_name = 'hgrn2_hyena_gated_hybrid_prefix_dit'


def rmsnorm(x, w):
    xf = x.astype(jnp.float32)
    r = xf * lax.rsqrt(jnp.mean(xf * xf, axis=-1, keepdims=True) + EPS)
    return (r * w.astype(jnp.float32)).astype(x.dtype)


def modulate(h, shift, scale):
    return h * (1 + scale) + shift


def to_heads(t):
    b, l, _ = t.shape
    return t.reshape(b, l, HG_HEADS, -1).transpose(0, 2, 1, 3)


def flip_seq(t):
    return jnp.flip(t, axis=2)


def hgrn_gates(z, lb):
    f = lb + (1.0 - lb) * jax.nn.sigmoid(z.astype(jnp.float32))
    return to_heads(jnp.log(f)), to_heads(1.0 - f)


def _chunk(t):
    b, h, l, d = t.shape
    return t.reshape(b, h, l // CHUNK, CHUNK, d)


def _chunk_states(s0, kc, vc, a):
    a_last = a[..., -1:, :]
    ds = jnp.einsum('bhnsd,bhnsv->bhndv', kc * jnp.exp(a_last - a), vc)
    decay = jnp.exp(a_last[..., 0, :])

    def step(s, inp):
        d, dsn = inp
        return d[..., None] * s + dsn, s

    s_fin, s_starts = lax.scan(step, s0, (jnp.moveaxis(decay, 2, 0), jnp.moveaxis(ds, 2, 0)))
    return s_fin, jnp.moveaxis(s_starts, 0, 2)


def gla_scan(q, k, v, logf, s0):
    b, h, l, _ = q.shape
    qc, kc, vc = _chunk(q), _chunk(k), _chunk(v)
    a = jnp.cumsum(_chunk(logf), axis=3)
    s_fin, s_starts = _chunk_states(s0, kc, vc, a)
    qe = qc * jnp.exp(a)
    scores = jnp.einsum('bhncd,bhnsd->bhncs', qe, kc * jnp.exp(-a))
    mask = jnp.tril(jnp.ones((CHUNK, CHUNK), dtype=bool))
    scores = jnp.where(mask, scores, 0.0)
    o = jnp.einsum('bhncs,bhnsv->bhncv', scores, vc) + jnp.einsum('bhncd,bhndv->bhncv', qe, s_starts)
    return o.reshape(b, h, l, -1), s_fin


def gla_final_state(k, v, logf, s0):
    s_fin, _ = _chunk_states(s0, _chunk(k), _chunk(v), jnp.cumsum(_chunk(logf), axis=3))
    return s_fin


def hgrn_context_states(i, zf, zb, lb, s0):
    vh = to_heads(i.astype(jnp.float32))
    logf_f, k_f = hgrn_gates(zf, lb)
    logf_b, k_b = hgrn_gates(zb, lb)
    s_f = gla_final_state(k_f, vh, logf_f, s0)
    s_b = gla_final_state(flip_seq(k_b), flip_seq(vh), flip_seq(logf_b), s0)
    return s_f, s_b


def hgrn_branch(i, zf, zb, q, g, lb, g_norm, s0f, s0b):
    b, l, _ = i.shape
    qh = to_heads(jax.nn.silu(q.astype(jnp.float32)))
    vh = to_heads(i.astype(jnp.float32))
    logf_f, k_f = hgrn_gates(zf, lb)
    logf_b, k_b = hgrn_gates(zb, lb)
    o_f, s_f = gla_scan(qh, k_f, vh, logf_f, s0f)
    o_b, s_b = gla_scan(flip_seq(qh), flip_seq(k_b), flip_seq(vh), flip_seq(logf_b), s0b)
    o = o_f + flip_seq(o_b)
    o = o * lax.rsqrt(jnp.mean(o * o, axis=-1, keepdims=True) + EPS) * g_norm.astype(jnp.float32)
    o = o.transpose(0, 2, 1, 3).reshape(b, l, HG_WIDTH) * jax.nn.silu(g.astype(jnp.float32))
    return o.astype(i.dtype), s_f, s_b


def short_conv(u, w, bias):
    l = u.shape[-2]
    up = jnp.pad(u, [(0, 0)] * (u.ndim - 2) + [(1, 1), (0, 0)])
    return up[..., 0:l, :] * w[0] + up[..., 1:l + 1, :] * w[1] + up[..., 2:l + 2, :] * w[2] + bias


def hyena_filters(length, f_w1, f_b1, f_w2, f_b2, f_w3, f_freq):
    f32 = jnp.float32
    pos = jnp.arange(length, dtype=f32)
    t = pos / max(length - 1, 1)
    w = 2.0 * math.pi * pos / length
    bands = jnp.linspace(1e-4, HY_BANDS - 1, HY_BANDS, dtype=f32)
    ang = w[:, None] * bands[None, :]
    z = jnp.concatenate([t[:, None], jnp.cos(ang), -jnp.sin(ang)], axis=-1)
    fr = f_freq.astype(f32)
    hdn = jnp.sin(fr * (z @ f_w1.astype(f32) + f_b1.astype(f32)))
    hdn = jnp.sin(fr * (hdn @ f_w2.astype(f32) + f_b2.astype(f32)))
    h = (hdn @ f_w3.astype(f32)).reshape(length, 2, HY_WIDTH)
    min_decay = math.log(HY_DECAY_TARGET) / HY_SLOW_PCT
    max_decay = math.log(HY_DECAY_TARGET) / HY_FAST_PCT
    deltas = jnp.abs(jnp.linspace(min_decay, max_decay, HY_WIDTH, dtype=f32))
    h = h * jnp.exp(-t[:, None] * deltas[None, :])[:, None, :]
    return h[:, 0], h[:, 1]


def long_conv_bidir(u, h_fwd, h_bwd, d_skip):
    l = u.shape[1]
    n = 2 * l
    kern = jnp.concatenate([h_fwd, jnp.zeros((1, HY_WIDTH), jnp.float32), h_bwd[:0:-1]], axis=0)
    uf32 = u.astype(jnp.float32)
    y = jnp.fft.irfft(jnp.fft.rfft(uf32, n=n, axis=1) * jnp.fft.rfft(kern, n=n, axis=0)[None], n=n, axis=1)[:, :l]
    return (y + uf32 * d_skip.astype(jnp.float32)).astype(u.dtype)


def hyena_branch(u, grid, hy_short_w, hy_short_b, f_w1, f_b1, f_w2, f_b2, f_w3, f_freq, hy_d):
    b, l, cdim = u.shape
    if grid:
        rows = l // GRID_W
        uc = short_conv(u.reshape(b, rows, GRID_W, cdim), hy_short_w, hy_short_b).reshape(b, l, cdim)
    else:
        uc = short_conv(u, hy_short_w, hy_short_b)
    x0, x1, v = uc[..., :HY_WIDTH], uc[..., HY_WIDTH:2 * HY_WIDTH], uc[..., 2 * HY_WIDTH:]
    h_fwd, h_bwd = hyena_filters(l, f_w1, f_b1, f_w2, f_b2, f_w3, f_freq)
    v = long_conv_bidir(v * x1, h_fwd, h_bwd, hy_d)
    return v * x0


def mixer(p, lb, s0f, s0b, grid, g_norm, hy_short_w, hy_short_b, f_w1, f_b1, f_w2, f_b2, f_w3,
          f_freq, hy_d, w_pa, w_pb, w_out):
    i, zf, zb, q, g = (p[..., k * HG_WIDTH:(k + 1) * HG_WIDTH] for k in range(5))
    u = p[..., HY_OFF:GATE_OFF]
    gates = jax.nn.sigmoid(p[..., GATE_OFF:])
    a, s_f, s_b = hgrn_branch(i, zf, zb, q, g, lb, g_norm, s0f, s0b)
    y = hyena_branch(u, grid, hy_short_w, hy_short_b, f_w1, f_b1, f_w2, f_b2, f_w3, f_freq, hy_d)
    merged = gates[..., :D_MODEL] * (a @ w_pa) + gates[..., D_MODEL:] * (y @ w_pb)
    return merged @ w_out, s_f, s_b


def sq_relu_mlp(h, w1, w2):
    return jnp.square(jax.nn.relu(h @ w1)) @ w2


def setup_inputs(seed: int = 0) -> dict:
    key = jax.random.key(seed)
    ks = jax.random.split(key, 26)
    f32 = jnp.float32
    nrm = lambda k, shape, s: (jax.random.normal(k, shape, f32) * s)
    d = D_MODEL
    return {
        'x': nrm(ks[0], (BATCH, SEQ, d), 1.0),
        'c': nrm(ks[1], (BATCH, d), 1.0),
        'ctx': nrm(ks[2], (BATCH, CTX_LEN, d), 1.0),
        'c_ctx': nrm(ks[3], (d,), 1.0),
        'w_ada': nrm(ks[4], (DEPTH, d, N_MOD * d), 0.5 * d ** -0.5),
        'b_ada': nrm(ks[5], (DEPTH, N_MOD * d), 0.02),
        'norm_w': 1.0 + nrm(ks[6], (DEPTH, 4, d), 0.02),
        'w_in': nrm(ks[7], (DEPTH, d, IN_COLS), d ** -0.5),
        'lb_param': nrm(ks[8], (DEPTH + 1, HG_WIDTH), 0.1),
        'g_norm': 1.0 + nrm(ks[9], (DEPTH, HG_DV), 0.02),
        'hy_short_w': nrm(ks[10], (DEPTH, HY_SHORT, 3 * HY_WIDTH), HY_SHORT ** -0.5),
        'hy_short_b': nrm(ks[11], (DEPTH, 3 * HY_WIDTH), 0.02),
        'f_w1': nrm(ks[12], (DEPTH, HY_EMB, HY_FILTER_HIDDEN), HY_EMB ** -0.5),
        'f_b1': nrm(ks[13], (DEPTH, HY_FILTER_HIDDEN), 0.1),
        'f_w2': nrm(ks[14], (DEPTH, HY_FILTER_HIDDEN, HY_FILTER_HIDDEN), HY_FILTER_HIDDEN ** -0.5),
        'f_b2': nrm(ks[15], (DEPTH, HY_FILTER_HIDDEN), 0.1),
        'f_w3': nrm(ks[16], (DEPTH, HY_FILTER_HIDDEN, 2 * HY_WIDTH), 0.05 * HY_FILTER_HIDDEN ** -0.5),
        'f_freq': 1.0 + nrm(ks[17], (DEPTH, HY_FILTER_HIDDEN), 0.01),
        'hy_d': nrm(ks[18], (DEPTH, HY_WIDTH), 0.5),
        'w_pa': nrm(ks[19], (DEPTH, HG_WIDTH, d), HG_WIDTH ** -0.5),
        'w_pb': nrm(ks[20], (DEPTH, HY_WIDTH, d), HY_WIDTH ** -0.5),
        'w_out': nrm(ks[21], (DEPTH, d, d), d ** -0.5),
        'w_mlp1': nrm(ks[22], (DEPTH, d, D_FF), d ** -0.5),
        'w_mlp2': nrm(ks[23], (DEPTH, D_FF, d), D_FF ** -0.5),
    }


def reference(x, c, ctx, c_ctx, w_ada, b_ada, norm_w, w_in, lb_param, g_norm, hy_short_w, hy_short_b,
              f_w1, f_b1, f_w2, f_b2, f_w3, f_freq, hy_d, w_pa, w_pb, w_out, w_mlp1, w_mlp2):
    b_, _, _ = x.shape
    lb_all = jnp.cumsum(jax.nn.softmax(lb_param.astype(jnp.float32), axis=0), axis=0)
    s0 = jnp.zeros((b_, HG_HEADS, HG_DK, HG_DV), jnp.float32)
    x_lat, x_ctx = x, ctx
    for layer in range(DEPTH):
        last = layer == DEPTH - 1
        lb = lb_all[layer]
        nw = norm_w[layer]
        mod = (jax.nn.silu(c) @ w_ada[layer] + b_ada[layer]).reshape(b_, N_MOD, 1, D_MODEL)
        mod_c = (jax.nn.silu(c_ctx) @ w_ada[layer] + b_ada[layer]).reshape(N_MOD, D_MODEL)
        mix_args = (g_norm[layer], hy_short_w[layer], hy_short_b[layer], f_w1[layer], f_b1[layer],
                    f_w2[layer], f_b2[layer], f_w3[layer], f_freq[layer], hy_d[layer],
                    w_pa[layer], w_pb[layer], w_out[layer])
        h_lat = modulate(rmsnorm(x_lat, nw[0]), mod[:, 1], mod[:, 0])
        h_ctx = modulate(rmsnorm(x_ctx, nw[0]), mod_c[1], mod_c[0])
        if last:
            p_ctx = h_ctx @ w_in[layer][:, :3 * HG_WIDTH]
            s_cf, s_cb = hgrn_context_states(p_ctx[..., :HG_WIDTH], p_ctx[..., HG_WIDTH:2 * HG_WIDTH],
                                             p_ctx[..., 2 * HG_WIDTH:], lb, s0)
        else:
            p_ctx = h_ctx @ w_in[layer]
            mix_ctx, s_cf, s_cb = mixer(p_ctx, lb, s0, s0, False, *mix_args)
            x_ctx = x_ctx + mod_c[2] * rmsnorm(mix_ctx, nw[1])
            hc = modulate(rmsnorm(x_ctx, nw[2]), mod_c[4], mod_c[3])
            x_ctx = x_ctx + mod_c[5] * rmsnorm(sq_relu_mlp(hc, w_mlp1[layer], w_mlp2[layer]), nw[3])
        p_lat = h_lat @ w_in[layer]
        mix_lat, _, _ = mixer(p_lat, lb, s_cf, s_cb, True, *mix_args)
        x_lat = x_lat + mod[:, 2] * rmsnorm(mix_lat, nw[1])
        hl = modulate(rmsnorm(x_lat, nw[2]), mod[:, 4], mod[:, 3])
        x_lat = x_lat + mod[:, 5] * rmsnorm(sq_relu_mlp(hl, w_mlp1[layer], w_mlp2[layer]), nw[3])
    return x_lat
```

```cpp
#include <hip/hip_runtime.h>
#include <math.h>

namespace {
constexpr int D = 1024, NB = 8, L = 4096, LC = 256, INC = 6144, FF = 4096, HW = 512;
constexpr float EPS = 1e-6f;

__device__ __forceinline__ float sigmoidf_(float x) { return 1.f / (1.f + expf(-x)); }
__device__ __forceinline__ float siluf_(float x) { return x / (1.f + expf(-x)); }
__device__ __forceinline__ float wave_sum(float v) {
#pragma unroll
    for (int o = 1; o < 64; o <<= 1) v += __shfl_xor(v, o);
    return v;
}

__global__ void k_mod(const float* c, const float* c_ctx, const float* w_ada, const float* b_ada, float* mod) {
    __shared__ float sc[D];
    const int r = blockIdx.y; const float* cv = r < 8 ? c + r * D : c_ctx;
    for (int i = threadIdx.x; i < D; i += 256) sc[i] = siluf_(cv[i]);
    __syncthreads();
    const int j = blockIdx.x * 256 + threadIdx.x;
    float acc = 0.f;
    for (int k = 0; k < D; ++k) acc += sc[k] * w_ada[(size_t)k * INC + j];
    mod[r * INC + j] = acc + b_ada[j];
}
__global__ void k_lb(const float* lbp, float* lb) {
    const int j = blockIdx.x * blockDim.x + threadIdx.x;
    if (j < HW) { const float a = lbp[j], b = lbp[HW + j], m = fmaxf(a, b); const float ea = expf(a - m), eb = expf(b - m); lb[j] = ea / (ea + eb); }
}
__global__ void k_norm_mod(const float* x, const float* nw, const float* scale, const float* shift, float* out, int rows) {
    const int row = blockIdx.x * 4 + (threadIdx.x >> 6), lane = threadIdx.x & 63;
    if (row >= rows) return;
    const float* xr = x + (size_t)row * D; float v[16]; float s = 0.f;
#pragma unroll
    for (int i = 0; i < 16; ++i) { v[i] = xr[lane + 64 * i]; s += v[i] * v[i]; }
    const float r = rsqrtf(wave_sum(s) * (1.f / D) + EPS);
#pragma unroll
    for (int i = 0; i < 16; ++i) { const int k = lane + 64 * i; out[(size_t)row * D + k] = v[i] * r * nw[k] * (1.f + scale[k]) + shift[k]; }
}
__global__ void k_resid_norm(const float* x, const float* y, const float* nw, const float* gate, float* out, int rows) {
    const int row = blockIdx.x * 4 + (threadIdx.x >> 6), lane = threadIdx.x & 63;
    if (row >= rows) return;
    const float* yr = y + (size_t)row * D; float v[16]; float s = 0.f;
#pragma unroll
    for (int i = 0; i < 16; ++i) { v[i] = yr[lane + 64 * i]; s += v[i] * v[i]; }
    const float r = rsqrtf(wave_sum(s) * (1.f / D) + EPS);
#pragma unroll
    for (int i = 0; i < 16; ++i) { const int k = lane + 64 * i; out[(size_t)row * D + k] = x[(size_t)row * D + k] + gate[k] * (v[i] * r * nw[k]); }
}
template <int ACT>
__global__ void k_gemm(const float* A, int lda, const float* W, int ldw, float* C, int ldc, int K) {
    __shared__ float As[16][65];
    __shared__ float Ws[16][64];
    const int tx = threadIdx.x & 15, ty = threadIdx.x >> 4;
    const int m0 = blockIdx.y * 64, n0 = blockIdx.x * 64;
    float acc[4][4];
#pragma unroll
    for (int i = 0; i < 4; ++i)
#pragma unroll
        for (int j = 0; j < 4; ++j) acc[i][j] = 0.f;
    for (int k0 = 0; k0 < K; k0 += 16) {
#pragma unroll
        for (int i = 0; i < 4; ++i) { const int idx = threadIdx.x + i * 256; const int m = idx >> 4, k = idx & 15; As[k][m] = A[(size_t)(m0 + m) * lda + k0 + k]; }
#pragma unroll
        for (int i = 0; i < 4; ++i) { const int idx = threadIdx.x + i * 256; const int k = idx >> 6, n = idx & 63; Ws[k][n] = W[(size_t)(k0 + k) * ldw + n0 + n]; }
        __syncthreads();
#pragma unroll
        for (int k = 0; k < 16; ++k) {
            float a[4], b[4];
#pragma unroll
            for (int i = 0; i < 4; ++i) a[i] = As[k][ty * 4 + i];
#pragma unroll
            for (int j = 0; j < 4; ++j) b[j] = Ws[k][tx * 4 + j];
#pragma unroll
            for (int i = 0; i < 4; ++i)
#pragma unroll
                for (int j = 0; j < 4; ++j) acc[i][j] += a[i] * b[j];
        }
        __syncthreads();
    }
#pragma unroll
    for (int i = 0; i < 4; ++i)
#pragma unroll
        for (int j = 0; j < 4; ++j) { float v = acc[i][j]; if (ACT == 1) { v = fmaxf(v, 0.f); v = v * v; } C[(size_t)(m0 + ty * 4 + i) * ldc + n0 + tx * 4 + j] = v; }
}
__global__ void k_hgrn_scan(const float* p, int ldp, int Lseq, const float* lb, const float* s_in, float* s_out, float* o_out, int has_q) {
    const int h = blockIdx.x, dir = blockIdx.y, tid = threadIdx.x, v = tid & 127, dg = tid >> 7;
    __shared__ float fb[8][128], qb[8][128], vb[8][128], pb[8][4][128];
    float S[32];
#pragma unroll
    for (int i = 0; i < 32; ++i) S[i] = s_in ? s_in[(((size_t)dir * 4 + h) * 128 + dg * 32 + i) * 128 + v] : 0.f;
    for (int t0 = 0; t0 < Lseq; t0 += 8) {
        for (int e = tid; e < 8 * 128; e += 512) {
            const int tt = e >> 7, dd = e & 127; const int t = dir ? (Lseq - 1 - (t0 + tt)) : (t0 + tt);
            const float* pr = p + (size_t)t * ldp; const int col = h * 128 + dd;
            const float z = pr[(dir ? 1024 : 512) + col]; const float lbv = lb[col];
            fb[tt][dd] = lbv + (1.f - lbv) * sigmoidf_(z);
            qb[tt][dd] = has_q ? siluf_(pr[1536 + col]) : 0.f;
            vb[tt][dd] = pr[col];
        }
        __syncthreads();
#pragma unroll 1
        for (int tt = 0; tt < 8; ++tt) {
            const float vv = vb[tt][v]; float part = 0.f;
#pragma unroll
            for (int i = 0; i < 32; ++i) { const float f = fb[tt][dg * 32 + i]; S[i] = f * S[i] + (1.f - f) * vv; part += S[i] * qb[tt][dg * 32 + i]; }
            pb[tt][dg][v] = part;
        }
        __syncthreads();
        if (o_out) for (int e = tid; e < 8 * 128; e += 512) {
            const int tt = e >> 7, vv = e & 127; const int t = dir ? (Lseq - 1 - (t0 + tt)) : (t0 + tt);
            o_out[((size_t)dir * Lseq + t) * HW + h * 128 + vv] = pb[tt][0][vv] + pb[tt][1][vv] + pb[tt][2][vv] + pb[tt][3][vv];
        }
        __syncthreads();
    }
    if (s_out) {
#pragma unroll
        for (int i = 0; i < 32; ++i) s_out[(((size_t)dir * 4 + h) * 128 + dg * 32 + i) * 128 + v] = S[i];
    }
}
__global__ void k_hgrn_out(const float* o, const float* p, int ldp, const float* g_norm, float* a, int Lseq) {
    const int w = blockIdx.x * 4 + (threadIdx.x >> 6), lane = threadIdx.x & 63; const int t = w >> 2, h = w & 3;
    if (t >= Lseq) return;
    float v[2]; float s = 0.f;
#pragma unroll
    for (int i = 0; i < 2; ++i) { const int c = h * 128 + lane + 64 * i; v[i] = o[(size_t)t * HW + c] + o[((size_t)Lseq + t) * HW + c]; s += v[i] * v[i]; }
    const float r = rsqrtf(wave_sum(s) * (1.f / 128.f) + EPS);
#pragma unroll
    for (int i = 0; i < 2; ++i) { const int vv = lane + 64 * i, c = h * 128 + vv; a[(size_t)t * HW + c] = v[i] * r * g_norm[vv] * siluf_(p[(size_t)t * ldp + 2048 + c]); }
}
__global__ void k_filters(const float* f_w1, const float* f_b1, const float* f_w2, const float* f_b2, const float* f_w3, const float* f_freq, const float* hy_d, float* Gt) {
    const int t = blockIdx.x, k = threadIdx.x;
    __shared__ float z[33], h1[64], h2[64];
    const float tn = (float)t / (float)(L - 1);
    if (k < 33) {
        float val;
        if (k == 0) val = tn;
        else {
            const int bi = (k - 1) & 15; const float band = 1e-4f + (float)bi * ((15.f - 1e-4f) / 15.f);
            const float w = 2.0f * 3.14159265358979323846f * (float)t / (float)L; const float ang = w * band;
            val = (k <= 16) ? cosf(ang) : -sinf(ang);
        }
        z[k] = val;
    }
    __syncthreads();
    { float acc = f_b1[k]; for (int i = 0; i < 33; ++i) acc += z[i] * f_w1[i * 64 + k]; h1[k] = sinf(f_freq[k] * acc); }
    __syncthreads();
    { float acc = f_b2[k]; for (int i = 0; i < 64; ++i) acc += h1[i] * f_w2[i * 64 + k]; h2[k] = sinf(f_freq[k] * acc); }
    __syncthreads();
    const float mind = logf(1e-2f) / 1.5f, maxd = logf(1e-2f) / 0.3f;
    for (int j = k; j < 1024; j += 64) {
        float acc = 0.f; for (int i = 0; i < 64; ++i) acc += h2[i] * f_w3[i * 1024 + j];
        const int dirb = j >> 9, c = j & 511;
        const float delta = fabsf(mind + (maxd - mind) * ((float)c / 511.f));
        float val = acc * expf(-tn * delta);
        if (dirb == 0) { if (t == 0) val += hy_d[c]; Gt[(size_t)c * 8192 + 4095 + t] = val; }
        else if (t > 0) Gt[(size_t)c * 8192 + 4095 - t] = val;
    }
}
__global__ void k_shortconv(const float* p, int ldp, const float* sw, const float* sb, float* wv, float* x0c, int Lseq) {
    const int idx = blockIdx.x * 256 + threadIdx.x; const int t = idx >> 9, c = idx & 511;
    if (t >= Lseq) return;
    const int j = t & 63;
    float r[3];
#pragma unroll
    for (int s = 0; s < 3; ++s) {
        const int col = s * 512 + c; const float* pc = p + 2560 + col;
        float acc = sb[col] + pc[(size_t)t * ldp] * sw[1 * 1536 + col];
        if (j > 0) acc += pc[(size_t)(t - 1) * ldp] * sw[0 * 1536 + col];
        if (j < 63) acc += pc[(size_t)(t + 1) * ldp] * sw[2 * 1536 + col];
        r[s] = acc;
    }
    x0c[(size_t)t * HW + c] = r[0]; wv[(size_t)t * HW + c] = r[2] * r[1];
}
__global__ void k_longconv(const float* wv, const float* x0c, const float* Gt, float* y) {
    const int c = blockIdx.x, tid = threadIdx.x;
    __shared__ float ws_[L]; __shared__ float gt[8192];
    for (int i = tid; i < L; i += 512) ws_[i] = wv[(size_t)i * HW + c];
    for (int i = tid; i < 8191; i += 512) gt[i] = Gt[(size_t)c * 8192 + i];
    __syncthreads();
    float acc[8];
#pragma unroll
    for (int j = 0; j < 8; ++j) acc[j] = 0.f;
    for (int s = 0; s < L; ++s) {
        const float w = ws_[s];
#pragma unroll
        for (int j = 0; j < 8; ++j) acc[j] += gt[4095 + tid + 512 * j - s] * w;
    }
#pragma unroll
    for (int j = 0; j < 8; ++j) { const int t = tid + 512 * j; y[(size_t)t * HW + c] = acc[j] * x0c[(size_t)t * HW + c]; }
}
__global__ void k_merge(const float* p, int ldp, const float* pa, const float* pb, float* merged, int rows) {
    const size_t idx = (size_t)blockIdx.x * 256 + threadIdx.x; const int t = (int)(idx >> 10), n = (int)(idx & 1023);
    if (t >= rows) return;
    merged[idx] = sigmoidf_(p[(size_t)t * ldp + 4096 + n]) * pa[idx] + sigmoidf_(p[(size_t)t * ldp + 5120 + n]) * pb[idx];
}
}

extern "C" void kernel_launch(void* const* d_in, const int* in_sizes, int n_in, void* d_out, int out_size, void* d_ws, size_t ws_size, hipStream_t stream) {
    const float* x = (const float*)d_in[0]; const float* c = (const float*)d_in[1]; const float* ctx = (const float*)d_in[2]; const float* c_ctx = (const float*)d_in[3];
    const float* w_ada = (const float*)d_in[4]; const float* b_ada = (const float*)d_in[5]; const float* norm_w = (const float*)d_in[6]; const float* w_in = (const float*)d_in[7];
    const float* lb_param = (const float*)d_in[8]; const float* g_norm = (const float*)d_in[9]; const float* hy_sw = (const float*)d_in[10]; const float* hy_sb = (const float*)d_in[11];
    const float* f_w1 = (const float*)d_in[12]; const float* f_b1 = (const float*)d_in[13]; const float* f_w2 = (const float*)d_in[14]; const float* f_b2 = (const float*)d_in[15];
    const float* f_w3 = (const float*)d_in[16]; const float* f_freq = (const float*)d_in[17]; const float* hy_d = (const float*)d_in[18]; const float* w_pa = (const float*)d_in[19];
    const float* w_pb = (const float*)d_in[20]; const float* w_out = (const float*)d_in[21]; const float* w_mlp1 = (const float*)d_in[22]; const float* w_mlp2 = (const float*)d_in[23];
    float* out = (float*)d_out;
    float* ws = (float*)d_ws; size_t off = 0;
    auto take = [&](size_t n) { float* r = ws + off; off += (n + 63) & ~(size_t)63; return r; };
    float* mod = take(9 * INC); float* lb = take(HW); float* Gt = take((size_t)512 * 8192);
    float* hctx = take((size_t)LC * D); float* pctx = take((size_t)LC * 1536); float* sctx = take((size_t)2 * 4 * 128 * 128);
    float* h = take((size_t)L * D); float* p = take((size_t)L * INC); float* o = take((size_t)2 * L * HW); float* a = take((size_t)L * HW);
    float* wv = take((size_t)L * HW); float* x0c = take((size_t)L * HW); float* y = take((size_t)L * HW);
    float* pa = take((size_t)L * D); float* pb = take((size_t)L * D); float* merged = take((size_t)L * D); float* mix = take((size_t)L * D);
    float* x1 = take((size_t)L * D); float* hl = take((size_t)L * D); float* h1 = take((size_t)L * FF); float* mlp = take((size_t)L * D);

    k_mod<<<dim3(INC / 256, 9), 256, 0, stream>>>(c, c_ctx, w_ada, b_ada, mod);
    k_lb<<<2, 256, 0, stream>>>(lb_param, lb);
    k_filters<<<L, 64, 0, stream>>>(f_w1, f_b1, f_w2, f_b2, f_w3, f_freq, hy_d, Gt);
    const float* nw = norm_w; const float* modc = mod + 8 * INC;
    for (int b = 0; b < NB; ++b) {
        const float* mb = mod + (size_t)b * INC; const float* xb = x + (size_t)b * L * D; const float* cb = ctx + (size_t)b * LC * D; float* ob = out + (size_t)b * L * D;
        k_norm_mod<<<LC / 4, 256, 0, stream>>>(cb, nw, modc, modc + D, hctx, LC);
        k_gemm<0><<<dim3(1536 / 64, LC / 64), 256, 0, stream>>>(hctx, D, w_in, INC, pctx, 1536, D);
        k_hgrn_scan<<<dim3(4, 2), 512, 0, stream>>>(pctx, 1536, LC, lb, nullptr, sctx, nullptr, 0);
        k_norm_mod<<<L / 4, 256, 0, stream>>>(xb, nw, mb, mb + D, h, L);
        k_gemm<0><<<dim3(INC / 64, L / 64), 256, 0, stream>>>(h, D, w_in, INC, p, INC, D);
        k_hgrn_scan<<<dim3(4, 2), 512, 0, stream>>>(p, INC, L, lb, sctx, nullptr, o, 1);
        k_hgrn_out<<<L * 4 / 4, 256, 0, stream>>>(o, p, INC, g_norm, a, L);
        k_shortconv<<<L * HW / 256, 256, 0, stream>>>(p, INC, hy_sw, hy_sb, wv, x0c, L);
        k_longconv<<<HW, 512, 0, stream>>>(wv, x0c, Gt, y);
        k_gemm<0><<<dim3(D / 64, L / 64), 256, 0, stream>>>(a, HW, w_pa, D, pa, D, HW);
        k_gemm<0><<<dim3(D / 64, L / 64), 256, 0, stream>>>(y, HW, w_pb, D, pb, D, HW);
        k_merge<<<L * D / 256, 256, 0, stream>>>(p, INC, pa, pb, merged, L);
        k_gemm<0><<<dim3(D / 64, L / 64), 256, 0, stream>>>(merged, D, w_out, D, mix, D, D);
        k_resid_norm<<<L / 4, 256, 0, stream>>>(xb, mix, nw + D, mb + 2 * D, x1, L);
        k_norm_mod<<<L / 4, 256, 0, stream>>>(x1, nw + 2 * D, mb + 3 * D, mb + 4 * D, hl, L);
        k_gemm<1><<<dim3(FF / 64, L / 64), 256, 0, stream>>>(hl, D, w_mlp1, FF, h1, FF, D);
        k_gemm<0><<<dim3(D / 64, L / 64), 256, 0, stream>>>(h1, FF, w_mlp2, D, mlp, D, FF);
        k_resid_norm<<<L / 4, 256, 0, stream>>>(x1, mlp, nw + 3 * D, mb + 5 * D, ob, L);
    }
}
```

```cpp
#include <hip/hip_runtime.h>
#include <hip/hip_cooperative_groups.h>
#include <cstdio>
#include <math.h>
namespace cg = cooperative_groups;

namespace pg8 {
#define PG8_LAS __attribute__((address_space(3)))
typedef unsigned short bf16_t;
typedef short bf16x8 __attribute__((ext_vector_type(8)));
typedef float f32x4 __attribute__((ext_vector_type(4)));
typedef unsigned u32x4 __attribute__((ext_vector_type(4)));
typedef unsigned u32x2 __attribute__((ext_vector_type(2)));
constexpr int BM = 256, BK = 64, HALF = 128, HTB = HALF * BK * 2, STAGE_BYTES = 8 * HTB, NXCD = 8, WGM = 8;

__device__ __forceinline__ int lds_byte(int r, int c) { const int st = (r >> 4) * 2 + (c >> 5), rr = r & 15, cc = c & 31, ob = rr * 64 + cc * 2; return st * 1024 + (ob ^ (((ob >> 9) & 1) << 5)); }
__device__ __forceinline__ void stage_rc(int b, int& R, int& C) { const int st = b / 1024, sb = b % 1024, swz = sb ^ (((sb >> 9) & 1) << 5); R = (st >> 1) * 16 + swz / 64; C = (st & 1) * 32 + (swz % 64) / 2; }
__device__ __forceinline__ int perm32(int rho) { const int n = rho >> 4, i = rho & 15; return 8 * (i >> 2) + 4 * n + (i & 3); }

struct Unit { int pm, pn; };
struct Gemm { const bf16_t* A; const bf16_t* Bt; int lda, ldb, K; };

struct StaticOrder {
    int nM, nN, nwg, G, c;
    __device__ void init(int M, int N, int G_, int c_) { nM = M / BM; nN = N / BM; nwg = nM * nN; G = G_; c = c_; }
    __device__ bool next(int i, Unit& u) const {
        const long L = (long)i * G + c; if (L >= nwg) return false;
        int wgid = (int)L; { const int q = nwg / NXCD, r = nwg % NXCD, xcd = wgid % NXCD, off = wgid / NXCD; wgid = (xcd < r ? xcd * (q + 1) : r * (q + 1) + (xcd - r) * q) + off; }
        const int nig = WGM * nN, gid = wgid / nig, fm = gid * WGM, gsz = (nM - fm) < WGM ? (nM - fm) : WGM;
        u.pm = fm + ((wgid % nig) % gsz); u.pn = (wgid % nig) / gsz; return true;
    }
};

__device__ __forceinline__ unsigned cvt_pk_bf16(float lo, float hi) { unsigned r; asm volatile("v_cvt_pk_bf16_f32 %0, %1, %2" : "=v"(r) : "v"(lo), "v"(hi)); return r; }
__device__ __forceinline__ float sigm(float x) { return __builtin_amdgcn_rcpf(1.0f + __builtin_amdgcn_exp2f(-1.4426950408889634f * x)); }
__device__ __forceinline__ float bflo(unsigned u) { return __uint_as_float(u << 16); }
__device__ __forceinline__ float bfhi(unsigned u) { return __uint_as_float(u & 0xffff0000u); }

template <int ACT  > struct EpiBf16 {
    static constexpr bool PERM = true;
    bf16_t* O; int ldc;
    __device__ __forceinline__ void operator()(const f32x4 (&acc)[2][2][4][2], const Unit& u, int wr, int wc, int fr, int fq) const {
        const int row0 = u.pm * BM + wr * 64 + fr, col0 = u.pn * BM + wc * 32 + 8 * fq;
#pragma unroll
        for (int ai = 0; ai < 2; ++ai)
#pragma unroll
            for (int m = 0; m < 4; ++m) { bf16_t* rowp = O + (size_t)(row0 + ai * HALF + m * 16) * ldc + col0;
#pragma unroll
                for (int bj = 0; bj < 2; ++bj) { f32x4 v0 = acc[ai][bj][m][0], v1 = acc[ai][bj][m][1];
                    if (ACT == 3) {
#pragma unroll
                        for (int j = 0; j < 4; ++j) { const float a = fmaxf(v0[j], 0.f), b = fmaxf(v1[j], 0.f); v0[j] = a * a; v1[j] = b * b; } }
                    u32x4 w; w.x = cvt_pk_bf16(v0[0], v0[1]); w.y = cvt_pk_bf16(v0[2], v0[3]); w.z = cvt_pk_bf16(v1[0], v1[1]); w.w = cvt_pk_bf16(v1[2], v1[3]);
                    *(u32x4*)(rowp + bj * HALF) = w; } }
    }
};
struct EpiG1 {
    static constexpr bool PERM = true;
    bf16_t *PI, *PZ, *PQ, *PG, *GATES;
    __device__ __forceinline__ void operator()(const f32x4 (&acc)[2][2][4][2], const Unit& u, int wr, int wc, int fr, int fq) const {
        const int pn = u.pn; bf16_t* base; int ld, cb, act;
        if (pn < 2) { base = PI; ld = 512; cb = pn * 256; act = 0; }
        else if (pn < 6) { base = PZ; ld = 1024; cb = (pn - 2) * 256; act = 0; }
        else if (pn < 8) { base = PQ; ld = 512; cb = (pn - 6) * 256; act = 1; }
        else if (pn < 10) { base = PG; ld = 512; cb = (pn - 8) * 256; act = 1; }
        else { base = GATES; ld = 2048; cb = (pn - 10) * 256; act = 2; }
        const int row0 = u.pm * BM + wr * 64 + fr, col0 = cb + wc * 32 + 8 * fq;
#pragma unroll
        for (int ai = 0; ai < 2; ++ai)
#pragma unroll
            for (int m = 0; m < 4; ++m) { bf16_t* rowp = base + (size_t)(row0 + ai * HALF + m * 16) * ld + col0;
#pragma unroll
                for (int bj = 0; bj < 2; ++bj) { f32x4 v0 = acc[ai][bj][m][0], v1 = acc[ai][bj][m][1];
                    if (act != 0) {
#pragma unroll
                        for (int j = 0; j < 4; ++j) { const float s0 = sigm(v0[j]), s1 = sigm(v1[j]); v0[j] = act == 1 ? v0[j] * s0 : s0; v1[j] = act == 1 ? v1[j] * s1 : s1; } }
                    u32x4 w; w.x = cvt_pk_bf16(v0[0], v0[1]); w.y = cvt_pk_bf16(v0[2], v0[3]); w.z = cvt_pk_bf16(v1[0], v1[1]); w.w = cvt_pk_bf16(v1[2], v1[3]);
                    *(u32x4*)(rowp + bj * HALF) = w; } }
    }
};
template <int PASS> struct EpiMerge {
    static constexpr bool PERM = true;
    bf16_t* O; const bf16_t* GATES; int goff;
    __device__ __forceinline__ void operator()(const f32x4 (&acc)[2][2][4][2], const Unit& u, int wr, int wc, int fr, int fq) const {
        const int row0 = u.pm * BM + wr * 64 + fr, col0 = u.pn * BM + wc * 32 + 8 * fq;
#pragma unroll
        for (int ai = 0; ai < 2; ++ai)
#pragma unroll
            for (int m = 0; m < 4; ++m) { const size_t r = (size_t)(row0 + ai * HALF + m * 16);
#pragma unroll
                for (int bj = 0; bj < 2; ++bj) { f32x4 v0 = acc[ai][bj][m][0], v1 = acc[ai][bj][m][1];
                    const u32x4 g = *(const u32x4*)(GATES + r * 2048 + goff + col0 + bj * HALF);
                    v0[0] *= bflo(g.x); v0[1] *= bfhi(g.x); v0[2] *= bflo(g.y); v0[3] *= bfhi(g.y); v1[0] *= bflo(g.z); v1[1] *= bfhi(g.z); v1[2] *= bflo(g.w); v1[3] *= bfhi(g.w);
                    bf16_t* op = O + r * 1024 + col0 + bj * HALF;
                    if (PASS == 1) { const u32x4 o = *(const u32x4*)op;
                        v0[0] += bflo(o.x); v0[1] += bfhi(o.x); v0[2] += bflo(o.y); v0[3] += bfhi(o.y); v1[0] += bflo(o.z); v1[1] += bfhi(o.z); v1[2] += bflo(o.w); v1[3] += bfhi(o.w); }
                    u32x4 w; w.x = cvt_pk_bf16(v0[0], v0[1]); w.y = cvt_pk_bf16(v0[2], v0[3]); w.z = cvt_pk_bf16(v1[0], v1[1]); w.w = cvt_pk_bf16(v1[2], v1[3]);
                    *(u32x4*)op = w; } }
    }
};

template <class Epi, class Sched>
__device__ __forceinline__ void gemm_phase(PG8_LAS unsigned char* lds, const Gemm g, const Sched& S, const Epi& E) {
    const int tid = threadIdx.x, wid = __builtin_amdgcn_readfirstlane(tid >> 6), lane = tid & 63, wr = wid >> 2, wc = wid & 3, fr = lane & 15, fq = lane >> 4;
    const int nt = g.K / BK;
    unsigned voffA[2], voffB[2];
#pragma unroll
    for (int i = 0; i < 2; ++i) { int R, C; stage_rc(tid * 16 + i * 8192, R, C); const int Rb = Epi::PERM ? ((R & ~31) + perm32(R & 31)) : R;
        voffA[i] = (unsigned)(R * g.lda + C) * 2u; voffB[i] = (unsigned)(Rb * g.ldb + C) * 2u; }
    const size_t kstep = (size_t)(BK * 2);
    const size_t hstepA = (size_t)HALF * g.lda * 2, hstepB = (size_t)HALF * g.ldb * 2;
    const size_t tstepA = 2 * hstepA, tstepB = 2 * hstepB;
    const unsigned ldsw = (unsigned)wid * 1024u;
    const int aoff = lds_byte(wr * 64 + fr, fq * 8), boff = lds_byte(wc * 32 + fr, fq * 8);
#define PG8_SA(b, h) (((b) * 2 + (h)) * HTB)
#define PG8_SB(b, h) ((4 + (b) * 2 + (h)) * HTB)
#define PG8_STAGE(bufoff, gbase, voff) do { _Pragma("unroll") for (int _i = 0; _i < 2; ++_i) \
        __builtin_amdgcn_global_load_lds((const unsigned*)((const char*)(gbase) + (voff)[_i]), (PG8_LAS unsigned*)(lds + (bufoff) + ldsw + _i * 8192), 16, 0, 0); } while (0)
#define PG8_LDA(dst, b, h) do { _Pragma("unroll") for (int m = 0; m < 4; ++m) _Pragma("unroll") for (int k = 0; k < 2; ++k) dst[m][k] = *(const PG8_LAS bf16x8*)(lds + PG8_SA(b, h) + aoff + m * 2048 + k * 1024); } while (0)
#define PG8_LDB(dst, b, h) do { _Pragma("unroll") for (int n = 0; n < 2; ++n) _Pragma("unroll") for (int k = 0; k < 2; ++k) dst[n][k] = *(const PG8_LAS bf16x8*)(lds + PG8_SB(b, h) + boff + n * 2048 + k * 1024); } while (0)
#define PG8_MMA(ai, bj, At, Bt) do { __builtin_amdgcn_s_setprio(1); _Pragma("unroll") for (int m = 0; m < 4; ++m) _Pragma("unroll") for (int n = 0; n < 2; ++n) _Pragma("unroll") for (int k = 0; k < 2; ++k) \
        acc[ai][bj][m][n] = __builtin_amdgcn_mfma_f32_16x16x32_bf16(Bt[n][k], At[m][k], acc[ai][bj][m][n], 0, 0, 0); __builtin_amdgcn_s_setprio(0); } while (0)
#define PG8_WAIT_V(n) asm volatile("s_waitcnt vmcnt(" #n ")" ::: "memory")
#define PG8_WAIT_L(n) asm volatile("s_waitcnt lgkmcnt(" #n ")" ::: "memory")
#define PG8_BAR __builtin_amdgcn_s_barrier()
#define PG8_SCHED __builtin_amdgcn_sched_barrier(0)
    Unit cur, nxt; int ui = 0;
    if (!S.next(0, cur)) return;
    f32x4 acc[2][2][4][2];
#pragma unroll
    for (int a = 0; a < 2; ++a)
#pragma unroll
        for (int b = 0; b < 2; ++b)
#pragma unroll
            for (int m = 0; m < 4; ++m)
#pragma unroll
                for (int n = 0; n < 2; ++n) acc[a][b][m][n] = (f32x4){0.f, 0.f, 0.f, 0.f};
    bf16x8 At[4][2], B0[2][2], B1[2][2];
    const char* cA = (const char*)g.A + (size_t)cur.pm * tstepA; const char* cB = (const char*)g.Bt + (size_t)cur.pn * tstepB;
    PG8_STAGE(PG8_SB(0, 0), cB, voffB); PG8_STAGE(PG8_SA(0, 0), cA, voffA); PG8_STAGE(PG8_SB(0, 1), cB + hstepB, voffB); PG8_STAGE(PG8_SA(0, 1), cA + hstepA, voffA);
    if (wr == 1) PG8_BAR;
    PG8_WAIT_V(4); PG8_BAR;
    PG8_STAGE(PG8_SB(1, 0), cB + kstep, voffB); PG8_STAGE(PG8_SA(1, 0), cA + kstep, voffA); PG8_STAGE(PG8_SB(1, 1), cB + hstepB + kstep, voffB);
    PG8_WAIT_V(6); PG8_BAR;
    for (;;) {
        const bool has_next = S.next(ui + 1, nxt);
        const char* nA = has_next ? (const char*)g.A + (size_t)nxt.pm * tstepA : cA; const char* nB = has_next ? (const char*)g.Bt + (size_t)nxt.pn * tstepB : cB;
        for (int t = 0; t < nt; t += 2) {
            const bool last = (t == nt - 2);
            const char* a1 = cA + (size_t)(t + 1) * kstep;
            const char* a2 = last ? nA : cA + (size_t)(t + 2) * kstep; const char* b2 = last ? nB : cB + (size_t)(t + 2) * kstep;
            const char* a3 = a2 + kstep; const char* b3 = b2 + kstep;
            PG8_LDB(B0, 0, 0); PG8_SCHED; PG8_LDA(At, 0, 0); PG8_STAGE(PG8_SA(1, 1), a1 + hstepA, voffA);
            PG8_WAIT_L(8); PG8_BAR; PG8_WAIT_L(0); PG8_MMA(0, 0, At, B0); PG8_BAR; PG8_SCHED;
            PG8_LDB(B1, 0, 1); PG8_STAGE(PG8_SB(0, 0), b2, voffB);
            PG8_BAR; PG8_WAIT_L(0); PG8_MMA(0, 1, At, B1); PG8_BAR;
            PG8_LDA(At, 0, 1); PG8_STAGE(PG8_SA(0, 0), a2, voffA);
            PG8_BAR; PG8_WAIT_L(0); PG8_MMA(1, 0, At, B0); PG8_BAR; PG8_SCHED;
            PG8_STAGE(PG8_SB(0, 1), b2 + hstepB, voffB);
            PG8_WAIT_V(6); PG8_BAR; PG8_MMA(1, 1, At, B1); PG8_BAR;
            PG8_LDB(B0, 1, 0); PG8_SCHED; PG8_LDA(At, 1, 0); PG8_STAGE(PG8_SA(0, 1), a2 + hstepA, voffA);
            PG8_WAIT_L(8); PG8_BAR; PG8_WAIT_L(0); PG8_MMA(0, 0, At, B0); PG8_BAR; PG8_SCHED;
            PG8_LDB(B1, 1, 1); PG8_STAGE(PG8_SB(1, 0), b3, voffB);
            PG8_BAR; PG8_WAIT_L(0); PG8_MMA(0, 1, At, B1); PG8_BAR;
            PG8_LDA(At, 1, 1); PG8_STAGE(PG8_SA(1, 0), a3, voffA);
            PG8_BAR; PG8_WAIT_L(0); PG8_MMA(1, 0, At, B0); PG8_BAR; PG8_SCHED;
            PG8_STAGE(PG8_SB(1, 1), b3 + hstepB, voffB);
            PG8_WAIT_V(6); PG8_BAR; PG8_MMA(1, 1, At, B1); PG8_BAR;
        }
        E(acc, cur, wr, wc, fr, fq);
        if (!has_next) break;
#pragma unroll
        for (int a = 0; a < 2; ++a)
#pragma unroll
            for (int b = 0; b < 2; ++b)
#pragma unroll
                for (int m = 0; m < 4; ++m)
#pragma unroll
                    for (int n = 0; n < 2; ++n) acc[a][b][m][n] = (f32x4){0.f, 0.f, 0.f, 0.f};
        cur = nxt; cA = nA; cB = nB; ++ui;
    }
    PG8_WAIT_V(0);
    if (wr == 0) PG8_BAR;
    PG8_BAR;
#undef PG8_SA
#undef PG8_SB
#undef PG8_STAGE
#undef PG8_LDA
#undef PG8_LDB
#undef PG8_MMA
#undef PG8_WAIT_V
#undef PG8_WAIT_L
#undef PG8_BAR
#undef PG8_SCHED
}
}

namespace {
using pg8::bf16_t; using pg8::f32x4; using pg8::u32x4; using pg8::u32x2;
#define LAS __attribute__((address_space(3)))
constexpr int D = 1024, NB = 8, L = 4096, LC = 256, INC = 6144, FF = 4096, HW = 512;
constexpr int NT = NB * L, NCX = NB * LC;
constexpr float EPS = 1e-6f;
constexpr size_t MiB = 1u << 20;
constexpr size_t WS_MOD = 64 * 1024, WS_LB = 512 * 1024, WS_GT = 2 * MiB  ;
constexpr size_t WS_WIN = 18 * MiB, WS_WPAB = 30 * MiB, WS_WOUT = 32 * MiB, WS_W1 = 34 * MiB, WS_W2 = 42 * MiB;
constexpr size_t WS_HCTX = 50 * MiB, WS_PCTX = 54 * MiB, WS_SCTX = 60 * MiB;
constexpr size_t WS_HLAT = 64 * MiB;
constexpr size_t WS_PI = 128 * MiB, WS_PZ = 160 * MiB, WS_PQ = 224 * MiB, WS_PG = 256 * MiB, WS_GATES = 288 * MiB, WS_PHYT = 416 * MiB;
constexpr size_t WS_AY = 160 * MiB;
constexpr size_t WS_AY2 = 64 * MiB;
constexpr size_t WS_MERGED = 128 * MiB;
constexpr size_t WS_MIX = 448 * MiB, WS_MLP = 384 * MiB, WS_H1 = 128 * MiB, WS_HL = 64 * MiB;
constexpr size_t WS_END = 512 * MiB;
constexpr int LDS_BYTES = 147456;

__device__ __forceinline__ float bf2f(bf16_t h) { return __uint_as_float(((unsigned)h) << 16); }
__device__ __forceinline__ unsigned f2bf(float f) { unsigned u = __float_as_uint(f); return (u + 0x7fffu + ((u >> 16) & 1u)) >> 16; }
__device__ __forceinline__ unsigned pk2(float lo, float hi) { return f2bf(lo) | (f2bf(hi) << 16); }
__device__ __forceinline__ float sigmoidf_(float x) { return 1.f / (1.f + expf(-x)); }
__device__ __forceinline__ float siluf_(float x) { return x / (1.f + expf(-x)); }
__device__ __forceinline__ float wave_sum(float v) {
#pragma unroll
    for (int o = 1; o < 64; o <<= 1) v += __shfl_xor(v, o);
    return v;
}
#define LDS_WAIT() asm volatile("s_waitcnt lgkmcnt(0)" ::: "memory")

struct Params { const float* in[24]; float* out; unsigned char* ws; };

__device__ __forceinline__ void transpose_item(const float* W, int N, bf16_t* WT, int ldk, int koff, int remap, LAS float* scr, int item, int lane) {
    const int nblk = N / 32, kb = item / nblk, nb = item % nblk, k0 = 64 * kb, n0 = 32 * nb;
    int rbase = n0;
    if (remap) rbase = n0 < 2560 ? n0 : (n0 < 4096 ? n0 + 2048 : n0 - 1536);
#pragma unroll 8
    for (int i = 0; i < 32; ++i) { const int kk = 2 * i + (lane >> 5); scr[kk * 33 + (lane & 31)] = W[(size_t)(k0 + kk) * N + n0 + (lane & 31)]; }
    LDS_WAIT();
    const int c = lane & 7;
#pragma unroll
    for (int j = 0; j < 4; ++j) { const int n = (lane >> 3) + 8 * j; const LAS float* s = scr + (8 * c) * 33 + n;
        u32x4 o; o.x = pk2(s[0 * 33], s[1 * 33]); o.y = pk2(s[2 * 33], s[3 * 33]); o.z = pk2(s[4 * 33], s[5 * 33]); o.w = pk2(s[6 * 33], s[7 * 33]);
        *(u32x4*)(WT + (size_t)(rbase + n) * ldk + koff + k0 + 8 * c) = o; }
    LDS_WAIT();
}

__device__ __forceinline__ void row_norm_mod_bf16(const float* xrow, const float* nw, const float* scale, const float* shift, bf16_t* orow, int lane) {
    const f32x4* xr = (const f32x4*)xrow + lane; f32x4 v[4]; float s = 0.f;
#pragma unroll
    for (int j = 0; j < 4; ++j) { v[j] = xr[64 * j]; s += (v[j].x * v[j].x + v[j].y * v[j].y) + (v[j].z * v[j].z + v[j].w * v[j].w); }
    const float r = rsqrtf(wave_sum(s) * (1.f / D) + EPS);
    unsigned long long* o8 = (unsigned long long*)orow + lane;
#pragma unroll
    for (int j = 0; j < 4; ++j) { const f32x4 w = ((const f32x4*)nw)[lane + 64 * j], sc = ((const f32x4*)scale)[lane + 64 * j], sh = ((const f32x4*)shift)[lane + 64 * j];
        const f32x4 o = v[j] * r * w * (1.f + sc) + sh;
        o8[64 * j] = (unsigned long long)pk2(o.x, o.y) | ((unsigned long long)pk2(o.z, o.w) << 32); }
}
__device__ __forceinline__ f32x4 ld_bf4(const bf16_t* p) { const u32x2 u = *(const u32x2*)p; return (f32x4){pg8::bflo(u.x), pg8::bfhi(u.x), pg8::bflo(u.y), pg8::bfhi(u.y)}; }
__device__ __forceinline__ void row_x1(const float* xrow, const bf16_t* mixrow, const float* nw1, const float* g2, f32x4 (&x1)[4], int lane) {
    f32x4 mv[4]; float s = 0.f;
#pragma unroll
    for (int j = 0; j < 4; ++j) { mv[j] = ld_bf4(mixrow + 4 * lane + 256 * j); s += (mv[j].x * mv[j].x + mv[j].y * mv[j].y) + (mv[j].z * mv[j].z + mv[j].w * mv[j].w); }
    const float r = rsqrtf(wave_sum(s) * (1.f / D) + EPS);
#pragma unroll
    for (int j = 0; j < 4; ++j) { const f32x4 w = ((const f32x4*)nw1)[lane + 64 * j], g = ((const f32x4*)g2)[lane + 64 * j], xv = ((const f32x4*)xrow)[lane + 64 * j];
        x1[j] = xv + g * (mv[j] * r * w); }
}

__device__ __forceinline__ void hgrn_chain(LAS float* sm, const bf16_t* pi, int ldi, const bf16_t* pz, int ldz, const bf16_t* pq, int ldq, int Lseq, int h, int dir,
                                           const float* lb, const float* s_in, float* s_out, float* o_out) {
    const int tid = threadIdx.x, v = tid & 127, dg = tid >> 7;
    LAS float* fb = sm; LAS float* qb = sm + 1024; LAS float* vb = sm + 2048; LAS float* pb = sm + 3072;
    float S[32];
#pragma unroll
    for (int i = 0; i < 32; ++i) S[i] = s_in ? s_in[(size_t)(dg * 32 + i) * 128 + v] : 0.f;
    for (int t0 = 0; t0 < Lseq; t0 += 8) {
        for (int e = tid; e < 8 * 128; e += 512) {
            const int tt = e >> 7, dd = e & 127; const int t = dir ? (Lseq - 1 - (t0 + tt)) : (t0 + tt); const int col = h * 128 + dd;
            const float z = bf2f(pz[(size_t)t * ldz + col]); const float lbv = lb[col];
            fb[e] = lbv + (1.f - lbv) * sigmoidf_(z);
            qb[e] = pq ? bf2f(pq[(size_t)t * ldq + col]) : 0.f;
            vb[e] = bf2f(pi[(size_t)t * ldi + col]);
        }
        __syncthreads();
#pragma unroll 1
        for (int tt = 0; tt < 8; ++tt) {
            const float vv = vb[tt * 128 + v]; float part = 0.f;
#pragma unroll
            for (int i = 0; i < 32; ++i) { const float f = fb[tt * 128 + dg * 32 + i]; S[i] = f * S[i] + (1.f - f) * vv; part += S[i] * qb[tt * 128 + dg * 32 + i]; }
            pb[(tt * 4 + dg) * 128 + v] = part;
        }
        __syncthreads();
        if (o_out) for (int e = tid; e < 8 * 128; e += 512) {
            const int tt = e >> 7, vv = e & 127; const int t = dir ? (Lseq - 1 - (t0 + tt)) : (t0 + tt);
            o_out[(size_t)t * HW + h * 128 + vv] = pb[(tt * 4 + 0) * 128 + vv] + pb[(tt * 4 + 1) * 128 + vv] + pb[(tt * 4 + 2) * 128 + vv] + pb[(tt * 4 + 3) * 128 + vv];
        }
        __syncthreads();
    }
    if (s_out) {
#pragma unroll
        for (int i = 0; i < 32; ++i) s_out[(size_t)(dg * 32 + i) * 128 + v] = S[i];
    }
}

__global__ void __launch_bounds__(512, 2) mega(Params P) {
    extern __shared__ __attribute__((aligned(16))) unsigned char lds_raw[];
    cg::grid_group grid = cg::this_grid();
    LAS unsigned char* lds = (LAS unsigned char*)lds_raw;
    const int tid = threadIdx.x, lane = tid & 63, wave = __builtin_amdgcn_readfirstlane(tid >> 6);
    const int G = gridDim.x, bx = blockIdx.x;
    const int vcu = (G % 8 == 0) ? (bx % 8) * (G / 8) + bx / 8 : bx;
    const int gw = vcu * 8 + wave, NGW = G * 8;
    unsigned char* ws = P.ws;
    const float* x = P.in[0]; const float* cvec = P.in[1]; const float* ctx = P.in[2]; const float* c_ctx = P.in[3];
    const float* w_ada = P.in[4]; const float* b_ada = P.in[5]; const float* norm_w = P.in[6]; const float* w_in = P.in[7];
    const float* lb_param = P.in[8]; const float* g_norm = P.in[9]; const float* hy_sw = P.in[10]; const float* hy_sb = P.in[11];
    const float* f_w1 = P.in[12]; const float* f_b1 = P.in[13]; const float* f_w2 = P.in[14]; const float* f_b2 = P.in[15];
    const float* f_w3 = P.in[16]; const float* f_freq = P.in[17]; const float* hy_d = P.in[18]; const float* w_pa = P.in[19];
    const float* w_pb = P.in[20]; const float* w_out = P.in[21]; const float* w_mlp1 = P.in[22]; const float* w_mlp2 = P.in[23];
    float* MOD = (float*)(ws + WS_MOD); float* LB = (float*)(ws + WS_LB); float* GT = (float*)(ws + WS_GT);
    bf16_t* WIN = (bf16_t*)(ws + WS_WIN); bf16_t* WPAB = (bf16_t*)(ws + WS_WPAB); bf16_t* WOUT = (bf16_t*)(ws + WS_WOUT); bf16_t* W1 = (bf16_t*)(ws + WS_W1); bf16_t* W2 = (bf16_t*)(ws + WS_W2);
    bf16_t* HCTX = (bf16_t*)(ws + WS_HCTX); bf16_t* PCTX = (bf16_t*)(ws + WS_PCTX); float* SCTX = (float*)(ws + WS_SCTX);
    bf16_t* HLAT = (bf16_t*)(ws + WS_HLAT); bf16_t* PI = (bf16_t*)(ws + WS_PI); bf16_t* PZ = (bf16_t*)(ws + WS_PZ); bf16_t* PQ = (bf16_t*)(ws + WS_PQ);
    bf16_t* PG = (bf16_t*)(ws + WS_PG); bf16_t* GATES = (bf16_t*)(ws + WS_GATES); bf16_t* PHYT = (bf16_t*)(ws + WS_PHYT);
    bf16_t* AY = (bf16_t*)(ws + WS_AY2); bf16_t* MERGED = (bf16_t*)(ws + WS_MERGED); bf16_t* MIX = (bf16_t*)(ws + WS_MIX);
    bf16_t* MLP = (bf16_t*)(ws + WS_MLP); bf16_t* H1 = (bf16_t*)(ws + WS_H1); bf16_t* HL = (bf16_t*)(ws + WS_HL);
    float* O2 = P.out;

    {
        if (bx < 96) {
            LAS float* sc = (LAS float*)lds;
            LAS float* ps = (LAS float*)(lds + 40960);
            for (int i = tid; i < 9 * D; i += 512) { const int r = i >> 10, k = i & 1023; sc[i] = siluf_(r < 8 ? cvec[r * D + k] : c_ctx[k]); }
            __syncthreads();
            const int j = bx * 64 + lane; float a9[9];
#pragma unroll
            for (int r = 0; r < 9; ++r) a9[r] = 0.f;
            for (int k = wave * 128; k < wave * 128 + 128; ++k) { const float w = w_ada[(size_t)k * INC + j];
#pragma unroll
                for (int r = 0; r < 9; ++r) a9[r] += sc[r * D + k] * w; }
#pragma unroll
            for (int r = 0; r < 9; ++r) ps[(wave * 9 + r) * 64 + lane] = a9[r];
            __syncthreads();
            for (int i = tid; i < 9 * 64; i += 512) { const int r = i >> 6, l = i & 63; float s = b_ada[bx * 64 + l];
#pragma unroll
                for (int w = 0; w < 8; ++w) s += ps[(w * 9 + r) * 64 + l];
                MOD[r * INC + bx * 64 + l] = s; }
            __syncthreads();
        }
        if (bx == G - 1) { const float a = lb_param[tid], b = lb_param[HW + tid], m = fmaxf(a, b); const float ea = expf(a - m), eb = expf(b - m); LB[tid] = ea / (ea + eb); }
        LAS float* scr = (LAS float*)(lds + wave * 16384);
        constexpr int I_IN = 16 * 192, I_PA = 8 * 32, I_OUT = 16 * 32, I_1 = 16 * 128, I_2 = 64 * 32;
        constexpr int NITEMS = I_IN + 2 * I_PA + I_OUT + I_1 + I_2;
        for (int it = gw; it < NITEMS; it += NGW) {
            int r = it;
            if (r < I_IN) { transpose_item(w_in, INC, WIN, D, 0, 1, scr, r, lane); continue; } r -= I_IN;
            if (r < I_PA) { transpose_item(w_pa, D, WPAB, D, 0, 0, scr, r, lane); continue; } r -= I_PA;
            if (r < I_PA) { transpose_item(w_pb, D, WPAB, D, 512, 0, scr, r, lane); continue; } r -= I_PA;
            if (r < I_OUT) { transpose_item(w_out, D, WOUT, D, 0, 0, scr, r, lane); continue; } r -= I_OUT;
            if (r < I_1) { transpose_item(w_mlp1, FF, W1, D, 0, 0, scr, r, lane); continue; } r -= I_1;
            transpose_item(w_mlp2, D, W2, FF, 0, 0, scr, r, lane);
        }
        for (int t = gw; t < L; t += NGW) {
            LAS float* z = scr; LAS float* h1 = scr + 64; LAS float* h2 = scr + 128;
            const float tn = (float)t / (float)(L - 1);
            if (lane < 33) {
                float val;
                if (lane == 0) val = tn;
                else { const int bi = (lane - 1) & 15; const float band = 1e-4f + (float)bi * ((15.f - 1e-4f) / 15.f);
                    const float w = 2.0f * 3.14159265358979323846f * (float)t / (float)L; const float ang = w * band;
                    val = (lane <= 16) ? cosf(ang) : -sinf(ang); }
                z[lane] = val;
            }
            LDS_WAIT();
            { float acc = f_b1[lane]; for (int i = 0; i < 33; ++i) acc += z[i] * f_w1[i * 64 + lane]; h1[lane] = sinf(f_freq[lane] * acc); }
            LDS_WAIT();
            { float acc = f_b2[lane]; for (int i = 0; i < 64; ++i) acc += h1[i] * f_w2[i * 64 + lane]; h2[lane] = sinf(f_freq[lane] * acc); }
            LDS_WAIT();
            const float mind = logf(1e-2f) / 1.5f, maxd = logf(1e-2f) / 0.3f;
            for (int j = lane; j < 1024; j += 64) {
                float acc = 0.f; for (int i = 0; i < 64; ++i) acc += h2[i] * f_w3[i * 1024 + j];
                const int dirb = j >> 9, c = j & 511;
                const float delta = fabsf(mind + (maxd - mind) * ((float)c / 511.f));
                float val = acc * expf(-tn * delta);
                if (dirb == 0) { if (t == 0) val += hy_d[c]; GT[(size_t)c * 8192 + 4095 + t] = val; }
                else if (t > 0) GT[(size_t)c * 8192 + 4095 - t] = val;
            }
            LDS_WAIT();
        }
    }
    grid.sync();
    for (int m = gw; m < NT + NCX; m += NGW) {
        if (m < NT) { const float* mb = MOD + (size_t)(m >> 12) * INC; row_norm_mod_bf16(x + (size_t)m * D, norm_w, mb, mb + D, HLAT + (size_t)m * D, lane); }
        else { const int mc = m - NT; const float* mb = MOD + (size_t)8 * INC; row_norm_mod_bf16(ctx + (size_t)mc * D, norm_w, mb, mb + D, HCTX + (size_t)mc * D, lane); }
    }
    grid.sync();
    {
        { pg8::Gemm g{HLAT, WIN, D, D, D}; pg8::StaticOrder S; S.init(NT, 4608, G, bx); pg8::EpiG1 E{PI, PZ, PQ, PG, GATES};
          pg8::gemm_phase(lds, g, S, E); }
        { pg8::Gemm g{WIN + (size_t)4608 * D, HLAT, D, D, D}; pg8::StaticOrder S; S.init(1536, NT, G, bx); pg8::EpiBf16<0> E{PHYT, NT};
          pg8::gemm_phase(lds, g, S, E); }
        { pg8::Gemm g{HCTX, WIN, D, D, D}; pg8::StaticOrder S; S.init(NCX, 1536, G, bx); pg8::EpiBf16<0> E{PCTX, 1536};
          pg8::gemm_phase(lds, g, S, E); }
    }
    grid.sync();
    if (bx < 64) { const int b = bx >> 3, h = (bx >> 1) & 3, dir = bx & 1;
        hgrn_chain((LAS float*)lds, PCTX + (size_t)b * LC * 1536, 1536, PCTX + (size_t)b * LC * 1536 + (dir ? 1024 : 512), 1536, nullptr, 0, LC, h, dir, LB,
                   nullptr, SCTX + (size_t)((b * 2 + dir) * 4 + h) * 16384, nullptr); }
    grid.sync();
    if (bx < 64) { const int b = bx >> 3, h = (bx >> 1) & 3, dir = bx & 1;
        hgrn_chain((LAS float*)lds, PI + (size_t)b * L * 512, 512, PZ + (size_t)b * L * 1024 + (dir ? 512 : 0), 1024, PQ + (size_t)b * L * 512, 512, L, h, dir, LB,
                   SCTX + (size_t)((b * 2 + dir) * 4 + h) * 16384, nullptr, O2 + ((size_t)dir * NT + (size_t)b * L) * HW); }
    else {
        LAS float* raw = (LAS float*)lds;
        LAS float* gt = raw + 3 * 4096;
        LAS float* wv = gt + 8192;
        LAS float* x0c = wv + 4096;
        for (int item = bx - 64; item < 4096; item += G - 64) {
            const int c = item >> 3, b = item & 7;
            __syncthreads();
            for (int s = 0; s < 3; ++s) { const bf16_t* src = PHYT + (size_t)(s * 512 + c) * NT + (size_t)b * L;
                for (int i = tid; i < L; i += 512) raw[s * 4096 + i] = bf2f(src[i]); }
            for (int i = tid; i < 8191; i += 512) gt[i] = GT[(size_t)c * 8192 + i];
            __syncthreads();
            for (int i = tid; i < L; i += 512) { const int j = i & 63; float r3[3];
#pragma unroll
                for (int s = 0; s < 3; ++s) { const int col = s * 512 + c; float a = hy_sb[col] + raw[s * 4096 + i] * hy_sw[1536 + col];
                    if (j > 0) a += raw[s * 4096 + i - 1] * hy_sw[col];
                    if (j < 63) a += raw[s * 4096 + i + 1] * hy_sw[2 * 1536 + col];
                    r3[s] = a; }
                x0c[i] = r3[0]; wv[i] = r3[2] * r3[1]; }
            __syncthreads();
            float acc[8];
#pragma unroll
            for (int j = 0; j < 8; ++j) acc[j] = 0.f;
            for (int s = 0; s < L; ++s) { const float w = wv[s];
#pragma unroll
                for (int j = 0; j < 8; ++j) acc[j] += gt[4095 + tid + 512 * j - s] * w; }
#pragma unroll
            for (int j = 0; j < 8; ++j) { const int t = tid + 512 * j; AY[((size_t)b * L + t) * 1024 + 512 + c] = (bf16_t)f2bf(acc[j] * x0c[t]); }
        }
    }
    grid.sync();
    for (int w = gw; w < NT * 4; w += NGW) { const int t = w >> 2, h = w & 3; float v[2]; float s = 0.f;
#pragma unroll
        for (int i = 0; i < 2; ++i) { const int c = h * 128 + lane + 64 * i; v[i] = O2[(size_t)t * HW + c] + O2[((size_t)NT + t) * HW + c]; s += v[i] * v[i]; }
        const float r = rsqrtf(wave_sum(s) * (1.f / 128.f) + EPS);
#pragma unroll
        for (int i = 0; i < 2; ++i) { const int vv = lane + 64 * i, c = h * 128 + vv; AY[(size_t)t * 1024 + c] = (bf16_t)f2bf(v[i] * r * g_norm[vv] * bf2f(PG[(size_t)t * 512 + c])); } }
    grid.sync();
    {
        { pg8::Gemm g{AY, WPAB, D, D, 512}; pg8::StaticOrder S; S.init(NT, D, G, bx); pg8::EpiMerge<0> E{MERGED, GATES, 0}; pg8::gemm_phase(lds, g, S, E); }
        { pg8::Gemm g{AY + 512, WPAB + 512, D, D, 512}; pg8::StaticOrder S; S.init(NT, D, G, bx); pg8::EpiMerge<1> E{MERGED, GATES, 1024}; pg8::gemm_phase(lds, g, S, E); }
    }
    grid.sync();
    { pg8::Gemm g{MERGED, WOUT, D, D, D}; pg8::StaticOrder S; S.init(NT, D, G, bx); pg8::EpiBf16<0> E{MIX, D}; pg8::gemm_phase(lds, g, S, E); }
    grid.sync();
    for (int m = gw; m < NT; m += NGW) { const float* mb = MOD + (size_t)(m >> 12) * INC; f32x4 x1[4];
        row_x1(x + (size_t)m * D, MIX + (size_t)m * D, norm_w + D, mb + 2 * D, x1, lane);
        float s = 0.f;
#pragma unroll
        for (int j = 0; j < 4; ++j) s += (x1[j].x * x1[j].x + x1[j].y * x1[j].y) + (x1[j].z * x1[j].z + x1[j].w * x1[j].w);
        const float r = rsqrtf(wave_sum(s) * (1.f / D) + EPS);
        unsigned long long* o8 = (unsigned long long*)(HL + (size_t)m * D) + lane;
#pragma unroll
        for (int j = 0; j < 4; ++j) { const f32x4 w = ((const f32x4*)(norm_w + 2 * D))[lane + 64 * j], sc = ((const f32x4*)(mb + 3 * D))[lane + 64 * j], sh = ((const f32x4*)(mb + 4 * D))[lane + 64 * j];
            const f32x4 o = x1[j] * r * w * (1.f + sc) + sh;
            o8[64 * j] = (unsigned long long)pk2(o.x, o.y) | ((unsigned long long)pk2(o.z, o.w) << 32); } }
    grid.sync();
    { pg8::Gemm g{HL, W1, D, D, D}; pg8::StaticOrder S; S.init(NT, FF, G, bx); pg8::EpiBf16<3> E{H1, FF}; pg8::gemm_phase(lds, g, S, E); }
    grid.sync();
    { pg8::Gemm g{H1, W2, FF, FF, FF}; pg8::StaticOrder S; S.init(NT, D, G, bx); pg8::EpiBf16<0> E{MLP, D}; pg8::gemm_phase(lds, g, S, E); }
    grid.sync();
    for (int m = gw; m < NT; m += NGW) { const float* mb = MOD + (size_t)(m >> 12) * INC; f32x4 x1[4];
        row_x1(x + (size_t)m * D, MIX + (size_t)m * D, norm_w + D, mb + 2 * D, x1, lane);
        f32x4 mv[4]; float s = 0.f;
#pragma unroll
        for (int j = 0; j < 4; ++j) { mv[j] = ld_bf4(MLP + (size_t)m * D + 4 * lane + 256 * j); s += (mv[j].x * mv[j].x + mv[j].y * mv[j].y) + (mv[j].z * mv[j].z + mv[j].w * mv[j].w); }
        const float r = rsqrtf(wave_sum(s) * (1.f / D) + EPS);
#pragma unroll
        for (int j = 0; j < 4; ++j) { const f32x4 w = ((const f32x4*)(norm_w + 3 * D))[lane + 64 * j], g = ((const f32x4*)(mb + 5 * D))[lane + 64 * j];
            ((f32x4*)(P.out + (size_t)m * D))[lane + 64 * j] = x1[j] + g * (mv[j] * r * w); } }
}
}

extern "C" void kernel_launch(void* const* d_in, const int* in_sizes, int n_in, void* d_out, int out_size, void* d_ws, size_t ws_size, hipStream_t stream) {
    static int grid = 0;
    if (grid == 0) {
        if (n_in != 24 || ws_size < WS_END) { fprintf(stderr, "kernel_launch: unexpected n_in %d / ws_size %zu\n", n_in, ws_size); grid = -1; return; }
        int dev = 0, cus = 0, per_cu = 0;
        hipGetDevice(&dev); hipDeviceGetAttribute(&cus, hipDeviceAttributeMultiprocessorCount, dev);
        hipFuncSetAttribute((const void*)mega, hipFuncAttributeMaxDynamicSharedMemorySize, LDS_BYTES);
        hipOccupancyMaxActiveBlocksPerMultiprocessor(&per_cu, (const void*)mega, 512, LDS_BYTES);
        if (per_cu < 1) { fprintf(stderr, "kernel_launch: occupancy query says %d blocks per CU\n", per_cu); grid = -1; return; }
        grid = cus;
    }
    if (grid < 0) return;
    Params p{};
    for (int i = 0; i < 24; ++i) p.in[i] = (const float*)d_in[i];
    p.out = (float*)d_out; p.ws = (unsigned char*)d_ws;
    void* args[] = {&p};
    hipError_t e = hipLaunchCooperativeKernel((const void*)mega, dim3(grid), dim3(512), args, LDS_BYTES, stream);
    if (e != hipSuccess) fprintf(stderr, "cooperative launch failed: %s (grid %d)\n", hipGetErrorString(e), grid);
}
```

```cpp
#include <hip/hip_runtime.h>
#include <hip/hip_cooperative_groups.h>
#include <cstdio>
#include <math.h>
namespace cg = cooperative_groups;

namespace pg8 {
#define PG8_LAS __attribute__((address_space(3)))
typedef unsigned short bf16_t;
typedef short bf16x8 __attribute__((ext_vector_type(8)));
typedef float f32x4 __attribute__((ext_vector_type(4)));
typedef unsigned u32x4 __attribute__((ext_vector_type(4)));
typedef unsigned u32x2 __attribute__((ext_vector_type(2)));
constexpr int BM = 256, BK = 64, HALF = 128, HTB = HALF * BK * 2, STAGE_BYTES = 8 * HTB, NXCD = 8, WGM = 8;

__device__ __forceinline__ int lds_byte(int r, int c) { const int st = (r >> 4) * 2 + (c >> 5), rr = r & 15, cc = c & 31, ob = rr * 64 + cc * 2; return st * 1024 + (ob ^ (((ob >> 9) & 1) << 5)); }
__device__ __forceinline__ void stage_rc(int b, int& R, int& C) { const int st = b / 1024, sb = b % 1024, swz = sb ^ (((sb >> 9) & 1) << 5); R = (st >> 1) * 16 + swz / 64; C = (st & 1) * 32 + (swz % 64) / 2; }
__device__ __forceinline__ int perm32(int rho) { const int n = rho >> 4, i = rho & 15; return 8 * (i >> 2) + 4 * n + (i & 3); }

struct Unit { int pm, pn; };
struct Gemm { const bf16_t* A; const bf16_t* Bt; int lda, ldb, K; };

struct StaticOrder {
    int nM, nN, nwg, G, c;
    __device__ void init(int M, int N, int G_, int c_) { nM = M / BM; nN = N / BM; nwg = nM * nN; G = G_; c = c_; }
    __device__ bool next(int i, Unit& u) const {
        const long L = (long)i * G + c; if (L >= nwg) return false;
        int wgid = (int)L; { const int q = nwg / NXCD, r = nwg % NXCD, xcd = wgid % NXCD, off = wgid / NXCD; wgid = (xcd < r ? xcd * (q + 1) : r * (q + 1) + (xcd - r) * q) + off; }
        const int nig = WGM * nN, gid = wgid / nig, fm = gid * WGM, gsz = (nM - fm) < WGM ? (nM - fm) : WGM;
        u.pm = fm + ((wgid % nig) % gsz); u.pn = (wgid % nig) / gsz; return true;
    }
};

__device__ __forceinline__ unsigned cvt_pk_bf16(float lo, float hi) { unsigned r; asm volatile("v_cvt_pk_bf16_f32 %0, %1, %2" : "=v"(r) : "v"(lo), "v"(hi)); return r; }
__device__ __forceinline__ float sigm(float x) { return __builtin_amdgcn_rcpf(1.0f + __builtin_amdgcn_exp2f(-1.4426950408889634f * x)); }
__device__ __forceinline__ float bflo(unsigned u) { return __uint_as_float(u << 16); }
__device__ __forceinline__ float bfhi(unsigned u) { return __uint_as_float(u & 0xffff0000u); }

template <int ACT  > struct EpiBf16 {
    static constexpr bool PERM = true;
    bf16_t* O; int ldc;
    __device__ __forceinline__ void operator()(const f32x4 (&acc)[2][2][4][2], const Unit& u, int wr, int wc, int fr, int fq) const {
        const int row0 = u.pm * BM + wr * 64 + fr, col0 = u.pn * BM + wc * 32 + 8 * fq;
#pragma unroll
        for (int ai = 0; ai < 2; ++ai)
#pragma unroll
            for (int m = 0; m < 4; ++m) { bf16_t* rowp = O + (size_t)(row0 + ai * HALF + m * 16) * ldc + col0;
#pragma unroll
                for (int bj = 0; bj < 2; ++bj) { f32x4 v0 = acc[ai][bj][m][0], v1 = acc[ai][bj][m][1];
                    if (ACT == 3) {
#pragma unroll
                        for (int j = 0; j < 4; ++j) { const float a = fmaxf(v0[j], 0.f), b = fmaxf(v1[j], 0.f); v0[j] = a * a; v1[j] = b * b; } }
                    u32x4 w; w.x = cvt_pk_bf16(v0[0], v0[1]); w.y = cvt_pk_bf16(v0[2], v0[3]); w.z = cvt_pk_bf16(v1[0], v1[1]); w.w = cvt_pk_bf16(v1[2], v1[3]);
                    *(u32x4*)(rowp + bj * HALF) = w; } }
    }
};
struct EpiG1 {
    static constexpr bool PERM = true;
    bf16_t *PI, *PZ, *PQ, *PG, *GATES;
    __device__ __forceinline__ void operator()(const f32x4 (&acc)[2][2][4][2], const Unit& u, int wr, int wc, int fr, int fq) const {
        const int pn = u.pn; bf16_t* base; int ld, cb, act;
        if (pn < 2) { base = PI; ld = 512; cb = pn * 256; act = 0; }
        else if (pn < 6) { base = PZ; ld = 1024; cb = (pn - 2) * 256; act = 0; }
        else if (pn < 8) { base = PQ; ld = 512; cb = (pn - 6) * 256; act = 1; }
        else if (pn < 10) { base = PG; ld = 512; cb = (pn - 8) * 256; act = 1; }
        else { base = GATES; ld = 2048; cb = (pn - 10) * 256; act = 2; }
        const int row0 = u.pm * BM + wr * 64 + fr, col0 = cb + wc * 32 + 8 * fq;
#pragma unroll
        for (int ai = 0; ai < 2; ++ai)
#pragma unroll
            for (int m = 0; m < 4; ++m) { bf16_t* rowp = base + (size_t)(row0 + ai * HALF + m * 16) * ld + col0;
#pragma unroll
                for (int bj = 0; bj < 2; ++bj) { f32x4 v0 = acc[ai][bj][m][0], v1 = acc[ai][bj][m][1];
                    if (act != 0) {
#pragma unroll
                        for (int j = 0; j < 4; ++j) { const float s0 = sigm(v0[j]), s1 = sigm(v1[j]); v0[j] = act == 1 ? v0[j] * s0 : s0; v1[j] = act == 1 ? v1[j] * s1 : s1; } }
                    u32x4 w; w.x = cvt_pk_bf16(v0[0], v0[1]); w.y = cvt_pk_bf16(v0[2], v0[3]); w.z = cvt_pk_bf16(v1[0], v1[1]); w.w = cvt_pk_bf16(v1[2], v1[3]);
                    *(u32x4*)(rowp + bj * HALF) = w; } }
    }
};
template <int PASS> struct EpiMerge {
    static constexpr bool PERM = true;
    bf16_t* O; const bf16_t* GATES; int goff;
    __device__ __forceinline__ void operator()(const f32x4 (&acc)[2][2][4][2], const Unit& u, int wr, int wc, int fr, int fq) const {
        const int row0 = u.pm * BM + wr * 64 + fr, col0 = u.pn * BM + wc * 32 + 8 * fq;
#pragma unroll
        for (int ai = 0; ai < 2; ++ai)
#pragma unroll
            for (int m = 0; m < 4; ++m) { const size_t r = (size_t)(row0 + ai * HALF + m * 16);
#pragma unroll
                for (int bj = 0; bj < 2; ++bj) { f32x4 v0 = acc[ai][bj][m][0], v1 = acc[ai][bj][m][1];
                    const u32x4 g = *(const u32x4*)(GATES + r * 2048 + goff + col0 + bj * HALF);
                    v0[0] *= bflo(g.x); v0[1] *= bfhi(g.x); v0[2] *= bflo(g.y); v0[3] *= bfhi(g.y); v1[0] *= bflo(g.z); v1[1] *= bfhi(g.z); v1[2] *= bflo(g.w); v1[3] *= bfhi(g.w);
                    bf16_t* op = O + r * 1024 + col0 + bj * HALF;
                    if (PASS == 1) { const u32x4 o = *(const u32x4*)op;
                        v0[0] += bflo(o.x); v0[1] += bfhi(o.x); v0[2] += bflo(o.y); v0[3] += bfhi(o.y); v1[0] += bflo(o.z); v1[1] += bfhi(o.z); v1[2] += bflo(o.w); v1[3] += bfhi(o.w); }
                    u32x4 w; w.x = cvt_pk_bf16(v0[0], v0[1]); w.y = cvt_pk_bf16(v0[2], v0[3]); w.z = cvt_pk_bf16(v1[0], v1[1]); w.w = cvt_pk_bf16(v1[2], v1[3]);
                    *(u32x4*)op = w; } }
    }
};

template <class Epi, class Sched>
__device__ __forceinline__ void gemm_phase(PG8_LAS unsigned char* lds, const Gemm g, const Sched& S, const Epi& E) {
    const int tid = threadIdx.x, wid = __builtin_amdgcn_readfirstlane(tid >> 6), lane = tid & 63, wr = wid >> 2, wc = wid & 3, fr = lane & 15, fq = lane >> 4;
    const int nt = g.K / BK;
    unsigned voffA[2], voffB[2];
#pragma unroll
    for (int i = 0; i < 2; ++i) { int R, C; stage_rc(tid * 16 + i * 8192, R, C); const int Rb = Epi::PERM ? ((R & ~31) + perm32(R & 31)) : R;
        voffA[i] = (unsigned)(R * g.lda + C) * 2u; voffB[i] = (unsigned)(Rb * g.ldb + C) * 2u; }
    const size_t kstep = (size_t)(BK * 2);
    const size_t hstepA = (size_t)HALF * g.lda * 2, hstepB = (size_t)HALF * g.ldb * 2;
    const size_t tstepA = 2 * hstepA, tstepB = 2 * hstepB;
    const unsigned ldsw = (unsigned)wid * 1024u;
    const int aoff = lds_byte(wr * 64 + fr, fq * 8), boff = lds_byte(wc * 32 + fr, fq * 8);
#define PG8_SA(b, h) (((b) * 2 + (h)) * HTB)
#define PG8_SB(b, h) ((4 + (b) * 2 + (h)) * HTB)
#define PG8_STAGE(bufoff, gbase, voff) do { _Pragma("unroll") for (int _i = 0; _i < 2; ++_i) \
        __builtin_amdgcn_global_load_lds((const unsigned*)((const char*)(gbase) + (voff)[_i]), (PG8_LAS unsigned*)(lds + (bufoff) + ldsw + _i * 8192), 16, 0, 0); } while (0)
#define PG8_LDA(dst, b, h) do { _Pragma("unroll") for (int m = 0; m < 4; ++m) _Pragma("unroll") for (int k = 0; k < 2; ++k) dst[m][k] = *(const PG8_LAS bf16x8*)(lds + PG8_SA(b, h) + aoff + m * 2048 + k * 1024); } while (0)
#define PG8_LDB(dst, b, h) do { _Pragma("unroll") for (int n = 0; n < 2; ++n) _Pragma("unroll") for (int k = 0; k < 2; ++k) dst[n][k] = *(const PG8_LAS bf16x8*)(lds + PG8_SB(b, h) + boff + n * 2048 + k * 1024); } while (0)
#define PG8_MMA(ai, bj, At, Bt) do { __builtin_amdgcn_s_setprio(1); _Pragma("unroll") for (int m = 0; m < 4; ++m) _Pragma("unroll") for (int n = 0; n < 2; ++n) _Pragma("unroll") for (int k = 0; k < 2; ++k) \
        acc[ai][bj][m][n] = __builtin_amdgcn_mfma_f32_16x16x32_bf16(Bt[n][k], At[m][k], acc[ai][bj][m][n], 0, 0, 0); __builtin_amdgcn_s_setprio(0); } while (0)
#define PG8_WAIT_V(n) asm volatile("s_waitcnt vmcnt(" #n ")" ::: "memory")
#define PG8_WAIT_L(n) asm volatile("s_waitcnt lgkmcnt(" #n ")" ::: "memory")
#define PG8_BAR __builtin_amdgcn_s_barrier()
#define PG8_SCHED __builtin_amdgcn_sched_barrier(0)
    Unit cur, nxt; int ui = 0;
    if (!S.next(0, cur)) return;
    f32x4 acc[2][2][4][2];
#pragma unroll
    for (int a = 0; a < 2; ++a)
#pragma unroll
        for (int b = 0; b < 2; ++b)
#pragma unroll
            for (int m = 0; m < 4; ++m)
#pragma unroll
                for (int n = 0; n < 2; ++n) acc[a][b][m][n] = (f32x4){0.f, 0.f, 0.f, 0.f};
    bf16x8 At[4][2], B0[2][2], B1[2][2];
    const char* cA = (const char*)g.A + (size_t)cur.pm * tstepA; const char* cB = (const char*)g.Bt + (size_t)cur.pn * tstepB;
    PG8_STAGE(PG8_SB(0, 0), cB, voffB); PG8_STAGE(PG8_SA(0, 0), cA, voffA); PG8_STAGE(PG8_SB(0, 1), cB + hstepB, voffB); PG8_STAGE(PG8_SA(0, 1), cA + hstepA, voffA);
    if (wr == 1) PG8_BAR;
    PG8_WAIT_V(4); PG8_BAR;
    PG8_STAGE(PG8_SB(1, 0), cB + kstep, voffB); PG8_STAGE(PG8_SA(1, 0), cA + kstep, voffA); PG8_STAGE(PG8_SB(1, 1), cB + hstepB + kstep, voffB);
    PG8_WAIT_V(6); PG8_BAR;
    for (;;) {
        const bool has_next = S.next(ui + 1, nxt);
        const char* nA = has_next ? (const char*)g.A + (size_t)nxt.pm * tstepA : cA; const char* nB = has_next ? (const char*)g.Bt + (size_t)nxt.pn * tstepB : cB;
        for (int t = 0; t < nt; t += 2) {
            const bool last = (t == nt - 2);
            const char* a1 = cA + (size_t)(t + 1) * kstep;
            const char* a2 = last ? nA : cA + (size_t)(t + 2) * kstep; const char* b2 = last ? nB : cB + (size_t)(t + 2) * kstep;
            const char* a3 = a2 + kstep; const char* b3 = b2 + kstep;
            PG8_LDB(B0, 0, 0); PG8_SCHED; PG8_LDA(At, 0, 0); PG8_STAGE(PG8_SA(1, 1), a1 + hstepA, voffA);
            PG8_WAIT_L(8); PG8_BAR; PG8_WAIT_L(0); PG8_MMA(0, 0, At, B0); PG8_BAR; PG8_SCHED;
            PG8_LDB(B1, 0, 1); PG8_STAGE(PG8_SB(0, 0), b2, voffB);
            PG8_BAR; PG8_WAIT_L(0); PG8_MMA(0, 1, At, B1); PG8_BAR;
            PG8_LDA(At, 0, 1); PG8_STAGE(PG8_SA(0, 0), a2, voffA);
            PG8_BAR; PG8_WAIT_L(0); PG8_MMA(1, 0, At, B0); PG8_BAR; PG8_SCHED;
            PG8_STAGE(PG8_SB(0, 1), b2 + hstepB, voffB);
            PG8_WAIT_V(6); PG8_BAR; PG8_MMA(1, 1, At, B1); PG8_BAR;
            PG8_LDB(B0, 1, 0); PG8_SCHED; PG8_LDA(At, 1, 0); PG8_STAGE(PG8_SA(0, 1), a2 + hstepA, voffA);
            PG8_WAIT_L(8); PG8_BAR; PG8_WAIT_L(0); PG8_MMA(0, 0, At, B0); PG8_BAR; PG8_SCHED;
            PG8_LDB(B1, 1, 1); PG8_STAGE(PG8_SB(1, 0), b3, voffB);
            PG8_BAR; PG8_WAIT_L(0); PG8_MMA(0, 1, At, B1); PG8_BAR;
            PG8_LDA(At, 1, 1); PG8_STAGE(PG8_SA(1, 0), a3, voffA);
            PG8_BAR; PG8_WAIT_L(0); PG8_MMA(1, 0, At, B0); PG8_BAR; PG8_SCHED;
            PG8_STAGE(PG8_SB(1, 1), b3 + hstepB, voffB);
            PG8_WAIT_V(6); PG8_BAR; PG8_MMA(1, 1, At, B1); PG8_BAR;
        }
        E(acc, cur, wr, wc, fr, fq);
        if (!has_next) break;
#pragma unroll
        for (int a = 0; a < 2; ++a)
#pragma unroll
            for (int b = 0; b < 2; ++b)
#pragma unroll
                for (int m = 0; m < 4; ++m)
#pragma unroll
                    for (int n = 0; n < 2; ++n) acc[a][b][m][n] = (f32x4){0.f, 0.f, 0.f, 0.f};
        cur = nxt; cA = nA; cB = nB; ++ui;
    }
    PG8_WAIT_V(0);
    if (wr == 0) PG8_BAR;
    PG8_BAR;
#undef PG8_SA
#undef PG8_SB
#undef PG8_STAGE
#undef PG8_LDA
#undef PG8_LDB
#undef PG8_MMA
#undef PG8_WAIT_V
#undef PG8_WAIT_L
#undef PG8_BAR
#undef PG8_SCHED
}
}

namespace {
using pg8::bf16_t; using pg8::f32x4; using pg8::u32x4; using pg8::u32x2;
#define LAS __attribute__((address_space(3)))
constexpr int D = 1024, NB = 8, L = 4096, LC = 256, INC = 6144, FF = 4096, HW = 512;
constexpr int NT = NB * L, NCX = NB * LC;
constexpr float EPS = 1e-6f;
constexpr size_t MiB = 1u << 20;
constexpr size_t WS_MOD = 64 * 1024, WS_LB = 512 * 1024, WS_GT = 2 * MiB  ;
constexpr size_t WS_WIN = 18 * MiB, WS_WPAB = 30 * MiB, WS_WOUT = 32 * MiB, WS_W1 = 34 * MiB, WS_W2 = 42 * MiB;
constexpr size_t WS_HCTX = 50 * MiB, WS_PCTX = 54 * MiB, WS_SCTX = 60 * MiB;
constexpr size_t WS_HLAT = 64 * MiB;
constexpr size_t WS_PI = 128 * MiB, WS_PZ = 160 * MiB, WS_PQ = 224 * MiB, WS_PG = 256 * MiB, WS_GATES = 288 * MiB, WS_PHYT = 416 * MiB;
constexpr size_t WS_AY = 160 * MiB;
constexpr size_t WS_AY2 = 64 * MiB;
constexpr size_t WS_MERGED = 128 * MiB;
constexpr size_t WS_MIX = 448 * MiB, WS_MLP = 384 * MiB, WS_H1 = 128 * MiB, WS_HL = 64 * MiB;
constexpr size_t WS_END = 512 * MiB;
constexpr int LDS_BYTES = 147456;

__device__ __forceinline__ float bf2f(bf16_t h) { return __uint_as_float(((unsigned)h) << 16); }
__device__ __forceinline__ unsigned f2bf(float f) { unsigned u = __float_as_uint(f); return (u + 0x7fffu + ((u >> 16) & 1u)) >> 16; }
__device__ __forceinline__ unsigned pk2(float lo, float hi) { return f2bf(lo) | (f2bf(hi) << 16); }
__device__ __forceinline__ float sigmoidf_(float x) { return 1.f / (1.f + expf(-x)); }
__device__ __forceinline__ float siluf_(float x) { return x / (1.f + expf(-x)); }
__device__ __forceinline__ float wave_sum(float v) {
#pragma unroll
    for (int o = 1; o < 64; o <<= 1) v += __shfl_xor(v, o);
    return v;
}
#define LDS_WAIT() asm volatile("s_waitcnt lgkmcnt(0)" ::: "memory")

struct Params { const float* in[24]; float* out; unsigned char* ws; };

__device__ __forceinline__ void transpose_item(const float* W, int N, bf16_t* WT, int ldk, int koff, int remap, LAS float* scr, int item, int lane) {
    const int nblk = N / 32, kb = item / nblk, nb = item % nblk, k0 = 64 * kb, n0 = 32 * nb;
    int rbase = n0;
    if (remap) rbase = n0 < 2560 ? n0 : (n0 < 4096 ? n0 + 2048 : n0 - 1536);
#pragma unroll 8
    for (int i = 0; i < 32; ++i) { const int kk = 2 * i + (lane >> 5); scr[kk * 33 + (lane & 31)] = W[(size_t)(k0 + kk) * N + n0 + (lane & 31)]; }
    LDS_WAIT();
    const int c = lane & 7;
#pragma unroll
    for (int j = 0; j < 4; ++j) { const int n = (lane >> 3) + 8 * j; const LAS float* s = scr + (8 * c) * 33 + n;
        u32x4 o; o.x = pk2(s[0 * 33], s[1 * 33]); o.y = pk2(s[2 * 33], s[3 * 33]); o.z = pk2(s[4 * 33], s[5 * 33]); o.w = pk2(s[6 * 33], s[7 * 33]);
        *(u32x4*)(WT + (size_t)(rbase + n) * ldk + koff + k0 + 8 * c) = o; }
    LDS_WAIT();
}

__device__ __forceinline__ void row_norm_mod_bf16(const float* xrow, const float* nw, const float* scale, const float* shift, bf16_t* orow, int lane) {
    const f32x4* xr = (const f32x4*)xrow + lane; f32x4 v[4]; float s = 0.f;
#pragma unroll
    for (int j = 0; j < 4; ++j) { v[j] = xr[64 * j]; s += (v[j].x * v[j].x + v[j].y * v[j].y) + (v[j].z * v[j].z + v[j].w * v[j].w); }
    const float r = rsqrtf(wave_sum(s) * (1.f / D) + EPS);
    unsigned long long* o8 = (unsigned long long*)orow + lane;
#pragma unroll
    for (int j = 0; j < 4; ++j) { const f32x4 w = ((const f32x4*)nw)[lane + 64 * j], sc = ((const f32x4*)scale)[lane + 64 * j], sh = ((const f32x4*)shift)[lane + 64 * j];
        const f32x4 o = v[j] * r * w * (1.f + sc) + sh;
        o8[64 * j] = (unsigned long long)pk2(o.x, o.y) | ((unsigned long long)pk2(o.z, o.w) << 32); }
}
__device__ __forceinline__ f32x4 ld_bf4(const bf16_t* p) { const u32x2 u = *(const u32x2*)p; return (f32x4){pg8::bflo(u.x), pg8::bfhi(u.x), pg8::bflo(u.y), pg8::bfhi(u.y)}; }
__device__ __forceinline__ void row_x1(const float* xrow, const bf16_t* mixrow, const float* nw1, const float* g2, f32x4 (&x1)[4], int lane) {
    f32x4 mv[4]; float s = 0.f;
#pragma unroll
    for (int j = 0; j < 4; ++j) { mv[j] = ld_bf4(mixrow + 4 * lane + 256 * j); s += (mv[j].x * mv[j].x + mv[j].y * mv[j].y) + (mv[j].z * mv[j].z + mv[j].w * mv[j].w); }
    const float r = rsqrtf(wave_sum(s) * (1.f / D) + EPS);
#pragma unroll
    for (int j = 0; j < 4; ++j) { const f32x4 w = ((const f32x4*)nw1)[lane + 64 * j], g = ((const f32x4*)g2)[lane + 64 * j], xv = ((const f32x4*)xrow)[lane + 64 * j];
        x1[j] = xv + g * (mv[j] * r * w); }
}

__device__ __forceinline__ void hgrn_chain(LAS float* sm, const bf16_t* pi, int ldi, const bf16_t* pz, int ldz, const bf16_t* pq, int ldq, int Lseq, int h, int dir,
                                           const float* lb, const float* s_in, float* s_out, float* o_out) {
    const int tid = threadIdx.x, v = tid & 127, dg = tid >> 7;
    LAS float* fb = sm; LAS float* qb = sm + 1024; LAS float* vb = sm + 2048; LAS float* pb = sm + 3072;
    float S[32];
#pragma unroll
    for (int i = 0; i < 32; ++i) S[i] = s_in ? s_in[(size_t)(dg * 32 + i) * 128 + v] : 0.f;
    for (int t0 = 0; t0 < Lseq; t0 += 8) {
        for (int e = tid; e < 8 * 128; e += 512) {
            const int tt = e >> 7, dd = e & 127; const int t = dir ? (Lseq - 1 - (t0 + tt)) : (t0 + tt); const int col = h * 128 + dd;
            const float z = bf2f(pz[(size_t)t * ldz + col]); const float lbv = lb[col];
            fb[e] = lbv + (1.f - lbv) * sigmoidf_(z);
            qb[e] = pq ? bf2f(pq[(size_t)t * ldq + col]) : 0.f;
            vb[e] = bf2f(pi[(size_t)t * ldi + col]);
        }
        __syncthreads();
#pragma unroll 1
        for (int tt = 0; tt < 8; ++tt) {
            const float vv = vb[tt * 128 + v]; float part = 0.f;
#pragma unroll
            for (int i = 0; i < 32; ++i) { const float f = fb[tt * 128 + dg * 32 + i]; S[i] = f * S[i] + (1.f - f) * vv; part += S[i] * qb[tt * 128 + dg * 32 + i]; }
            pb[(tt * 4 + dg) * 128 + v] = part;
        }
        __syncthreads();
        if (o_out) for (int e = tid; e < 8 * 128; e += 512) {
            const int tt = e >> 7, vv = e & 127; const int t = dir ? (Lseq - 1 - (t0 + tt)) : (t0 + tt);
            o_out[(size_t)t * HW + h * 128 + vv] = pb[(tt * 4 + 0) * 128 + vv] + pb[(tt * 4 + 1) * 128 + vv] + pb[(tt * 4 + 2) * 128 + vv] + pb[(tt * 4 + 3) * 128 + vv];
        }
        __syncthreads();
    }
    if (s_out) {
#pragma unroll
        for (int i = 0; i < 32; ++i) s_out[(size_t)(dg * 32 + i) * 128 + v] = S[i];
    }
}


typedef float f32x16 __attribute__((ext_vector_type(16)));
typedef float f32x2_t __attribute__((ext_vector_type(2)));
typedef __bf16 bf16x2_t __attribute__((ext_vector_type(2)));
__device__ __forceinline__ unsigned cvtpk(float lo, float hi) { const f32x2_t v = {lo, hi}; const bf16x2_t b = __builtin_convertvector(v, bf16x2_t); return __builtin_bit_cast(unsigned, b); }
constexpr int HY_PITCH = 8720;
constexpr int HY_TAB0 = 8 * HY_PITCH;
constexpr int HY_TAB1 = HY_TAB0 + 17408 + 64;
__device__ __forceinline__ void conv8(const u32x4 raw, float left, float right, float w0, float w1, float w2, float bias, float (&o)[8]) {
    float in[10]; in[0] = left; in[9] = right;
    in[1] = pg8::bflo(raw.x); in[2] = pg8::bfhi(raw.x); in[3] = pg8::bflo(raw.y); in[4] = pg8::bfhi(raw.y); in[5] = pg8::bflo(raw.z); in[6] = pg8::bfhi(raw.z); in[7] = pg8::bflo(raw.w); in[8] = pg8::bfhi(raw.w);
#pragma unroll
    for (int j = 0; j < 8; ++j) o[j] = bias + w0 * in[j] + w1 * in[j + 1] + w2 * in[j + 2];
}
__device__ __forceinline__ void hyena_channel(LAS unsigned char* lds, int c, bf16_t* PHYT, const bf16_t* GTB, const float* hy_sw, const float* hy_sb) {
    const int tid = threadIdx.x, lane = tid & 63, wave = __builtin_amdgcn_readfirstlane(tid >> 6);
    __syncthreads();
    for (int ci = tid; ci < 1088; ci += 512) { u32x4 v = (u32x4){0u, 0u, 0u, 0u};
        if (ci >= 32 && ci < 1056) v = *(const u32x4*)(GTB + (size_t)c * 8192 + (ci - 32) * 8);
        *(LAS u32x4*)(lds + HY_TAB0 + ci * 16) = v; }
    {
        const bf16_t* x1r = PHYT + (size_t)(512 + c) * NT; const bf16_t* vr = PHYT + (size_t)(1024 + c) * NT;
        const float xw0 = hy_sw[512 + c], xw1 = hy_sw[1536 + 512 + c], xw2 = hy_sw[3072 + 512 + c], xb = hy_sb[512 + c];
        const float vw0 = hy_sw[1024 + c], vw1 = hy_sw[1536 + 1024 + c], vw2 = hy_sw[3072 + 1024 + c], vb = hy_sb[1024 + c];
        for (int q = tid; q < 4096; q += 512) { const int b = q >> 9, s8 = (q & 511) * 8; const size_t o = (size_t)b * L + s8;
            const u32x4 xa = *(const u32x4*)(x1r + o), va = *(const u32x4*)(vr + o);
            const bool hl = (s8 & 63) != 0, hr = ((s8 + 8) & 63) != 0;
            const float xl = hl ? bf2f(x1r[o - 1]) : 0.f, xr = hr ? bf2f(x1r[o + 8]) : 0.f, vl = hl ? bf2f(vr[o - 1]) : 0.f, vrr = hr ? bf2f(vr[o + 8]) : 0.f;
            float cx[8], cv[8]; conv8(xa, xl, xr, xw0, xw1, xw2, xb, cx); conv8(va, vl, vrr, vw0, vw1, vw2, vb, cv);
            u32x4 w; w.x = cvtpk(cx[0] * cv[0], cx[1] * cv[1]); w.y = cvtpk(cx[2] * cv[2], cx[3] * cv[3]); w.z = cvtpk(cx[4] * cv[4], cx[5] * cv[5]); w.w = cvtpk(cx[6] * cv[6], cx[7] * cv[7]);
            *(LAS u32x4*)(lds + b * HY_PITCH + (128 + s8) * 2) = w; }
        if (tid < 256) { const int b = tid >> 5, side = (tid >> 4) & 1, k = tid & 15;
            *(LAS u32x4*)(lds + b * HY_PITCH + (side ? (128 + 4096) * 2 : 0) + k * 16) = (u32x4){0u, 0u, 0u, 0u}; }
    }
    __syncthreads();
    for (int ci = tid; ci < 1088; ci += 512) { const u32x4 d = *(const LAS u32x4*)(lds + HY_TAB0 + ci * 16); const unsigned d4 = ci < 1087 ? *(const LAS unsigned*)(lds + HY_TAB0 + ci * 16 + 16) : 0u;
        u32x4 o; o.x = __builtin_amdgcn_alignbit(d.y, d.x, 16); o.y = __builtin_amdgcn_alignbit(d.z, d.y, 16); o.z = __builtin_amdgcn_alignbit(d.w, d.z, 16); o.w = __builtin_amdgcn_alignbit(d4, d.w, 16);
        *(LAS u32x4*)(lds + HY_TAB1 + ci * 16) = o; }
    __syncthreads();
    const int T0 = 512 * wave, r = lane & 31, h = lane >> 5, bb = r >> 2, tb = r & 3;
    f32x16 acc[4];
#pragma unroll
    for (int i = 0; i < 4; ++i)
#pragma unroll
        for (int j = 0; j < 16; ++j) acc[i][j] = 0.f;
    {
        const int Dfirst = T0 - 4080;
        const int e0 = 4351 - Dfirst - r + 8 * h;
        unsigned aaddr = (unsigned)((e0 & 1) ? HY_TAB1 : HY_TAB0) + (unsigned)(e0 & ~1) * 2u;
        unsigned baddr = (unsigned)(bb * HY_PITCH + (128 + T0 + 32 * tb - Dfirst + 8 * h) * 2);
#define HY_LDA(dst, ad) do { u32x4 _t; _t.x = *(const LAS unsigned*)(lds + (ad)); _t.y = *(const LAS unsigned*)(lds + (ad) + 4); _t.z = *(const LAS unsigned*)(lds + (ad) + 8); _t.w = *(const LAS unsigned*)(lds + (ad) + 12); dst = __builtin_bit_cast(pg8::bf16x8, _t); } while (0)
#define HY_LDB(dst, ad) dst = *(const LAS pg8::bf16x8*)(lds + (ad))
        pg8::bf16x8 A, B0, B1, B2, B3;
        const pg8::bf16x8 zz = (pg8::bf16x8){0, 0, 0, 0, 0, 0, 0, 0};
        HY_LDA(A, aaddr); HY_LDB(B0, baddr); B1 = zz; B2 = zz; B3 = zz;
        for (int st = 0; st < 286; ++st) {
            const int d = -4080 + 16 * st, dn = d + 16;
            pg8::bf16x8 An, B0n = zz, B1n = zz, B2n = zz, B3n = zz;
            const unsigned an = aaddr - 32u, bn = baddr - 32u;
            HY_LDA(An, an);
            if (dn <= 96) HY_LDB(B0n, bn);
            if (dn >= -3952 && dn <= 224) HY_LDB(B1n, bn + 256);
            if (dn >= -3824 && dn <= 352) HY_LDB(B2n, bn + 512);
            if (dn >= -3696 && dn <= 480) HY_LDB(B3n, bn + 768);
            if (d <= 96) acc[0] = __builtin_amdgcn_mfma_f32_32x32x16_bf16(A, B0, acc[0], 0, 0, 0);
            if (d >= -3952 && d <= 224) acc[1] = __builtin_amdgcn_mfma_f32_32x32x16_bf16(A, B1, acc[1], 0, 0, 0);
            if (d >= -3824 && d <= 352) acc[2] = __builtin_amdgcn_mfma_f32_32x32x16_bf16(A, B2, acc[2], 0, 0, 0);
            if (d >= -3696) acc[3] = __builtin_amdgcn_mfma_f32_32x32x16_bf16(A, B3, acc[3], 0, 0, 0);
            A = An; B0 = B0n; B1 = B1n; B2 = B2n; B3 = B3n; aaddr = an; baddr = bn;
        }
#undef HY_LDA
#undef HY_LDB
    }
    __syncthreads();
#pragma unroll
    for (int i = 0; i < 4; ++i)
#pragma unroll
        for (int g = 0; g < 4; ++g) { const int t = T0 + 128 * i + 32 * tb + 8 * g + 4 * h;
            pg8::u32x2 w; w.x = cvtpk(acc[i][4 * g], acc[i][4 * g + 1]); w.y = cvtpk(acc[i][4 * g + 2], acc[i][4 * g + 3]);
            *(LAS pg8::u32x2*)(lds + bb * HY_PITCH + (128 + t) * 2) = w; }
    __syncthreads();
    {
        const bf16_t* x0r = PHYT + (size_t)c * NT; bf16_t* yr = PHYT + (size_t)(1024 + c) * NT;
        const float w0 = hy_sw[c], w1 = hy_sw[1536 + c], w2 = hy_sw[3072 + c], bs = hy_sb[c];
        for (int q = tid; q < 4096; q += 512) { const int b = q >> 9, s8 = (q & 511) * 8; const size_t o = (size_t)b * L + s8;
            const u32x4 xa = *(const u32x4*)(x0r + o);
            const bool hl = (s8 & 63) != 0, hr = ((s8 + 8) & 63) != 0;
            const float xl = hl ? bf2f(x0r[o - 1]) : 0.f, xr = hr ? bf2f(x0r[o + 8]) : 0.f;
            float cx[8]; conv8(xa, xl, xr, w0, w1, w2, bs, cx);
            const u32x4 y = *(const LAS u32x4*)(lds + b * HY_PITCH + (128 + s8) * 2);
            u32x4 w; w.x = cvtpk(cx[0] * pg8::bflo(y.x), cx[1] * pg8::bfhi(y.x)); w.y = cvtpk(cx[2] * pg8::bflo(y.y), cx[3] * pg8::bfhi(y.y));
            w.z = cvtpk(cx[4] * pg8::bflo(y.z), cx[5] * pg8::bfhi(y.z)); w.w = cvtpk(cx[6] * pg8::bflo(y.w), cx[7] * pg8::bfhi(y.w));
            *(u32x4*)(yr + o) = w; }
    }
}

__global__ void __launch_bounds__(512, 2) mega(Params P) {
    extern __shared__ __attribute__((aligned(16))) unsigned char lds_raw[];
    cg::grid_group grid = cg::this_grid();
    LAS unsigned char* lds = (LAS unsigned char*)lds_raw;
    const int tid = threadIdx.x, lane = tid & 63, wave = __builtin_amdgcn_readfirstlane(tid >> 6);
    const int G = gridDim.x, bx = blockIdx.x;
    const int vcu = (G % 8 == 0) ? (bx % 8) * (G / 8) + bx / 8 : bx;
    const int gw = vcu * 8 + wave, NGW = G * 8;
    unsigned char* ws = P.ws;
    const float* x = P.in[0]; const float* cvec = P.in[1]; const float* ctx = P.in[2]; const float* c_ctx = P.in[3];
    const float* w_ada = P.in[4]; const float* b_ada = P.in[5]; const float* norm_w = P.in[6]; const float* w_in = P.in[7];
    const float* lb_param = P.in[8]; const float* g_norm = P.in[9]; const float* hy_sw = P.in[10]; const float* hy_sb = P.in[11];
    const float* f_w1 = P.in[12]; const float* f_b1 = P.in[13]; const float* f_w2 = P.in[14]; const float* f_b2 = P.in[15];
    const float* f_w3 = P.in[16]; const float* f_freq = P.in[17]; const float* hy_d = P.in[18]; const float* w_pa = P.in[19];
    const float* w_pb = P.in[20]; const float* w_out = P.in[21]; const float* w_mlp1 = P.in[22]; const float* w_mlp2 = P.in[23];
    float* MOD = (float*)(ws + WS_MOD); float* LB = (float*)(ws + WS_LB); bf16_t* GTB = (bf16_t*)(ws + WS_GT);
    bf16_t* WIN = (bf16_t*)(ws + WS_WIN); bf16_t* WPAB = (bf16_t*)(ws + WS_WPAB); bf16_t* WOUT = (bf16_t*)(ws + WS_WOUT); bf16_t* W1 = (bf16_t*)(ws + WS_W1); bf16_t* W2 = (bf16_t*)(ws + WS_W2);
    bf16_t* HCTX = (bf16_t*)(ws + WS_HCTX); bf16_t* PCTX = (bf16_t*)(ws + WS_PCTX); float* SCTX = (float*)(ws + WS_SCTX);
    bf16_t* HLAT = (bf16_t*)(ws + WS_HLAT); bf16_t* PI = (bf16_t*)(ws + WS_PI); bf16_t* PZ = (bf16_t*)(ws + WS_PZ); bf16_t* PQ = (bf16_t*)(ws + WS_PQ);
    bf16_t* PG = (bf16_t*)(ws + WS_PG); bf16_t* GATES = (bf16_t*)(ws + WS_GATES); bf16_t* PHYT = (bf16_t*)(ws + WS_PHYT);
    bf16_t* AY = (bf16_t*)(ws + WS_AY2); bf16_t* MERGED = (bf16_t*)(ws + WS_MERGED); bf16_t* MIX = (bf16_t*)(ws + WS_MIX);
    bf16_t* MLP = (bf16_t*)(ws + WS_MLP); bf16_t* H1 = (bf16_t*)(ws + WS_H1); bf16_t* HL = (bf16_t*)(ws + WS_HL);
    float* O2 = P.out;

    {
        if (bx < 96) {
            LAS float* sc = (LAS float*)lds;
            LAS float* ps = (LAS float*)(lds + 40960);
            for (int i = tid; i < 9 * D; i += 512) { const int r = i >> 10, k = i & 1023; sc[i] = siluf_(r < 8 ? cvec[r * D + k] : c_ctx[k]); }
            __syncthreads();
            const int j = bx * 64 + lane; float a9[9];
#pragma unroll
            for (int r = 0; r < 9; ++r) a9[r] = 0.f;
            for (int k = wave * 128; k < wave * 128 + 128; ++k) { const float w = w_ada[(size_t)k * INC + j];
#pragma unroll
                for (int r = 0; r < 9; ++r) a9[r] += sc[r * D + k] * w; }
#pragma unroll
            for (int r = 0; r < 9; ++r) ps[(wave * 9 + r) * 64 + lane] = a9[r];
            __syncthreads();
            for (int i = tid; i < 9 * 64; i += 512) { const int r = i >> 6, l = i & 63; float s = b_ada[bx * 64 + l];
#pragma unroll
                for (int w = 0; w < 8; ++w) s += ps[(w * 9 + r) * 64 + l];
                MOD[r * INC + bx * 64 + l] = s; }
            __syncthreads();
        }
        if (bx == G - 1) { const float a = lb_param[tid], b = lb_param[HW + tid], m = fmaxf(a, b); const float ea = expf(a - m), eb = expf(b - m); LB[tid] = ea / (ea + eb); }
        LAS float* scr = (LAS float*)(lds + wave * 16384);
        constexpr int I_IN = 16 * 192, I_PA = 8 * 32, I_OUT = 16 * 32, I_1 = 16 * 128, I_2 = 64 * 32;
        constexpr int NITEMS = I_IN + 2 * I_PA + I_OUT + I_1 + I_2;
        for (int it = gw; it < NITEMS; it += NGW) {
            int r = it;
            if (r < I_IN) { transpose_item(w_in, INC, WIN, D, 0, 1, scr, r, lane); continue; } r -= I_IN;
            if (r < I_PA) { transpose_item(w_pa, D, WPAB, D, 0, 0, scr, r, lane); continue; } r -= I_PA;
            if (r < I_PA) { transpose_item(w_pb, D, WPAB, D, 512, 0, scr, r, lane); continue; } r -= I_PA;
            if (r < I_OUT) { transpose_item(w_out, D, WOUT, D, 0, 0, scr, r, lane); continue; } r -= I_OUT;
            if (r < I_1) { transpose_item(w_mlp1, FF, W1, D, 0, 0, scr, r, lane); continue; } r -= I_1;
            transpose_item(w_mlp2, D, W2, FF, 0, 0, scr, r, lane);
        }
        for (int t = gw; t < L; t += NGW) {
            LAS float* z = scr; LAS float* h1 = scr + 64; LAS float* h2 = scr + 128;
            const float tn = (float)t / (float)(L - 1);
            if (lane < 33) {
                float val;
                if (lane == 0) val = tn;
                else { const int bi = (lane - 1) & 15; const float band = 1e-4f + (float)bi * ((15.f - 1e-4f) / 15.f);
                    const float w = 2.0f * 3.14159265358979323846f * (float)t / (float)L; const float ang = w * band;
                    val = (lane <= 16) ? cosf(ang) : -sinf(ang); }
                z[lane] = val;
            }
            LDS_WAIT();
            { float acc = f_b1[lane]; for (int i = 0; i < 33; ++i) acc += z[i] * f_w1[i * 64 + lane]; h1[lane] = sinf(f_freq[lane] * acc); }
            LDS_WAIT();
            { float acc = f_b2[lane]; for (int i = 0; i < 64; ++i) acc += h1[i] * f_w2[i * 64 + lane]; h2[lane] = sinf(f_freq[lane] * acc); }
            LDS_WAIT();
            const float mind = logf(1e-2f) / 1.5f, maxd = logf(1e-2f) / 0.3f;
            for (int j = lane; j < 1024; j += 64) {
                float acc = 0.f; for (int i = 0; i < 64; ++i) acc += h2[i] * f_w3[i * 1024 + j];
                const int dirb = j >> 9, c = j & 511;
                const float delta = fabsf(mind + (maxd - mind) * ((float)c / 511.f));
                float val = acc * expf(-tn * delta);
                if (dirb == 0) { if (t == 0) val += hy_d[c]; GTB[(size_t)c * 8192 + 4095 - t] = (bf16_t)f2bf(val); }
                else if (t > 0) GTB[(size_t)c * 8192 + 4095 + t] = (bf16_t)f2bf(val);
                else GTB[(size_t)c * 8192 + 8191] = (bf16_t)0;
            }
            LDS_WAIT();
        }
    }
    grid.sync();
    for (int m = gw; m < NT + NCX; m += NGW) {
        if (m < NT) { const float* mb = MOD + (size_t)(m >> 12) * INC; row_norm_mod_bf16(x + (size_t)m * D, norm_w, mb, mb + D, HLAT + (size_t)m * D, lane); }
        else { const int mc = m - NT; const float* mb = MOD + (size_t)8 * INC; row_norm_mod_bf16(ctx + (size_t)mc * D, norm_w, mb, mb + D, HCTX + (size_t)mc * D, lane); }
    }
    grid.sync();
    {
        { pg8::Gemm g{HLAT, WIN, D, D, D}; pg8::StaticOrder S; S.init(NT, 4608, G, bx); pg8::EpiG1 E{PI, PZ, PQ, PG, GATES};
          pg8::gemm_phase(lds, g, S, E); }
        { pg8::Gemm g{WIN + (size_t)4608 * D, HLAT, D, D, D}; pg8::StaticOrder S; S.init(1536, NT, G, bx); pg8::EpiBf16<0> E{PHYT, NT};
          pg8::gemm_phase(lds, g, S, E); }
        { pg8::Gemm g{HCTX, WIN, D, D, D}; pg8::StaticOrder S; S.init(NCX, 1536, G, bx); pg8::EpiBf16<0> E{PCTX, 1536};
          pg8::gemm_phase(lds, g, S, E); }
    }
    grid.sync();
    if (bx < 64) { const int b = bx >> 3, h = (bx >> 1) & 3, dir = bx & 1;
        hgrn_chain((LAS float*)lds, PCTX + (size_t)b * LC * 1536, 1536, PCTX + (size_t)b * LC * 1536 + (dir ? 1024 : 512), 1536, nullptr, 0, LC, h, dir, LB,
                   nullptr, SCTX + (size_t)((b * 2 + dir) * 4 + h) * 16384, nullptr); }
    grid.sync();
    if (bx < 64) { const int b = bx >> 3, h = (bx >> 1) & 3, dir = bx & 1;
        hgrn_chain((LAS float*)lds, PI + (size_t)b * L * 512, 512, PZ + (size_t)b * L * 1024 + (dir ? 512 : 0), 1024, PQ + (size_t)b * L * 512, 512, L, h, dir, LB,
                   SCTX + (size_t)((b * 2 + dir) * 4 + h) * 16384, nullptr, O2 + ((size_t)dir * NT + (size_t)b * L) * HW); }
    else {
        for (int c = bx - 64; c < HW; c += G - 64) hyena_channel(lds, c, PHYT, GTB, hy_sw, hy_sb);
    }
    grid.sync();
    for (int w = gw; w < NT * 4; w += NGW) { const int t = w >> 2, h = w & 3; float v[2]; float s = 0.f;
#pragma unroll
        for (int i = 0; i < 2; ++i) { const int c = h * 128 + lane + 64 * i; v[i] = O2[(size_t)t * HW + c] + O2[((size_t)NT + t) * HW + c]; s += v[i] * v[i]; }
        const float r = rsqrtf(wave_sum(s) * (1.f / 128.f) + EPS);
#pragma unroll
        for (int i = 0; i < 2; ++i) { const int vv = lane + 64 * i, c = h * 128 + vv; AY[(size_t)t * 1024 + c] = (bf16_t)f2bf(v[i] * r * g_norm[vv] * bf2f(PG[(size_t)t * 512 + c])); } }
    {
        LAS bf16_t* tl = (LAS bf16_t*)(lds + wave * 16384);
        for (int it = gw; it < 8 * 512; it += NGW) { const int c0 = (it & 7) * 64, tok0 = (it >> 3) * 64;
#pragma unroll
            for (int i = 0; i < 8; ++i) { const int ch = lane + 64 * i, rr = ch >> 3, cc = (ch & 7) * 8;
                const u32x4 v = *(const u32x4*)(PHYT + (size_t)(1024 + c0 + rr) * NT + tok0 + cc);
                LAS unsigned* d = (LAS unsigned*)(tl + rr * 66 + cc); d[0] = v.x; d[1] = v.y; d[2] = v.z; d[3] = v.w; }
            LDS_WAIT();
#pragma unroll
            for (int i = 0; i < 8; ++i) { const int ch = lane + 64 * i, tt = ch >> 3, cc = (ch & 7) * 8; unsigned o[4];
#pragma unroll
                for (int q = 0; q < 4; ++q) o[q] = (unsigned)tl[(cc + 2 * q) * 66 + tt] | ((unsigned)tl[(cc + 2 * q + 1) * 66 + tt] << 16);
                *(u32x4*)(AY + (size_t)(tok0 + tt) * 1024 + 512 + c0 + cc) = (u32x4){o[0], o[1], o[2], o[3]}; }
            LDS_WAIT();
        }
    }
    grid.sync();
    {
        { pg8::Gemm g{AY, WPAB, D, D, 512}; pg8::StaticOrder S; S.init(NT, D, G, bx); pg8::EpiMerge<0> E{MERGED, GATES, 0}; pg8::gemm_phase(lds, g, S, E); }
        { pg8::Gemm g{AY + 512, WPAB + 512, D, D, 512}; pg8::StaticOrder S; S.init(NT, D, G, bx); pg8::EpiMerge<1> E{MERGED, GATES, 1024}; pg8::gemm_phase(lds, g, S, E); }
    }
    grid.sync();
    { pg8::Gemm g{MERGED, WOUT, D, D, D}; pg8::StaticOrder S; S.init(NT, D, G, bx); pg8::EpiBf16<0> E{MIX, D}; pg8::gemm_phase(lds, g, S, E); }
    grid.sync();
    for (int m = gw; m < NT; m += NGW) { const float* mb = MOD + (size_t)(m >> 12) * INC; f32x4 x1[4];
        row_x1(x + (size_t)m * D, MIX + (size_t)m * D, norm_w + D, mb + 2 * D, x1, lane);
        float s = 0.f;
#pragma unroll
        for (int j = 0; j < 4; ++j) s += (x1[j].x * x1[j].x + x1[j].y * x1[j].y) + (x1[j].z * x1[j].z + x1[j].w * x1[j].w);
        const float r = rsqrtf(wave_sum(s) * (1.f / D) + EPS);
        unsigned long long* o8 = (unsigned long long*)(HL + (size_t)m * D) + lane;
#pragma unroll
        for (int j = 0; j < 4; ++j) { const f32x4 w = ((const f32x4*)(norm_w + 2 * D))[lane + 64 * j], sc = ((const f32x4*)(mb + 3 * D))[lane + 64 * j], sh = ((const f32x4*)(mb + 4 * D))[lane + 64 * j];
            const f32x4 o = x1[j] * r * w * (1.f + sc) + sh;
            o8[64 * j] = (unsigned long long)pk2(o.x, o.y) | ((unsigned long long)pk2(o.z, o.w) << 32); } }
    grid.sync();
    { pg8::Gemm g{HL, W1, D, D, D}; pg8::StaticOrder S; S.init(NT, FF, G, bx); pg8::EpiBf16<3> E{H1, FF}; pg8::gemm_phase(lds, g, S, E); }
    grid.sync();
    { pg8::Gemm g{H1, W2, FF, FF, FF}; pg8::StaticOrder S; S.init(NT, D, G, bx); pg8::EpiBf16<0> E{MLP, D}; pg8::gemm_phase(lds, g, S, E); }
    grid.sync();
    for (int m = gw; m < NT; m += NGW) { const float* mb = MOD + (size_t)(m >> 12) * INC; f32x4 x1[4];
        row_x1(x + (size_t)m * D, MIX + (size_t)m * D, norm_w + D, mb + 2 * D, x1, lane);
        f32x4 mv[4]; float s = 0.f;
#pragma unroll
        for (int j = 0; j < 4; ++j) { mv[j] = ld_bf4(MLP + (size_t)m * D + 4 * lane + 256 * j); s += (mv[j].x * mv[j].x + mv[j].y * mv[j].y) + (mv[j].z * mv[j].z + mv[j].w * mv[j].w); }
        const float r = rsqrtf(wave_sum(s) * (1.f / D) + EPS);
#pragma unroll
        for (int j = 0; j < 4; ++j) { const f32x4 w = ((const f32x4*)(norm_w + 3 * D))[lane + 64 * j], g = ((const f32x4*)(mb + 5 * D))[lane + 64 * j];
            ((f32x4*)(P.out + (size_t)m * D))[lane + 64 * j] = x1[j] + g * (mv[j] * r * w); } }
}
}

extern "C" void kernel_launch(void* const* d_in, const int* in_sizes, int n_in, void* d_out, int out_size, void* d_ws, size_t ws_size, hipStream_t stream) {
    static int grid = 0;
    if (grid == 0) {
        if (n_in != 24 || ws_size < WS_END) { fprintf(stderr, "kernel_launch: unexpected n_in %d / ws_size %zu\n", n_in, ws_size); grid = -1; return; }
        int dev = 0, cus = 0, per_cu = 0;
        hipGetDevice(&dev); hipDeviceGetAttribute(&cus, hipDeviceAttributeMultiprocessorCount, dev);
        hipFuncSetAttribute((const void*)mega, hipFuncAttributeMaxDynamicSharedMemorySize, LDS_BYTES);
        hipOccupancyMaxActiveBlocksPerMultiprocessor(&per_cu, (const void*)mega, 512, LDS_BYTES);
        if (per_cu < 1) { fprintf(stderr, "kernel_launch: occupancy query says %d blocks per CU\n", per_cu); grid = -1; return; }
        grid = cus;
    }
    if (grid < 0) return;
    Params p{};
    for (int i = 0; i < 24; ++i) p.in[i] = (const float*)d_in[i];
    p.out = (float*)d_out; p.ws = (unsigned char*)d_ws;
    void* args[] = {&p};
    hipError_t e = hipLaunchCooperativeKernel((const void*)mega, dim3(grid), dim3(512), args, LDS_BYTES, stream);
    if (e != hipSuccess) fprintf(stderr, "cooperative launch failed: %s (grid %d)\n", hipGetErrorString(e), grid);
}
```

```cpp
#include <hip/hip_runtime.h>
#include <hip/hip_cooperative_groups.h>
#include <cstdio>
#include <math.h>
namespace cg = cooperative_groups;

namespace pg8 {
#define PG8_LAS __attribute__((address_space(3)))
typedef unsigned short bf16_t;
typedef short bf16x8 __attribute__((ext_vector_type(8)));
typedef float f32x4 __attribute__((ext_vector_type(4)));
typedef unsigned u32x4 __attribute__((ext_vector_type(4)));
typedef unsigned u32x2 __attribute__((ext_vector_type(2)));
constexpr int BM = 256, BK = 64, HALF = 128, HTB = HALF * BK * 2, STAGE_BYTES = 8 * HTB, NXCD = 8, WGM = 8;

__device__ __forceinline__ int lds_byte(int r, int c) { const int st = (r >> 4) * 2 + (c >> 5), rr = r & 15, cc = c & 31, ob = rr * 64 + cc * 2; return st * 1024 + (ob ^ (((ob >> 9) & 1) << 5)); }
__device__ __forceinline__ void stage_rc(int b, int& R, int& C) { const int st = b / 1024, sb = b % 1024, swz = sb ^ (((sb >> 9) & 1) << 5); R = (st >> 1) * 16 + swz / 64; C = (st & 1) * 32 + (swz % 64) / 2; }
__device__ __forceinline__ int perm32(int rho) { const int n = rho >> 4, i = rho & 15; return 8 * (i >> 2) + 4 * n + (i & 3); }

struct Unit { int pm, pn; };
struct Gemm { const bf16_t* A; const bf16_t* Bt; int lda, ldb, K; };

struct StaticOrder {
    int nM, nN, nwg, G, c;
    __device__ void init(int M, int N, int G_, int c_) { nM = M / BM; nN = N / BM; nwg = nM * nN; G = G_; c = c_; }
    __device__ bool next(int i, Unit& u) const {
        const long L = (long)i * G + c; if (L >= nwg) return false;
        int wgid = (int)L; { const int q = nwg / NXCD, r = nwg % NXCD, xcd = wgid % NXCD, off = wgid / NXCD; wgid = (xcd < r ? xcd * (q + 1) : r * (q + 1) + (xcd - r) * q) + off; }
        const int nig = WGM * nN, gid = wgid / nig, fm = gid * WGM, gsz = (nM - fm) < WGM ? (nM - fm) : WGM;
        u.pm = fm + ((wgid % nig) % gsz); u.pn = (wgid % nig) / gsz; return true;
    }
};

__device__ __forceinline__ unsigned cvt_pk_bf16(float lo, float hi) { unsigned r; asm volatile("v_cvt_pk_bf16_f32 %0, %1, %2" : "=v"(r) : "v"(lo), "v"(hi)); return r; }
__device__ __forceinline__ float sigm(float x) { return __builtin_amdgcn_rcpf(1.0f + __builtin_amdgcn_exp2f(-1.4426950408889634f * x)); }
__device__ __forceinline__ float bflo(unsigned u) { return __uint_as_float(u << 16); }
__device__ __forceinline__ float bfhi(unsigned u) { return __uint_as_float(u & 0xffff0000u); }

template <int ACT  > struct EpiBf16 {
    static constexpr bool PERM = true;
    bf16_t* O; int ldc;
    __device__ __forceinline__ void operator()(const f32x4 (&acc)[2][2][4][2], const Unit& u, int wr, int wc, int fr, int fq) const {
        const int row0 = u.pm * BM + wr * 64 + fr, col0 = u.pn * BM + wc * 32 + 8 * fq;
#pragma unroll
        for (int ai = 0; ai < 2; ++ai)
#pragma unroll
            for (int m = 0; m < 4; ++m) { bf16_t* rowp = O + (size_t)(row0 + ai * HALF + m * 16) * ldc + col0;
#pragma unroll
                for (int bj = 0; bj < 2; ++bj) { f32x4 v0 = acc[ai][bj][m][0], v1 = acc[ai][bj][m][1];
                    if (ACT == 3) {
#pragma unroll
                        for (int j = 0; j < 4; ++j) { const float a = fmaxf(v0[j], 0.f), b = fmaxf(v1[j], 0.f); v0[j] = a * a; v1[j] = b * b; } }
                    u32x4 w; w.x = cvt_pk_bf16(v0[0], v0[1]); w.y = cvt_pk_bf16(v0[2], v0[3]); w.z = cvt_pk_bf16(v1[0], v1[1]); w.w = cvt_pk_bf16(v1[2], v1[3]);
                    *(u32x4*)(rowp + bj * HALF) = w; } }
    }
};
struct EpiG1 {
    static constexpr bool PERM = true;
    bf16_t *PI, *PZ, *PQ, *PG, *GATES;
    __device__ __forceinline__ void operator()(const f32x4 (&acc)[2][2][4][2], const Unit& u, int wr, int wc, int fr, int fq) const {
        const int pn = u.pn; bf16_t* base; int ld, cb, act;
        if (pn < 2) { base = PI; ld = 512; cb = pn * 256; act = 0; }
        else if (pn < 6) { base = PZ; ld = 1024; cb = (pn - 2) * 256; act = 0; }
        else if (pn < 8) { base = PQ; ld = 512; cb = (pn - 6) * 256; act = 1; }
        else if (pn < 10) { base = PG; ld = 512; cb = (pn - 8) * 256; act = 1; }
        else { base = GATES; ld = 2048; cb = (pn - 10) * 256; act = 2; }
        const int row0 = u.pm * BM + wr * 64 + fr, col0 = cb + wc * 32 + 8 * fq;
#pragma unroll
        for (int ai = 0; ai < 2; ++ai)
#pragma unroll
            for (int m = 0; m < 4; ++m) { bf16_t* rowp = base + (size_t)(row0 + ai * HALF + m * 16) * ld + col0;
#pragma unroll
                for (int bj = 0; bj < 2; ++bj) { f32x4 v0 = acc[ai][bj][m][0], v1 = acc[ai][bj][m][1];
                    if (act != 0) {
#pragma unroll
                        for (int j = 0; j < 4; ++j) { const float s0 = sigm(v0[j]), s1 = sigm(v1[j]); v0[j] = act == 1 ? v0[j] * s0 : s0; v1[j] = act == 1 ? v1[j] * s1 : s1; } }
                    u32x4 w; w.x = cvt_pk_bf16(v0[0], v0[1]); w.y = cvt_pk_bf16(v0[2], v0[3]); w.z = cvt_pk_bf16(v1[0], v1[1]); w.w = cvt_pk_bf16(v1[2], v1[3]);
                    *(u32x4*)(rowp + bj * HALF) = w; } }
    }
};
template <int PASS> struct EpiMerge {
    static constexpr bool PERM = true;
    bf16_t* O; const bf16_t* GATES; int goff;
    __device__ __forceinline__ void operator()(const f32x4 (&acc)[2][2][4][2], const Unit& u, int wr, int wc, int fr, int fq) const {
        const int row0 = u.pm * BM + wr * 64 + fr, col0 = u.pn * BM + wc * 32 + 8 * fq;
#pragma unroll
        for (int ai = 0; ai < 2; ++ai)
#pragma unroll
            for (int m = 0; m < 4; ++m) { const size_t r = (size_t)(row0 + ai * HALF + m * 16);
#pragma unroll
                for (int bj = 0; bj < 2; ++bj) { f32x4 v0 = acc[ai][bj][m][0], v1 = acc[ai][bj][m][1];
                    const u32x4 g = *(const u32x4*)(GATES + r * 2048 + goff + col0 + bj * HALF);
                    v0[0] *= bflo(g.x); v0[1] *= bfhi(g.x); v0[2] *= bflo(g.y); v0[3] *= bfhi(g.y); v1[0] *= bflo(g.z); v1[1] *= bfhi(g.z); v1[2] *= bflo(g.w); v1[3] *= bfhi(g.w);
                    bf16_t* op = O + r * 1024 + col0 + bj * HALF;
                    if (PASS == 1) { const u32x4 o = *(const u32x4*)op;
                        v0[0] += bflo(o.x); v0[1] += bfhi(o.x); v0[2] += bflo(o.y); v0[3] += bfhi(o.y); v1[0] += bflo(o.z); v1[1] += bfhi(o.z); v1[2] += bflo(o.w); v1[3] += bfhi(o.w); }
                    u32x4 w; w.x = cvt_pk_bf16(v0[0], v0[1]); w.y = cvt_pk_bf16(v0[2], v0[3]); w.z = cvt_pk_bf16(v1[0], v1[1]); w.w = cvt_pk_bf16(v1[2], v1[3]);
                    *(u32x4*)op = w; } }
    }
};

template <class Epi, class Sched>
__device__ __forceinline__ void gemm_phase(PG8_LAS unsigned char* lds, const Gemm g, const Sched& S, const Epi& E) {
    const int tid = threadIdx.x, wid = __builtin_amdgcn_readfirstlane(tid >> 6), lane = tid & 63, wr = wid >> 2, wc = wid & 3, fr = lane & 15, fq = lane >> 4;
    const int nt = g.K / BK;
    unsigned voffA[2], voffB[2];
#pragma unroll
    for (int i = 0; i < 2; ++i) { int R, C; stage_rc(tid * 16 + i * 8192, R, C); const int Rb = Epi::PERM ? ((R & ~31) + perm32(R & 31)) : R;
        voffA[i] = (unsigned)(R * g.lda + C) * 2u; voffB[i] = (unsigned)(Rb * g.ldb + C) * 2u; }
    const size_t kstep = (size_t)(BK * 2);
    const size_t hstepA = (size_t)HALF * g.lda * 2, hstepB = (size_t)HALF * g.ldb * 2;
    const size_t tstepA = 2 * hstepA, tstepB = 2 * hstepB;
    const unsigned ldsw = (unsigned)wid * 1024u;
    const int aoff = lds_byte(wr * 64 + fr, fq * 8), boff = lds_byte(wc * 32 + fr, fq * 8);
#define PG8_SA(b, h) (((b) * 2 + (h)) * HTB)
#define PG8_SB(b, h) ((4 + (b) * 2 + (h)) * HTB)
#define PG8_STAGE(bufoff, gbase, voff) do { _Pragma("unroll") for (int _i = 0; _i < 2; ++_i) \
        __builtin_amdgcn_global_load_lds((const unsigned*)((const char*)(gbase) + (voff)[_i]), (PG8_LAS unsigned*)(lds + (bufoff) + ldsw + _i * 8192), 16, 0, 0); } while (0)
#define PG8_LDA(dst, b, h) do { _Pragma("unroll") for (int m = 0; m < 4; ++m) _Pragma("unroll") for (int k = 0; k < 2; ++k) dst[m][k] = *(const PG8_LAS bf16x8*)(lds + PG8_SA(b, h) + aoff + m * 2048 + k * 1024); } while (0)
#define PG8_LDB(dst, b, h) do { _Pragma("unroll") for (int n = 0; n < 2; ++n) _Pragma("unroll") for (int k = 0; k < 2; ++k) dst[n][k] = *(const PG8_LAS bf16x8*)(lds + PG8_SB(b, h) + boff + n * 2048 + k * 1024); } while (0)
#define PG8_MMA(ai, bj, At, Bt) do { __builtin_amdgcn_s_setprio(1); _Pragma("unroll") for (int m = 0; m < 4; ++m) _Pragma("unroll") for (int n = 0; n < 2; ++n) _Pragma("unroll") for (int k = 0; k < 2; ++k) \
        acc[ai][bj][m][n] = __builtin_amdgcn_mfma_f32_16x16x32_bf16(Bt[n][k], At[m][k], acc[ai][bj][m][n], 0, 0, 0); __builtin_amdgcn_s_setprio(0); } while (0)
#define PG8_WAIT_V(n) asm volatile("s_waitcnt vmcnt(" #n ")" ::: "memory")
#define PG8_WAIT_L(n) asm volatile("s_waitcnt lgkmcnt(" #n ")" ::: "memory")
#define PG8_BAR __builtin_amdgcn_s_barrier()
#define PG8_SCHED __builtin_amdgcn_sched_barrier(0)
    Unit cur, nxt; int ui = 0;
    if (!S.next(0, cur)) return;
    f32x4 acc[2][2][4][2];
#pragma unroll
    for (int a = 0; a < 2; ++a)
#pragma unroll
        for (int b = 0; b < 2; ++b)
#pragma unroll
            for (int m = 0; m < 4; ++m)
#pragma unroll
                for (int n = 0; n < 2; ++n) acc[a][b][m][n] = (f32x4){0.f, 0.f, 0.f, 0.f};
    bf16x8 At[4][2], B0[2][2], B1[2][2];
    const char* cA = (const char*)g.A + (size_t)cur.pm * tstepA; const char* cB = (const char*)g.Bt + (size_t)cur.pn * tstepB;
    PG8_STAGE(PG8_SB(0, 0), cB, voffB); PG8_STAGE(PG8_SA(0, 0), cA, voffA); PG8_STAGE(PG8_SB(0, 1), cB + hstepB, voffB); PG8_STAGE(PG8_SA(0, 1), cA + hstepA, voffA);
    if (wr == 1) PG8_BAR;
    PG8_WAIT_V(4); PG8_BAR;
    PG8_STAGE(PG8_SB(1, 0), cB + kstep, voffB); PG8_STAGE(PG8_SA(1, 0), cA + kstep, voffA); PG8_STAGE(PG8_SB(1, 1), cB + hstepB + kstep, voffB);
    PG8_WAIT_V(6); PG8_BAR;
    for (;;) {
        const bool has_next = S.next(ui + 1, nxt);
        const char* nA = has_next ? (const char*)g.A + (size_t)nxt.pm * tstepA : cA; const char* nB = has_next ? (const char*)g.Bt + (size_t)nxt.pn * tstepB : cB;
        for (int t = 0; t < nt; t += 2) {
            const bool last = (t == nt - 2);
            const char* a1 = cA + (size_t)(t + 1) * kstep;
            const char* a2 = last ? nA : cA + (size_t)(t + 2) * kstep; const char* b2 = last ? nB : cB + (size_t)(t + 2) * kstep;
            const char* a3 = a2 + kstep; const char* b3 = b2 + kstep;
            PG8_LDB(B0, 0, 0); PG8_SCHED; PG8_LDA(At, 0, 0); PG8_STAGE(PG8_SA(1, 1), a1 + hstepA, voffA);
            PG8_WAIT_L(8); PG8_BAR; PG8_WAIT_L(0); PG8_MMA(0, 0, At, B0); PG8_BAR; PG8_SCHED;
            PG8_LDB(B1, 0, 1); PG8_STAGE(PG8_SB(0, 0), b2, voffB);
            PG8_BAR; PG8_WAIT_L(0); PG8_MMA(0, 1, At, B1); PG8_BAR;
            PG8_LDA(At, 0, 1); PG8_STAGE(PG8_SA(0, 0), a2, voffA);
            PG8_BAR; PG8_WAIT_L(0); PG8_MMA(1, 0, At, B0); PG8_BAR; PG8_SCHED;
            PG8_STAGE(PG8_SB(0, 1), b2 + hstepB, voffB);
            PG8_WAIT_V(6); PG8_BAR; PG8_MMA(1, 1, At, B1); PG8_BAR;
            PG8_LDB(B0, 1, 0); PG8_SCHED; PG8_LDA(At, 1, 0); PG8_STAGE(PG8_SA(0, 1), a2 + hstepA, voffA);
            PG8_WAIT_L(8); PG8_BAR; PG8_WAIT_L(0); PG8_MMA(0, 0, At, B0); PG8_BAR; PG8_SCHED;
            PG8_LDB(B1, 1, 1); PG8_STAGE(PG8_SB(1, 0), b3, voffB);
            PG8_BAR; PG8_WAIT_L(0); PG8_MMA(0, 1, At, B1); PG8_BAR;
            PG8_LDA(At, 1, 1); PG8_STAGE(PG8_SA(1, 0), a3, voffA);
            PG8_BAR; PG8_WAIT_L(0); PG8_MMA(1, 0, At, B0); PG8_BAR; PG8_SCHED;
            PG8_STAGE(PG8_SB(1, 1), b3 + hstepB, voffB);
            PG8_WAIT_V(6); PG8_BAR; PG8_MMA(1, 1, At, B1); PG8_BAR;
        }
        E(acc, cur, wr, wc, fr, fq);
        if (!has_next) break;
#pragma unroll
        for (int a = 0; a < 2; ++a)
#pragma unroll
            for (int b = 0; b < 2; ++b)
#pragma unroll
                for (int m = 0; m < 4; ++m)
#pragma unroll
                    for (int n = 0; n < 2; ++n) acc[a][b][m][n] = (f32x4){0.f, 0.f, 0.f, 0.f};
        cur = nxt; cA = nA; cB = nB; ++ui;
    }
    PG8_WAIT_V(0);
    if (wr == 0) PG8_BAR;
    PG8_BAR;
#undef PG8_SA
#undef PG8_SB
#undef PG8_STAGE
#undef PG8_LDA
#undef PG8_LDB
#undef PG8_MMA
#undef PG8_WAIT_V
#undef PG8_WAIT_L
#undef PG8_BAR
#undef PG8_SCHED
}
}

namespace {
using pg8::bf16_t; using pg8::f32x4; using pg8::u32x4; using pg8::u32x2;
#define LAS __attribute__((address_space(3)))
constexpr int D = 1024, NB = 8, L = 4096, LC = 256, INC = 6144, FF = 4096, HW = 512;
constexpr int NT = NB * L, NCX = NB * LC;
constexpr float EPS = 1e-6f;
constexpr size_t MiB = 1u << 20;
constexpr size_t WS_MOD = 64 * 1024, WS_LB = 512 * 1024, WS_GT = 2 * MiB  ;
constexpr size_t WS_WIN = 18 * MiB, WS_WPAB = 30 * MiB, WS_WOUT = 32 * MiB, WS_W1 = 34 * MiB, WS_W2 = 42 * MiB;
constexpr size_t WS_HCTX = 50 * MiB, WS_PCTX = 54 * MiB, WS_SCTX = 60 * MiB;
constexpr size_t WS_HLAT = 64 * MiB;
constexpr size_t WS_PI = 128 * MiB, WS_PZ = 160 * MiB, WS_PQ = 224 * MiB, WS_PG = 256 * MiB, WS_GATES = 288 * MiB, WS_PHYT = 416 * MiB;
constexpr size_t WS_AY = 160 * MiB;
constexpr size_t WS_AY2 = 64 * MiB;
constexpr size_t WS_MERGED = 128 * MiB;
constexpr size_t WS_MIX = 448 * MiB, WS_MLP = 384 * MiB, WS_H1 = 128 * MiB, WS_HL = 64 * MiB;
constexpr size_t WS_END = 512 * MiB;
constexpr int LDS_BYTES = 147456;

__device__ __forceinline__ float bf2f(bf16_t h) { return __uint_as_float(((unsigned)h) << 16); }
__device__ __forceinline__ unsigned f2bf(float f) { unsigned u = __float_as_uint(f); return (u + 0x7fffu + ((u >> 16) & 1u)) >> 16; }
__device__ __forceinline__ unsigned pk2(float lo, float hi) { return f2bf(lo) | (f2bf(hi) << 16); }
__device__ __forceinline__ float sigmoidf_(float x) { return 1.f / (1.f + expf(-x)); }
__device__ __forceinline__ float siluf_(float x) { return x / (1.f + expf(-x)); }
__device__ __forceinline__ float wave_sum(float v) {
#pragma unroll
    for (int o = 1; o < 64; o <<= 1) v += __shfl_xor(v, o);
    return v;
}
#define LDS_WAIT() asm volatile("s_waitcnt lgkmcnt(0)" ::: "memory")

struct Params { const float* in[24]; float* out; unsigned char* ws; };

__device__ __forceinline__ void transpose_item(const float* W, int N, bf16_t* WT, int ldk, int koff, int remap, LAS float* scr, int item, int lane) {
    const int nblk = N / 32, kb = item / nblk, nb = item % nblk, k0 = 64 * kb, n0 = 32 * nb;
    int rbase = n0;
    if (remap) rbase = n0 < 2560 ? n0 : (n0 < 4096 ? n0 + 2048 : n0 - 1536);
#pragma unroll 8
    for (int i = 0; i < 32; ++i) { const int kk = 2 * i + (lane >> 5); scr[kk * 33 + (lane & 31)] = W[(size_t)(k0 + kk) * N + n0 + (lane & 31)]; }
    LDS_WAIT();
    const int c = lane & 7;
#pragma unroll
    for (int j = 0; j < 4; ++j) { const int n = (lane >> 3) + 8 * j; const LAS float* s = scr + (8 * c) * 33 + n;
        u32x4 o; o.x = pk2(s[0 * 33], s[1 * 33]); o.y = pk2(s[2 * 33], s[3 * 33]); o.z = pk2(s[4 * 33], s[5 * 33]); o.w = pk2(s[6 * 33], s[7 * 33]);
        *(u32x4*)(WT + (size_t)(rbase + n) * ldk + koff + k0 + 8 * c) = o; }
    LDS_WAIT();
}

__device__ __forceinline__ void row_norm_mod_bf16(const float* xrow, const float* nw, const float* scale, const float* shift, bf16_t* orow, int lane) {
    const f32x4* xr = (const f32x4*)xrow + lane; f32x4 v[4]; float s = 0.f;
#pragma unroll
    for (int j = 0; j < 4; ++j) { v[j] = xr[64 * j]; s += (v[j].x * v[j].x + v[j].y * v[j].y) + (v[j].z * v[j].z + v[j].w * v[j].w); }
    const float r = rsqrtf(wave_sum(s) * (1.f / D) + EPS);
    unsigned long long* o8 = (unsigned long long*)orow + lane;
#pragma unroll
    for (int j = 0; j < 4; ++j) { const f32x4 w = ((const f32x4*)nw)[lane + 64 * j], sc = ((const f32x4*)scale)[lane + 64 * j], sh = ((const f32x4*)shift)[lane + 64 * j];
        const f32x4 o = v[j] * r * w * (1.f + sc) + sh;
        o8[64 * j] = (unsigned long long)pk2(o.x, o.y) | ((unsigned long long)pk2(o.z, o.w) << 32); }
}
__device__ __forceinline__ f32x4 ld_bf4(const bf16_t* p) { const u32x2 u = *(const u32x2*)p; return (f32x4){pg8::bflo(u.x), pg8::bfhi(u.x), pg8::bflo(u.y), pg8::bfhi(u.y)}; }
__device__ __forceinline__ void row_x1(const float* xrow, const bf16_t* mixrow, const float* nw1, const float* g2, f32x4 (&x1)[4], int lane) {
    f32x4 mv[4]; float s = 0.f;
#pragma unroll
    for (int j = 0; j < 4; ++j) { mv[j] = ld_bf4(mixrow + 4 * lane + 256 * j); s += (mv[j].x * mv[j].x + mv[j].y * mv[j].y) + (mv[j].z * mv[j].z + mv[j].w * mv[j].w); }
    const float r = rsqrtf(wave_sum(s) * (1.f / D) + EPS);
#pragma unroll
    for (int j = 0; j < 4; ++j) { const f32x4 w = ((const f32x4*)nw1)[lane + 64 * j], g = ((const f32x4*)g2)[lane + 64 * j], xv = ((const f32x4*)xrow)[lane + 64 * j];
        x1[j] = xv + g * (mv[j] * r * w); }
}

__device__ __forceinline__ void hgrn_chain(LAS float* sm, const bf16_t* pi, int ldi, const bf16_t* pz, int ldz, const bf16_t* pq, int ldq, int Lseq, int h, int dir,
                                           const float* lb, const float* s_in, float* s_out, float* o_out) {
    const int tid = threadIdx.x, v = tid & 127, dg = tid >> 7;
    LAS float* fb = sm; LAS float* qb = sm + 1024; LAS float* vb = sm + 2048; LAS float* pb = sm + 3072;
    float S[32];
#pragma unroll
    for (int i = 0; i < 32; ++i) S[i] = s_in ? s_in[(size_t)(dg * 32 + i) * 128 + v] : 0.f;
    for (int t0 = 0; t0 < Lseq; t0 += 8) {
        for (int e = tid; e < 8 * 128; e += 512) {
            const int tt = e >> 7, dd = e & 127; const int t = dir ? (Lseq - 1 - (t0 + tt)) : (t0 + tt); const int col = h * 128 + dd;
            const float z = bf2f(pz[(size_t)t * ldz + col]); const float lbv = lb[col];
            fb[e] = lbv + (1.f - lbv) * sigmoidf_(z);
            qb[e] = pq ? bf2f(pq[(size_t)t * ldq + col]) : 0.f;
            vb[e] = bf2f(pi[(size_t)t * ldi + col]);
        }
        __syncthreads();
#pragma unroll 1
        for (int tt = 0; tt < 8; ++tt) {
            const float vv = vb[tt * 128 + v]; float part = 0.f;
#pragma unroll
            for (int i = 0; i < 32; ++i) { const float f = fb[tt * 128 + dg * 32 + i]; S[i] = f * S[i] + (1.f - f) * vv; part += S[i] * qb[tt * 128 + dg * 32 + i]; }
            pb[(tt * 4 + dg) * 128 + v] = part;
        }
        __syncthreads();
        if (o_out) for (int e = tid; e < 8 * 128; e += 512) {
            const int tt = e >> 7, vv = e & 127; const int t = dir ? (Lseq - 1 - (t0 + tt)) : (t0 + tt);
            o_out[(size_t)t * HW + h * 128 + vv] = pb[(tt * 4 + 0) * 128 + vv] + pb[(tt * 4 + 1) * 128 + vv] + pb[(tt * 4 + 2) * 128 + vv] + pb[(tt * 4 + 3) * 128 + vv];
        }
        __syncthreads();
    }
    if (s_out) {
#pragma unroll
        for (int i = 0; i < 32; ++i) s_out[(size_t)(dg * 32 + i) * 128 + v] = S[i];
    }
}


typedef float f32x16 __attribute__((ext_vector_type(16)));
typedef float f32x2_t __attribute__((ext_vector_type(2)));
typedef __bf16 bf16x2_t __attribute__((ext_vector_type(2)));
__device__ __forceinline__ unsigned cvtpk(float lo, float hi) { const f32x2_t v = {lo, hi}; const bf16x2_t b = __builtin_convertvector(v, bf16x2_t); return __builtin_bit_cast(unsigned, b); }
constexpr int HY_PITCH = 8720;
constexpr int HY_TAB0 = 8 * HY_PITCH;
constexpr int HY_TAB1 = HY_TAB0 + 17408 + 64;
__device__ __forceinline__ void conv8(const u32x4 raw, float left, float right, float w0, float w1, float w2, float bias, float (&o)[8]) {
    float in[10]; in[0] = left; in[9] = right;
    in[1] = pg8::bflo(raw.x); in[2] = pg8::bfhi(raw.x); in[3] = pg8::bflo(raw.y); in[4] = pg8::bfhi(raw.y); in[5] = pg8::bflo(raw.z); in[6] = pg8::bfhi(raw.z); in[7] = pg8::bflo(raw.w); in[8] = pg8::bfhi(raw.w);
#pragma unroll
    for (int j = 0; j < 8; ++j) o[j] = bias + w0 * in[j] + w1 * in[j + 1] + w2 * in[j + 2];
}
__device__ __forceinline__ void hyena_channel(LAS unsigned char* lds, int c, bf16_t* PHYT, const bf16_t* GTB, const float* hy_sw, const float* hy_sb) {
    const int tid = threadIdx.x, lane = tid & 63, wave = __builtin_amdgcn_readfirstlane(tid >> 6);
    __syncthreads();
    for (int ci = tid; ci < 1088; ci += 512) { u32x4 v = (u32x4){0u, 0u, 0u, 0u};
        if (ci >= 32 && ci < 1056) v = *(const u32x4*)(GTB + (size_t)c * 8192 + (ci - 32) * 8);
        *(LAS u32x4*)(lds + HY_TAB0 + ci * 16) = v; }
    {
        const bf16_t* x1r = PHYT + (size_t)(512 + c) * NT; const bf16_t* vr = PHYT + (size_t)(1024 + c) * NT;
        const float xw0 = hy_sw[512 + c], xw1 = hy_sw[1536 + 512 + c], xw2 = hy_sw[3072 + 512 + c], xb = hy_sb[512 + c];
        const float vw0 = hy_sw[1024 + c], vw1 = hy_sw[1536 + 1024 + c], vw2 = hy_sw[3072 + 1024 + c], vb = hy_sb[1024 + c];
        for (int q = tid; q < 4096; q += 512) { const int b = q >> 9, s8 = (q & 511) * 8; const size_t o = (size_t)b * L + s8;
            const u32x4 xa = *(const u32x4*)(x1r + o), va = *(const u32x4*)(vr + o);
            const bool hl = (s8 & 63) != 0, hr = ((s8 + 8) & 63) != 0;
            const float xl = hl ? bf2f(x1r[o - 1]) : 0.f, xr = hr ? bf2f(x1r[o + 8]) : 0.f, vl = hl ? bf2f(vr[o - 1]) : 0.f, vrr = hr ? bf2f(vr[o + 8]) : 0.f;
            float cx[8], cv[8]; conv8(xa, xl, xr, xw0, xw1, xw2, xb, cx); conv8(va, vl, vrr, vw0, vw1, vw2, vb, cv);
            u32x4 w; w.x = cvtpk(cx[0] * cv[0], cx[1] * cv[1]); w.y = cvtpk(cx[2] * cv[2], cx[3] * cv[3]); w.z = cvtpk(cx[4] * cv[4], cx[5] * cv[5]); w.w = cvtpk(cx[6] * cv[6], cx[7] * cv[7]);
            *(LAS u32x4*)(lds + b * HY_PITCH + (128 + s8) * 2) = w; }
        if (tid < 256) { const int b = tid >> 5, side = (tid >> 4) & 1, k = tid & 15;
            *(LAS u32x4*)(lds + b * HY_PITCH + (side ? (128 + 4096) * 2 : 0) + k * 16) = (u32x4){0u, 0u, 0u, 0u}; }
    }
    __syncthreads();
    for (int ci = tid; ci < 1088; ci += 512) { const u32x4 d = *(const LAS u32x4*)(lds + HY_TAB0 + ci * 16); const unsigned d4 = ci < 1087 ? *(const LAS unsigned*)(lds + HY_TAB0 + ci * 16 + 16) : 0u;
        u32x4 o; o.x = __builtin_amdgcn_alignbit(d.y, d.x, 16); o.y = __builtin_amdgcn_alignbit(d.z, d.y, 16); o.z = __builtin_amdgcn_alignbit(d.w, d.z, 16); o.w = __builtin_amdgcn_alignbit(d4, d.w, 16);
        *(LAS u32x4*)(lds + HY_TAB1 + ci * 16) = o; }
    __syncthreads();
    const int T0 = 512 * wave, r = lane & 31, h = lane >> 5, bb = r >> 2, tb = r & 3;
    f32x16 acc[4];
#pragma unroll
    for (int i = 0; i < 4; ++i)
#pragma unroll
        for (int j = 0; j < 16; ++j) acc[i][j] = 0.f;
    {
        const int Dfirst = T0 - 4080;
        const int e0 = 4351 - Dfirst - r + 8 * h;
        unsigned aaddr = (unsigned)((e0 & 1) ? HY_TAB1 : HY_TAB0) + (unsigned)(e0 & ~1) * 2u;
        unsigned baddr = (unsigned)(bb * HY_PITCH + (128 + T0 + 32 * tb - Dfirst + 8 * h) * 2);
#define HY_LDA(dst, ad) do { u32x4 _t; _t.x = *(const LAS unsigned*)(lds + (ad)); _t.y = *(const LAS unsigned*)(lds + (ad) + 4); _t.z = *(const LAS unsigned*)(lds + (ad) + 8); _t.w = *(const LAS unsigned*)(lds + (ad) + 12); dst = __builtin_bit_cast(pg8::bf16x8, _t); } while (0)
#define HY_LDB(dst, ad) dst = *(const LAS pg8::bf16x8*)(lds + (ad))
        pg8::bf16x8 A, B0, B1, B2, B3;
        const pg8::bf16x8 zz = (pg8::bf16x8){0, 0, 0, 0, 0, 0, 0, 0};
        HY_LDA(A, aaddr); HY_LDB(B0, baddr); B1 = zz; B2 = zz; B3 = zz;
        for (int st = 0; st < 286; ++st) {
            const int d = -4080 + 16 * st, dn = d + 16;
            pg8::bf16x8 An, B0n = zz, B1n = zz, B2n = zz, B3n = zz;
            const unsigned an = aaddr - 32u, bn = baddr - 32u;
            HY_LDA(An, an);
            if (dn <= 96) HY_LDB(B0n, bn);
            if (dn >= -3952 && dn <= 224) HY_LDB(B1n, bn + 256);
            if (dn >= -3824 && dn <= 352) HY_LDB(B2n, bn + 512);
            if (dn >= -3696 && dn <= 480) HY_LDB(B3n, bn + 768);
            if (d <= 96) acc[0] = __builtin_amdgcn_mfma_f32_32x32x16_bf16(A, B0, acc[0], 0, 0, 0);
            if (d >= -3952 && d <= 224) acc[1] = __builtin_amdgcn_mfma_f32_32x32x16_bf16(A, B1, acc[1], 0, 0, 0);
            if (d >= -3824 && d <= 352) acc[2] = __builtin_amdgcn_mfma_f32_32x32x16_bf16(A, B2, acc[2], 0, 0, 0);
            if (d >= -3696) acc[3] = __builtin_amdgcn_mfma_f32_32x32x16_bf16(A, B3, acc[3], 0, 0, 0);
            A = An; B0 = B0n; B1 = B1n; B2 = B2n; B3 = B3n; aaddr = an; baddr = bn;
        }
#undef HY_LDA
#undef HY_LDB
    }
    __syncthreads();
#pragma unroll
    for (int i = 0; i < 4; ++i)
#pragma unroll
        for (int g = 0; g < 4; ++g) { const int t = T0 + 128 * i + 32 * tb + 8 * g + 4 * h;
            pg8::u32x2 w; w.x = cvtpk(acc[i][4 * g], acc[i][4 * g + 1]); w.y = cvtpk(acc[i][4 * g + 2], acc[i][4 * g + 3]);
            *(LAS pg8::u32x2*)(lds + bb * HY_PITCH + (128 + t) * 2) = w; }
    __syncthreads();
    {
        const bf16_t* x0r = PHYT + (size_t)c * NT; bf16_t* yr = PHYT + (size_t)(1024 + c) * NT;
        const float w0 = hy_sw[c], w1 = hy_sw[1536 + c], w2 = hy_sw[3072 + c], bs = hy_sb[c];
        for (int q = tid; q < 4096; q += 512) { const int b = q >> 9, s8 = (q & 511) * 8; const size_t o = (size_t)b * L + s8;
            const u32x4 xa = *(const u32x4*)(x0r + o);
            const bool hl = (s8 & 63) != 0, hr = ((s8 + 8) & 63) != 0;
            const float xl = hl ? bf2f(x0r[o - 1]) : 0.f, xr = hr ? bf2f(x0r[o + 8]) : 0.f;
            float cx[8]; conv8(xa, xl, xr, w0, w1, w2, bs, cx);
            const u32x4 y = *(const LAS u32x4*)(lds + b * HY_PITCH + (128 + s8) * 2);
            u32x4 w; w.x = cvtpk(cx[0] * pg8::bflo(y.x), cx[1] * pg8::bfhi(y.x)); w.y = cvtpk(cx[2] * pg8::bflo(y.y), cx[3] * pg8::bfhi(y.y));
            w.z = cvtpk(cx[4] * pg8::bflo(y.z), cx[5] * pg8::bfhi(y.z)); w.w = cvtpk(cx[6] * pg8::bflo(y.w), cx[7] * pg8::bfhi(y.w));
            *(u32x4*)(yr + o) = w; }
    }
}


constexpr int HG_QE = 0, HG_KE = 17408, HG_KDT = 34816, HG_VT = 53248, HG_SC = 71680, HG_DEC = 80896, HG_SEG = 81408;
template <bool HAS_Q>
__device__ __forceinline__ void hgrn_chain_mfma(LAS unsigned char* lds, const bf16_t* pi, int ldi, const bf16_t* pz, int ldz, const bf16_t* pq, int ldq, int Lseq, int h, int dir,
                                                const float* lb, const float* s_in, float* s_out, float* o_out) {
    const int tid = threadIdx.x, lane = tid & 63, wave = __builtin_amdgcn_readfirstlane(tid >> 6);
    const int dp = lane, cs = wave, fr = lane & 15, kg = lane >> 4;
    const float lb0 = lb[h * 128 + 2 * dp], lb1 = lb[h * 128 + 2 * dp + 1];
    f32x4 S[8];
#pragma unroll
    for (int blk = 0; blk < 8; ++blk)
#pragma unroll
        for (int r = 0; r < 4; ++r) S[blk][r] = s_in ? s_in[(size_t)(16 * blk + 4 * kg + r) * 128 + 16 * wave + fr] : 0.f;
    const int nch = Lseq / 64;
    unsigned zr[8], qr[8], vr[8];
#define HG_LOAD(n) do { const int _base = dir ? (Lseq - 64 * ((n) + 1)) : 64 * (n); _Pragma("unroll") for (int i = 0; i < 8; ++i) { const int _cp = 8 * cs + i; const int _t = _base + (dir ? 63 - _cp : _cp); \
        zr[i] = *(const unsigned*)(pz + (size_t)_t * ldz + h * 128 + 2 * dp); vr[i] = *(const unsigned*)(pi + (size_t)_t * ldi + h * 128 + 2 * dp); \
        if (HAS_Q) qr[i] = *(const unsigned*)(pq + (size_t)_t * ldq + h * 128 + 2 * dp); } } while (0)
    HG_LOAD(0);
    __syncthreads();
    for (int n = 0; n < nch; ++n) {
        float F0[8], F1[8], k0[8], k1[8];
        {
            float p0 = 1.f, p1 = 1.f;
#pragma unroll
            for (int i = 0; i < 8; ++i) { const float f0 = lb0 + (1.f - lb0) * pg8::sigm(pg8::bflo(zr[i])), f1 = lb1 + (1.f - lb1) * pg8::sigm(pg8::bfhi(zr[i]));
                k0[i] = 1.f - f0; k1[i] = 1.f - f1; p0 *= f0; p1 *= f1; F0[i] = p0; F1[i] = p1; }
            *(LAS f32x2_t*)(lds + HG_SEG + (cs * 128 + 2 * dp) * 4) = (f32x2_t){p0, p1};
        }
        __syncthreads();
        {
            u32x4 lo, hi;
            lo.x = (vr[0] & 0xffffu) | (vr[1] << 16); lo.y = (vr[2] & 0xffffu) | (vr[3] << 16); lo.z = (vr[4] & 0xffffu) | (vr[5] << 16); lo.w = (vr[6] & 0xffffu) | (vr[7] << 16);
            hi.x = (vr[0] >> 16) | (vr[1] & 0xffff0000u); hi.y = (vr[2] >> 16) | (vr[3] & 0xffff0000u); hi.z = (vr[4] >> 16) | (vr[5] & 0xffff0000u); hi.w = (vr[6] >> 16) | (vr[7] & 0xffff0000u);
            *(LAS u32x4*)(lds + HG_VT + (2 * dp) * 144 + 16 * cs) = lo; *(LAS u32x4*)(lds + HG_VT + (2 * dp + 1) * 144 + 16 * cs) = hi;
        }
        {
            float pre0 = 1.f, pre1 = 1.f, fl0 = 1.f, fl1 = 1.f;
#pragma unroll
            for (int s = 0; s < 8; ++s) { const f32x2_t t = *(const LAS f32x2_t*)(lds + HG_SEG + (s * 128 + 2 * dp) * 4); fl0 *= t.x; fl1 *= t.y; if (s < cs) { pre0 *= t.x; pre1 *= t.y; } }
            if (cs == 0) *(LAS f32x2_t*)(lds + HG_DEC + 2 * dp * 4) = (f32x2_t){fl0, fl1};
            unsigned kd0[8], kd1[8];
#pragma unroll
            for (int i = 0; i < 8; ++i) { const float Fa = F0[i] * pre0, Fb = F1[i] * pre1; const float ia = __builtin_amdgcn_rcpf(Fa), ib = __builtin_amdgcn_rcpf(Fb);
                const float kea = k0[i] * ia, keb = k1[i] * ib; const int cp = 8 * cs + i;
                if (HAS_Q) { *(LAS unsigned*)(lds + HG_QE + cp * 272 + 4 * dp) = cvtpk(pg8::bflo(qr[i]) * Fa, pg8::bfhi(qr[i]) * Fb);
                             *(LAS unsigned*)(lds + HG_KE + cp * 272 + 4 * dp) = cvtpk(kea, keb); }
                kd0[i] = __float_as_uint(kea * fl0); kd1[i] = __float_as_uint(keb * fl1); }
            u32x4 a, b;
            a.x = cvtpk(__uint_as_float(kd0[0]), __uint_as_float(kd0[1])); a.y = cvtpk(__uint_as_float(kd0[2]), __uint_as_float(kd0[3])); a.z = cvtpk(__uint_as_float(kd0[4]), __uint_as_float(kd0[5])); a.w = cvtpk(__uint_as_float(kd0[6]), __uint_as_float(kd0[7]));
            b.x = cvtpk(__uint_as_float(kd1[0]), __uint_as_float(kd1[1])); b.y = cvtpk(__uint_as_float(kd1[2]), __uint_as_float(kd1[3])); b.z = cvtpk(__uint_as_float(kd1[4]), __uint_as_float(kd1[5])); b.w = cvtpk(__uint_as_float(kd1[6]), __uint_as_float(kd1[7]));
            *(LAS u32x4*)(lds + HG_KDT + (2 * dp) * 144 + 16 * cs) = a; *(LAS u32x4*)(lds + HG_KDT + (2 * dp + 1) * 144 + 16 * cs) = b;
        }
        if (n + 1 < nch) HG_LOAD(n + 1);
        __syncthreads();
        if (HAS_Q) {
            const int cb = wave >> 1;
#pragma unroll
            for (int u = 0; u < 2; ++u) { const int sb = 2 * (wave & 1) + u; f32x4 sc = (f32x4){0.f, 0.f, 0.f, 0.f};
                if (sb <= cb) {
#pragma unroll
                    for (int ks = 0; ks < 4; ++ks) { const pg8::bf16x8 A = *(const LAS pg8::bf16x8*)(lds + HG_QE + (16 * cb + fr) * 272 + (32 * ks + 8 * kg) * 2);
                        const pg8::bf16x8 B = *(const LAS pg8::bf16x8*)(lds + HG_KE + (16 * sb + fr) * 272 + (32 * ks + 8 * kg) * 2);
                        sc = __builtin_amdgcn_mfma_f32_16x16x32_bf16(A, B, sc, 0, 0, 0); } }
#pragma unroll
                for (int r = 0; r < 4; ++r) { const int c = 16 * cb + 4 * kg + r, s = 16 * sb + fr; const float v = (s <= c) ? sc[r] : 0.f;
                    *(LAS bf16_t*)(lds + HG_SC + c * 144 + s * 2) = (bf16_t)f2bf(v); } }
        }
        __syncthreads();
        {
            pg8::bf16x8 Bv[2];
#pragma unroll
            for (int ks = 0; ks < 2; ++ks) Bv[ks] = *(const LAS pg8::bf16x8*)(lds + HG_VT + (16 * wave + fr) * 144 + (32 * ks + 8 * kg) * 2);
            if (HAS_Q) {
                pg8::bf16x8 Bs[4];
#pragma unroll
                for (int kp = 0; kp < 4; ++kp) { u32x4 t; t.x = cvtpk(S[2 * kp][0], S[2 * kp][1]); t.y = cvtpk(S[2 * kp][2], S[2 * kp][3]); t.z = cvtpk(S[2 * kp + 1][0], S[2 * kp + 1][1]); t.w = cvtpk(S[2 * kp + 1][2], S[2 * kp + 1][3]);
                    Bs[kp] = __builtin_bit_cast(pg8::bf16x8, t); }
                const int base = dir ? (Lseq - 64 * (n + 1)) : 64 * n;
#pragma unroll
                for (int cb = 0; cb < 4; ++cb) { f32x4 o = (f32x4){0.f, 0.f, 0.f, 0.f};
#pragma unroll
                    for (int ks = 0; ks < 2; ++ks) { const pg8::bf16x8 A = *(const LAS pg8::bf16x8*)(lds + HG_SC + (16 * cb + fr) * 144 + (32 * ks + 8 * kg) * 2);
                        o = __builtin_amdgcn_mfma_f32_16x16x32_bf16(A, Bv[ks], o, 0, 0, 0); }
#pragma unroll
                    for (int kp = 0; kp < 4; ++kp) { const u32x2 a0 = *(const LAS u32x2*)(lds + HG_QE + (16 * cb + fr) * 272 + (32 * kp + 4 * kg) * 2), a1 = *(const LAS u32x2*)(lds + HG_QE + (16 * cb + fr) * 272 + (32 * kp + 16 + 4 * kg) * 2);
                        const pg8::bf16x8 A = __builtin_bit_cast(pg8::bf16x8, (u32x4){a0.x, a0.y, a1.x, a1.y});
                        o = __builtin_amdgcn_mfma_f32_16x16x32_bf16(A, Bs[kp], o, 0, 0, 0); }
#pragma unroll
                    for (int r = 0; r < 4; ++r) { const int cp = 16 * cb + 4 * kg + r; const int t = base + (dir ? 63 - cp : cp); o_out[(size_t)t * HW + h * 128 + 16 * wave + fr] = o[r]; } }
            }
#pragma unroll
            for (int blk = 0; blk < 8; ++blk) { const f32x4 dc = *(const LAS f32x4*)(lds + HG_DEC + (16 * blk + 4 * kg) * 4); f32x4 s = S[blk] * dc;
#pragma unroll
                for (int ks = 0; ks < 2; ++ks) { const pg8::bf16x8 A = *(const LAS pg8::bf16x8*)(lds + HG_KDT + (16 * blk + fr) * 144 + (32 * ks + 8 * kg) * 2);
                    s = __builtin_amdgcn_mfma_f32_16x16x32_bf16(A, Bv[ks], s, 0, 0, 0); }
                S[blk] = s; }
        }
    }
#undef HG_LOAD
    if (s_out) {
#pragma unroll
        for (int blk = 0; blk < 8; ++blk)
#pragma unroll
            for (int r = 0; r < 4; ++r) s_out[(size_t)(16 * blk + 4 * kg + r) * 128 + 16 * wave + fr] = S[blk][r];
    }
    __syncthreads();
}

__global__ void __launch_bounds__(512, 2) mega(Params P) {
    extern __shared__ __attribute__((aligned(16))) unsigned char lds_raw[];
    cg::grid_group grid = cg::this_grid();
    LAS unsigned char* lds = (LAS unsigned char*)lds_raw;
    const int tid = threadIdx.x, lane = tid & 63, wave = __builtin_amdgcn_readfirstlane(tid >> 6);
    const int G = gridDim.x, bx = blockIdx.x;
    const int vcu = (G % 8 == 0) ? (bx % 8) * (G / 8) + bx / 8 : bx;
    const int gw = vcu * 8 + wave, NGW = G * 8;
    unsigned char* ws = P.ws;
    const float* x = P.in[0]; const float* cvec = P.in[1]; const float* ctx = P.in[2]; const float* c_ctx = P.in[3];
    const float* w_ada = P.in[4]; const float* b_ada = P.in[5]; const float* norm_w = P.in[6]; const float* w_in = P.in[7];
    const float* lb_param = P.in[8]; const float* g_norm = P.in[9]; const float* hy_sw = P.in[10]; const float* hy_sb = P.in[11];
    const float* f_w1 = P.in[12]; const float* f_b1 = P.in[13]; const float* f_w2 = P.in[14]; const float* f_b2 = P.in[15];
    const float* f_w3 = P.in[16]; const float* f_freq = P.in[17]; const float* hy_d = P.in[18]; const float* w_pa = P.in[19];
    const float* w_pb = P.in[20]; const float* w_out = P.in[21]; const float* w_mlp1 = P.in[22]; const float* w_mlp2 = P.in[23];
    float* MOD = (float*)(ws + WS_MOD); float* LB = (float*)(ws + WS_LB); bf16_t* GTB = (bf16_t*)(ws + WS_GT);
    bf16_t* WIN = (bf16_t*)(ws + WS_WIN); bf16_t* WPAB = (bf16_t*)(ws + WS_WPAB); bf16_t* WOUT = (bf16_t*)(ws + WS_WOUT); bf16_t* W1 = (bf16_t*)(ws + WS_W1); bf16_t* W2 = (bf16_t*)(ws + WS_W2);
    bf16_t* HCTX = (bf16_t*)(ws + WS_HCTX); bf16_t* PCTX = (bf16_t*)(ws + WS_PCTX); float* SCTX = (float*)(ws + WS_SCTX);
    bf16_t* HLAT = (bf16_t*)(ws + WS_HLAT); bf16_t* PI = (bf16_t*)(ws + WS_PI); bf16_t* PZ = (bf16_t*)(ws + WS_PZ); bf16_t* PQ = (bf16_t*)(ws + WS_PQ);
    bf16_t* PG = (bf16_t*)(ws + WS_PG); bf16_t* GATES = (bf16_t*)(ws + WS_GATES); bf16_t* PHYT = (bf16_t*)(ws + WS_PHYT);
    bf16_t* AY = (bf16_t*)(ws + WS_AY2); bf16_t* MERGED = (bf16_t*)(ws + WS_MERGED); bf16_t* MIX = (bf16_t*)(ws + WS_MIX);
    bf16_t* MLP = (bf16_t*)(ws + WS_MLP); bf16_t* H1 = (bf16_t*)(ws + WS_H1); bf16_t* HL = (bf16_t*)(ws + WS_HL);
    float* O2 = P.out;

    {
        if (bx < 96) {
            LAS float* sc = (LAS float*)lds;
            LAS float* ps = (LAS float*)(lds + 40960);
            for (int i = tid; i < 9 * D; i += 512) { const int r = i >> 10, k = i & 1023; sc[i] = siluf_(r < 8 ? cvec[r * D + k] : c_ctx[k]); }
            __syncthreads();
            const int j = bx * 64 + lane; float a9[9];
#pragma unroll
            for (int r = 0; r < 9; ++r) a9[r] = 0.f;
            for (int k = wave * 128; k < wave * 128 + 128; ++k) { const float w = w_ada[(size_t)k * INC + j];
#pragma unroll
                for (int r = 0; r < 9; ++r) a9[r] += sc[r * D + k] * w; }
#pragma unroll
            for (int r = 0; r < 9; ++r) ps[(wave * 9 + r) * 64 + lane] = a9[r];
            __syncthreads();
            for (int i = tid; i < 9 * 64; i += 512) { const int r = i >> 6, l = i & 63; float s = b_ada[bx * 64 + l];
#pragma unroll
                for (int w = 0; w < 8; ++w) s += ps[(w * 9 + r) * 64 + l];
                MOD[r * INC + bx * 64 + l] = s; }
            __syncthreads();
        }
        if (bx == G - 1) { const float a = lb_param[tid], b = lb_param[HW + tid], m = fmaxf(a, b); const float ea = expf(a - m), eb = expf(b - m); LB[tid] = ea / (ea + eb); }
        LAS float* scr = (LAS float*)(lds + wave * 16384);
        constexpr int I_IN = 16 * 192, I_PA = 8 * 32, I_OUT = 16 * 32, I_1 = 16 * 128, I_2 = 64 * 32;
        constexpr int NITEMS = I_IN + 2 * I_PA + I_OUT + I_1 + I_2;
        for (int it = gw; it < NITEMS; it += NGW) {
            int r = it;
            if (r < I_IN) { transpose_item(w_in, INC, WIN, D, 0, 1, scr, r, lane); continue; } r -= I_IN;
            if (r < I_PA) { transpose_item(w_pa, D, WPAB, D, 0, 0, scr, r, lane); continue; } r -= I_PA;
            if (r < I_PA) { transpose_item(w_pb, D, WPAB, D, 512, 0, scr, r, lane); continue; } r -= I_PA;
            if (r < I_OUT) { transpose_item(w_out, D, WOUT, D, 0, 0, scr, r, lane); continue; } r -= I_OUT;
            if (r < I_1) { transpose_item(w_mlp1, FF, W1, D, 0, 0, scr, r, lane); continue; } r -= I_1;
            transpose_item(w_mlp2, D, W2, FF, 0, 0, scr, r, lane);
        }
        for (int t = gw; t < L; t += NGW) {
            LAS float* z = scr; LAS float* h1 = scr + 64; LAS float* h2 = scr + 128;
            const float tn = (float)t / (float)(L - 1);
            if (lane < 33) {
                float val;
                if (lane == 0) val = tn;
                else { const int bi = (lane - 1) & 15; const float band = 1e-4f + (float)bi * ((15.f - 1e-4f) / 15.f);
                    const float w = 2.0f * 3.14159265358979323846f * (float)t / (float)L; const float ang = w * band;
                    val = (lane <= 16) ? cosf(ang) : -sinf(ang); }
                z[lane] = val;
            }
            LDS_WAIT();
            { float acc = f_b1[lane]; for (int i = 0; i < 33; ++i) acc += z[i] * f_w1[i * 64 + lane]; h1[lane] = sinf(f_freq[lane] * acc); }
            LDS_WAIT();
            { float acc = f_b2[lane]; for (int i = 0; i < 64; ++i) acc += h1[i] * f_w2[i * 64 + lane]; h2[lane] = sinf(f_freq[lane] * acc); }
            LDS_WAIT();
            const float mind = logf(1e-2f) / 1.5f, maxd = logf(1e-2f) / 0.3f;
            for (int j = lane; j < 1024; j += 64) {
                float acc = 0.f; for (int i = 0; i < 64; ++i) acc += h2[i] * f_w3[i * 1024 + j];
                const int dirb = j >> 9, c = j & 511;
                const float delta = fabsf(mind + (maxd - mind) * ((float)c / 511.f));
                float val = acc * expf(-tn * delta);
                if (dirb == 0) { if (t == 0) val += hy_d[c]; GTB[(size_t)c * 8192 + 4095 - t] = (bf16_t)f2bf(val); }
                else if (t > 0) GTB[(size_t)c * 8192 + 4095 + t] = (bf16_t)f2bf(val);
                else GTB[(size_t)c * 8192 + 8191] = (bf16_t)0;
            }
            LDS_WAIT();
        }
    }
    grid.sync();
    for (int m = gw; m < NT + NCX; m += NGW) {
        if (m < NT) { const float* mb = MOD + (size_t)(m >> 12) * INC; row_norm_mod_bf16(x + (size_t)m * D, norm_w, mb, mb + D, HLAT + (size_t)m * D, lane); }
        else { const int mc = m - NT; const float* mb = MOD + (size_t)8 * INC; row_norm_mod_bf16(ctx + (size_t)mc * D, norm_w, mb, mb + D, HCTX + (size_t)mc * D, lane); }
    }
    grid.sync();
    {
        { pg8::Gemm g{HLAT, WIN, D, D, D}; pg8::StaticOrder S; S.init(NT, 4608, G, bx); pg8::EpiG1 E{PI, PZ, PQ, PG, GATES};
          pg8::gemm_phase(lds, g, S, E); }
        { pg8::Gemm g{WIN + (size_t)4608 * D, HLAT, D, D, D}; pg8::StaticOrder S; S.init(1536, NT, G, bx); pg8::EpiBf16<0> E{PHYT, NT};
          pg8::gemm_phase(lds, g, S, E); }
        { pg8::Gemm g{HCTX, WIN, D, D, D}; pg8::StaticOrder S; S.init(NCX, 1536, G, bx); pg8::EpiBf16<0> E{PCTX, 1536};
          pg8::gemm_phase(lds, g, S, E); }
    }
    grid.sync();
    if (bx < 64) { const int b = bx >> 3, h = (bx >> 1) & 3, dir = bx & 1;
        hgrn_chain_mfma<false>(lds, PCTX + (size_t)b * LC * 1536, 1536, PCTX + (size_t)b * LC * 1536 + (dir ? 1024 : 512), 1536, nullptr, 0, LC, h, dir, LB,
                   nullptr, SCTX + (size_t)((b * 2 + dir) * 4 + h) * 16384, nullptr); }
    grid.sync();
    if (bx < 64) { const int b = bx >> 3, h = (bx >> 1) & 3, dir = bx & 1;
        hgrn_chain_mfma<true>(lds, PI + (size_t)b * L * 512, 512, PZ + (size_t)b * L * 1024 + (dir ? 512 : 0), 1024, PQ + (size_t)b * L * 512, 512, L, h, dir, LB,
                   SCTX + (size_t)((b * 2 + dir) * 4 + h) * 16384, nullptr, O2 + ((size_t)dir * NT + (size_t)b * L) * HW); }
    else {
        for (int c = bx - 64; c < HW; c += G - 64) hyena_channel(lds, c, PHYT, GTB, hy_sw, hy_sb);
    }
    grid.sync();
    for (int w = gw; w < NT * 4; w += NGW) { const int t = w >> 2, h = w & 3; float v[2]; float s = 0.f;
#pragma unroll
        for (int i = 0; i < 2; ++i) { const int c = h * 128 + lane + 64 * i; v[i] = O2[(size_t)t * HW + c] + O2[((size_t)NT + t) * HW + c]; s += v[i] * v[i]; }
        const float r = rsqrtf(wave_sum(s) * (1.f / 128.f) + EPS);
#pragma unroll
        for (int i = 0; i < 2; ++i) { const int vv = lane + 64 * i, c = h * 128 + vv; AY[(size_t)t * 1024 + c] = (bf16_t)f2bf(v[i] * r * g_norm[vv] * bf2f(PG[(size_t)t * 512 + c])); } }
    {
        LAS bf16_t* tl = (LAS bf16_t*)(lds + wave * 16384);
        for (int it = gw; it < 8 * 512; it += NGW) { const int c0 = (it & 7) * 64, tok0 = (it >> 3) * 64;
#pragma unroll
            for (int i = 0; i < 8; ++i) { const int ch = lane + 64 * i, rr = ch >> 3, cc = (ch & 7) * 8;
                const u32x4 v = *(const u32x4*)(PHYT + (size_t)(1024 + c0 + rr) * NT + tok0 + cc);
                LAS unsigned* d = (LAS unsigned*)(tl + rr * 66 + cc); d[0] = v.x; d[1] = v.y; d[2] = v.z; d[3] = v.w; }
            LDS_WAIT();
#pragma unroll
            for (int i = 0; i < 8; ++i) { const int ch = lane + 64 * i, tt = ch >> 3, cc = (ch & 7) * 8; unsigned o[4];
#pragma unroll
                for (int q = 0; q < 4; ++q) o[q] = (unsigned)tl[(cc + 2 * q) * 66 + tt] | ((unsigned)tl[(cc + 2 * q + 1) * 66 + tt] << 16);
                *(u32x4*)(AY + (size_t)(tok0 + tt) * 1024 + 512 + c0 + cc) = (u32x4){o[0], o[1], o[2], o[3]}; }
            LDS_WAIT();
        }
    }
    grid.sync();
    {
        { pg8::Gemm g{AY, WPAB, D, D, 512}; pg8::StaticOrder S; S.init(NT, D, G, bx); pg8::EpiMerge<0> E{MERGED, GATES, 0}; pg8::gemm_phase(lds, g, S, E); }
        { pg8::Gemm g{AY + 512, WPAB + 512, D, D, 512}; pg8::StaticOrder S; S.init(NT, D, G, bx); pg8::EpiMerge<1> E{MERGED, GATES, 1024}; pg8::gemm_phase(lds, g, S, E); }
    }
    grid.sync();
    { pg8::Gemm g{MERGED, WOUT, D, D, D}; pg8::StaticOrder S; S.init(NT, D, G, bx); pg8::EpiBf16<0> E{MIX, D}; pg8::gemm_phase(lds, g, S, E); }
    grid.sync();
    for (int m = gw; m < NT; m += NGW) { const float* mb = MOD + (size_t)(m >> 12) * INC; f32x4 x1[4];
        row_x1(x + (size_t)m * D, MIX + (size_t)m * D, norm_w + D, mb + 2 * D, x1, lane);
        float s = 0.f;
#pragma unroll
        for (int j = 0; j < 4; ++j) s += (x1[j].x * x1[j].x + x1[j].y * x1[j].y) + (x1[j].z * x1[j].z + x1[j].w * x1[j].w);
        const float r = rsqrtf(wave_sum(s) * (1.f / D) + EPS);
        unsigned long long* o8 = (unsigned long long*)(HL + (size_t)m * D) + lane;
#pragma unroll
        for (int j = 0; j < 4; ++j) { const f32x4 w = ((const f32x4*)(norm_w + 2 * D))[lane + 64 * j], sc = ((const f32x4*)(mb + 3 * D))[lane + 64 * j], sh = ((const f32x4*)(mb + 4 * D))[lane + 64 * j];
            const f32x4 o = x1[j] * r * w * (1.f + sc) + sh;
            o8[64 * j] = (unsigned long long)pk2(o.x, o.y) | ((unsigned long long)pk2(o.z, o.w) << 32); } }
    grid.sync();
    { pg8::Gemm g{HL, W1, D, D, D}; pg8::StaticOrder S; S.init(NT, FF, G, bx); pg8::EpiBf16<3> E{H1, FF}; pg8::gemm_phase(lds, g, S, E); }
    grid.sync();
    { pg8::Gemm g{H1, W2, FF, FF, FF}; pg8::StaticOrder S; S.init(NT, D, G, bx); pg8::EpiBf16<0> E{MLP, D}; pg8::gemm_phase(lds, g, S, E); }
    grid.sync();
    for (int m = gw; m < NT; m += NGW) { const float* mb = MOD + (size_t)(m >> 12) * INC; f32x4 x1[4];
        row_x1(x + (size_t)m * D, MIX + (size_t)m * D, norm_w + D, mb + 2 * D, x1, lane);
        f32x4 mv[4]; float s = 0.f;
#pragma unroll
        for (int j = 0; j < 4; ++j) { mv[j] = ld_bf4(MLP + (size_t)m * D + 4 * lane + 256 * j); s += (mv[j].x * mv[j].x + mv[j].y * mv[j].y) + (mv[j].z * mv[j].z + mv[j].w * mv[j].w); }
        const float r = rsqrtf(wave_sum(s) * (1.f / D) + EPS);
#pragma unroll
        for (int j = 0; j < 4; ++j) { const f32x4 w = ((const f32x4*)(norm_w + 3 * D))[lane + 64 * j], g = ((const f32x4*)(mb + 5 * D))[lane + 64 * j];
            ((f32x4*)(P.out + (size_t)m * D))[lane + 64 * j] = x1[j] + g * (mv[j] * r * w); } }
}
}

extern "C" void kernel_launch(void* const* d_in, const int* in_sizes, int n_in, void* d_out, int out_size, void* d_ws, size_t ws_size, hipStream_t stream) {
    static int grid = 0;
    if (grid == 0) {
        if (n_in != 24 || ws_size < WS_END) { fprintf(stderr, "kernel_launch: unexpected n_in %d / ws_size %zu\n", n_in, ws_size); grid = -1; return; }
        int dev = 0, cus = 0, per_cu = 0;
        hipGetDevice(&dev); hipDeviceGetAttribute(&cus, hipDeviceAttributeMultiprocessorCount, dev);
        hipFuncSetAttribute((const void*)mega, hipFuncAttributeMaxDynamicSharedMemorySize, LDS_BYTES);
        hipOccupancyMaxActiveBlocksPerMultiprocessor(&per_cu, (const void*)mega, 512, LDS_BYTES);
        if (per_cu < 1) { fprintf(stderr, "kernel_launch: occupancy query says %d blocks per CU\n", per_cu); grid = -1; return; }
        grid = cus;
    }
    if (grid < 0) return;
    Params p{};
    for (int i = 0; i < 24; ++i) p.in[i] = (const float*)d_in[i];
    p.out = (float*)d_out; p.ws = (unsigned char*)d_ws;
    void* args[] = {&p};
    hipError_t e = hipLaunchCooperativeKernel((const void*)mega, dim3(grid), dim3(512), args, LDS_BYTES, stream);
    if (e != hipSuccess) fprintf(stderr, "cooperative launch failed: %s (grid %d)\n", hipGetErrorString(e), grid);
}
```

```cpp
#include <hip/hip_runtime.h>
#include <hip/hip_cooperative_groups.h>
#include <cstdio>
#include <math.h>
namespace cg = cooperative_groups;
#ifndef PROBE_MASK
#define PROBE_MASK 0
#endif
#ifndef PROBE_XSYNC
#define PROBE_XSYNC 0
#endif

namespace pg8 {
#define PG8_LAS __attribute__((address_space(3)))
typedef unsigned short bf16_t;
typedef short bf16x8 __attribute__((ext_vector_type(8)));
typedef float f32x4 __attribute__((ext_vector_type(4)));
typedef unsigned u32x4 __attribute__((ext_vector_type(4)));
typedef unsigned u32x2 __attribute__((ext_vector_type(2)));
constexpr int BM = 256, BK = 64, HALF = 128, HTB = HALF * BK * 2, STAGE_BYTES = 8 * HTB, NXCD = 8, WGM = 8;

__device__ __forceinline__ int lds_byte(int r, int c) { const int st = (r >> 4) * 2 + (c >> 5), rr = r & 15, cc = c & 31, ob = rr * 64 + cc * 2; return st * 1024 + (ob ^ (((ob >> 9) & 1) << 5)); }
__device__ __forceinline__ void stage_rc(int b, int& R, int& C) { const int st = b / 1024, sb = b % 1024, swz = sb ^ (((sb >> 9) & 1) << 5); R = (st >> 1) * 16 + swz / 64; C = (st & 1) * 32 + (swz % 64) / 2; }
__device__ __forceinline__ int perm32(int rho) { const int n = rho >> 4, i = rho & 15; return 8 * (i >> 2) + 4 * n + (i & 3); }

struct Unit { int pm, pn; };
struct Gemm { const bf16_t* A; const bf16_t* Bt; int lda, ldb, K; };

struct StaticOrder {
    int nM, nN, nwg, G, c;
    __device__ void init(int M, int N, int G_, int c_) { nM = M / BM; nN = N / BM; nwg = nM * nN; G = G_; c = c_; }
    __device__ bool next(int i, Unit& u) const {
        const long L = (long)i * G + c; if (L >= nwg) return false;
        int wgid = (int)L; { const int q = nwg / NXCD, r = nwg % NXCD, xcd = wgid % NXCD, off = wgid / NXCD; wgid = (xcd < r ? xcd * (q + 1) : r * (q + 1) + (xcd - r) * q) + off; }
        const int nig = WGM * nN, gid = wgid / nig, fm = gid * WGM, gsz = (nM - fm) < WGM ? (nM - fm) : WGM;
        u.pm = fm + ((wgid % nig) % gsz); u.pn = (wgid % nig) / gsz; return true;
    }
};

__device__ __forceinline__ unsigned cvt_pk_bf16(float lo, float hi) { unsigned r; asm volatile("v_cvt_pk_bf16_f32 %0, %1, %2" : "=v"(r) : "v"(lo), "v"(hi)); return r; }
__device__ __forceinline__ float sigm(float x) { return __builtin_amdgcn_rcpf(1.0f + __builtin_amdgcn_exp2f(-1.4426950408889634f * x)); }
__device__ __forceinline__ float bflo(unsigned u) { return __uint_as_float(u << 16); }
__device__ __forceinline__ float bfhi(unsigned u) { return __uint_as_float(u & 0xffff0000u); }

template <int ACT  > struct EpiBf16 {
    static constexpr bool PERM = true;
    bf16_t* O; int ldc;
    __device__ __forceinline__ void operator()(const f32x4 (&acc)[2][2][4][2], const Unit& u, int wr, int wc, int fr, int fq) const {
        const int row0 = u.pm * BM + wr * 64 + fr, col0 = u.pn * BM + wc * 32 + 8 * fq;
#pragma unroll
        for (int ai = 0; ai < 2; ++ai)
#pragma unroll
            for (int m = 0; m < 4; ++m) { bf16_t* rowp = O + (size_t)(row0 + ai * HALF + m * 16) * ldc + col0;
#pragma unroll
                for (int bj = 0; bj < 2; ++bj) { f32x4 v0 = acc[ai][bj][m][0], v1 = acc[ai][bj][m][1];
                    if (ACT == 3) {
#pragma unroll
                        for (int j = 0; j < 4; ++j) { const float a = fmaxf(v0[j], 0.f), b = fmaxf(v1[j], 0.f); v0[j] = a * a; v1[j] = b * b; } }
                    u32x4 w; w.x = cvt_pk_bf16(v0[0], v0[1]); w.y = cvt_pk_bf16(v0[2], v0[3]); w.z = cvt_pk_bf16(v1[0], v1[1]); w.w = cvt_pk_bf16(v1[2], v1[3]);
                    *(u32x4*)(rowp + bj * HALF) = w; } }
    }
};
struct EpiG1 {
    static constexpr bool PERM = true;
    bf16_t *PI, *PZ, *PQ, *PG, *GATES;
    __device__ __forceinline__ void operator()(const f32x4 (&acc)[2][2][4][2], const Unit& u, int wr, int wc, int fr, int fq) const {
        const int pn = u.pn; bf16_t* base; int ld, cb, act;
        if (pn < 2) { base = PI; ld = 512; cb = pn * 256; act = 0; }
        else if (pn < 6) { base = PZ; ld = 1024; cb = (pn - 2) * 256; act = 0; }
        else if (pn < 8) { base = PQ; ld = 512; cb = (pn - 6) * 256; act = 1; }
        else if (pn < 10) { base = PG; ld = 512; cb = (pn - 8) * 256; act = 1; }
        else { base = GATES; ld = 2048; cb = (pn - 10) * 256; act = 2; }
        const int row0 = u.pm * BM + wr * 64 + fr, col0 = cb + wc * 32 + 8 * fq;
#pragma unroll
        for (int ai = 0; ai < 2; ++ai)
#pragma unroll
            for (int m = 0; m < 4; ++m) { bf16_t* rowp = base + (size_t)(row0 + ai * HALF + m * 16) * ld + col0;
#pragma unroll
                for (int bj = 0; bj < 2; ++bj) { f32x4 v0 = acc[ai][bj][m][0], v1 = acc[ai][bj][m][1];
                    if (act != 0) {
#pragma unroll
                        for (int j = 0; j < 4; ++j) { const float s0 = sigm(v0[j]), s1 = sigm(v1[j]); v0[j] = act == 1 ? v0[j] * s0 : s0; v1[j] = act == 1 ? v1[j] * s1 : s1; } }
                    u32x4 w; w.x = cvt_pk_bf16(v0[0], v0[1]); w.y = cvt_pk_bf16(v0[2], v0[3]); w.z = cvt_pk_bf16(v1[0], v1[1]); w.w = cvt_pk_bf16(v1[2], v1[3]);
                    *(u32x4*)(rowp + bj * HALF) = w; } }
    }
};
template <int PASS> struct EpiMerge {
    static constexpr bool PERM = true;
    bf16_t* O; const bf16_t* GATES; int goff;
    __device__ __forceinline__ void operator()(const f32x4 (&acc)[2][2][4][2], const Unit& u, int wr, int wc, int fr, int fq) const {
        const int row0 = u.pm * BM + wr * 64 + fr, col0 = u.pn * BM + wc * 32 + 8 * fq;
#pragma unroll
        for (int ai = 0; ai < 2; ++ai)
#pragma unroll
            for (int m = 0; m < 4; ++m) { const size_t r = (size_t)(row0 + ai * HALF + m * 16);
#pragma unroll
                for (int bj = 0; bj < 2; ++bj) { f32x4 v0 = acc[ai][bj][m][0], v1 = acc[ai][bj][m][1];
                    const u32x4 g = *(const u32x4*)(GATES + r * 2048 + goff + col0 + bj * HALF);
                    v0[0] *= bflo(g.x); v0[1] *= bfhi(g.x); v0[2] *= bflo(g.y); v0[3] *= bfhi(g.y); v1[0] *= bflo(g.z); v1[1] *= bfhi(g.z); v1[2] *= bflo(g.w); v1[3] *= bfhi(g.w);
                    bf16_t* op = O + r * 1024 + col0 + bj * HALF;
                    if (PASS == 1) { const u32x4 o = *(const u32x4*)op;
                        v0[0] += bflo(o.x); v0[1] += bfhi(o.x); v0[2] += bflo(o.y); v0[3] += bfhi(o.y); v1[0] += bflo(o.z); v1[1] += bfhi(o.z); v1[2] += bflo(o.w); v1[3] += bfhi(o.w); }
                    u32x4 w; w.x = cvt_pk_bf16(v0[0], v0[1]); w.y = cvt_pk_bf16(v0[2], v0[3]); w.z = cvt_pk_bf16(v1[0], v1[1]); w.w = cvt_pk_bf16(v1[2], v1[3]);
                    *(u32x4*)op = w; } }
    }
};

template <class Epi, class Sched>
__device__ __forceinline__ void gemm_phase(PG8_LAS unsigned char* lds, const Gemm g, const Sched& S, const Epi& E) {
    const int tid = threadIdx.x, wid = __builtin_amdgcn_readfirstlane(tid >> 6), lane = tid & 63, wr = wid >> 2, wc = wid & 3, fr = lane & 15, fq = lane >> 4;
    const int nt = g.K / BK;
    unsigned voffA[2], voffB[2];
#pragma unroll
    for (int i = 0; i < 2; ++i) { int R, C; stage_rc(tid * 16 + i * 8192, R, C); const int Rb = Epi::PERM ? ((R & ~31) + perm32(R & 31)) : R;
        voffA[i] = (unsigned)(R * g.lda + C) * 2u; voffB[i] = (unsigned)(Rb * g.ldb + C) * 2u; }
    const size_t kstep = (size_t)(BK * 2);
    const size_t hstepA = (size_t)HALF * g.lda * 2, hstepB = (size_t)HALF * g.ldb * 2;
    const size_t tstepA = 2 * hstepA, tstepB = 2 * hstepB;
    const unsigned ldsw = (unsigned)wid * 1024u;
    const int aoff = lds_byte(wr * 64 + fr, fq * 8), boff = lds_byte(wc * 32 + fr, fq * 8);
#define PG8_SA(b, h) (((b) * 2 + (h)) * HTB)
#define PG8_SB(b, h) ((4 + (b) * 2 + (h)) * HTB)
#define PG8_STAGE(bufoff, gbase, voff) do { _Pragma("unroll") for (int _i = 0; _i < 2; ++_i) \
        __builtin_amdgcn_global_load_lds((const unsigned*)((const char*)(gbase) + (voff)[_i]), (PG8_LAS unsigned*)(lds + (bufoff) + ldsw + _i * 8192), 16, 0, 0); } while (0)
#define PG8_LDA(dst, b, h) do { _Pragma("unroll") for (int m = 0; m < 4; ++m) _Pragma("unroll") for (int k = 0; k < 2; ++k) dst[m][k] = *(const PG8_LAS bf16x8*)(lds + PG8_SA(b, h) + aoff + m * 2048 + k * 1024); } while (0)
#define PG8_LDB(dst, b, h) do { _Pragma("unroll") for (int n = 0; n < 2; ++n) _Pragma("unroll") for (int k = 0; k < 2; ++k) dst[n][k] = *(const PG8_LAS bf16x8*)(lds + PG8_SB(b, h) + boff + n * 2048 + k * 1024); } while (0)
#define PG8_MMA(ai, bj, At, Bt) do { __builtin_amdgcn_s_setprio(1); _Pragma("unroll") for (int m = 0; m < 4; ++m) _Pragma("unroll") for (int n = 0; n < 2; ++n) _Pragma("unroll") for (int k = 0; k < 2; ++k) \
        acc[ai][bj][m][n] = __builtin_amdgcn_mfma_f32_16x16x32_bf16(Bt[n][k], At[m][k], acc[ai][bj][m][n], 0, 0, 0); __builtin_amdgcn_s_setprio(0); } while (0)
#define PG8_WAIT_V(n) asm volatile("s_waitcnt vmcnt(" #n ")" ::: "memory")
#define PG8_WAIT_L(n) asm volatile("s_waitcnt lgkmcnt(" #n ")" ::: "memory")
#define PG8_BAR __builtin_amdgcn_s_barrier()
#define PG8_SCHED __builtin_amdgcn_sched_barrier(0)
    Unit cur, nxt; int ui = 0;
    if (!S.next(0, cur)) return;
    f32x4 acc[2][2][4][2];
#pragma unroll
    for (int a = 0; a < 2; ++a)
#pragma unroll
        for (int b = 0; b < 2; ++b)
#pragma unroll
            for (int m = 0; m < 4; ++m)
#pragma unroll
                for (int n = 0; n < 2; ++n) acc[a][b][m][n] = (f32x4){0.f, 0.f, 0.f, 0.f};
    bf16x8 At[4][2], B0[2][2], B1[2][2];
    const char* cA = (const char*)g.A + (size_t)cur.pm * tstepA; const char* cB = (const char*)g.Bt + (size_t)cur.pn * tstepB;
    PG8_STAGE(PG8_SB(0, 0), cB, voffB); PG8_STAGE(PG8_SA(0, 0), cA, voffA); PG8_STAGE(PG8_SB(0, 1), cB + hstepB, voffB); PG8_STAGE(PG8_SA(0, 1), cA + hstepA, voffA);
    if (wr == 1) PG8_BAR;
    PG8_WAIT_V(4); PG8_BAR;
    PG8_STAGE(PG8_SB(1, 0), cB + kstep, voffB); PG8_STAGE(PG8_SA(1, 0), cA + kstep, voffA); PG8_STAGE(PG8_SB(1, 1), cB + hstepB + kstep, voffB);
    PG8_WAIT_V(6); PG8_BAR;
    for (;;) {
        const bool has_next = S.next(ui + 1, nxt);
        const char* nA = has_next ? (const char*)g.A + (size_t)nxt.pm * tstepA : cA; const char* nB = has_next ? (const char*)g.Bt + (size_t)nxt.pn * tstepB : cB;
        for (int t = 0; t < nt; t += 2) {
            const bool last = (t == nt - 2);
            const char* a1 = cA + (size_t)(t + 1) * kstep;
            const char* a2 = last ? nA : cA + (size_t)(t + 2) * kstep; const char* b2 = last ? nB : cB + (size_t)(t + 2) * kstep;
            const char* a3 = a2 + kstep; const char* b3 = b2 + kstep;
            PG8_LDB(B0, 0, 0); PG8_SCHED; PG8_LDA(At, 0, 0); PG8_STAGE(PG8_SA(1, 1), a1 + hstepA, voffA);
            PG8_WAIT_L(8); PG8_BAR; PG8_WAIT_L(0); PG8_MMA(0, 0, At, B0); PG8_BAR; PG8_SCHED;
            PG8_LDB(B1, 0, 1); PG8_STAGE(PG8_SB(0, 0), b2, voffB);
            PG8_BAR; PG8_WAIT_L(0); PG8_MMA(0, 1, At, B1); PG8_BAR;
            PG8_LDA(At, 0, 1); PG8_STAGE(PG8_SA(0, 0), a2, voffA);
            PG8_BAR; PG8_WAIT_L(0); PG8_MMA(1, 0, At, B0); PG8_BAR; PG8_SCHED;
            PG8_STAGE(PG8_SB(0, 1), b2 + hstepB, voffB);
            PG8_WAIT_V(6); PG8_BAR; PG8_MMA(1, 1, At, B1); PG8_BAR;
            PG8_LDB(B0, 1, 0); PG8_SCHED; PG8_LDA(At, 1, 0); PG8_STAGE(PG8_SA(0, 1), a2 + hstepA, voffA);
            PG8_WAIT_L(8); PG8_BAR; PG8_WAIT_L(0); PG8_MMA(0, 0, At, B0); PG8_BAR; PG8_SCHED;
            PG8_LDB(B1, 1, 1); PG8_STAGE(PG8_SB(1, 0), b3, voffB);
            PG8_BAR; PG8_WAIT_L(0); PG8_MMA(0, 1, At, B1); PG8_BAR;
            PG8_LDA(At, 1, 1); PG8_STAGE(PG8_SA(1, 0), a3, voffA);
            PG8_BAR; PG8_WAIT_L(0); PG8_MMA(1, 0, At, B0); PG8_BAR; PG8_SCHED;
            PG8_STAGE(PG8_SB(1, 1), b3 + hstepB, voffB);
            PG8_WAIT_V(6); PG8_BAR; PG8_MMA(1, 1, At, B1); PG8_BAR;
        }
        E(acc, cur, wr, wc, fr, fq);
        if (!has_next) break;
#pragma unroll
        for (int a = 0; a < 2; ++a)
#pragma unroll
            for (int b = 0; b < 2; ++b)
#pragma unroll
                for (int m = 0; m < 4; ++m)
#pragma unroll
                    for (int n = 0; n < 2; ++n) acc[a][b][m][n] = (f32x4){0.f, 0.f, 0.f, 0.f};
        cur = nxt; cA = nA; cB = nB; ++ui;
    }
    PG8_WAIT_V(0);
    if (wr == 0) PG8_BAR;
    PG8_BAR;
#undef PG8_SA
#undef PG8_SB
#undef PG8_STAGE
#undef PG8_LDA
#undef PG8_LDB
#undef PG8_MMA
#undef PG8_WAIT_V
#undef PG8_WAIT_L
#undef PG8_BAR
#undef PG8_SCHED
}
}

namespace {
using pg8::bf16_t; using pg8::f32x4; using pg8::u32x4; using pg8::u32x2;
#define LAS __attribute__((address_space(3)))
constexpr int D = 1024, NB = 8, L = 4096, LC = 256, INC = 6144, FF = 4096, HW = 512;
constexpr int NT = NB * L, NCX = NB * LC;
constexpr float EPS = 1e-6f;
constexpr size_t MiB = 1u << 20;
constexpr size_t WS_MOD = 64 * 1024, WS_LB = 512 * 1024, WS_GT = 2 * MiB  ;
constexpr size_t WS_WIN = 18 * MiB, WS_WPAB = 30 * MiB, WS_WOUT = 32 * MiB, WS_W1 = 34 * MiB, WS_W2 = 42 * MiB;
constexpr size_t WS_HCTX = 50 * MiB, WS_PCTX = 54 * MiB, WS_SCTX = 60 * MiB;
constexpr size_t WS_HLAT = 64 * MiB;
constexpr size_t WS_PI = 128 * MiB, WS_PZ = 160 * MiB, WS_PQ = 224 * MiB, WS_PG = 256 * MiB, WS_GATES = 288 * MiB, WS_PHYT = 416 * MiB;
constexpr size_t WS_AY = 160 * MiB;
constexpr size_t WS_AY2 = 64 * MiB;
constexpr size_t WS_MERGED = 128 * MiB;
constexpr size_t WS_MIX = 448 * MiB, WS_MLP = 384 * MiB, WS_H1 = 128 * MiB, WS_HL = 64 * MiB;
constexpr size_t WS_END = 512 * MiB;
constexpr int LDS_BYTES = 147456;

__device__ __forceinline__ float bf2f(bf16_t h) { return __uint_as_float(((unsigned)h) << 16); }
__device__ __forceinline__ unsigned f2bf(float f) { unsigned u = __float_as_uint(f); return (u + 0x7fffu + ((u >> 16) & 1u)) >> 16; }
__device__ __forceinline__ unsigned pk2(float lo, float hi) { return f2bf(lo) | (f2bf(hi) << 16); }
__device__ __forceinline__ float sigmoidf_(float x) { return 1.f / (1.f + expf(-x)); }
__device__ __forceinline__ float siluf_(float x) { return x / (1.f + expf(-x)); }
__device__ __forceinline__ float wave_sum(float v) {
#pragma unroll
    for (int o = 1; o < 64; o <<= 1) v += __shfl_xor(v, o);
    return v;
}
#define LDS_WAIT() asm volatile("s_waitcnt lgkmcnt(0)" ::: "memory")

struct Params { const float* in[24]; float* out; unsigned char* ws; };

#define XB_TMO      128
#define XB_XCNT(j)  (256  + 64 * (j))
#define XB_XSUB(j)  (1280 + 64 * (j))
#define XB_XGEN(j)  (2304 + 64 * (j))
#define XB_TOP      3328
#define XB_TOPGEN   3392
#define XCD_BAR_WORDS 3456
#define XB_SPIN_CAP (1u << 18)

__device__ __forceinline__ unsigned xb_ld(unsigned* p)              { return __hip_atomic_load(p, __ATOMIC_RELAXED, __HIP_MEMORY_SCOPE_AGENT); }
__device__ __forceinline__ unsigned xb_add(unsigned* p, unsigned v) { return __hip_atomic_fetch_add(p, v, __ATOMIC_RELAXED, __HIP_MEMORY_SCOPE_AGENT); }
__device__ __forceinline__ unsigned xb_xcc_id() { return (unsigned)__builtin_amdgcn_s_getreg((3 << 11) | 20) & 0xFu; }
#define XB_SPIN(cond, bar) do { unsigned _sp = 0; while (cond) { __builtin_amdgcn_s_sleep(1); \
    if ((++_sp & 255u) == 0u) { if (xb_ld(&(bar)[XB_TMO])) break; if (_sp > XB_SPIN_CAP) { atomicAdd(&(bar)[XB_TMO], 1u); break; } } } } while (0)

struct XcdBarrier {
    unsigned* bar; unsigned x;
    volatile LAS unsigned* st;
};

__device__ __forceinline__ XcdBarrier xcd_barrier_post(unsigned* bar, volatile LAS unsigned* st) {
    XcdBarrier b; b.bar = bar; b.x = xb_xcc_id(); b.st = st;
    if (threadIdx.x == 0) (void)xb_add(&bar[XB_XCNT(b.x)], 1u);
    return b;
}
__device__ __forceinline__ void xcd_barrier_complete(unsigned* bar, unsigned x, unsigned& nloc, unsigned& nx) {
    const unsigned G = gridDim.x * gridDim.y * gridDim.z;
    unsigned sum, cnt, mine, sp = 0u;
    for (;;) {
        sum = 0u; cnt = 0u; mine = 0u;
#pragma unroll
        for (unsigned j = 0; j < 16; ++j) { const unsigned c = xb_ld(&bar[XB_XCNT(j)]); sum += c; cnt += (c > 0u) ? 1u : 0u; mine = (j == x) ? c : mine; }
        if (sum == G) break;
        __builtin_amdgcn_s_sleep(1);
        if ((++sp & 255u) == 0u) { if (xb_ld(&bar[XB_TMO])) break; if (sp > XB_SPIN_CAP) { atomicAdd(&bar[XB_TMO], 1u); break; } }
    }
    nloc = mine > 0u ? mine : 1u; nx = cnt > 0u ? cnt : 1u;
}

__device__ __forceinline__ void xcd_barrier(const XcdBarrier& b) {
    asm volatile("s_waitcnt vmcnt(0)" ::: "memory");
    __syncthreads();
    if (threadIdx.x == 0) {
        unsigned* bar = b.bar;
        __builtin_amdgcn_s_waitcnt(0);
        unsigned nloc = b.st[0], nx = b.st[1];
        if (nloc == 0u) { xcd_barrier_complete(bar, b.x, nloc, nx); b.st[0] = nloc; b.st[1] = nx; }
        const unsigned old = xb_add(&bar[XB_XSUB(b.x)], 1u);
        const unsigned gen = old / nloc;
        if (old + 1u == (gen + 1u) * nloc) {
            __builtin_amdgcn_fence(__ATOMIC_RELEASE, "agent");
            asm volatile("s_waitcnt vmcnt(0)" ::: "memory");
            const unsigned og = xb_add(&bar[XB_TOP], 1u);
            const unsigned tg = og / nx;
            if (og + 1u == (tg + 1u) * nx) xb_add(&bar[XB_TOPGEN], 1u);
            else XB_SPIN(xb_ld(&bar[XB_TOPGEN]) == tg, bar);
            __builtin_amdgcn_fence(__ATOMIC_ACQUIRE, "agent");
            xb_add(&bar[XB_XGEN(b.x)], 1u);
            asm volatile("s_waitcnt vmcnt(0)" ::: "memory");
        } else {
            XB_SPIN(xb_ld(&bar[XB_XGEN(b.x)]) == gen, bar);
            __builtin_amdgcn_fence(__ATOMIC_ACQUIRE, "agent");
            asm volatile("s_waitcnt vmcnt(0)" ::: "memory");
        }
    }
    __syncthreads();
}


__device__ __forceinline__ void transpose_item(const float* W, int N, bf16_t* WT, int ldk, int koff, int remap, LAS float* scr, int item, int lane) {
    const int nblk = N / 32, kb = item / nblk, nb = item % nblk, k0 = 64 * kb, n0 = 32 * nb;
    int rbase = n0;
    if (remap) rbase = n0 < 2560 ? n0 : (n0 < 4096 ? n0 + 2048 : n0 - 1536);
#pragma unroll 8
    for (int i = 0; i < 32; ++i) { const int kk = 2 * i + (lane >> 5); scr[kk * 33 + (lane & 31)] = W[(size_t)(k0 + kk) * N + n0 + (lane & 31)]; }
    LDS_WAIT();
    const int c = lane & 7;
#pragma unroll
    for (int j = 0; j < 4; ++j) { const int n = (lane >> 3) + 8 * j; const LAS float* s = scr + (8 * c) * 33 + n;
        u32x4 o; o.x = pk2(s[0 * 33], s[1 * 33]); o.y = pk2(s[2 * 33], s[3 * 33]); o.z = pk2(s[4 * 33], s[5 * 33]); o.w = pk2(s[6 * 33], s[7 * 33]);
        *(u32x4*)(WT + (size_t)(rbase + n) * ldk + koff + k0 + 8 * c) = o; }
    LDS_WAIT();
}

__device__ __forceinline__ void row_norm_mod_bf16(const float* xrow, const float* nw, const float* scale, const float* shift, bf16_t* orow, int lane) {
    const f32x4* xr = (const f32x4*)xrow + lane; f32x4 v[4]; float s = 0.f;
#pragma unroll
    for (int j = 0; j < 4; ++j) { v[j] = xr[64 * j]; s += (v[j].x * v[j].x + v[j].y * v[j].y) + (v[j].z * v[j].z + v[j].w * v[j].w); }
    const float r = rsqrtf(wave_sum(s) * (1.f / D) + EPS);
    unsigned long long* o8 = (unsigned long long*)orow + lane;
#pragma unroll
    for (int j = 0; j < 4; ++j) { const f32x4 w = ((const f32x4*)nw)[lane + 64 * j], sc = ((const f32x4*)scale)[lane + 64 * j], sh = ((const f32x4*)shift)[lane + 64 * j];
        const f32x4 o = v[j] * r * w * (1.f + sc) + sh;
        o8[64 * j] = (unsigned long long)pk2(o.x, o.y) | ((unsigned long long)pk2(o.z, o.w) << 32); }
}
__device__ __forceinline__ f32x4 ld_bf4(const bf16_t* p) { const u32x2 u = *(const u32x2*)p; return (f32x4){pg8::bflo(u.x), pg8::bfhi(u.x), pg8::bflo(u.y), pg8::bfhi(u.y)}; }
__device__ __forceinline__ void row_x1(const float* xrow, const bf16_t* mixrow, const float* nw1, const float* g2, f32x4 (&x1)[4], int lane) {
    f32x4 mv[4]; float s = 0.f;
#pragma unroll
    for (int j = 0; j < 4; ++j) { mv[j] = ld_bf4(mixrow + 4 * lane + 256 * j); s += (mv[j].x * mv[j].x + mv[j].y * mv[j].y) + (mv[j].z * mv[j].z + mv[j].w * mv[j].w); }
    const float r = rsqrtf(wave_sum(s) * (1.f / D) + EPS);
#pragma unroll
    for (int j = 0; j < 4; ++j) { const f32x4 w = ((const f32x4*)nw1)[lane + 64 * j], g = ((const f32x4*)g2)[lane + 64 * j], xv = ((const f32x4*)xrow)[lane + 64 * j];
        x1[j] = xv + g * (mv[j] * r * w); }
}

typedef float f32x16 __attribute__((ext_vector_type(16)));
typedef float f32x2_t __attribute__((ext_vector_type(2)));
typedef __bf16 bf16x2_t __attribute__((ext_vector_type(2)));
__device__ __forceinline__ unsigned cvtpk(float lo, float hi) { const f32x2_t v = {lo, hi}; const bf16x2_t b = __builtin_convertvector(v, bf16x2_t); return __builtin_bit_cast(unsigned, b); }
constexpr int HY_PITCH = 8720;
constexpr int HY_TAB0 = 8 * HY_PITCH;
constexpr int HY_TAB1 = HY_TAB0 + 17408 + 64;
__device__ __forceinline__ void conv8(const u32x4 raw, float left, float right, float w0, float w1, float w2, float bias, float (&o)[8]) {
    float in[10]; in[0] = left; in[9] = right;
    in[1] = pg8::bflo(raw.x); in[2] = pg8::bfhi(raw.x); in[3] = pg8::bflo(raw.y); in[4] = pg8::bfhi(raw.y); in[5] = pg8::bflo(raw.z); in[6] = pg8::bfhi(raw.z); in[7] = pg8::bflo(raw.w); in[8] = pg8::bfhi(raw.w);
#pragma unroll
    for (int j = 0; j < 8; ++j) o[j] = bias + w0 * in[j] + w1 * in[j + 1] + w2 * in[j + 2];
}
__device__ __forceinline__ void hyena_channel(LAS unsigned char* lds, int c, bf16_t* PHYT, const bf16_t* GTB, const float* hy_sw, const float* hy_sb) {
    const int tid = threadIdx.x, lane = tid & 63, wave = __builtin_amdgcn_readfirstlane(tid >> 6);
    __syncthreads();
    for (int ci = tid; ci < 1088; ci += 512) { u32x4 v = (u32x4){0u, 0u, 0u, 0u};
        if (ci >= 32 && ci < 1056) v = *(const u32x4*)(GTB + (size_t)c * 8192 + (ci - 32) * 8);
        *(LAS u32x4*)(lds + HY_TAB0 + ci * 16) = v; }
    {
        const bf16_t* x1r = PHYT + (size_t)(512 + c) * NT; const bf16_t* vr = PHYT + (size_t)(1024 + c) * NT;
        const float xw0 = hy_sw[512 + c], xw1 = hy_sw[1536 + 512 + c], xw2 = hy_sw[3072 + 512 + c], xb = hy_sb[512 + c];
        const float vw0 = hy_sw[1024 + c], vw1 = hy_sw[1536 + 1024 + c], vw2 = hy_sw[3072 + 1024 + c], vb = hy_sb[1024 + c];
        for (int q = tid; q < 4096; q += 512) { const int b = q >> 9, s8 = (q & 511) * 8; const size_t o = (size_t)b * L + s8;
            const u32x4 xa = *(const u32x4*)(x1r + o), va = *(const u32x4*)(vr + o);
            const bool hl = (s8 & 63) != 0, hr = ((s8 + 8) & 63) != 0;
            const float xl = hl ? bf2f(x1r[o - 1]) : 0.f, xr = hr ? bf2f(x1r[o + 8]) : 0.f, vl = hl ? bf2f(vr[o - 1]) : 0.f, vrr = hr ? bf2f(vr[o + 8]) : 0.f;
            float cx[8], cv[8]; conv8(xa, xl, xr, xw0, xw1, xw2, xb, cx); conv8(va, vl, vrr, vw0, vw1, vw2, vb, cv);
            u32x4 w; w.x = cvtpk(cx[0] * cv[0], cx[1] * cv[1]); w.y = cvtpk(cx[2] * cv[2], cx[3] * cv[3]); w.z = cvtpk(cx[4] * cv[4], cx[5] * cv[5]); w.w = cvtpk(cx[6] * cv[6], cx[7] * cv[7]);
            *(LAS u32x4*)(lds + b * HY_PITCH + (128 + s8) * 2) = w; }
        if (tid < 256) { const int b = tid >> 5, side = (tid >> 4) & 1, k = tid & 15;
            *(LAS u32x4*)(lds + b * HY_PITCH + (side ? (128 + 4096) * 2 : 0) + k * 16) = (u32x4){0u, 0u, 0u, 0u}; }
    }
    __syncthreads();
    for (int ci = tid; ci < 1088; ci += 512) { const u32x4 d = *(const LAS u32x4*)(lds + HY_TAB0 + ci * 16); const unsigned d4 = ci < 1087 ? *(const LAS unsigned*)(lds + HY_TAB0 + ci * 16 + 16) : 0u;
        u32x4 o; o.x = __builtin_amdgcn_alignbit(d.y, d.x, 16); o.y = __builtin_amdgcn_alignbit(d.z, d.y, 16); o.z = __builtin_amdgcn_alignbit(d.w, d.z, 16); o.w = __builtin_amdgcn_alignbit(d4, d.w, 16);
        *(LAS u32x4*)(lds + HY_TAB1 + ci * 16) = o; }
    __syncthreads();
    const int T0 = 512 * wave, r = lane & 31, h = lane >> 5, bb = r >> 2, tb = r & 3;
    f32x16 acc[4];
#pragma unroll
    for (int i = 0; i < 4; ++i)
#pragma unroll
        for (int j = 0; j < 16; ++j) acc[i][j] = 0.f;
    {
        const int Dfirst = T0 - 4080;
        const int e0 = 4351 - Dfirst - r + 8 * h;
        unsigned aaddr = (unsigned)((e0 & 1) ? HY_TAB1 : HY_TAB0) + (unsigned)(e0 & ~1) * 2u;
        unsigned baddr = (unsigned)(bb * HY_PITCH + (128 + T0 + 32 * tb - Dfirst + 8 * h) * 2);
#define HY_LDA(dst, ad) do { u32x4 _t; _t.x = *(const LAS unsigned*)(lds + (ad)); _t.y = *(const LAS unsigned*)(lds + (ad) + 4); _t.z = *(const LAS unsigned*)(lds + (ad) + 8); _t.w = *(const LAS unsigned*)(lds + (ad) + 12); dst = __builtin_bit_cast(pg8::bf16x8, _t); } while (0)
#define HY_LDB(dst, ad) dst = *(const LAS pg8::bf16x8*)(lds + (ad))
        pg8::bf16x8 A, B0, B1, B2, B3;
        const pg8::bf16x8 zz = (pg8::bf16x8){0, 0, 0, 0, 0, 0, 0, 0};
        HY_LDA(A, aaddr); HY_LDB(B0, baddr); B1 = zz; B2 = zz; B3 = zz;
        for (int st = 0; st < 286; ++st) {
            const int d = -4080 + 16 * st, dn = d + 16;
            pg8::bf16x8 An, B0n = zz, B1n = zz, B2n = zz, B3n = zz;
            const unsigned an = aaddr - 32u, bn = baddr - 32u;
            HY_LDA(An, an);
            if (dn <= 96) HY_LDB(B0n, bn);
            if (dn >= -3952 && dn <= 224) HY_LDB(B1n, bn + 256);
            if (dn >= -3824 && dn <= 352) HY_LDB(B2n, bn + 512);
            if (dn >= -3696 && dn <= 480) HY_LDB(B3n, bn + 768);
            if (d <= 96) acc[0] = __builtin_amdgcn_mfma_f32_32x32x16_bf16(A, B0, acc[0], 0, 0, 0);
            if (d >= -3952 && d <= 224) acc[1] = __builtin_amdgcn_mfma_f32_32x32x16_bf16(A, B1, acc[1], 0, 0, 0);
            if (d >= -3824 && d <= 352) acc[2] = __builtin_amdgcn_mfma_f32_32x32x16_bf16(A, B2, acc[2], 0, 0, 0);
            if (d >= -3696) acc[3] = __builtin_amdgcn_mfma_f32_32x32x16_bf16(A, B3, acc[3], 0, 0, 0);
            A = An; B0 = B0n; B1 = B1n; B2 = B2n; B3 = B3n; aaddr = an; baddr = bn;
        }
#undef HY_LDA
#undef HY_LDB
    }
    __syncthreads();
#pragma unroll
    for (int i = 0; i < 4; ++i)
#pragma unroll
        for (int g = 0; g < 4; ++g) { const int t = T0 + 128 * i + 32 * tb + 8 * g + 4 * h;
            pg8::u32x2 w; w.x = cvtpk(acc[i][4 * g], acc[i][4 * g + 1]); w.y = cvtpk(acc[i][4 * g + 2], acc[i][4 * g + 3]);
            *(LAS pg8::u32x2*)(lds + bb * HY_PITCH + (128 + t) * 2) = w; }
    __syncthreads();
    {
        const bf16_t* x0r = PHYT + (size_t)c * NT; bf16_t* yr = PHYT + (size_t)(1024 + c) * NT;
        const float w0 = hy_sw[c], w1 = hy_sw[1536 + c], w2 = hy_sw[3072 + c], bs = hy_sb[c];
        for (int q = tid; q < 4096; q += 512) { const int b = q >> 9, s8 = (q & 511) * 8; const size_t o = (size_t)b * L + s8;
            const u32x4 xa = *(const u32x4*)(x0r + o);
            const bool hl = (s8 & 63) != 0, hr = ((s8 + 8) & 63) != 0;
            const float xl = hl ? bf2f(x0r[o - 1]) : 0.f, xr = hr ? bf2f(x0r[o + 8]) : 0.f;
            float cx[8]; conv8(xa, xl, xr, w0, w1, w2, bs, cx);
            const u32x4 y = *(const LAS u32x4*)(lds + b * HY_PITCH + (128 + s8) * 2);
            u32x4 w; w.x = cvtpk(cx[0] * pg8::bflo(y.x), cx[1] * pg8::bfhi(y.x)); w.y = cvtpk(cx[2] * pg8::bflo(y.y), cx[3] * pg8::bfhi(y.y));
            w.z = cvtpk(cx[4] * pg8::bflo(y.z), cx[5] * pg8::bfhi(y.z)); w.w = cvtpk(cx[6] * pg8::bflo(y.w), cx[7] * pg8::bfhi(y.w));
            *(u32x4*)(yr + o) = w; }
    }
}


constexpr int HG_QE = 0, HG_KE = 17408, HG_KDT = 34816, HG_VT = 53248, HG_SC = 71680, HG_DEC = 80896, HG_SEG = 81408;
template <bool HAS_Q>
__device__ __forceinline__ void hgrn_chain_mfma(LAS unsigned char* lds, const bf16_t* pi, int ldi, const bf16_t* pz, int ldz, const bf16_t* pq, int ldq, int Lseq, int h, int dir,
                                                const float* lb, const float* s_in, float* s_out, float* o_out) {
    const int tid = threadIdx.x, lane = tid & 63, wave = __builtin_amdgcn_readfirstlane(tid >> 6);
    const int dp = lane, cs = wave, fr = lane & 15, kg = lane >> 4;
    const float lb0 = lb[h * 128 + 2 * dp], lb1 = lb[h * 128 + 2 * dp + 1];
    f32x4 S[8];
#pragma unroll
    for (int blk = 0; blk < 8; ++blk)
#pragma unroll
        for (int r = 0; r < 4; ++r) S[blk][r] = s_in ? s_in[(size_t)(16 * blk + 4 * kg + r) * 128 + 16 * wave + fr] : 0.f;
    const int nch = Lseq / 64;
#define HG_BAR() do { asm volatile("s_waitcnt lgkmcnt(0)" ::: "memory"); __builtin_amdgcn_s_barrier(); asm volatile("" ::: "memory"); } while (0)
    unsigned zr[8], qr[8], vr[8];
#define HG_LOAD(n) do { const int _base = dir ? (Lseq - 64 * ((n) + 1)) : 64 * (n); _Pragma("unroll") for (int i = 0; i < 8; ++i) { const int _cp = 8 * cs + i; const int _t = _base + (dir ? 63 - _cp : _cp); \
        zr[i] = *(const unsigned*)(pz + (size_t)_t * ldz + h * 128 + 2 * dp); vr[i] = *(const unsigned*)(pi + (size_t)_t * ldi + h * 128 + 2 * dp); \
        if (HAS_Q) qr[i] = *(const unsigned*)(pq + (size_t)_t * ldq + h * 128 + 2 * dp); } } while (0)
    HG_LOAD(0);
    __syncthreads();
    for (int n = 0; n < nch; ++n) {
        float F0[8], F1[8], k0[8], k1[8];
        {
            float p0 = 1.f, p1 = 1.f;
#pragma unroll
            for (int i = 0; i < 8; ++i) { const float f0 = lb0 + (1.f - lb0) * pg8::sigm(pg8::bflo(zr[i])), f1 = lb1 + (1.f - lb1) * pg8::sigm(pg8::bfhi(zr[i]));
                k0[i] = 1.f - f0; k1[i] = 1.f - f1; p0 *= f0; p1 *= f1; F0[i] = p0; F1[i] = p1; }
            *(LAS f32x2_t*)(lds + HG_SEG + (cs * 128 + 2 * dp) * 4) = (f32x2_t){p0, p1};
        }
        HG_BAR();
        {
            u32x4 lo, hi;
            lo.x = (vr[0] & 0xffffu) | (vr[1] << 16); lo.y = (vr[2] & 0xffffu) | (vr[3] << 16); lo.z = (vr[4] & 0xffffu) | (vr[5] << 16); lo.w = (vr[6] & 0xffffu) | (vr[7] << 16);
            hi.x = (vr[0] >> 16) | (vr[1] & 0xffff0000u); hi.y = (vr[2] >> 16) | (vr[3] & 0xffff0000u); hi.z = (vr[4] >> 16) | (vr[5] & 0xffff0000u); hi.w = (vr[6] >> 16) | (vr[7] & 0xffff0000u);
            *(LAS u32x4*)(lds + HG_VT + (2 * dp) * 144 + 16 * cs) = lo; *(LAS u32x4*)(lds + HG_VT + (2 * dp + 1) * 144 + 16 * cs) = hi;
        }
        {
            float pre0 = 1.f, pre1 = 1.f, fl0 = 1.f, fl1 = 1.f;
#pragma unroll
            for (int s = 0; s < 8; ++s) { const f32x2_t t = *(const LAS f32x2_t*)(lds + HG_SEG + (s * 128 + 2 * dp) * 4); fl0 *= t.x; fl1 *= t.y; if (s < cs) { pre0 *= t.x; pre1 *= t.y; } }
            if (cs == 0) *(LAS f32x2_t*)(lds + HG_DEC + 2 * dp * 4) = (f32x2_t){fl0, fl1};
            unsigned kd0[8], kd1[8];
#pragma unroll
            for (int i = 0; i < 8; ++i) { const float Fa = F0[i] * pre0, Fb = F1[i] * pre1; const float ia = __builtin_amdgcn_rcpf(Fa), ib = __builtin_amdgcn_rcpf(Fb);
                const float kea = k0[i] * ia, keb = k1[i] * ib; const int cp = 8 * cs + i;
                if (HAS_Q) { *(LAS unsigned*)(lds + HG_QE + cp * 272 + 4 * dp) = cvtpk(pg8::bflo(qr[i]) * Fa, pg8::bfhi(qr[i]) * Fb);
                             *(LAS unsigned*)(lds + HG_KE + cp * 272 + 4 * dp) = cvtpk(kea, keb); }
                kd0[i] = __float_as_uint(kea * fl0); kd1[i] = __float_as_uint(keb * fl1); }
            u32x4 a, b;
            a.x = cvtpk(__uint_as_float(kd0[0]), __uint_as_float(kd0[1])); a.y = cvtpk(__uint_as_float(kd0[2]), __uint_as_float(kd0[3])); a.z = cvtpk(__uint_as_float(kd0[4]), __uint_as_float(kd0[5])); a.w = cvtpk(__uint_as_float(kd0[6]), __uint_as_float(kd0[7]));
            b.x = cvtpk(__uint_as_float(kd1[0]), __uint_as_float(kd1[1])); b.y = cvtpk(__uint_as_float(kd1[2]), __uint_as_float(kd1[3])); b.z = cvtpk(__uint_as_float(kd1[4]), __uint_as_float(kd1[5])); b.w = cvtpk(__uint_as_float(kd1[6]), __uint_as_float(kd1[7]));
            *(LAS u32x4*)(lds + HG_KDT + (2 * dp) * 144 + 16 * cs) = a; *(LAS u32x4*)(lds + HG_KDT + (2 * dp + 1) * 144 + 16 * cs) = b;
        }
        if (n + 1 < nch) HG_LOAD(n + 1);
        HG_BAR();
        if (HAS_Q) {
            const int cb = wave >> 1;
#pragma unroll
            for (int u = 0; u < 2; ++u) { const int sb = 2 * (wave & 1) + u; f32x4 sc = (f32x4){0.f, 0.f, 0.f, 0.f};
                if (sb <= cb) {
#pragma unroll
                    for (int ks = 0; ks < 4; ++ks) { const pg8::bf16x8 A = *(const LAS pg8::bf16x8*)(lds + HG_QE + (16 * cb + fr) * 272 + (32 * ks + 8 * kg) * 2);
                        const pg8::bf16x8 B = *(const LAS pg8::bf16x8*)(lds + HG_KE + (16 * sb + fr) * 272 + (32 * ks + 8 * kg) * 2);
                        sc = __builtin_amdgcn_mfma_f32_16x16x32_bf16(A, B, sc, 0, 0, 0); } }
#pragma unroll
                for (int r = 0; r < 4; ++r) { const int c = 16 * cb + 4 * kg + r, s = 16 * sb + fr; const float v = (s <= c) ? sc[r] : 0.f;
                    *(LAS bf16_t*)(lds + HG_SC + c * 144 + s * 2) = (bf16_t)f2bf(v); } }
        }
        HG_BAR();
        {
            pg8::bf16x8 Bv[2];
#pragma unroll
            for (int ks = 0; ks < 2; ++ks) Bv[ks] = *(const LAS pg8::bf16x8*)(lds + HG_VT + (16 * wave + fr) * 144 + (32 * ks + 8 * kg) * 2);
            if (HAS_Q) {
                pg8::bf16x8 Bs[4];
#pragma unroll
                for (int kp = 0; kp < 4; ++kp) { u32x4 t; t.x = cvtpk(S[2 * kp][0], S[2 * kp][1]); t.y = cvtpk(S[2 * kp][2], S[2 * kp][3]); t.z = cvtpk(S[2 * kp + 1][0], S[2 * kp + 1][1]); t.w = cvtpk(S[2 * kp + 1][2], S[2 * kp + 1][3]);
                    Bs[kp] = __builtin_bit_cast(pg8::bf16x8, t); }
                const int base = dir ? (Lseq - 64 * (n + 1)) : 64 * n;
#pragma unroll
                for (int cb = 0; cb < 4; ++cb) { f32x4 o = (f32x4){0.f, 0.f, 0.f, 0.f};
#pragma unroll
                    for (int ks = 0; ks < 2; ++ks) { const pg8::bf16x8 A = *(const LAS pg8::bf16x8*)(lds + HG_SC + (16 * cb + fr) * 144 + (32 * ks + 8 * kg) * 2);
                        o = __builtin_amdgcn_mfma_f32_16x16x32_bf16(A, Bv[ks], o, 0, 0, 0); }
#pragma unroll
                    for (int kp = 0; kp < 4; ++kp) { const u32x2 a0 = *(const LAS u32x2*)(lds + HG_QE + (16 * cb + fr) * 272 + (32 * kp + 4 * kg) * 2), a1 = *(const LAS u32x2*)(lds + HG_QE + (16 * cb + fr) * 272 + (32 * kp + 16 + 4 * kg) * 2);
                        const pg8::bf16x8 A = __builtin_bit_cast(pg8::bf16x8, (u32x4){a0.x, a0.y, a1.x, a1.y});
                        o = __builtin_amdgcn_mfma_f32_16x16x32_bf16(A, Bs[kp], o, 0, 0, 0); }
#pragma unroll
                    for (int r = 0; r < 4; ++r) { const int cp = 16 * cb + 4 * kg + r; const int t = base + (dir ? 63 - cp : cp); o_out[(size_t)t * HW + h * 128 + 16 * wave + fr] = o[r]; } }
            }
#pragma unroll
            for (int blk = 0; blk < 8; ++blk) { const f32x4 dc = *(const LAS f32x4*)(lds + HG_DEC + (16 * blk + 4 * kg) * 4); f32x4 s = S[blk] * dc;
#pragma unroll
                for (int ks = 0; ks < 2; ++ks) { const pg8::bf16x8 A = *(const LAS pg8::bf16x8*)(lds + HG_KDT + (16 * blk + fr) * 144 + (32 * ks + 8 * kg) * 2);
                    s = __builtin_amdgcn_mfma_f32_16x16x32_bf16(A, Bv[ks], s, 0, 0, 0); }
                S[blk] = s; }
        }
    }
#undef HG_LOAD
#undef HG_BAR
    if (s_out) {
#pragma unroll
        for (int blk = 0; blk < 8; ++blk)
#pragma unroll
            for (int r = 0; r < 4; ++r) s_out[(size_t)(16 * blk + 4 * kg + r) * 128 + 16 * wave + fr] = S[blk][r];
    }
    __syncthreads();
}

__global__ void __launch_bounds__(512, 2) mega(Params P) {
    extern __shared__ __attribute__((aligned(16))) unsigned char lds_raw[];
    cg::grid_group grid = cg::this_grid();
    LAS unsigned char* lds = (LAS unsigned char*)lds_raw;
    const int tid = threadIdx.x, lane = tid & 63, wave = __builtin_amdgcn_readfirstlane(tid >> 6);
    const int G = gridDim.x, bx = blockIdx.x;
    const int vcu = (G % 8 == 0) ? (bx % 8) * (G / 8) + bx / 8 : bx;
    const int gw = vcu * 8 + wave, NGW = G * 8;
    unsigned char* ws = P.ws;
    const float* x = P.in[0]; const float* cvec = P.in[1]; const float* ctx = P.in[2]; const float* c_ctx = P.in[3];
    const float* w_ada = P.in[4]; const float* b_ada = P.in[5]; const float* norm_w = P.in[6]; const float* w_in = P.in[7];
    const float* lb_param = P.in[8]; const float* g_norm = P.in[9]; const float* hy_sw = P.in[10]; const float* hy_sb = P.in[11];
    const float* f_w1 = P.in[12]; const float* f_b1 = P.in[13]; const float* f_w2 = P.in[14]; const float* f_b2 = P.in[15];
    const float* f_w3 = P.in[16]; const float* f_freq = P.in[17]; const float* hy_d = P.in[18]; const float* w_pa = P.in[19];
    const float* w_pb = P.in[20]; const float* w_out = P.in[21]; const float* w_mlp1 = P.in[22]; const float* w_mlp2 = P.in[23];
    float* MOD = (float*)(ws + WS_MOD); float* LB = (float*)(ws + WS_LB); bf16_t* GTB = (bf16_t*)(ws + WS_GT);
    bf16_t* WIN = (bf16_t*)(ws + WS_WIN); bf16_t* WPAB = (bf16_t*)(ws + WS_WPAB); bf16_t* WOUT = (bf16_t*)(ws + WS_WOUT); bf16_t* W1 = (bf16_t*)(ws + WS_W1); bf16_t* W2 = (bf16_t*)(ws + WS_W2);
    bf16_t* HCTX = (bf16_t*)(ws + WS_HCTX); bf16_t* PCTX = (bf16_t*)(ws + WS_PCTX); float* SCTX = (float*)(ws + WS_SCTX);
    bf16_t* HLAT = (bf16_t*)(ws + WS_HLAT); bf16_t* PI = (bf16_t*)(ws + WS_PI); bf16_t* PZ = (bf16_t*)(ws + WS_PZ); bf16_t* PQ = (bf16_t*)(ws + WS_PQ);
    bf16_t* PG = (bf16_t*)(ws + WS_PG); bf16_t* GATES = (bf16_t*)(ws + WS_GATES); bf16_t* PHYT = (bf16_t*)(ws + WS_PHYT);
    bf16_t* AY = (bf16_t*)(ws + WS_AY2); bf16_t* MERGED = (bf16_t*)(ws + WS_MERGED); bf16_t* MIX = (bf16_t*)(ws + WS_MIX);
    bf16_t* MLP = (bf16_t*)(ws + WS_MLP); bf16_t* H1 = (bf16_t*)(ws + WS_H1); bf16_t* HL = (bf16_t*)(ws + WS_HL);
    float* O2 = P.out;

    volatile LAS unsigned* MISC = (volatile LAS unsigned*)(lds + 131072 + 64);
    if (tid < 16) MISC[tid] = 0u;
    __syncthreads();
    const XcdBarrier xbar = xcd_barrier_post((unsigned*)ws, MISC);
#define SEAM_RAW(k) do { if ((k) == 0) grid.sync(); else xcd_barrier(xbar); } while (0)
#if PROBE_MASK
    unsigned long long t_prev = __builtin_amdgcn_s_memrealtime(), t_spin = 0ull;
#ifndef PROBE_BUSY_PHASE
#define PROBE_BUSY_PHASE -1
#define PROBE_BUSY_BLOCK 0
#endif
#define SEAM(k) do { if ((k) == PROBE_BUSY_PHASE && bx == PROBE_BUSY_BLOCK && tid == 0) *(volatile unsigned long long*)(ws + 32768) = __builtin_amdgcn_s_memrealtime() - t_prev; \
    SEAM_RAW(k); { const unsigned long long _t = __builtin_amdgcn_s_memrealtime(); if ((PROBE_MASK >> (k)) & 1) t_spin += _t - t_prev; \
    if ((k) == PROBE_BUSY_PHASE) t_spin += *(volatile unsigned long long*)(ws + 32768); t_prev = _t; } } while (0)
#else
#define SEAM(k) SEAM_RAW(k)
#endif
    {
        if (bx < 96) {
            LAS float* sc = (LAS float*)lds;
            LAS float* ps = (LAS float*)(lds + 40960);
            for (int i = tid; i < 9 * D; i += 512) { const int r = i >> 10, k = i & 1023; sc[i] = siluf_(r < 8 ? cvec[r * D + k] : c_ctx[k]); }
            __syncthreads();
            const int j = bx * 64 + lane; float a9[9];
#pragma unroll
            for (int r = 0; r < 9; ++r) a9[r] = 0.f;
            for (int k = wave * 128; k < wave * 128 + 128; ++k) { const float w = w_ada[(size_t)k * INC + j];
#pragma unroll
                for (int r = 0; r < 9; ++r) a9[r] += sc[r * D + k] * w; }
#pragma unroll
            for (int r = 0; r < 9; ++r) ps[(wave * 9 + r) * 64 + lane] = a9[r];
            __syncthreads();
            for (int i = tid; i < 9 * 64; i += 512) { const int r = i >> 6, l = i & 63; float s = b_ada[bx * 64 + l];
#pragma unroll
                for (int w = 0; w < 8; ++w) s += ps[(w * 9 + r) * 64 + l];
                MOD[r * INC + bx * 64 + l] = s; }
            __syncthreads();
        }
        if (bx == G - 1) { const float a = lb_param[tid], b = lb_param[HW + tid], m = fmaxf(a, b); const float ea = expf(a - m), eb = expf(b - m); LB[tid] = ea / (ea + eb); }
        LAS float* scr = (LAS float*)(lds + wave * 16384);
        constexpr int I_IN = 16 * 192, I_PA = 8 * 32, I_OUT = 16 * 32, I_1 = 16 * 128, I_2 = 64 * 32;
        constexpr int NITEMS = I_IN + 2 * I_PA + I_OUT + I_1 + I_2;
        for (int it = gw; it < NITEMS; it += NGW) {
            int r = it;
            if (r < I_IN) { transpose_item(w_in, INC, WIN, D, 0, 1, scr, r, lane); continue; } r -= I_IN;
            if (r < I_PA) { transpose_item(w_pa, D, WPAB, D, 0, 0, scr, r, lane); continue; } r -= I_PA;
            if (r < I_PA) { transpose_item(w_pb, D, WPAB, D, 512, 0, scr, r, lane); continue; } r -= I_PA;
            if (r < I_OUT) { transpose_item(w_out, D, WOUT, D, 0, 0, scr, r, lane); continue; } r -= I_OUT;
            if (r < I_1) { transpose_item(w_mlp1, FF, W1, D, 0, 0, scr, r, lane); continue; } r -= I_1;
            transpose_item(w_mlp2, D, W2, FF, 0, 0, scr, r, lane);
        }
        for (int t = gw; t < L; t += NGW) {
            LAS float* z = scr; LAS float* h1 = scr + 64; LAS float* h2 = scr + 128;
            const float tn = (float)t / (float)(L - 1);
            if (lane < 33) {
                float val;
                if (lane == 0) val = tn;
                else { const int bi = (lane - 1) & 15; const float band = 1e-4f + (float)bi * ((15.f - 1e-4f) / 15.f);
                    const float w = 2.0f * 3.14159265358979323846f * (float)t / (float)L; const float ang = w * band;
                    val = (lane <= 16) ? cosf(ang) : -sinf(ang); }
                z[lane] = val;
            }
            LDS_WAIT();
            { float acc = f_b1[lane]; for (int i = 0; i < 33; ++i) acc += z[i] * f_w1[i * 64 + lane]; h1[lane] = sinf(f_freq[lane] * acc); }
            LDS_WAIT();
            { float acc = f_b2[lane]; for (int i = 0; i < 64; ++i) acc += h1[i] * f_w2[i * 64 + lane]; h2[lane] = sinf(f_freq[lane] * acc); }
            LDS_WAIT();
            const float mind = logf(1e-2f) / 1.5f, maxd = logf(1e-2f) / 0.3f;
            for (int j = lane; j < 1024; j += 64) {
                float acc = 0.f; for (int i = 0; i < 64; ++i) acc += h2[i] * f_w3[i * 1024 + j];
                const int dirb = j >> 9, c = j & 511;
                const float delta = fabsf(mind + (maxd - mind) * ((float)c / 511.f));
                float val = acc * expf(-tn * delta);
                if (dirb == 0) { if (t == 0) val += hy_d[c]; GTB[(size_t)c * 8192 + 4095 - t] = (bf16_t)f2bf(val); }
                else if (t > 0) GTB[(size_t)c * 8192 + 4095 + t] = (bf16_t)f2bf(val);
                else GTB[(size_t)c * 8192 + 8191] = (bf16_t)0;
            }
            LDS_WAIT();
        }
    }
    SEAM(0);
    for (int m = gw; m < NT + NCX; m += NGW) {
        if (m < NT) { const float* mb = MOD + (size_t)(m >> 12) * INC; row_norm_mod_bf16(x + (size_t)m * D, norm_w, mb, mb + D, HLAT + (size_t)m * D, lane); }
        else { const int mc = m - NT; const float* mb = MOD + (size_t)8 * INC; row_norm_mod_bf16(ctx + (size_t)mc * D, norm_w, mb, mb + D, HCTX + (size_t)mc * D, lane); }
    }
    SEAM(1);
    {
        { pg8::Gemm g{HLAT, WIN, D, D, D}; pg8::StaticOrder S; S.init(NT, 4608, G, bx); pg8::EpiG1 E{PI, PZ, PQ, PG, GATES};
          pg8::gemm_phase(lds, g, S, E); }
        { pg8::Gemm g{WIN + (size_t)4608 * D, HLAT, D, D, D}; pg8::StaticOrder S; S.init(1536, NT, G, bx); pg8::EpiBf16<0> E{PHYT, NT};
          pg8::gemm_phase(lds, g, S, E); }
        { pg8::Gemm g{HCTX, WIN, D, D, D}; pg8::StaticOrder S; S.init(NCX, 1536, G, bx); pg8::EpiBf16<0> E{PCTX, 1536};
          pg8::gemm_phase(lds, g, S, E); }
    }
    SEAM(2);
    if (bx < 64) { const int b = bx >> 3, h = (bx >> 1) & 3, dir = bx & 1;
        hgrn_chain_mfma<false>(lds, PCTX + (size_t)b * LC * 1536, 1536, PCTX + (size_t)b * LC * 1536 + (dir ? 1024 : 512), 1536, nullptr, 0, LC, h, dir, LB,
                   nullptr, SCTX + (size_t)((b * 2 + dir) * 4 + h) * 16384, nullptr); }
    SEAM(3);
    if (bx < 64) { const int b = bx >> 3, h = (bx >> 1) & 3, dir = bx & 1;
        hgrn_chain_mfma<true>(lds, PI + (size_t)b * L * 512, 512, PZ + (size_t)b * L * 1024 + (dir ? 512 : 0), 1024, PQ + (size_t)b * L * 512, 512, L, h, dir, LB,
                   SCTX + (size_t)((b * 2 + dir) * 4 + h) * 16384, nullptr, O2 + ((size_t)dir * NT + (size_t)b * L) * HW); }
    else {
        for (int c = bx - 64; c < HW; c += G - 64) hyena_channel(lds, c, PHYT, GTB, hy_sw, hy_sb);
    }
    SEAM(4);
    for (int w = gw; w < NT * 4; w += NGW) { const int t = w >> 2, h = w & 3; float v[2]; float s = 0.f;
#pragma unroll
        for (int i = 0; i < 2; ++i) { const int c = h * 128 + lane + 64 * i; v[i] = O2[(size_t)t * HW + c] + O2[((size_t)NT + t) * HW + c]; s += v[i] * v[i]; }
        const float r = rsqrtf(wave_sum(s) * (1.f / 128.f) + EPS);
#pragma unroll
        for (int i = 0; i < 2; ++i) { const int vv = lane + 64 * i, c = h * 128 + vv; AY[(size_t)t * 1024 + c] = (bf16_t)f2bf(v[i] * r * g_norm[vv] * bf2f(PG[(size_t)t * 512 + c])); } }
    {
        LAS bf16_t* tl = (LAS bf16_t*)(lds + wave * 16384);
        for (int it = gw; it < 8 * 512; it += NGW) { const int c0 = (it & 7) * 64, tok0 = (it >> 3) * 64;
#pragma unroll
            for (int i = 0; i < 8; ++i) { const int ch = lane + 64 * i, rr = ch >> 3, cc = (ch & 7) * 8;
                const u32x4 v = *(const u32x4*)(PHYT + (size_t)(1024 + c0 + rr) * NT + tok0 + cc);
                LAS unsigned* d = (LAS unsigned*)(tl + rr * 66 + cc); d[0] = v.x; d[1] = v.y; d[2] = v.z; d[3] = v.w; }
            LDS_WAIT();
#pragma unroll
            for (int i = 0; i < 8; ++i) { const int ch = lane + 64 * i, tt = ch >> 3, cc = (ch & 7) * 8; unsigned o[4];
#pragma unroll
                for (int q = 0; q < 4; ++q) o[q] = (unsigned)tl[(cc + 2 * q) * 66 + tt] | ((unsigned)tl[(cc + 2 * q + 1) * 66 + tt] << 16);
                *(u32x4*)(AY + (size_t)(tok0 + tt) * 1024 + 512 + c0 + cc) = (u32x4){o[0], o[1], o[2], o[3]}; }
            LDS_WAIT();
        }
    }
    SEAM(5);
    {
        { pg8::Gemm g{AY, WPAB, D, D, 512}; pg8::StaticOrder S; S.init(NT, D, G, bx); pg8::EpiMerge<0> E{MERGED, GATES, 0}; pg8::gemm_phase(lds, g, S, E); }
        { pg8::Gemm g{AY + 512, WPAB + 512, D, D, 512}; pg8::StaticOrder S; S.init(NT, D, G, bx); pg8::EpiMerge<1> E{MERGED, GATES, 1024}; pg8::gemm_phase(lds, g, S, E); }
    }
    SEAM(6);
    { pg8::Gemm g{MERGED, WOUT, D, D, D}; pg8::StaticOrder S; S.init(NT, D, G, bx); pg8::EpiBf16<0> E{MIX, D}; pg8::gemm_phase(lds, g, S, E); }
    SEAM(7);
    for (int m = gw; m < NT; m += NGW) { const float* mb = MOD + (size_t)(m >> 12) * INC; f32x4 x1[4];
        row_x1(x + (size_t)m * D, MIX + (size_t)m * D, norm_w + D, mb + 2 * D, x1, lane);
        float s = 0.f;
#pragma unroll
        for (int j = 0; j < 4; ++j) s += (x1[j].x * x1[j].x + x1[j].y * x1[j].y) + (x1[j].z * x1[j].z + x1[j].w * x1[j].w);
        const float r = rsqrtf(wave_sum(s) * (1.f / D) + EPS);
        unsigned long long* o8 = (unsigned long long*)(HL + (size_t)m * D) + lane;
#pragma unroll
        for (int j = 0; j < 4; ++j) { const f32x4 w = ((const f32x4*)(norm_w + 2 * D))[lane + 64 * j], sc = ((const f32x4*)(mb + 3 * D))[lane + 64 * j], sh = ((const f32x4*)(mb + 4 * D))[lane + 64 * j];
            const f32x4 o = x1[j] * r * w * (1.f + sc) + sh;
            o8[64 * j] = (unsigned long long)pk2(o.x, o.y) | ((unsigned long long)pk2(o.z, o.w) << 32); } }
    SEAM(8);
    { pg8::Gemm g{HL, W1, D, D, D}; pg8::StaticOrder S; S.init(NT, FF, G, bx); pg8::EpiBf16<3> E{H1, FF}; pg8::gemm_phase(lds, g, S, E); }
    SEAM(9);
    { pg8::Gemm g{H1, W2, FF, FF, FF}; pg8::StaticOrder S; S.init(NT, D, G, bx); pg8::EpiBf16<0> E{MLP, D}; pg8::gemm_phase(lds, g, S, E); }
    SEAM(10);
    for (int m = gw; m < NT; m += NGW) { const float* mb = MOD + (size_t)(m >> 12) * INC; f32x4 x1[4];
        row_x1(x + (size_t)m * D, MIX + (size_t)m * D, norm_w + D, mb + 2 * D, x1, lane);
        f32x4 mv[4]; float s = 0.f;
#pragma unroll
        for (int j = 0; j < 4; ++j) { mv[j] = ld_bf4(MLP + (size_t)m * D + 4 * lane + 256 * j); s += (mv[j].x * mv[j].x + mv[j].y * mv[j].y) + (mv[j].z * mv[j].z + mv[j].w * mv[j].w); }
        const float r = rsqrtf(wave_sum(s) * (1.f / D) + EPS);
#pragma unroll
        for (int j = 0; j < 4; ++j) { const f32x4 w = ((const f32x4*)(norm_w + 3 * D))[lane + 64 * j], g = ((const f32x4*)(mb + 5 * D))[lane + 64 * j];
            ((f32x4*)(P.out + (size_t)m * D))[lane + 64 * j] = x1[j] + g * (mv[j] * r * w); } }
#if PROBE_MASK
    { const unsigned long long _t = __builtin_amdgcn_s_memrealtime(); if ((PROBE_MASK >> 11) & 1) t_spin += _t - t_prev;
      if (bx == 0) { const unsigned long long t0 = __builtin_amdgcn_s_memrealtime(); while (__builtin_amdgcn_s_memrealtime() - t0 < t_spin) __builtin_amdgcn_s_sleep(8); } }
#endif
#if PROBE_XSYNC
    for (int i = 0; i < PROBE_XSYNC; ++i) grid.sync();
#endif
}
}

extern "C" void kernel_launch(void* const* d_in, const int* in_sizes, int n_in, void* d_out, int out_size, void* d_ws, size_t ws_size, hipStream_t stream) {
    static int grid = 0;
    if (grid == 0) {
        if (n_in != 24 || ws_size < WS_END) { fprintf(stderr, "kernel_launch: unexpected n_in %d / ws_size %zu\n", n_in, ws_size); grid = -1; return; }
        int dev = 0, cus = 0, per_cu = 0;
        hipGetDevice(&dev); hipDeviceGetAttribute(&cus, hipDeviceAttributeMultiprocessorCount, dev);
        hipFuncSetAttribute((const void*)mega, hipFuncAttributeMaxDynamicSharedMemorySize, LDS_BYTES);
        hipOccupancyMaxActiveBlocksPerMultiprocessor(&per_cu, (const void*)mega, 512, LDS_BYTES);
        if (per_cu < 1) { fprintf(stderr, "kernel_launch: occupancy query says %d blocks per CU\n", per_cu); grid = -1; return; }
        grid = cus;
    }
    if (grid < 0) return;
    if (hipMemsetAsync(d_ws, 0, 65536, stream) != hipSuccess) { fprintf(stderr, "kernel_launch: memset failed\n"); return; }
    Params p{};
    for (int i = 0; i < 24; ++i) p.in[i] = (const float*)d_in[i];
    p.out = (float*)d_out; p.ws = (unsigned char*)d_ws;
    void* args[] = {&p};
    hipError_t e = hipLaunchCooperativeKernel((const void*)mega, dim3(grid), dim3(512), args, LDS_BYTES, stream);
    if (e != hipSuccess) fprintf(stderr, "cooperative launch failed: %s (grid %d)\n", hipGetErrorString(e), grid);
}
```

```cpp
#include <hip/hip_runtime.h>
#include <hip/hip_cooperative_groups.h>
#include <cstdio>
#include <math.h>
namespace cg = cooperative_groups;
#ifndef PROBE_MASK
#define PROBE_MASK 0
#endif
#ifndef PROBE_XSYNC
#define PROBE_XSYNC 0
#endif

namespace pg8 {
#define PG8_LAS __attribute__((address_space(3)))
typedef unsigned short bf16_t;
typedef short bf16x8 __attribute__((ext_vector_type(8)));
typedef float f32x4 __attribute__((ext_vector_type(4)));
typedef unsigned u32x4 __attribute__((ext_vector_type(4)));
typedef unsigned u32x2 __attribute__((ext_vector_type(2)));
constexpr int BM = 256, BK = 64, HALF = 128, HTB = HALF * BK * 2, STAGE_BYTES = 8 * HTB, NXCD = 8, WGM = 8;

__device__ __forceinline__ int lds_byte(int r, int c) { const int st = (r >> 4) * 2 + (c >> 5), rr = r & 15, cc = c & 31, ob = rr * 64 + cc * 2; return st * 1024 + (ob ^ (((ob >> 9) & 1) << 5)); }
__device__ __forceinline__ void stage_rc(int b, int& R, int& C) { const int st = b / 1024, sb = b % 1024, swz = sb ^ (((sb >> 9) & 1) << 5); R = (st >> 1) * 16 + swz / 64; C = (st & 1) * 32 + (swz % 64) / 2; }
__device__ __forceinline__ int perm32(int rho) { const int n = rho >> 4, i = rho & 15; return 8 * (i >> 2) + 4 * n + (i & 3); }

struct Unit { int pm, pn; };
struct Gemm { const bf16_t* A; const bf16_t* Bt; int lda, ldb, K; };

struct StaticOrder {
    int nM, nN, nwg, G, c;
    __device__ void init(int M, int N, int G_, int c_) { nM = M / BM; nN = N / BM; nwg = nM * nN; G = G_; c = c_; }
    __device__ bool next(int i, Unit& u) const {
        const long L = (long)i * G + c; if (L >= nwg) return false;
        int wgid = (int)L; { const int q = nwg / NXCD, r = nwg % NXCD, xcd = wgid % NXCD, off = wgid / NXCD; wgid = (xcd < r ? xcd * (q + 1) : r * (q + 1) + (xcd - r) * q) + off; }
        const int nig = WGM * nN, gid = wgid / nig, fm = gid * WGM, gsz = (nM - fm) < WGM ? (nM - fm) : WGM;
        u.pm = fm + ((wgid % nig) % gsz); u.pn = (wgid % nig) / gsz; return true;
    }
};

__device__ __forceinline__ unsigned cvt_pk_bf16(float lo, float hi) { unsigned r; asm volatile("v_cvt_pk_bf16_f32 %0, %1, %2" : "=v"(r) : "v"(lo), "v"(hi)); return r; }
__device__ __forceinline__ float sigm(float x) { return __builtin_amdgcn_rcpf(1.0f + __builtin_amdgcn_exp2f(-1.4426950408889634f * x)); }
__device__ __forceinline__ float bflo(unsigned u) { return __uint_as_float(u << 16); }
__device__ __forceinline__ float bfhi(unsigned u) { return __uint_as_float(u & 0xffff0000u); }

template <int ACT  > struct EpiBf16 {
    static constexpr bool PERM = true;
    bf16_t* O; int ldc;
    __device__ __forceinline__ void operator()(const f32x4 (&acc)[2][2][4][2], const Unit& u, int wr, int wc, int fr, int fq) const {
        const int row0 = u.pm * BM + wr * 64 + fr, col0 = u.pn * BM + wc * 32 + 8 * fq;
#pragma unroll
        for (int ai = 0; ai < 2; ++ai)
#pragma unroll
            for (int m = 0; m < 4; ++m) { bf16_t* rowp = O + (size_t)(row0 + ai * HALF + m * 16) * ldc + col0;
#pragma unroll
                for (int bj = 0; bj < 2; ++bj) { f32x4 v0 = acc[ai][bj][m][0], v1 = acc[ai][bj][m][1];
                    if (ACT == 3) {
#pragma unroll
                        for (int j = 0; j < 4; ++j) { const float a = fmaxf(v0[j], 0.f), b = fmaxf(v1[j], 0.f); v0[j] = a * a; v1[j] = b * b; } }
                    u32x4 w; w.x = cvt_pk_bf16(v0[0], v0[1]); w.y = cvt_pk_bf16(v0[2], v0[3]); w.z = cvt_pk_bf16(v1[0], v1[1]); w.w = cvt_pk_bf16(v1[2], v1[3]);
                    *(u32x4*)(rowp + bj * HALF) = w; } }
    }
};
struct EpiG1 {
    static constexpr bool PERM = true;
    bf16_t *PI, *PZ, *PQ, *PG, *GATES;
    __device__ __forceinline__ void operator()(const f32x4 (&acc)[2][2][4][2], const Unit& u, int wr, int wc, int fr, int fq) const {
        const int pn = u.pn; bf16_t* base; int ld, cb, act;
        if (pn < 2) { base = PI; ld = 512; cb = pn * 256; act = 0; }
        else if (pn < 6) { base = PZ; ld = 1024; cb = (pn - 2) * 256; act = 0; }
        else if (pn < 8) { base = PQ; ld = 512; cb = (pn - 6) * 256; act = 1; }
        else if (pn < 10) { base = PG; ld = 512; cb = (pn - 8) * 256; act = 1; }
        else { base = GATES; ld = 2048; cb = (pn - 10) * 256; act = 2; }
        const int row0 = u.pm * BM + wr * 64 + fr, col0 = cb + wc * 32 + 8 * fq;
#pragma unroll
        for (int ai = 0; ai < 2; ++ai)
#pragma unroll
            for (int m = 0; m < 4; ++m) { bf16_t* rowp = base + (size_t)(row0 + ai * HALF + m * 16) * ld + col0;
#pragma unroll
                for (int bj = 0; bj < 2; ++bj) { f32x4 v0 = acc[ai][bj][m][0], v1 = acc[ai][bj][m][1];
                    if (act != 0) {
#pragma unroll
                        for (int j = 0; j < 4; ++j) { const float s0 = sigm(v0[j]), s1 = sigm(v1[j]); v0[j] = act == 1 ? v0[j] * s0 : s0; v1[j] = act == 1 ? v1[j] * s1 : s1; } }
                    u32x4 w; w.x = cvt_pk_bf16(v0[0], v0[1]); w.y = cvt_pk_bf16(v0[2], v0[3]); w.z = cvt_pk_bf16(v1[0], v1[1]); w.w = cvt_pk_bf16(v1[2], v1[3]);
                    *(u32x4*)(rowp + bj * HALF) = w; } }
    }
};
template <int PASS> struct EpiMerge {
    static constexpr bool PERM = true;
    bf16_t* O; const bf16_t* GATES; int goff;
    __device__ __forceinline__ void operator()(const f32x4 (&acc)[2][2][4][2], const Unit& u, int wr, int wc, int fr, int fq) const {
        const int row0 = u.pm * BM + wr * 64 + fr, col0 = u.pn * BM + wc * 32 + 8 * fq;
#pragma unroll
        for (int ai = 0; ai < 2; ++ai)
#pragma unroll
            for (int m = 0; m < 4; ++m) { const size_t r = (size_t)(row0 + ai * HALF + m * 16);
#pragma unroll
                for (int bj = 0; bj < 2; ++bj) { f32x4 v0 = acc[ai][bj][m][0], v1 = acc[ai][bj][m][1];
                    const u32x4 g = *(const u32x4*)(GATES + r * 2048 + goff + col0 + bj * HALF);
                    v0[0] *= bflo(g.x); v0[1] *= bfhi(g.x); v0[2] *= bflo(g.y); v0[3] *= bfhi(g.y); v1[0] *= bflo(g.z); v1[1] *= bfhi(g.z); v1[2] *= bflo(g.w); v1[3] *= bfhi(g.w);
                    bf16_t* op = O + r * 1024 + col0 + bj * HALF;
                    if (PASS == 1) { const u32x4 o = *(const u32x4*)op;
                        v0[0] += bflo(o.x); v0[1] += bfhi(o.x); v0[2] += bflo(o.y); v0[3] += bfhi(o.y); v1[0] += bflo(o.z); v1[1] += bfhi(o.z); v1[2] += bflo(o.w); v1[3] += bfhi(o.w); }
                    u32x4 w; w.x = cvt_pk_bf16(v0[0], v0[1]); w.y = cvt_pk_bf16(v0[2], v0[3]); w.z = cvt_pk_bf16(v1[0], v1[1]); w.w = cvt_pk_bf16(v1[2], v1[3]);
                    *(u32x4*)op = w; } }
    }
};

template <class Epi, class Sched>
__device__ __forceinline__ void gemm_phase(PG8_LAS unsigned char* lds, const Gemm g, const Sched& S, const Epi& E) {
    const int tid = threadIdx.x, wid = __builtin_amdgcn_readfirstlane(tid >> 6), lane = tid & 63, wr = wid >> 2, wc = wid & 3, fr = lane & 15, fq = lane >> 4;
    const int nt = g.K / BK;
    unsigned voffA[2], voffB[2];
#pragma unroll
    for (int i = 0; i < 2; ++i) { int R, C; stage_rc(tid * 16 + i * 8192, R, C); const int Rb = Epi::PERM ? ((R & ~31) + perm32(R & 31)) : R;
        voffA[i] = (unsigned)(R * g.lda + C) * 2u; voffB[i] = (unsigned)(Rb * g.ldb + C) * 2u; }
    const size_t kstep = (size_t)(BK * 2);
    const size_t hstepA = (size_t)HALF * g.lda * 2, hstepB = (size_t)HALF * g.ldb * 2;
    const size_t tstepA = 2 * hstepA, tstepB = 2 * hstepB;
    const unsigned ldsw = (unsigned)wid * 1024u;
    const int aoff = lds_byte(wr * 64 + fr, fq * 8), boff = lds_byte(wc * 32 + fr, fq * 8);
#define PG8_SA(b, h) (((b) * 2 + (h)) * HTB)
#define PG8_SB(b, h) ((4 + (b) * 2 + (h)) * HTB)
#define PG8_STAGE(bufoff, gbase, voff) do { _Pragma("unroll") for (int _i = 0; _i < 2; ++_i) \
        __builtin_amdgcn_global_load_lds((const unsigned*)((const char*)(gbase) + (voff)[_i]), (PG8_LAS unsigned*)(lds + (bufoff) + ldsw + _i * 8192), 16, 0, 0); } while (0)
#define PG8_LDA(dst, b, h) do { _Pragma("unroll") for (int m = 0; m < 4; ++m) _Pragma("unroll") for (int k = 0; k < 2; ++k) dst[m][k] = *(const PG8_LAS bf16x8*)(lds + PG8_SA(b, h) + aoff + m * 2048 + k * 1024); } while (0)
#define PG8_LDB(dst, b, h) do { _Pragma("unroll") for (int n = 0; n < 2; ++n) _Pragma("unroll") for (int k = 0; k < 2; ++k) dst[n][k] = *(const PG8_LAS bf16x8*)(lds + PG8_SB(b, h) + boff + n * 2048 + k * 1024); } while (0)
#define PG8_MMA(ai, bj, At, Bt) do { __builtin_amdgcn_s_setprio(1); _Pragma("unroll") for (int m = 0; m < 4; ++m) _Pragma("unroll") for (int n = 0; n < 2; ++n) _Pragma("unroll") for (int k = 0; k < 2; ++k) \
        acc[ai][bj][m][n] = __builtin_amdgcn_mfma_f32_16x16x32_bf16(Bt[n][k], At[m][k], acc[ai][bj][m][n], 0, 0, 0); __builtin_amdgcn_s_setprio(0); } while (0)
#define PG8_WAIT_V(n) asm volatile("s_waitcnt vmcnt(" #n ")" ::: "memory")
#define PG8_WAIT_L(n) asm volatile("s_waitcnt lgkmcnt(" #n ")" ::: "memory")
#define PG8_BAR __builtin_amdgcn_s_barrier()
#define PG8_SCHED __builtin_amdgcn_sched_barrier(0)
    Unit cur, nxt; int ui = 0;
    if (!S.next(0, cur)) return;
    f32x4 acc[2][2][4][2];
#pragma unroll
    for (int a = 0; a < 2; ++a)
#pragma unroll
        for (int b = 0; b < 2; ++b)
#pragma unroll
            for (int m = 0; m < 4; ++m)
#pragma unroll
                for (int n = 0; n < 2; ++n) acc[a][b][m][n] = (f32x4){0.f, 0.f, 0.f, 0.f};
    bf16x8 At[4][2], B0[2][2], B1[2][2];
    const char* cA = (const char*)g.A + (size_t)cur.pm * tstepA; const char* cB = (const char*)g.Bt + (size_t)cur.pn * tstepB;
    PG8_STAGE(PG8_SB(0, 0), cB, voffB); PG8_STAGE(PG8_SA(0, 0), cA, voffA); PG8_STAGE(PG8_SB(0, 1), cB + hstepB, voffB); PG8_STAGE(PG8_SA(0, 1), cA + hstepA, voffA);
    if (wr == 1) PG8_BAR;
    PG8_WAIT_V(4); PG8_BAR;
    PG8_STAGE(PG8_SB(1, 0), cB + kstep, voffB); PG8_STAGE(PG8_SA(1, 0), cA + kstep, voffA); PG8_STAGE(PG8_SB(1, 1), cB + hstepB + kstep, voffB);
    PG8_WAIT_V(6); PG8_BAR;
    for (;;) {
        const bool has_next = S.next(ui + 1, nxt);
        const char* nA = has_next ? (const char*)g.A + (size_t)nxt.pm * tstepA : cA; const char* nB = has_next ? (const char*)g.Bt + (size_t)nxt.pn * tstepB : cB;
        for (int t = 0; t < nt; t += 2) {
            const bool last = (t == nt - 2);
            const char* a1 = cA + (size_t)(t + 1) * kstep;
            const char* a2 = last ? nA : cA + (size_t)(t + 2) * kstep; const char* b2 = last ? nB : cB + (size_t)(t + 2) * kstep;
            const char* a3 = a2 + kstep; const char* b3 = b2 + kstep;
            PG8_LDB(B0, 0, 0); PG8_SCHED; PG8_LDA(At, 0, 0); PG8_STAGE(PG8_SA(1, 1), a1 + hstepA, voffA);
            PG8_WAIT_L(8); PG8_BAR; PG8_WAIT_L(0); PG8_MMA(0, 0, At, B0); PG8_BAR; PG8_SCHED;
            PG8_LDB(B1, 0, 1); PG8_STAGE(PG8_SB(0, 0), b2, voffB);
            PG8_BAR; PG8_WAIT_L(0); PG8_MMA(0, 1, At, B1); PG8_BAR;
            PG8_LDA(At, 0, 1); PG8_STAGE(PG8_SA(0, 0), a2, voffA);
            PG8_BAR; PG8_WAIT_L(0); PG8_MMA(1, 0, At, B0); PG8_BAR; PG8_SCHED;
            PG8_STAGE(PG8_SB(0, 1), b2 + hstepB, voffB);
            PG8_WAIT_V(6); PG8_BAR; PG8_MMA(1, 1, At, B1); PG8_BAR;
            PG8_LDB(B0, 1, 0); PG8_SCHED; PG8_LDA(At, 1, 0); PG8_STAGE(PG8_SA(0, 1), a2 + hstepA, voffA);
            PG8_WAIT_L(8); PG8_BAR; PG8_WAIT_L(0); PG8_MMA(0, 0, At, B0); PG8_BAR; PG8_SCHED;
            PG8_LDB(B1, 1, 1); PG8_STAGE(PG8_SB(1, 0), b3, voffB);
            PG8_BAR; PG8_WAIT_L(0); PG8_MMA(0, 1, At, B1); PG8_BAR;
            PG8_LDA(At, 1, 1); PG8_STAGE(PG8_SA(1, 0), a3, voffA);
            PG8_BAR; PG8_WAIT_L(0); PG8_MMA(1, 0, At, B0); PG8_BAR; PG8_SCHED;
            PG8_STAGE(PG8_SB(1, 1), b3 + hstepB, voffB);
            PG8_WAIT_V(6); PG8_BAR; PG8_MMA(1, 1, At, B1); PG8_BAR;
        }
        E(acc, cur, wr, wc, fr, fq);
        if (!has_next) break;
#pragma unroll
        for (int a = 0; a < 2; ++a)
#pragma unroll
            for (int b = 0; b < 2; ++b)
#pragma unroll
                for (int m = 0; m < 4; ++m)
#pragma unroll
                    for (int n = 0; n < 2; ++n) acc[a][b][m][n] = (f32x4){0.f, 0.f, 0.f, 0.f};
        cur = nxt; cA = nA; cB = nB; ++ui;
    }
    PG8_WAIT_V(0);
    if (wr == 0) PG8_BAR;
    PG8_BAR;
#undef PG8_SA
#undef PG8_SB
#undef PG8_STAGE
#undef PG8_LDA
#undef PG8_LDB
#undef PG8_MMA
#undef PG8_WAIT_V
#undef PG8_WAIT_L
#undef PG8_BAR
#undef PG8_SCHED
}
}

namespace {
using pg8::bf16_t; using pg8::f32x4; using pg8::u32x4; using pg8::u32x2;
#define LAS __attribute__((address_space(3)))
constexpr int D = 1024, NB = 8, L = 4096, LC = 256, INC = 6144, FF = 4096, HW = 512;
constexpr int NT = NB * L, NCX = NB * LC;
constexpr float EPS = 1e-6f;
constexpr size_t MiB = 1u << 20;
constexpr size_t WS_MOD = 64 * 1024, WS_LB = 512 * 1024, WS_GT = 2 * MiB  ;
constexpr size_t WS_WIN = 18 * MiB, WS_WPAB = 30 * MiB, WS_WOUT = 32 * MiB, WS_W1 = 34 * MiB, WS_W2 = 42 * MiB;
constexpr size_t WS_HCTX = 50 * MiB, WS_PCTX = 54 * MiB, WS_SCTX = 60 * MiB;
constexpr size_t WS_HLAT = 64 * MiB;
constexpr size_t WS_PI = 128 * MiB, WS_PZ = 160 * MiB, WS_PQ = 224 * MiB, WS_PG = 256 * MiB, WS_GATES = 288 * MiB, WS_PHYT = 416 * MiB;
constexpr size_t WS_AY = 160 * MiB;
constexpr size_t WS_AY2 = 64 * MiB;
constexpr size_t WS_MERGED = 128 * MiB;
constexpr size_t WS_MIX = 448 * MiB, WS_MLP = 384 * MiB, WS_H1 = 128 * MiB, WS_HL = 64 * MiB;
constexpr size_t WS_END = 512 * MiB;
constexpr int LDS_BYTES = 147456;

__device__ __forceinline__ float bf2f(bf16_t h) { return __uint_as_float(((unsigned)h) << 16); }
__device__ __forceinline__ unsigned f2bf(float f) { unsigned u = __float_as_uint(f); return (u + 0x7fffu + ((u >> 16) & 1u)) >> 16; }
__device__ __forceinline__ unsigned pk2(float lo, float hi) { return f2bf(lo) | (f2bf(hi) << 16); }
__device__ __forceinline__ float sigmoidf_(float x) { return 1.f / (1.f + expf(-x)); }
__device__ __forceinline__ float siluf_(float x) { return x / (1.f + expf(-x)); }
__device__ __forceinline__ float wave_sum(float v) {
#pragma unroll
    for (int o = 1; o < 64; o <<= 1) v += __shfl_xor(v, o);
    return v;
}
#define LDS_WAIT() asm volatile("s_waitcnt lgkmcnt(0)" ::: "memory")

struct Params { const float* in[24]; float* out; unsigned char* ws; };

#define XB_TMO      128
#define XB_XCNT(j)  (256  + 64 * (j))
#define XB_XSUB(j)  (1280 + 64 * (j))
#define XB_XGEN(j)  (2304 + 64 * (j))
#define XB_TOP      3328
#define XB_TOPGEN   3392
#define XCD_BAR_WORDS 3456
#define XB_SPIN_CAP (1u << 18)

__device__ __forceinline__ unsigned xb_ld(unsigned* p)              { return __hip_atomic_load(p, __ATOMIC_RELAXED, __HIP_MEMORY_SCOPE_AGENT); }
__device__ __forceinline__ unsigned xb_add(unsigned* p, unsigned v) { return __hip_atomic_fetch_add(p, v, __ATOMIC_RELAXED, __HIP_MEMORY_SCOPE_AGENT); }
__device__ __forceinline__ unsigned xb_xcc_id() { return (unsigned)__builtin_amdgcn_s_getreg((3 << 11) | 20) & 0xFu; }
#define XB_SPIN(cond, bar) do { unsigned _sp = 0; while (cond) { __builtin_amdgcn_s_sleep(1); \
    if ((++_sp & 255u) == 0u) { if (xb_ld(&(bar)[XB_TMO])) break; if (_sp > XB_SPIN_CAP) { atomicAdd(&(bar)[XB_TMO], 1u); break; } } } } while (0)

struct XcdBarrier {
    unsigned* bar; unsigned x;
    volatile LAS unsigned* st;
};

__device__ __forceinline__ XcdBarrier xcd_barrier_post(unsigned* bar, volatile LAS unsigned* st) {
    XcdBarrier b; b.bar = bar; b.x = xb_xcc_id(); b.st = st;
    if (threadIdx.x == 0) (void)xb_add(&bar[XB_XCNT(b.x)], 1u);
    return b;
}
__device__ __forceinline__ void xcd_barrier_complete(unsigned* bar, unsigned x, unsigned& nloc, unsigned& nx) {
    const unsigned G = gridDim.x * gridDim.y * gridDim.z;
    unsigned sum, cnt, mine, sp = 0u;
    for (;;) {
        sum = 0u; cnt = 0u; mine = 0u;
#pragma unroll
        for (unsigned j = 0; j < 16; ++j) { const unsigned c = xb_ld(&bar[XB_XCNT(j)]); sum += c; cnt += (c > 0u) ? 1u : 0u; mine = (j == x) ? c : mine; }
        if (sum == G) break;
        __builtin_amdgcn_s_sleep(1);
        if ((++sp & 255u) == 0u) { if (xb_ld(&bar[XB_TMO])) break; if (sp > XB_SPIN_CAP) { atomicAdd(&bar[XB_TMO], 1u); break; } }
    }
    nloc = mine > 0u ? mine : 1u; nx = cnt > 0u ? cnt : 1u;
}

__device__ __forceinline__ void xcd_barrier(const XcdBarrier& b) {
    asm volatile("s_waitcnt vmcnt(0)" ::: "memory");
    __syncthreads();
    if (threadIdx.x == 0) {
        unsigned* bar = b.bar;
        __builtin_amdgcn_s_waitcnt(0);
        unsigned nloc = b.st[0], nx = b.st[1];
        if (nloc == 0u) { xcd_barrier_complete(bar, b.x, nloc, nx); b.st[0] = nloc; b.st[1] = nx; }
        const unsigned old = xb_add(&bar[XB_XSUB(b.x)], 1u);
        const unsigned gen = old / nloc;
        if (old + 1u == (gen + 1u) * nloc) {
            __builtin_amdgcn_fence(__ATOMIC_RELEASE, "agent");
            asm volatile("s_waitcnt vmcnt(0)" ::: "memory");
            const unsigned og = xb_add(&bar[XB_TOP], 1u);
            const unsigned tg = og / nx;
            if (og + 1u == (tg + 1u) * nx) xb_add(&bar[XB_TOPGEN], 1u);
            else XB_SPIN(xb_ld(&bar[XB_TOPGEN]) == tg, bar);
            __builtin_amdgcn_fence(__ATOMIC_ACQUIRE, "agent");
            xb_add(&bar[XB_XGEN(b.x)], 1u);
            asm volatile("s_waitcnt vmcnt(0)" ::: "memory");
        } else {
            XB_SPIN(xb_ld(&bar[XB_XGEN(b.x)]) == gen, bar);
            __builtin_amdgcn_fence(__ATOMIC_ACQUIRE, "agent");
            asm volatile("s_waitcnt vmcnt(0)" ::: "memory");
        }
    }
    __syncthreads();
}


__device__ __forceinline__ void transpose_item(const float* W, int N, bf16_t* WT, int ldk, int koff, int remap, LAS float* scr, int item, int lane) {
    const int nblk = N / 32, kb = item / nblk, nb = item % nblk, k0 = 64 * kb, n0 = 32 * nb;
    int rbase = n0;
    if (remap) rbase = n0 < 2560 ? n0 : (n0 < 4096 ? n0 + 2048 : n0 - 1536);
#pragma unroll 8
    for (int i = 0; i < 32; ++i) { const int kk = 2 * i + (lane >> 5); scr[kk * 33 + (lane & 31)] = W[(size_t)(k0 + kk) * N + n0 + (lane & 31)]; }
    LDS_WAIT();
    const int c = lane & 7;
#pragma unroll
    for (int j = 0; j < 4; ++j) { const int n = (lane >> 3) + 8 * j; const LAS float* s = scr + (8 * c) * 33 + n;
        u32x4 o; o.x = pk2(s[0 * 33], s[1 * 33]); o.y = pk2(s[2 * 33], s[3 * 33]); o.z = pk2(s[4 * 33], s[5 * 33]); o.w = pk2(s[6 * 33], s[7 * 33]);
        *(u32x4*)(WT + (size_t)(rbase + n) * ldk + koff + k0 + 8 * c) = o; }
    LDS_WAIT();
}

__device__ __forceinline__ void row_norm_mod_bf16(const float* xrow, const float* nw, const float* scale, const float* shift, bf16_t* orow, int lane) {
    const f32x4* xr = (const f32x4*)xrow + lane; f32x4 v[4]; float s = 0.f;
#pragma unroll
    for (int j = 0; j < 4; ++j) { v[j] = xr[64 * j]; s += (v[j].x * v[j].x + v[j].y * v[j].y) + (v[j].z * v[j].z + v[j].w * v[j].w); }
    const float r = rsqrtf(wave_sum(s) * (1.f / D) + EPS);
    unsigned long long* o8 = (unsigned long long*)orow + lane;
#pragma unroll
    for (int j = 0; j < 4; ++j) { const f32x4 w = ((const f32x4*)nw)[lane + 64 * j], sc = ((const f32x4*)scale)[lane + 64 * j], sh = ((const f32x4*)shift)[lane + 64 * j];
        const f32x4 o = v[j] * r * w * (1.f + sc) + sh;
        o8[64 * j] = (unsigned long long)pk2(o.x, o.y) | ((unsigned long long)pk2(o.z, o.w) << 32); }
}
__device__ __forceinline__ f32x4 ld_bf4(const bf16_t* p) { const u32x2 u = *(const u32x2*)p; return (f32x4){pg8::bflo(u.x), pg8::bfhi(u.x), pg8::bflo(u.y), pg8::bfhi(u.y)}; }
__device__ __forceinline__ void row_x1(const float* xrow, const bf16_t* mixrow, const float* nw1, const float* g2, f32x4 (&x1)[4], int lane) {
    f32x4 mv[4]; float s = 0.f;
#pragma unroll
    for (int j = 0; j < 4; ++j) { mv[j] = ld_bf4(mixrow + 4 * lane + 256 * j); s += (mv[j].x * mv[j].x + mv[j].y * mv[j].y) + (mv[j].z * mv[j].z + mv[j].w * mv[j].w); }
    const float r = rsqrtf(wave_sum(s) * (1.f / D) + EPS);
#pragma unroll
    for (int j = 0; j < 4; ++j) { const f32x4 w = ((const f32x4*)nw1)[lane + 64 * j], g = ((const f32x4*)g2)[lane + 64 * j], xv = ((const f32x4*)xrow)[lane + 64 * j];
        x1[j] = xv + g * (mv[j] * r * w); }
}

typedef float f32x16 __attribute__((ext_vector_type(16)));
typedef float f32x2_t __attribute__((ext_vector_type(2)));
typedef __bf16 bf16x2_t __attribute__((ext_vector_type(2)));
__device__ __forceinline__ unsigned cvtpk(float lo, float hi) { const f32x2_t v = {lo, hi}; const bf16x2_t b = __builtin_convertvector(v, bf16x2_t); return __builtin_bit_cast(unsigned, b); }
constexpr int HY_PITCH = 8720;
constexpr int HY_TAB0 = 8 * HY_PITCH;
constexpr int HY_TAB1 = HY_TAB0 + 17408 + 64;
__device__ __forceinline__ void conv8(const u32x4 raw, float left, float right, float w0, float w1, float w2, float bias, float (&o)[8]) {
    float in[10]; in[0] = left; in[9] = right;
    in[1] = pg8::bflo(raw.x); in[2] = pg8::bfhi(raw.x); in[3] = pg8::bflo(raw.y); in[4] = pg8::bfhi(raw.y); in[5] = pg8::bflo(raw.z); in[6] = pg8::bfhi(raw.z); in[7] = pg8::bflo(raw.w); in[8] = pg8::bfhi(raw.w);
#pragma unroll
    for (int j = 0; j < 8; ++j) o[j] = bias + w0 * in[j] + w1 * in[j + 1] + w2 * in[j + 2];
}
__device__ __forceinline__ void hyena_channel(LAS unsigned char* lds, int c, bf16_t* PHYT, const bf16_t* GTB, const float* hy_sw, const float* hy_sb) {
    const int tid = threadIdx.x, lane = tid & 63, wave = __builtin_amdgcn_readfirstlane(tid >> 6);
    __syncthreads();
    for (int ci = tid; ci < 1088; ci += 512) { u32x4 v = (u32x4){0u, 0u, 0u, 0u};
        if (ci >= 32 && ci < 1056) v = *(const u32x4*)(GTB + (size_t)c * 8192 + (ci - 32) * 8);
        *(LAS u32x4*)(lds + HY_TAB0 + ci * 16) = v; }
    {
        const bf16_t* x1r = PHYT + (size_t)(512 + c) * NT; const bf16_t* vr = PHYT + (size_t)(1024 + c) * NT;
        const float xw0 = hy_sw[512 + c], xw1 = hy_sw[1536 + 512 + c], xw2 = hy_sw[3072 + 512 + c], xb = hy_sb[512 + c];
        const float vw0 = hy_sw[1024 + c], vw1 = hy_sw[1536 + 1024 + c], vw2 = hy_sw[3072 + 1024 + c], vb = hy_sb[1024 + c];
        for (int q = tid; q < 4096; q += 512) { const int b = q >> 9, s8 = (q & 511) * 8; const size_t o = (size_t)b * L + s8;
            const u32x4 xa = *(const u32x4*)(x1r + o), va = *(const u32x4*)(vr + o);
            const bool hl = (s8 & 63) != 0, hr = ((s8 + 8) & 63) != 0;
            const float xl = hl ? bf2f(x1r[o - 1]) : 0.f, xr = hr ? bf2f(x1r[o + 8]) : 0.f, vl = hl ? bf2f(vr[o - 1]) : 0.f, vrr = hr ? bf2f(vr[o + 8]) : 0.f;
            float cx[8], cv[8]; conv8(xa, xl, xr, xw0, xw1, xw2, xb, cx); conv8(va, vl, vrr, vw0, vw1, vw2, vb, cv);
            u32x4 w; w.x = cvtpk(cx[0] * cv[0], cx[1] * cv[1]); w.y = cvtpk(cx[2] * cv[2], cx[3] * cv[3]); w.z = cvtpk(cx[4] * cv[4], cx[5] * cv[5]); w.w = cvtpk(cx[6] * cv[6], cx[7] * cv[7]);
            *(LAS u32x4*)(lds + b * HY_PITCH + (128 + s8) * 2) = w; }
        if (tid < 256) { const int b = tid >> 5, side = (tid >> 4) & 1, k = tid & 15;
            *(LAS u32x4*)(lds + b * HY_PITCH + (side ? (128 + 4096) * 2 : 0) + k * 16) = (u32x4){0u, 0u, 0u, 0u}; }
    }
    __syncthreads();
    for (int ci = tid; ci < 1088; ci += 512) { const u32x4 d = *(const LAS u32x4*)(lds + HY_TAB0 + ci * 16); const unsigned d4 = ci < 1087 ? *(const LAS unsigned*)(lds + HY_TAB0 + ci * 16 + 16) : 0u;
        u32x4 o; o.x = __builtin_amdgcn_alignbit(d.y, d.x, 16); o.y = __builtin_amdgcn_alignbit(d.z, d.y, 16); o.z = __builtin_amdgcn_alignbit(d.w, d.z, 16); o.w = __builtin_amdgcn_alignbit(d4, d.w, 16);
        *(LAS u32x4*)(lds + HY_TAB1 + ci * 16) = o; }
    __syncthreads();
    const int T0 = 512 * wave, r = lane & 31, h = lane >> 5, bb = r >> 2, tb = r & 3;
    f32x16 acc[4];
#pragma unroll
    for (int i = 0; i < 4; ++i)
#pragma unroll
        for (int j = 0; j < 16; ++j) acc[i][j] = 0.f;
    {
        const int Dfirst = T0 - 4080;
        const int e0 = 4351 - Dfirst - r + 8 * h;
        unsigned aaddr = (unsigned)((e0 & 1) ? HY_TAB1 : HY_TAB0) + (unsigned)(e0 & ~1) * 2u;
        unsigned baddr = (unsigned)(bb * HY_PITCH + (128 + T0 + 32 * tb - Dfirst + 8 * h) * 2);
#define HY_LDA(dst, ad) do { u32x4 _t; _t.x = *(const LAS unsigned*)(lds + (ad)); _t.y = *(const LAS unsigned*)(lds + (ad) + 4); _t.z = *(const LAS unsigned*)(lds + (ad) + 8); _t.w = *(const LAS unsigned*)(lds + (ad) + 12); dst = __builtin_bit_cast(pg8::bf16x8, _t); } while (0)
#define HY_LDB(dst, ad) dst = *(const LAS pg8::bf16x8*)(lds + (ad))
        pg8::bf16x8 A, B0, B1, B2, B3;
        const pg8::bf16x8 zz = (pg8::bf16x8){0, 0, 0, 0, 0, 0, 0, 0};
        HY_LDA(A, aaddr); HY_LDB(B0, baddr); B1 = zz; B2 = zz; B3 = zz;
        for (int st = 0; st < 286; ++st) {
            const int d = -4080 + 16 * st, dn = d + 16;
            pg8::bf16x8 An, B0n = zz, B1n = zz, B2n = zz, B3n = zz;
            const unsigned an = aaddr - 32u, bn = baddr - 32u;
            HY_LDA(An, an);
            if (dn <= 96) HY_LDB(B0n, bn);
            if (dn >= -3952 && dn <= 224) HY_LDB(B1n, bn + 256);
            if (dn >= -3824 && dn <= 352) HY_LDB(B2n, bn + 512);
            if (dn >= -3696 && dn <= 480) HY_LDB(B3n, bn + 768);
            if (d <= 96) acc[0] = __builtin_amdgcn_mfma_f32_32x32x16_bf16(A, B0, acc[0], 0, 0, 0);
            if (d >= -3952 && d <= 224) acc[1] = __builtin_amdgcn_mfma_f32_32x32x16_bf16(A, B1, acc[1], 0, 0, 0);
            if (d >= -3824 && d <= 352) acc[2] = __builtin_amdgcn_mfma_f32_32x32x16_bf16(A, B2, acc[2], 0, 0, 0);
            if (d >= -3696) acc[3] = __builtin_amdgcn_mfma_f32_32x32x16_bf16(A, B3, acc[3], 0, 0, 0);
            A = An; B0 = B0n; B1 = B1n; B2 = B2n; B3 = B3n; aaddr = an; baddr = bn;
        }
#undef HY_LDA
#undef HY_LDB
    }
    __syncthreads();
#pragma unroll
    for (int i = 0; i < 4; ++i)
#pragma unroll
        for (int g = 0; g < 4; ++g) { const int t = T0 + 128 * i + 32 * tb + 8 * g + 4 * h;
            pg8::u32x2 w; w.x = cvtpk(acc[i][4 * g], acc[i][4 * g + 1]); w.y = cvtpk(acc[i][4 * g + 2], acc[i][4 * g + 3]);
            *(LAS pg8::u32x2*)(lds + bb * HY_PITCH + (128 + t) * 2) = w; }
    __syncthreads();
    {
        const bf16_t* x0r = PHYT + (size_t)c * NT; bf16_t* yr = PHYT + (size_t)(1024 + c) * NT;
        const float w0 = hy_sw[c], w1 = hy_sw[1536 + c], w2 = hy_sw[3072 + c], bs = hy_sb[c];
        for (int q = tid; q < 4096; q += 512) { const int b = q >> 9, s8 = (q & 511) * 8; const size_t o = (size_t)b * L + s8;
            const u32x4 xa = *(const u32x4*)(x0r + o);
            const bool hl = (s8 & 63) != 0, hr = ((s8 + 8) & 63) != 0;
            const float xl = hl ? bf2f(x0r[o - 1]) : 0.f, xr = hr ? bf2f(x0r[o + 8]) : 0.f;
            float cx[8]; conv8(xa, xl, xr, w0, w1, w2, bs, cx);
            const u32x4 y = *(const LAS u32x4*)(lds + b * HY_PITCH + (128 + s8) * 2);
            u32x4 w; w.x = cvtpk(cx[0] * pg8::bflo(y.x), cx[1] * pg8::bfhi(y.x)); w.y = cvtpk(cx[2] * pg8::bflo(y.y), cx[3] * pg8::bfhi(y.y));
            w.z = cvtpk(cx[4] * pg8::bflo(y.z), cx[5] * pg8::bfhi(y.z)); w.w = cvtpk(cx[6] * pg8::bflo(y.w), cx[7] * pg8::bfhi(y.w));
            *(u32x4*)(yr + o) = w; }
    }
}


constexpr int HG_QE = 0, HG_KE = 17408, HG_KDT = 34816, HG_VT = 53248, HG_SC = 71680, HG_DEC = 80896, HG_SEG = 81408;
template <bool HAS_Q>
__device__ __forceinline__ void hgrn_chain_mfma(LAS unsigned char* lds, const bf16_t* pi, int ldi, const bf16_t* pz, int ldz, const bf16_t* pq, int ldq, int Lseq, int h, int dir,
                                                const float* lb, const float* s_in, float* s_out, float* o_out) {
    const int tid = threadIdx.x, lane = tid & 63, wave = __builtin_amdgcn_readfirstlane(tid >> 6);
    const int dp = lane, cs = wave, fr = lane & 15, kg = lane >> 4;
    const float lb0 = lb[h * 128 + 2 * dp], lb1 = lb[h * 128 + 2 * dp + 1];
    f32x4 S[8];
#pragma unroll
    for (int blk = 0; blk < 8; ++blk)
#pragma unroll
        for (int r = 0; r < 4; ++r) S[blk][r] = s_in ? s_in[(size_t)(16 * blk + 4 * kg + r) * 128 + 16 * wave + fr] : 0.f;
    const int nch = Lseq / 64;
#define HG_BAR() do { asm volatile("s_waitcnt lgkmcnt(0)" ::: "memory"); __builtin_amdgcn_s_barrier(); asm volatile("" ::: "memory"); } while (0)
    unsigned zr[8], qr[8], vr[8];
#define HG_LOAD(n) do { const int _base = dir ? (Lseq - 64 * ((n) + 1)) : 64 * (n); _Pragma("unroll") for (int i = 0; i < 8; ++i) { const int _cp = 8 * cs + i; const int _t = _base + (dir ? 63 - _cp : _cp); \
        zr[i] = *(const unsigned*)(pz + (size_t)_t * ldz + h * 128 + 2 * dp); vr[i] = *(const unsigned*)(pi + (size_t)_t * ldi + h * 128 + 2 * dp); \
        if (HAS_Q) qr[i] = *(const unsigned*)(pq + (size_t)_t * ldq + h * 128 + 2 * dp); } } while (0)
    HG_LOAD(0);
    __syncthreads();
    for (int n = 0; n < nch; ++n) {
        float F0[8], F1[8], k0[8], k1[8];
        {
            float p0 = 1.f, p1 = 1.f;
#pragma unroll
            for (int i = 0; i < 8; ++i) { const float f0 = lb0 + (1.f - lb0) * pg8::sigm(pg8::bflo(zr[i])), f1 = lb1 + (1.f - lb1) * pg8::sigm(pg8::bfhi(zr[i]));
                k0[i] = 1.f - f0; k1[i] = 1.f - f1; p0 *= f0; p1 *= f1; F0[i] = p0; F1[i] = p1; }
            *(LAS f32x2_t*)(lds + HG_SEG + (cs * 128 + 2 * dp) * 4) = (f32x2_t){p0, p1};
        }
        HG_BAR();
        {
            u32x4 lo, hi;
            lo.x = (vr[0] & 0xffffu) | (vr[1] << 16); lo.y = (vr[2] & 0xffffu) | (vr[3] << 16); lo.z = (vr[4] & 0xffffu) | (vr[5] << 16); lo.w = (vr[6] & 0xffffu) | (vr[7] << 16);
            hi.x = (vr[0] >> 16) | (vr[1] & 0xffff0000u); hi.y = (vr[2] >> 16) | (vr[3] & 0xffff0000u); hi.z = (vr[4] >> 16) | (vr[5] & 0xffff0000u); hi.w = (vr[6] >> 16) | (vr[7] & 0xffff0000u);
            *(LAS u32x4*)(lds + HG_VT + (2 * dp) * 144 + 16 * cs) = lo; *(LAS u32x4*)(lds + HG_VT + (2 * dp + 1) * 144 + 16 * cs) = hi;
        }
        {
            float pre0 = 1.f, pre1 = 1.f, fl0 = 1.f, fl1 = 1.f;
#pragma unroll
            for (int s = 0; s < 8; ++s) { const f32x2_t t = *(const LAS f32x2_t*)(lds + HG_SEG + (s * 128 + 2 * dp) * 4); fl0 *= t.x; fl1 *= t.y; if (s < cs) { pre0 *= t.x; pre1 *= t.y; } }
            if (cs == 0) *(LAS f32x2_t*)(lds + HG_DEC + 2 * dp * 4) = (f32x2_t){fl0, fl1};
            unsigned kd0[8], kd1[8];
#pragma unroll
            for (int i = 0; i < 8; ++i) { const float Fa = F0[i] * pre0, Fb = F1[i] * pre1; const float ia = __builtin_amdgcn_rcpf(Fa), ib = __builtin_amdgcn_rcpf(Fb);
                const float kea = k0[i] * ia, keb = k1[i] * ib; const int cp = 8 * cs + i;
                if (HAS_Q) { *(LAS unsigned*)(lds + HG_QE + cp * 272 + 4 * dp) = cvtpk(pg8::bflo(qr[i]) * Fa, pg8::bfhi(qr[i]) * Fb);
                             *(LAS unsigned*)(lds + HG_KE + cp * 272 + 4 * dp) = cvtpk(kea, keb); }
                kd0[i] = __float_as_uint(kea * fl0); kd1[i] = __float_as_uint(keb * fl1); }
            u32x4 a, b;
            a.x = cvtpk(__uint_as_float(kd0[0]), __uint_as_float(kd0[1])); a.y = cvtpk(__uint_as_float(kd0[2]), __uint_as_float(kd0[3])); a.z = cvtpk(__uint_as_float(kd0[4]), __uint_as_float(kd0[5])); a.w = cvtpk(__uint_as_float(kd0[6]), __uint_as_float(kd0[7]));
            b.x = cvtpk(__uint_as_float(kd1[0]), __uint_as_float(kd1[1])); b.y = cvtpk(__uint_as_float(kd1[2]), __uint_as_float(kd1[3])); b.z = cvtpk(__uint_as_float(kd1[4]), __uint_as_float(kd1[5])); b.w = cvtpk(__uint_as_float(kd1[6]), __uint_as_float(kd1[7]));
            *(LAS u32x4*)(lds + HG_KDT + (2 * dp) * 144 + 16 * cs) = a; *(LAS u32x4*)(lds + HG_KDT + (2 * dp + 1) * 144 + 16 * cs) = b;
        }
        if (n + 1 < nch) HG_LOAD(n + 1);
        HG_BAR();
        if (HAS_Q) {
            const int cb = wave >> 1;
#pragma unroll
            for (int u = 0; u < 2; ++u) { const int sb = 2 * (wave & 1) + u; f32x4 sc = (f32x4){0.f, 0.f, 0.f, 0.f};
                if (sb <= cb) {
#pragma unroll
                    for (int ks = 0; ks < 4; ++ks) { const pg8::bf16x8 A = *(const LAS pg8::bf16x8*)(lds + HG_QE + (16 * cb + fr) * 272 + (32 * ks + 8 * kg) * 2);
                        const pg8::bf16x8 B = *(const LAS pg8::bf16x8*)(lds + HG_KE + (16 * sb + fr) * 272 + (32 * ks + 8 * kg) * 2);
                        sc = __builtin_amdgcn_mfma_f32_16x16x32_bf16(A, B, sc, 0, 0, 0); } }
#pragma unroll
                for (int r = 0; r < 4; ++r) { const int c = 16 * cb + 4 * kg + r, s = 16 * sb + fr; const float v = (s <= c) ? sc[r] : 0.f;
                    *(LAS bf16_t*)(lds + HG_SC + c * 144 + s * 2) = (bf16_t)f2bf(v); } }
        }
        HG_BAR();
        {
            pg8::bf16x8 Bv[2];
#pragma unroll
            for (int ks = 0; ks < 2; ++ks) Bv[ks] = *(const LAS pg8::bf16x8*)(lds + HG_VT + (16 * wave + fr) * 144 + (32 * ks + 8 * kg) * 2);
            if (HAS_Q) {
                pg8::bf16x8 Bs[4];
#pragma unroll
                for (int kp = 0; kp < 4; ++kp) { u32x4 t; t.x = cvtpk(S[2 * kp][0], S[2 * kp][1]); t.y = cvtpk(S[2 * kp][2], S[2 * kp][3]); t.z = cvtpk(S[2 * kp + 1][0], S[2 * kp + 1][1]); t.w = cvtpk(S[2 * kp + 1][2], S[2 * kp + 1][3]);
                    Bs[kp] = __builtin_bit_cast(pg8::bf16x8, t); }
                const int base = dir ? (Lseq - 64 * (n + 1)) : 64 * n;
#pragma unroll
                for (int cb = 0; cb < 4; ++cb) { f32x4 o = (f32x4){0.f, 0.f, 0.f, 0.f};
#pragma unroll
                    for (int ks = 0; ks < 2; ++ks) { const pg8::bf16x8 A = *(const LAS pg8::bf16x8*)(lds + HG_SC + (16 * cb + fr) * 144 + (32 * ks + 8 * kg) * 2);
                        o = __builtin_amdgcn_mfma_f32_16x16x32_bf16(A, Bv[ks], o, 0, 0, 0); }
#pragma unroll
                    for (int kp = 0; kp < 4; ++kp) { const u32x2 a0 = *(const LAS u32x2*)(lds + HG_QE + (16 * cb + fr) * 272 + (32 * kp + 4 * kg) * 2), a1 = *(const LAS u32x2*)(lds + HG_QE + (16 * cb + fr) * 272 + (32 * kp + 16 + 4 * kg) * 2);
                        const pg8::bf16x8 A = __builtin_bit_cast(pg8::bf16x8, (u32x4){a0.x, a0.y, a1.x, a1.y});
                        o = __builtin_amdgcn_mfma_f32_16x16x32_bf16(A, Bs[kp], o, 0, 0, 0); }
#pragma unroll
                    for (int r = 0; r < 4; ++r) { const int cp = 16 * cb + 4 * kg + r; const int t = base + (dir ? 63 - cp : cp); o_out[(size_t)t * HW + h * 128 + 16 * wave + fr] = o[r]; } }
            }
#pragma unroll
            for (int blk = 0; blk < 8; ++blk) { const f32x4 dc = *(const LAS f32x4*)(lds + HG_DEC + (16 * blk + 4 * kg) * 4); f32x4 s = S[blk] * dc;
#pragma unroll
                for (int ks = 0; ks < 2; ++ks) { const pg8::bf16x8 A = *(const LAS pg8::bf16x8*)(lds + HG_KDT + (16 * blk + fr) * 144 + (32 * ks + 8 * kg) * 2);
                    s = __builtin_amdgcn_mfma_f32_16x16x32_bf16(A, Bv[ks], s, 0, 0, 0); }
                S[blk] = s; }
        }
    }
#undef HG_LOAD
#undef HG_BAR
    if (s_out) {
#pragma unroll
        for (int blk = 0; blk < 8; ++blk)
#pragma unroll
            for (int r = 0; r < 4; ++r) s_out[(size_t)(16 * blk + 4 * kg + r) * 128 + 16 * wave + fr] = S[blk][r];
    }
    __syncthreads();
}

__global__ void __launch_bounds__(512, 2) mega(Params P) {
    extern __shared__ __attribute__((aligned(16))) unsigned char lds_raw[];
    cg::grid_group grid = cg::this_grid();
    LAS unsigned char* lds = (LAS unsigned char*)lds_raw;
    const int tid = threadIdx.x, lane = tid & 63, wave = __builtin_amdgcn_readfirstlane(tid >> 6);
    const int G = gridDim.x, bx = blockIdx.x;
    const int vcu = (G % 8 == 0) ? (bx % 8) * (G / 8) + bx / 8 : bx;
    const int gw = vcu * 8 + wave, NGW = G * 8;
    unsigned char* ws = P.ws;
    const float* x = P.in[0]; const float* cvec = P.in[1]; const float* ctx = P.in[2]; const float* c_ctx = P.in[3];
    const float* w_ada = P.in[4]; const float* b_ada = P.in[5]; const float* norm_w = P.in[6]; const float* w_in = P.in[7];
    const float* lb_param = P.in[8]; const float* g_norm = P.in[9]; const float* hy_sw = P.in[10]; const float* hy_sb = P.in[11];
    const float* f_w1 = P.in[12]; const float* f_b1 = P.in[13]; const float* f_w2 = P.in[14]; const float* f_b2 = P.in[15];
    const float* f_w3 = P.in[16]; const float* f_freq = P.in[17]; const float* hy_d = P.in[18]; const float* w_pa = P.in[19];
    const float* w_pb = P.in[20]; const float* w_out = P.in[21]; const float* w_mlp1 = P.in[22]; const float* w_mlp2 = P.in[23];
    float* MOD = (float*)(ws + WS_MOD); float* LB = (float*)(ws + WS_LB); bf16_t* GTB = (bf16_t*)(ws + WS_GT);
    bf16_t* WIN = (bf16_t*)(ws + WS_WIN); bf16_t* WPAB = (bf16_t*)(ws + WS_WPAB); bf16_t* WOUT = (bf16_t*)(ws + WS_WOUT); bf16_t* W1 = (bf16_t*)(ws + WS_W1); bf16_t* W2 = (bf16_t*)(ws + WS_W2);
    bf16_t* HCTX = (bf16_t*)(ws + WS_HCTX); bf16_t* PCTX = (bf16_t*)(ws + WS_PCTX); float* SCTX = (float*)(ws + WS_SCTX);
    bf16_t* HLAT = (bf16_t*)(ws + WS_HLAT); bf16_t* PI = (bf16_t*)(ws + WS_PI); bf16_t* PZ = (bf16_t*)(ws + WS_PZ); bf16_t* PQ = (bf16_t*)(ws + WS_PQ);
    bf16_t* PG = (bf16_t*)(ws + WS_PG); bf16_t* GATES = (bf16_t*)(ws + WS_GATES); bf16_t* PHYT = (bf16_t*)(ws + WS_PHYT);
    bf16_t* AY = (bf16_t*)(ws + WS_AY2); bf16_t* MERGED = (bf16_t*)(ws + WS_MERGED); bf16_t* MIX = (bf16_t*)(ws + WS_MIX);
    bf16_t* MLP = (bf16_t*)(ws + WS_MLP); bf16_t* H1 = (bf16_t*)(ws + WS_H1); bf16_t* HL = (bf16_t*)(ws + WS_HL);
    float* O2 = P.out;

    volatile LAS unsigned* MISC = (volatile LAS unsigned*)(lds + 131072 + 64);
    if (tid < 16) MISC[tid] = 0u;
    __syncthreads();
    const XcdBarrier xbar = xcd_barrier_post((unsigned*)ws, MISC);
#define SEAM_RAW(k) do { if ((k) == 0) grid.sync(); else xcd_barrier(xbar); } while (0)
#if PROBE_MASK
    unsigned long long t_prev = __builtin_amdgcn_s_memrealtime(), t_spin = 0ull;
#ifndef PROBE_BUSY_PHASE
#define PROBE_BUSY_PHASE -1
#define PROBE_BUSY_BLOCK 0
#endif
#define SEAM(k) do { if ((k) == PROBE_BUSY_PHASE && bx == PROBE_BUSY_BLOCK && tid == 0) *(volatile unsigned long long*)(ws + 32768) = __builtin_amdgcn_s_memrealtime() - t_prev; \
    SEAM_RAW(k); { const unsigned long long _t = __builtin_amdgcn_s_memrealtime(); if ((PROBE_MASK >> (k)) & 1) t_spin += _t - t_prev; \
    if ((k) == PROBE_BUSY_PHASE) t_spin += *(volatile unsigned long long*)(ws + 32768); t_prev = _t; } } while (0)
#else
#define SEAM(k) SEAM_RAW(k)
#endif
    {
        if (bx < 192) {
            const int cgp = bx % 96, kh = bx / 96;
            LAS float* sc = (LAS float*)lds;
            LAS float* ps = (LAS float*)(lds + 20480);
            for (int i = tid; i < 9 * 512; i += 512) { const int r = i >> 9, k = kh * 512 + (i & 511); sc[i] = siluf_(r < 8 ? cvec[r * D + k] : c_ctx[k]); }
            __syncthreads();
            const int j = cgp * 64 + lane; float a9[9];
#pragma unroll
            for (int r = 0; r < 9; ++r) a9[r] = 0.f;
            const float* wp = w_ada + (size_t)(kh * 512 + wave * 64) * INC + j;
#pragma unroll 1
            for (int kk = 0; kk < 64; kk += 16) { float w[16];
#pragma unroll
                for (int u = 0; u < 16; ++u) w[u] = wp[(size_t)(kk + u) * INC];
#pragma unroll
                for (int u = 0; u < 16; ++u)
#pragma unroll
                    for (int r = 0; r < 9; ++r) a9[r] += sc[r * 512 + wave * 64 + kk + u] * w[u]; }
#pragma unroll
            for (int r = 0; r < 9; ++r) ps[(wave * 9 + r) * 64 + lane] = a9[r];
            __syncthreads();
            for (int i = tid; i < 9 * 64; i += 512) { const int r = i >> 6, l = i & 63; float s = kh == 0 ? b_ada[cgp * 64 + l] : 0.f;
#pragma unroll
                for (int w = 0; w < 8; ++w) s += ps[(w * 9 + r) * 64 + l];
                atomicAdd(&MOD[r * INC + cgp * 64 + l], s); }
            __syncthreads();
        }
        if (bx == G - 1) { const float a = lb_param[tid], b = lb_param[HW + tid], m = fmaxf(a, b); const float ea = expf(a - m), eb = expf(b - m); LB[tid] = ea / (ea + eb); }
        {   LAS float* scr = (LAS float*)(lds + wave * 16384);
            for (int it = gw; it < 16 * 192; it += NGW) transpose_item(w_in, INC, WIN, D, 0, 1, scr, it, lane); }
        for (int tb = bx; tb < 256; tb += G) {
            __syncthreads();
            LAS float* zf = (LAS float*)lds; LAS float* h1 = zf + 17 * 36; LAS float* h2 = h1 + 17 * 64;
            for (int i = tid; i < 17 * 33; i += 512) { const int p = i / 33, k = i - 33 * p, t = 16 * tb + p; float val;
                if (k == 0) val = (float)t / (float)(L - 1);
                else { const int bi = (k - 1) & 15; const float band = 1e-4f + (float)bi * ((15.f - 1e-4f) / 15.f);
                    const float w = 2.0f * 3.14159265358979323846f * (float)t / (float)L; const float ang = w * band;
                    val = (k <= 16) ? cosf(ang) : -sinf(ang); }
                zf[p * 36 + k] = val; }
            __syncthreads();
            for (int i = tid; i < 17 * 64; i += 512) { const int p = i >> 6, k = i & 63; float acc = f_b1[k];
#pragma unroll 11
                for (int q = 0; q < 33; ++q) acc += zf[p * 36 + q] * f_w1[q * 64 + k];
                h1[i] = sinf(f_freq[k] * acc); }
            __syncthreads();
            for (int i = tid; i < 17 * 64; i += 512) { const int p = i >> 6, k = i & 63; float acc = f_b2[k];
#pragma unroll 16
                for (int q = 0; q < 64; ++q) acc += h1[p * 64 + q] * f_w2[q * 64 + k];
                h2[i] = sinf(f_freq[k] * acc); }
            __syncthreads();
            const int c = tid; float af[16], ab[16];
#pragma unroll
            for (int p = 0; p < 16; ++p) { af[p] = 0.f; ab[p] = 0.f; }
#pragma unroll 4
            for (int k = 0; k < 64; ++k) { const float wf = f_w3[k * 1024 + c], wb = f_w3[k * 1024 + 512 + c]; float hv[17];
#pragma unroll
                for (int p = 0; p < 17; ++p) hv[p] = h2[p * 64 + k];
#pragma unroll
                for (int p = 0; p < 16; ++p) { af[p] += hv[p] * wf; ab[p] += hv[p + 1] * wb; } }
            const float mind = logf(1e-2f) / 1.5f, maxd = logf(1e-2f) / 0.3f;
            const float delta = fabsf(mind + (maxd - mind) * ((float)c / 511.f));
            unsigned short of[16], ob[16];
#pragma unroll
            for (int p = 0; p < 16; ++p) { const int tf = 16 * tb + p, tbk = tf + 1;
                float vf = af[p] * expf(-((float)tf / (float)(L - 1)) * delta); if (tf == 0) vf += hy_d[c];
                float vb = ab[p] * expf(-((float)tbk / (float)(L - 1)) * delta); if (tbk >= L) vb = 0.f;
                of[15 - p] = (unsigned short)f2bf(vf); ob[p] = (unsigned short)f2bf(vb); }
            bf16_t* gf = GTB + (size_t)c * 8192 + (4080 - 16 * tb); bf16_t* gb = GTB + (size_t)c * 8192 + (4096 + 16 * tb);
            u32x4 w0, w1;
            w0.x = of[0] | ((unsigned)of[1] << 16); w0.y = of[2] | ((unsigned)of[3] << 16); w0.z = of[4] | ((unsigned)of[5] << 16); w0.w = of[6] | ((unsigned)of[7] << 16);
            w1.x = of[8] | ((unsigned)of[9] << 16); w1.y = of[10] | ((unsigned)of[11] << 16); w1.z = of[12] | ((unsigned)of[13] << 16); w1.w = of[14] | ((unsigned)of[15] << 16);
            *(u32x4*)gf = w0; *(u32x4*)(gf + 8) = w1;
            w0.x = ob[0] | ((unsigned)ob[1] << 16); w0.y = ob[2] | ((unsigned)ob[3] << 16); w0.z = ob[4] | ((unsigned)ob[5] << 16); w0.w = ob[6] | ((unsigned)ob[7] << 16);
            w1.x = ob[8] | ((unsigned)ob[9] << 16); w1.y = ob[10] | ((unsigned)ob[11] << 16); w1.z = ob[12] | ((unsigned)ob[13] << 16); w1.w = ob[14] | ((unsigned)ob[15] << 16);
            *(u32x4*)gb = w0; *(u32x4*)(gb + 8) = w1;
        }
    }
    SEAM(0);
    for (int m0 = gw; m0 < NT + NCX; m0 += 4 * NGW) {
        f32x4 v[4][4];
#pragma unroll
        for (int r = 0; r < 4; ++r) { const int m = m0 + r * NGW; if (m < NT + NCX) { const f32x4* xr = (const f32x4*)(m < NT ? x + (size_t)m * D : ctx + (size_t)(m - NT) * D) + lane;
#pragma unroll
                for (int j = 0; j < 4; ++j) v[r][j] = xr[64 * j]; } }
#pragma unroll
        for (int r = 0; r < 4; ++r) { const int m = m0 + r * NGW; if (m < NT + NCX) {
                const float* mb = MOD + (size_t)(m < NT ? (m >> 12) : 8) * INC; bf16_t* orow = m < NT ? HLAT + (size_t)m * D : HCTX + (size_t)(m - NT) * D;
                float s = 0.f;
#pragma unroll
                for (int j = 0; j < 4; ++j) s += (v[r][j].x * v[r][j].x + v[r][j].y * v[r][j].y) + (v[r][j].z * v[r][j].z + v[r][j].w * v[r][j].w);
                const float rs = rsqrtf(wave_sum(s) * (1.f / D) + EPS);
                unsigned long long* o8 = (unsigned long long*)orow + lane;
#pragma unroll
                for (int j = 0; j < 4; ++j) { const f32x4 w = ((const f32x4*)norm_w)[lane + 64 * j], sc = ((const f32x4*)mb)[lane + 64 * j], sh = ((const f32x4*)(mb + D))[lane + 64 * j];
                    const f32x4 o = v[r][j] * rs * w * (1.f + sc) + sh;
                    o8[64 * j] = (unsigned long long)cvtpk(o.x, o.y) | ((unsigned long long)cvtpk(o.z, o.w) << 32); } } }
    }
    SEAM(1);
    {
        { pg8::Gemm g{HLAT, WIN, D, D, D}; pg8::StaticOrder S; S.init(NT, 4608, G, bx); pg8::EpiG1 E{PI, PZ, PQ, PG, GATES};
          pg8::gemm_phase(lds, g, S, E); }
        { pg8::Gemm g{WIN + (size_t)4608 * D, HLAT, D, D, D}; pg8::StaticOrder S; S.init(1536, NT, G, bx); pg8::EpiBf16<0> E{PHYT, NT};
          pg8::gemm_phase(lds, g, S, E); }
        { pg8::Gemm g{HCTX, WIN, D, D, D}; pg8::StaticOrder S; S.init(NCX, 1536, G, bx); pg8::EpiBf16<0> E{PCTX, 1536};
          pg8::gemm_phase(lds, g, S, E); }
    }
    SEAM(2);
    if (bx < 64) { const int b = bx >> 3, h = (bx >> 1) & 3, dir = bx & 1;
        hgrn_chain_mfma<false>(lds, PCTX + (size_t)b * LC * 1536, 1536, PCTX + (size_t)b * LC * 1536 + (dir ? 1024 : 512), 1536, nullptr, 0, LC, h, dir, LB,
                   nullptr, SCTX + (size_t)((b * 2 + dir) * 4 + h) * 16384, nullptr); }
    else {
        LAS float* scr = (LAS float*)(lds + wave * 16384);
        constexpr int I_PA = 8 * 32, I_OUT = 16 * 32, I_1 = 16 * 128, I_2 = 64 * 32;
        for (int it = (bx - 64) * 8 + wave; it < 2 * I_PA + I_OUT + I_1 + I_2; it += (G - 64) * 8) {
            int r = it;
            if (r < I_PA) { transpose_item(w_pa, D, WPAB, D, 0, 0, scr, r, lane); continue; } r -= I_PA;
            if (r < I_PA) { transpose_item(w_pb, D, WPAB, D, 512, 0, scr, r, lane); continue; } r -= I_PA;
            if (r < I_OUT) { transpose_item(w_out, D, WOUT, D, 0, 0, scr, r, lane); continue; } r -= I_OUT;
            if (r < I_1) { transpose_item(w_mlp1, FF, W1, D, 0, 0, scr, r, lane); continue; } r -= I_1;
            transpose_item(w_mlp2, D, W2, FF, 0, 0, scr, r, lane);
        }
    }
    SEAM(3);
    if (bx < 64) { const int b = bx >> 3, h = (bx >> 1) & 3, dir = bx & 1;
        hgrn_chain_mfma<true>(lds, PI + (size_t)b * L * 512, 512, PZ + (size_t)b * L * 1024 + (dir ? 512 : 0), 1024, PQ + (size_t)b * L * 512, 512, L, h, dir, LB,
                   SCTX + (size_t)((b * 2 + dir) * 4 + h) * 16384, nullptr, O2 + ((size_t)dir * NT + (size_t)b * L) * HW); }
    else {
        for (int c = bx - 64; c < HW; c += G - 64) hyena_channel(lds, c, PHYT, GTB, hy_sw, hy_sb);
    }
    SEAM(4);
    {
        const f32x4 gn0 = ((const f32x4*)g_norm)[(2 * lane) & 31], gn1 = ((const f32x4*)g_norm)[(2 * lane + 1) & 31];
        for (int t0 = gw; t0 < NT; t0 += 2 * NGW) {
            f32x4 of[2][2], ob[2][2]; u32x4 pg[2];
#pragma unroll
            for (int r = 0; r < 2; ++r) { const int t = t0 + r * NGW; if (t < NT) {
                    of[r][0] = ((const f32x4*)(O2 + (size_t)t * HW))[2 * lane]; of[r][1] = ((const f32x4*)(O2 + (size_t)t * HW))[2 * lane + 1];
                    ob[r][0] = ((const f32x4*)(O2 + ((size_t)NT + t) * HW))[2 * lane]; ob[r][1] = ((const f32x4*)(O2 + ((size_t)NT + t) * HW))[2 * lane + 1];
                    pg[r] = ((const u32x4*)(PG + (size_t)t * 512))[lane]; } }
#pragma unroll
            for (int r = 0; r < 2; ++r) { const int t = t0 + r * NGW; if (t < NT) {
                    const f32x4 a0 = of[r][0] + ob[r][0], a1 = of[r][1] + ob[r][1];
                    float s = (a0.x * a0.x + a0.y * a0.y) + (a0.z * a0.z + a0.w * a0.w) + (a1.x * a1.x + a1.y * a1.y) + (a1.z * a1.z + a1.w * a1.w);
                    s += __shfl_xor(s, 1); s += __shfl_xor(s, 2); s += __shfl_xor(s, 4); s += __shfl_xor(s, 8);
                    const float rs = rsqrtf(s * (1.f / 128.f) + EPS);
                    u32x4 o;
                    o.x = cvtpk(a0.x * rs * gn0.x * pg8::bflo(pg[r].x), a0.y * rs * gn0.y * pg8::bfhi(pg[r].x)); o.y = cvtpk(a0.z * rs * gn0.z * pg8::bflo(pg[r].y), a0.w * rs * gn0.w * pg8::bfhi(pg[r].y));
                    o.z = cvtpk(a1.x * rs * gn1.x * pg8::bflo(pg[r].z), a1.y * rs * gn1.y * pg8::bfhi(pg[r].z)); o.w = cvtpk(a1.z * rs * gn1.z * pg8::bflo(pg[r].w), a1.w * rs * gn1.w * pg8::bfhi(pg[r].w));
                    *(u32x4*)(AY + (size_t)t * 1024 + 8 * lane) = o; } }
        }
    }
    {
        LAS bf16_t* tl = (LAS bf16_t*)(lds + wave * 16384);
        for (int it = gw; it < 8 * 512; it += NGW) { const int c0 = (it & 7) * 64, tok0 = (it >> 3) * 64;
#pragma unroll
            for (int i = 0; i < 8; ++i) { const int ch = lane + 64 * i, rr = ch >> 3, cc = (ch & 7) * 8;
                const u32x4 v = *(const u32x4*)(PHYT + (size_t)(1024 + c0 + rr) * NT + tok0 + cc);
                LAS unsigned* d = (LAS unsigned*)(tl + rr * 66 + cc); d[0] = v.x; d[1] = v.y; d[2] = v.z; d[3] = v.w; }
            LDS_WAIT();
#pragma unroll
            for (int i = 0; i < 8; ++i) { const int ch = lane + 64 * i, tt = ch >> 3, cc = (ch & 7) * 8; unsigned o[4];
#pragma unroll
                for (int q = 0; q < 4; ++q) o[q] = (unsigned)tl[(cc + 2 * q) * 66 + tt] | ((unsigned)tl[(cc + 2 * q + 1) * 66 + tt] << 16);
                *(u32x4*)(AY + (size_t)(tok0 + tt) * 1024 + 512 + c0 + cc) = (u32x4){o[0], o[1], o[2], o[3]}; }
            LDS_WAIT();
        }
    }
    SEAM(5);
    {
        { pg8::Gemm g{AY, WPAB, D, D, 512}; pg8::StaticOrder S; S.init(NT, D, G, bx); pg8::EpiMerge<0> E{MERGED, GATES, 0}; pg8::gemm_phase(lds, g, S, E); }
        { pg8::Gemm g{AY + 512, WPAB + 512, D, D, 512}; pg8::StaticOrder S; S.init(NT, D, G, bx); pg8::EpiMerge<1> E{MERGED, GATES, 1024}; pg8::gemm_phase(lds, g, S, E); }
    }
    SEAM(6);
    { pg8::Gemm g{MERGED, WOUT, D, D, D}; pg8::StaticOrder S; S.init(NT, D, G, bx); pg8::EpiBf16<0> E{MIX, D}; pg8::gemm_phase(lds, g, S, E); }
    SEAM(7);
    for (int m0 = gw; m0 < NT; m0 += 2 * NGW) {
        f32x4 xv[2][4]; u32x2 mx[2][4];
#pragma unroll
        for (int r = 0; r < 2; ++r) { const int m = m0 + r * NGW; if (m < NT) {
#pragma unroll
                for (int j = 0; j < 4; ++j) { xv[r][j] = ((const f32x4*)(x + (size_t)m * D))[lane + 64 * j]; mx[r][j] = *(const u32x2*)(MIX + (size_t)m * D + 4 * lane + 256 * j); } } }
#pragma unroll
        for (int r = 0; r < 2; ++r) { const int m = m0 + r * NGW; if (m < NT) { const float* mb = MOD + (size_t)(m >> 12) * INC;
                f32x4 mv[4], x1[4]; float s = 0.f;
#pragma unroll
                for (int j = 0; j < 4; ++j) { mv[j] = (f32x4){pg8::bflo(mx[r][j].x), pg8::bfhi(mx[r][j].x), pg8::bflo(mx[r][j].y), pg8::bfhi(mx[r][j].y)}; s += (mv[j].x * mv[j].x + mv[j].y * mv[j].y) + (mv[j].z * mv[j].z + mv[j].w * mv[j].w); }
                const float r1 = rsqrtf(wave_sum(s) * (1.f / D) + EPS); float s2 = 0.f;
#pragma unroll
                for (int j = 0; j < 4; ++j) { const f32x4 w = ((const f32x4*)(norm_w + D))[lane + 64 * j], g = ((const f32x4*)(mb + 2 * D))[lane + 64 * j];
                    x1[j] = xv[r][j] + g * (mv[j] * r1 * w); s2 += (x1[j].x * x1[j].x + x1[j].y * x1[j].y) + (x1[j].z * x1[j].z + x1[j].w * x1[j].w); }
                const float r2 = rsqrtf(wave_sum(s2) * (1.f / D) + EPS);
                unsigned long long* o8 = (unsigned long long*)(HL + (size_t)m * D) + lane;
#pragma unroll
                for (int j = 0; j < 4; ++j) { const f32x4 w = ((const f32x4*)(norm_w + 2 * D))[lane + 64 * j], sc = ((const f32x4*)(mb + 3 * D))[lane + 64 * j], sh = ((const f32x4*)(mb + 4 * D))[lane + 64 * j];
                    const f32x4 o = x1[j] * r2 * w * (1.f + sc) + sh;
                    o8[64 * j] = (unsigned long long)cvtpk(o.x, o.y) | ((unsigned long long)cvtpk(o.z, o.w) << 32); } } }
    }
    SEAM(8);
    { pg8::Gemm g{HL, W1, D, D, D}; pg8::StaticOrder S; S.init(NT, FF, G, bx); pg8::EpiBf16<3> E{H1, FF}; pg8::gemm_phase(lds, g, S, E); }
    SEAM(9);
    { pg8::Gemm g{H1, W2, FF, FF, FF}; pg8::StaticOrder S; S.init(NT, D, G, bx); pg8::EpiBf16<0> E{MLP, D}; pg8::gemm_phase(lds, g, S, E); }
    SEAM(10);
    for (int m0 = gw; m0 < NT; m0 += 2 * NGW) {
        f32x4 xv[2][4]; u32x2 mx[2][4], ml[2][4];
#pragma unroll
        for (int r = 0; r < 2; ++r) { const int m = m0 + r * NGW; if (m < NT) {
#pragma unroll
                for (int j = 0; j < 4; ++j) { xv[r][j] = ((const f32x4*)(x + (size_t)m * D))[lane + 64 * j]; mx[r][j] = *(const u32x2*)(MIX + (size_t)m * D + 4 * lane + 256 * j);
                    ml[r][j] = *(const u32x2*)(MLP + (size_t)m * D + 4 * lane + 256 * j); } } }
#pragma unroll
        for (int r = 0; r < 2; ++r) { const int m = m0 + r * NGW; if (m < NT) { const float* mb = MOD + (size_t)(m >> 12) * INC;
                f32x4 mv[4], lv[4]; float s = 0.f, s3 = 0.f;
#pragma unroll
                for (int j = 0; j < 4; ++j) { mv[j] = (f32x4){pg8::bflo(mx[r][j].x), pg8::bfhi(mx[r][j].x), pg8::bflo(mx[r][j].y), pg8::bfhi(mx[r][j].y)}; s += (mv[j].x * mv[j].x + mv[j].y * mv[j].y) + (mv[j].z * mv[j].z + mv[j].w * mv[j].w);
                    lv[j] = (f32x4){pg8::bflo(ml[r][j].x), pg8::bfhi(ml[r][j].x), pg8::bflo(ml[r][j].y), pg8::bfhi(ml[r][j].y)}; s3 += (lv[j].x * lv[j].x + lv[j].y * lv[j].y) + (lv[j].z * lv[j].z + lv[j].w * lv[j].w); }
                const float r1 = rsqrtf(wave_sum(s) * (1.f / D) + EPS), r3 = rsqrtf(wave_sum(s3) * (1.f / D) + EPS);
#pragma unroll
                for (int j = 0; j < 4; ++j) { const f32x4 w1 = ((const f32x4*)(norm_w + D))[lane + 64 * j], g2 = ((const f32x4*)(mb + 2 * D))[lane + 64 * j];
                    const f32x4 w3 = ((const f32x4*)(norm_w + 3 * D))[lane + 64 * j], g5 = ((const f32x4*)(mb + 5 * D))[lane + 64 * j];
                    const f32x4 x1 = xv[r][j] + g2 * (mv[j] * r1 * w1);
                    ((f32x4*)(P.out + (size_t)m * D))[lane + 64 * j] = x1 + g5 * (lv[j] * r3 * w3); } } }
    }
#if PROBE_MASK
    { const unsigned long long _t = __builtin_amdgcn_s_memrealtime(); if ((PROBE_MASK >> 11) & 1) t_spin += _t - t_prev;
      if (bx == 0) { const unsigned long long t0 = __builtin_amdgcn_s_memrealtime(); while (__builtin_amdgcn_s_memrealtime() - t0 < t_spin) __builtin_amdgcn_s_sleep(8); } }
#endif
#if PROBE_XSYNC
    for (int i = 0; i < PROBE_XSYNC; ++i) grid.sync();
#endif
}
}

extern "C" void kernel_launch(void* const* d_in, const int* in_sizes, int n_in, void* d_out, int out_size, void* d_ws, size_t ws_size, hipStream_t stream) {
    static int grid = 0;
    if (grid == 0) {
        if (n_in != 24 || ws_size < WS_END) { fprintf(stderr, "kernel_launch: unexpected n_in %d / ws_size %zu\n", n_in, ws_size); grid = -1; return; }
        int dev = 0, cus = 0, per_cu = 0;
        hipGetDevice(&dev); hipDeviceGetAttribute(&cus, hipDeviceAttributeMultiprocessorCount, dev);
        hipFuncSetAttribute((const void*)mega, hipFuncAttributeMaxDynamicSharedMemorySize, LDS_BYTES);
        hipOccupancyMaxActiveBlocksPerMultiprocessor(&per_cu, (const void*)mega, 512, LDS_BYTES);
        if (per_cu < 1) { fprintf(stderr, "kernel_launch: occupancy query says %d blocks per CU\n", per_cu); grid = -1; return; }
        grid = cus;
    }
    if (grid < 0) return;
    if (hipMemsetAsync(d_ws, 0, 327680, stream) != hipSuccess) { fprintf(stderr, "kernel_launch: memset failed\n"); return; }
    Params p{};
    for (int i = 0; i < 24; ++i) p.in[i] = (const float*)d_in[i];
    p.out = (float*)d_out; p.ws = (unsigned char*)d_ws;
    void* args[] = {&p};
    hipError_t e = hipLaunchCooperativeKernel((const void*)mega, dim3(grid), dim3(512), args, LDS_BYTES, stream);
    if (e != hipSuccess) fprintf(stderr, "cooperative launch failed: %s (grid %d)\n", hipGetErrorString(e), grid);
}
```

```cpp
#include <hip/hip_runtime.h>
#include <hip/hip_cooperative_groups.h>
#include <cstdio>
#include <math.h>
namespace cg = cooperative_groups;
#ifndef PROBE_MASK
#define PROBE_MASK 0
#endif
#ifndef PROBE_XSYNC
#define PROBE_XSYNC 0
#endif

namespace pg8 {
#define PG8_LAS __attribute__((address_space(3)))
typedef unsigned short bf16_t;
typedef short bf16x8 __attribute__((ext_vector_type(8)));
typedef float f32x4 __attribute__((ext_vector_type(4)));
typedef unsigned u32x4 __attribute__((ext_vector_type(4)));
typedef unsigned u32x2 __attribute__((ext_vector_type(2)));
constexpr int BM = 256, BK = 64, HALF = 128, HTB = HALF * BK * 2, STAGE_BYTES = 8 * HTB, NXCD = 8, WGM = 8;

__device__ __forceinline__ int lds_byte(int r, int c) { const int st = (r >> 4) * 2 + (c >> 5), rr = r & 15, cc = c & 31, ob = rr * 64 + cc * 2; return st * 1024 + (ob ^ (((ob >> 9) & 1) << 5)); }
__device__ __forceinline__ void stage_rc(int b, int& R, int& C) { const int st = b / 1024, sb = b % 1024, swz = sb ^ (((sb >> 9) & 1) << 5); R = (st >> 1) * 16 + swz / 64; C = (st & 1) * 32 + (swz % 64) / 2; }
__device__ __forceinline__ int perm32(int rho) { const int n = rho >> 4, i = rho & 15; return 8 * (i >> 2) + 4 * n + (i & 3); }

struct Unit { int pm, pn; };
struct Gemm { const bf16_t* A; const bf16_t* Bt; int lda, ldb, K; };

struct StaticOrder {
    int nM, nN, nwg, G, c;
    __device__ void init(int M, int N, int G_, int c_) { nM = M / BM; nN = N / BM; nwg = nM * nN; G = G_; c = c_; }
    __device__ bool next(int i, Unit& u) const {
        const long L = (long)i * G + c; if (L >= nwg) return false;
        int wgid = (int)L; { const int q = nwg / NXCD, r = nwg % NXCD, xcd = wgid % NXCD, off = wgid / NXCD; wgid = (xcd < r ? xcd * (q + 1) : r * (q + 1) + (xcd - r) * q) + off; }
        const int nig = WGM * nN, gid = wgid / nig, fm = gid * WGM, gsz = (nM - fm) < WGM ? (nM - fm) : WGM;
        u.pm = fm + ((wgid % nig) % gsz); u.pn = (wgid % nig) / gsz; return true;
    }
};

__device__ __forceinline__ unsigned cvt_pk_bf16(float lo, float hi) { unsigned r; asm volatile("v_cvt_pk_bf16_f32 %0, %1, %2" : "=v"(r) : "v"(lo), "v"(hi)); return r; }
__device__ __forceinline__ float sigm(float x) { return __builtin_amdgcn_rcpf(1.0f + __builtin_amdgcn_exp2f(-1.4426950408889634f * x)); }
__device__ __forceinline__ float bflo(unsigned u) { return __uint_as_float(u << 16); }
__device__ __forceinline__ float bfhi(unsigned u) { return __uint_as_float(u & 0xffff0000u); }

template <int ACT  > struct EpiBf16 {
    static constexpr bool PERM = true;
    bf16_t* O; int ldc;
    __device__ __forceinline__ void operator()(const f32x4 (&acc)[2][2][4][2], const Unit& u, int wr, int wc, int fr, int fq) const {
        const int row0 = u.pm * BM + wr * 64 + fr, col0 = u.pn * BM + wc * 32 + 8 * fq;
#pragma unroll
        for (int ai = 0; ai < 2; ++ai)
#pragma unroll
            for (int m = 0; m < 4; ++m) { bf16_t* rowp = O + (size_t)(row0 + ai * HALF + m * 16) * ldc + col0;
#pragma unroll
                for (int bj = 0; bj < 2; ++bj) { f32x4 v0 = acc[ai][bj][m][0], v1 = acc[ai][bj][m][1];
                    if (ACT == 3) {
#pragma unroll
                        for (int j = 0; j < 4; ++j) { const float a = fmaxf(v0[j], 0.f), b = fmaxf(v1[j], 0.f); v0[j] = a * a; v1[j] = b * b; } }
                    u32x4 w; w.x = cvt_pk_bf16(v0[0], v0[1]); w.y = cvt_pk_bf16(v0[2], v0[3]); w.z = cvt_pk_bf16(v1[0], v1[1]); w.w = cvt_pk_bf16(v1[2], v1[3]);
                    *(u32x4*)(rowp + bj * HALF) = w; } }
    }
};
struct EpiG1 {
    static constexpr bool PERM = true;
    bf16_t *PI, *PZ, *PQ, *PG, *GATES;
    __device__ __forceinline__ void operator()(const f32x4 (&acc)[2][2][4][2], const Unit& u, int wr, int wc, int fr, int fq) const {
        const int pn = u.pn; bf16_t* base; int ld, cb, act;
        if (pn < 2) { base = PI; ld = 512; cb = pn * 256; act = 0; }
        else if (pn < 6) { base = PZ; ld = 1024; cb = (pn - 2) * 256; act = 0; }
        else if (pn < 8) { base = PQ; ld = 512; cb = (pn - 6) * 256; act = 1; }
        else if (pn < 10) { base = PG; ld = 512; cb = (pn - 8) * 256; act = 1; }
        else { base = GATES; ld = 2048; cb = (pn - 10) * 256; act = 2; }
        const int row0 = u.pm * BM + wr * 64 + fr, col0 = cb + wc * 32 + 8 * fq;
#pragma unroll
        for (int ai = 0; ai < 2; ++ai)
#pragma unroll
            for (int m = 0; m < 4; ++m) { bf16_t* rowp = base + (size_t)(row0 + ai * HALF + m * 16) * ld + col0;
#pragma unroll
                for (int bj = 0; bj < 2; ++bj) { f32x4 v0 = acc[ai][bj][m][0], v1 = acc[ai][bj][m][1];
                    if (act != 0) {
#pragma unroll
                        for (int j = 0; j < 4; ++j) { const float s0 = sigm(v0[j]), s1 = sigm(v1[j]); v0[j] = act == 1 ? v0[j] * s0 : s0; v1[j] = act == 1 ? v1[j] * s1 : s1; } }
                    u32x4 w; w.x = cvt_pk_bf16(v0[0], v0[1]); w.y = cvt_pk_bf16(v0[2], v0[3]); w.z = cvt_pk_bf16(v1[0], v1[1]); w.w = cvt_pk_bf16(v1[2], v1[3]);
                    *(u32x4*)(rowp + bj * HALF) = w; } }
    }
};
template <int PASS> struct EpiMerge {
    static constexpr bool PERM = true;
    bf16_t* O; const bf16_t* GATES; int goff;
    __device__ __forceinline__ void operator()(const f32x4 (&acc)[2][2][4][2], const Unit& u, int wr, int wc, int fr, int fq) const {
        const int row0 = u.pm * BM + wr * 64 + fr, col0 = u.pn * BM + wc * 32 + 8 * fq;
#pragma unroll
        for (int ai = 0; ai < 2; ++ai)
#pragma unroll
            for (int m = 0; m < 4; ++m) { const size_t r = (size_t)(row0 + ai * HALF + m * 16);
#pragma unroll
                for (int bj = 0; bj < 2; ++bj) { f32x4 v0 = acc[ai][bj][m][0], v1 = acc[ai][bj][m][1];
                    const u32x4 g = *(const u32x4*)(GATES + r * 2048 + goff + col0 + bj * HALF);
                    v0[0] *= bflo(g.x); v0[1] *= bfhi(g.x); v0[2] *= bflo(g.y); v0[3] *= bfhi(g.y); v1[0] *= bflo(g.z); v1[1] *= bfhi(g.z); v1[2] *= bflo(g.w); v1[3] *= bfhi(g.w);
                    bf16_t* op = O + r * 1024 + col0 + bj * HALF;
                    if (PASS == 1) { const u32x4 o = *(const u32x4*)op;
                        v0[0] += bflo(o.x); v0[1] += bfhi(o.x); v0[2] += bflo(o.y); v0[3] += bfhi(o.y); v1[0] += bflo(o.z); v1[1] += bfhi(o.z); v1[2] += bflo(o.w); v1[3] += bfhi(o.w); }
                    u32x4 w; w.x = cvt_pk_bf16(v0[0], v0[1]); w.y = cvt_pk_bf16(v0[2], v0[3]); w.z = cvt_pk_bf16(v1[0], v1[1]); w.w = cvt_pk_bf16(v1[2], v1[3]);
                    *(u32x4*)op = w; } }
    }
};

template <class Epi, class Sched>
__device__ __forceinline__ void gemm_phase(PG8_LAS unsigned char* lds, const Gemm g, const Sched& S, const Epi& E) {
    const int tid = threadIdx.x, wid = __builtin_amdgcn_readfirstlane(tid >> 6), lane = tid & 63, wr = wid >> 2, wc = wid & 3, fr = lane & 15, fq = lane >> 4;
    const int nt = g.K / BK;
    unsigned voffA[2], voffB[2];
#pragma unroll
    for (int i = 0; i < 2; ++i) { int R, C; stage_rc(tid * 16 + i * 8192, R, C); const int Rb = Epi::PERM ? ((R & ~31) + perm32(R & 31)) : R;
        voffA[i] = (unsigned)(R * g.lda + C) * 2u; voffB[i] = (unsigned)(Rb * g.ldb + C) * 2u; }
    const size_t kstep = (size_t)(BK * 2);
    const size_t hstepA = (size_t)HALF * g.lda * 2, hstepB = (size_t)HALF * g.ldb * 2;
    const size_t tstepA = 2 * hstepA, tstepB = 2 * hstepB;
    const unsigned ldsw = (unsigned)wid * 1024u;
    const int aoff = lds_byte(wr * 64 + fr, fq * 8), boff = lds_byte(wc * 32 + fr, fq * 8);
#define PG8_SA(b, h) (((b) * 2 + (h)) * HTB)
#define PG8_SB(b, h) ((4 + (b) * 2 + (h)) * HTB)
#define PG8_STAGE(bufoff, gbase, voff) do { _Pragma("unroll") for (int _i = 0; _i < 2; ++_i) \
        __builtin_amdgcn_global_load_lds((const unsigned*)((const char*)(gbase) + (voff)[_i]), (PG8_LAS unsigned*)(lds + (bufoff) + ldsw + _i * 8192), 16, 0, 0); } while (0)
#define PG8_LDA(dst, b, h) do { _Pragma("unroll") for (int m = 0; m < 4; ++m) _Pragma("unroll") for (int k = 0; k < 2; ++k) dst[m][k] = *(const PG8_LAS bf16x8*)(lds + PG8_SA(b, h) + aoff + m * 2048 + k * 1024); } while (0)
#define PG8_LDB(dst, b, h) do { _Pragma("unroll") for (int n = 0; n < 2; ++n) _Pragma("unroll") for (int k = 0; k < 2; ++k) dst[n][k] = *(const PG8_LAS bf16x8*)(lds + PG8_SB(b, h) + boff + n * 2048 + k * 1024); } while (0)
#define PG8_MMA(ai, bj, At, Bt) do { __builtin_amdgcn_s_setprio(1); _Pragma("unroll") for (int m = 0; m < 4; ++m) _Pragma("unroll") for (int n = 0; n < 2; ++n) _Pragma("unroll") for (int k = 0; k < 2; ++k) \
        acc[ai][bj][m][n] = __builtin_amdgcn_mfma_f32_16x16x32_bf16(Bt[n][k], At[m][k], acc[ai][bj][m][n], 0, 0, 0); __builtin_amdgcn_s_setprio(0); } while (0)
#define PG8_WAIT_V(n) asm volatile("s_waitcnt vmcnt(" #n ")" ::: "memory")
#define PG8_WAIT_L(n) asm volatile("s_waitcnt lgkmcnt(" #n ")" ::: "memory")
#define PG8_BAR __builtin_amdgcn_s_barrier()
#define PG8_SCHED __builtin_amdgcn_sched_barrier(0)
    Unit cur, nxt; int ui = 0;
    if (!S.next(0, cur)) return;
    f32x4 acc[2][2][4][2];
#pragma unroll
    for (int a = 0; a < 2; ++a)
#pragma unroll
        for (int b = 0; b < 2; ++b)
#pragma unroll
            for (int m = 0; m < 4; ++m)
#pragma unroll
                for (int n = 0; n < 2; ++n) acc[a][b][m][n] = (f32x4){0.f, 0.f, 0.f, 0.f};
    bf16x8 At[4][2], B0[2][2], B1[2][2];
    const char* cA = (const char*)g.A + (size_t)cur.pm * tstepA; const char* cB = (const char*)g.Bt + (size_t)cur.pn * tstepB;
    PG8_STAGE(PG8_SB(0, 0), cB, voffB); PG8_STAGE(PG8_SA(0, 0), cA, voffA); PG8_STAGE(PG8_SB(0, 1), cB + hstepB, voffB); PG8_STAGE(PG8_SA(0, 1), cA + hstepA, voffA);
    if (wr == 1) PG8_BAR;
    PG8_WAIT_V(4); PG8_BAR;
    PG8_STAGE(PG8_SB(1, 0), cB + kstep, voffB); PG8_STAGE(PG8_SA(1, 0), cA + kstep, voffA); PG8_STAGE(PG8_SB(1, 1), cB + hstepB + kstep, voffB);
    PG8_WAIT_V(6); PG8_BAR;
    for (;;) {
        const bool has_next = S.next(ui + 1, nxt);
        const char* nA = has_next ? (const char*)g.A + (size_t)nxt.pm * tstepA : cA; const char* nB = has_next ? (const char*)g.Bt + (size_t)nxt.pn * tstepB : cB;
        for (int t = 0; t < nt; t += 2) {
            const bool last = (t == nt - 2);
            const char* a1 = cA + (size_t)(t + 1) * kstep;
            const char* a2 = last ? nA : cA + (size_t)(t + 2) * kstep; const char* b2 = last ? nB : cB + (size_t)(t + 2) * kstep;
            const char* a3 = a2 + kstep; const char* b3 = b2 + kstep;
            PG8_LDB(B0, 0, 0); PG8_SCHED; PG8_LDA(At, 0, 0); PG8_STAGE(PG8_SA(1, 1), a1 + hstepA, voffA);
            PG8_WAIT_L(8); PG8_BAR; PG8_WAIT_L(0); PG8_MMA(0, 0, At, B0); PG8_BAR; PG8_SCHED;
            PG8_LDB(B1, 0, 1); PG8_STAGE(PG8_SB(0, 0), b2, voffB);
            PG8_BAR; PG8_WAIT_L(0); PG8_MMA(0, 1, At, B1); PG8_BAR;
            PG8_LDA(At, 0, 1); PG8_STAGE(PG8_SA(0, 0), a2, voffA);
            PG8_BAR; PG8_WAIT_L(0); PG8_MMA(1, 0, At, B0); PG8_BAR; PG8_SCHED;
            PG8_STAGE(PG8_SB(0, 1), b2 + hstepB, voffB);
            PG8_WAIT_V(6); PG8_BAR; PG8_MMA(1, 1, At, B1); PG8_BAR;
            PG8_LDB(B0, 1, 0); PG8_SCHED; PG8_LDA(At, 1, 0); PG8_STAGE(PG8_SA(0, 1), a2 + hstepA, voffA);
            PG8_WAIT_L(8); PG8_BAR; PG8_WAIT_L(0); PG8_MMA(0, 0, At, B0); PG8_BAR; PG8_SCHED;
            PG8_LDB(B1, 1, 1); PG8_STAGE(PG8_SB(1, 0), b3, voffB);
            PG8_BAR; PG8_WAIT_L(0); PG8_MMA(0, 1, At, B1); PG8_BAR;
            PG8_LDA(At, 1, 1); PG8_STAGE(PG8_SA(1, 0), a3, voffA);
            PG8_BAR; PG8_WAIT_L(0); PG8_MMA(1, 0, At, B0); PG8_BAR; PG8_SCHED;
            PG8_STAGE(PG8_SB(1, 1), b3 + hstepB, voffB);
            PG8_WAIT_V(6); PG8_BAR; PG8_MMA(1, 1, At, B1); PG8_BAR;
        }
        E(acc, cur, wr, wc, fr, fq);
        if (!has_next) break;
#pragma unroll
        for (int a = 0; a < 2; ++a)
#pragma unroll
            for (int b = 0; b < 2; ++b)
#pragma unroll
                for (int m = 0; m < 4; ++m)
#pragma unroll
                    for (int n = 0; n < 2; ++n) acc[a][b][m][n] = (f32x4){0.f, 0.f, 0.f, 0.f};
        cur = nxt; cA = nA; cB = nB; ++ui;
    }
    PG8_WAIT_V(0);
    if (wr == 0) PG8_BAR;
    PG8_BAR;
#undef PG8_SA
#undef PG8_SB
#undef PG8_STAGE
#undef PG8_LDA
#undef PG8_LDB
#undef PG8_MMA
#undef PG8_WAIT_V
#undef PG8_WAIT_L
#undef PG8_BAR
#undef PG8_SCHED
}
}

namespace {
using pg8::bf16_t; using pg8::f32x4; using pg8::u32x4; using pg8::u32x2;
#define LAS __attribute__((address_space(3)))
constexpr int D = 1024, NB = 8, L = 4096, LC = 256, INC = 6144, FF = 4096, HW = 512;
constexpr int NT = NB * L, NCX = NB * LC;
constexpr float EPS = 1e-6f;
constexpr size_t MiB = 1u << 20;
constexpr size_t WS_MOD = 64 * 1024, WS_LB = 512 * 1024, WS_GT = 2 * MiB  ;
constexpr size_t WS_WIN = 18 * MiB, WS_WPAB = 30 * MiB, WS_WOUT = 32 * MiB, WS_W1 = 34 * MiB, WS_W2 = 42 * MiB;
constexpr size_t WS_HCTX = 50 * MiB, WS_PCTX = 54 * MiB, WS_SCTX = 60 * MiB;
constexpr size_t WS_HLAT = 64 * MiB;
constexpr size_t WS_PI = 128 * MiB, WS_PZ = 160 * MiB, WS_PQ = 224 * MiB, WS_PG = 256 * MiB, WS_GATES = 288 * MiB, WS_PHYT = 416 * MiB;
constexpr size_t WS_AY = 160 * MiB;
constexpr size_t WS_AY2 = 64 * MiB;
constexpr size_t WS_MERGED = 128 * MiB;
constexpr size_t WS_MIX = 448 * MiB, WS_MLP = 384 * MiB, WS_H1 = 128 * MiB, WS_HL = 64 * MiB;
constexpr size_t WS_END = 512 * MiB;
constexpr int LDS_BYTES = 163840;

__device__ __forceinline__ float bf2f(bf16_t h) { return __uint_as_float(((unsigned)h) << 16); }
__device__ __forceinline__ unsigned f2bf(float f) { unsigned u = __float_as_uint(f); return (u + 0x7fffu + ((u >> 16) & 1u)) >> 16; }
__device__ __forceinline__ unsigned pk2(float lo, float hi) { return f2bf(lo) | (f2bf(hi) << 16); }
__device__ __forceinline__ float sigmoidf_(float x) { return 1.f / (1.f + expf(-x)); }
__device__ __forceinline__ float siluf_(float x) { return x / (1.f + expf(-x)); }
__device__ __forceinline__ float wave_sum(float v) {
#pragma unroll
    for (int o = 1; o < 64; o <<= 1) v += __shfl_xor(v, o);
    return v;
}
#define LDS_WAIT() asm volatile("s_waitcnt lgkmcnt(0)" ::: "memory")

struct Params { const float* in[24]; float* out; unsigned char* ws; };

#define XB_TMO      128
#define XB_XCNT(j)  (256  + 64 * (j))
#define XB_XSUB(j)  (1280 + 64 * (j))
#define XB_XGEN(j)  (2304 + 64 * (j))
#define XB_TOP      3328
#define XB_TOPGEN   3392
#define XCD_BAR_WORDS 3456
#define XB_SPIN_CAP (1u << 18)

__device__ __forceinline__ unsigned xb_ld(unsigned* p)              { return __hip_atomic_load(p, __ATOMIC_RELAXED, __HIP_MEMORY_SCOPE_AGENT); }
__device__ __forceinline__ unsigned xb_add(unsigned* p, unsigned v) { return __hip_atomic_fetch_add(p, v, __ATOMIC_RELAXED, __HIP_MEMORY_SCOPE_AGENT); }
__device__ __forceinline__ unsigned xb_xcc_id() { return (unsigned)__builtin_amdgcn_s_getreg((3 << 11) | 20) & 0xFu; }
#define XB_SPIN(cond, bar) do { unsigned _sp = 0; while (cond) { __builtin_amdgcn_s_sleep(1); \
    if ((++_sp & 255u) == 0u) { if (xb_ld(&(bar)[XB_TMO])) break; if (_sp > XB_SPIN_CAP) { atomicAdd(&(bar)[XB_TMO], 1u); break; } } } } while (0)

struct XcdBarrier {
    unsigned* bar; unsigned x;
    volatile LAS unsigned* st;
};

__device__ __forceinline__ XcdBarrier xcd_barrier_post(unsigned* bar, volatile LAS unsigned* st) {
    XcdBarrier b; b.bar = bar; b.x = xb_xcc_id(); b.st = st;
    if (threadIdx.x == 0) (void)xb_add(&bar[XB_XCNT(b.x)], 1u);
    return b;
}
__device__ __forceinline__ void xcd_barrier_complete(unsigned* bar, unsigned x, unsigned& nloc, unsigned& nx) {
    const unsigned G = gridDim.x * gridDim.y * gridDim.z;
    unsigned sum, cnt, mine, sp = 0u;
    for (;;) {
        sum = 0u; cnt = 0u; mine = 0u;
#pragma unroll
        for (unsigned j = 0; j < 16; ++j) { const unsigned c = xb_ld(&bar[XB_XCNT(j)]); sum += c; cnt += (c > 0u) ? 1u : 0u; mine = (j == x) ? c : mine; }
        if (sum == G) break;
        __builtin_amdgcn_s_sleep(1);
        if ((++sp & 255u) == 0u) { if (xb_ld(&bar[XB_TMO])) break; if (sp > XB_SPIN_CAP) { atomicAdd(&bar[XB_TMO], 1u); break; } }
    }
    nloc = mine > 0u ? mine : 1u; nx = cnt > 0u ? cnt : 1u;
}

__device__ __forceinline__ void xcd_barrier(const XcdBarrier& b) {
    asm volatile("s_waitcnt vmcnt(0)" ::: "memory");
    __syncthreads();
    if (threadIdx.x == 0) {
        unsigned* bar = b.bar;
        __builtin_amdgcn_s_waitcnt(0);
        unsigned nloc = b.st[0], nx = b.st[1];
        if (nloc == 0u) { xcd_barrier_complete(bar, b.x, nloc, nx); b.st[0] = nloc; b.st[1] = nx; }
        const unsigned old = xb_add(&bar[XB_XSUB(b.x)], 1u);
        const unsigned gen = old / nloc;
        if (old + 1u == (gen + 1u) * nloc) {
            __builtin_amdgcn_fence(__ATOMIC_RELEASE, "agent");
            asm volatile("s_waitcnt vmcnt(0)" ::: "memory");
            const unsigned og = xb_add(&bar[XB_TOP], 1u);
            const unsigned tg = og / nx;
            if (og + 1u == (tg + 1u) * nx) xb_add(&bar[XB_TOPGEN], 1u);
            else XB_SPIN(xb_ld(&bar[XB_TOPGEN]) == tg, bar);
            __builtin_amdgcn_fence(__ATOMIC_ACQUIRE, "agent");
            xb_add(&bar[XB_XGEN(b.x)], 1u);
            asm volatile("s_waitcnt vmcnt(0)" ::: "memory");
        } else {
            XB_SPIN(xb_ld(&bar[XB_XGEN(b.x)]) == gen, bar);
            __builtin_amdgcn_fence(__ATOMIC_ACQUIRE, "agent");
            asm volatile("s_waitcnt vmcnt(0)" ::: "memory");
        }
    }
    __syncthreads();
}


__device__ __forceinline__ void transpose_item(const float* W, int N, bf16_t* WT, int ldk, int koff, int remap, LAS float* scr, int item, int lane) {
    const int nblk = N / 32, kb = item / nblk, nb = item % nblk, k0 = 64 * kb, n0 = 32 * nb;
    int rbase = n0;
    if (remap) rbase = n0 < 2560 ? n0 : (n0 < 4096 ? n0 + 2048 : n0 - 1536);
#pragma unroll 8
    for (int i = 0; i < 32; ++i) { const int kk = 2 * i + (lane >> 5); scr[kk * 33 + (lane & 31)] = W[(size_t)(k0 + kk) * N + n0 + (lane & 31)]; }
    LDS_WAIT();
    const int c = lane & 7;
#pragma unroll
    for (int j = 0; j < 4; ++j) { const int n = (lane >> 3) + 8 * j; const LAS float* s = scr + (8 * c) * 33 + n;
        u32x4 o; o.x = pk2(s[0 * 33], s[1 * 33]); o.y = pk2(s[2 * 33], s[3 * 33]); o.z = pk2(s[4 * 33], s[5 * 33]); o.w = pk2(s[6 * 33], s[7 * 33]);
        *(u32x4*)(WT + (size_t)(rbase + n) * ldk + koff + k0 + 8 * c) = o; }
    LDS_WAIT();
}

__device__ __forceinline__ void row_norm_mod_bf16(const float* xrow, const float* nw, const float* scale, const float* shift, bf16_t* orow, int lane) {
    const f32x4* xr = (const f32x4*)xrow + lane; f32x4 v[4]; float s = 0.f;
#pragma unroll
    for (int j = 0; j < 4; ++j) { v[j] = xr[64 * j]; s += (v[j].x * v[j].x + v[j].y * v[j].y) + (v[j].z * v[j].z + v[j].w * v[j].w); }
    const float r = rsqrtf(wave_sum(s) * (1.f / D) + EPS);
    unsigned long long* o8 = (unsigned long long*)orow + lane;
#pragma unroll
    for (int j = 0; j < 4; ++j) { const f32x4 w = ((const f32x4*)nw)[lane + 64 * j], sc = ((const f32x4*)scale)[lane + 64 * j], sh = ((const f32x4*)shift)[lane + 64 * j];
        const f32x4 o = v[j] * r * w * (1.f + sc) + sh;
        o8[64 * j] = (unsigned long long)pk2(o.x, o.y) | ((unsigned long long)pk2(o.z, o.w) << 32); }
}
__device__ __forceinline__ f32x4 ld_bf4(const bf16_t* p) { const u32x2 u = *(const u32x2*)p; return (f32x4){pg8::bflo(u.x), pg8::bfhi(u.x), pg8::bflo(u.y), pg8::bfhi(u.y)}; }
__device__ __forceinline__ void row_x1(const float* xrow, const bf16_t* mixrow, const float* nw1, const float* g2, f32x4 (&x1)[4], int lane) {
    f32x4 mv[4]; float s = 0.f;
#pragma unroll
    for (int j = 0; j < 4; ++j) { mv[j] = ld_bf4(mixrow + 4 * lane + 256 * j); s += (mv[j].x * mv[j].x + mv[j].y * mv[j].y) + (mv[j].z * mv[j].z + mv[j].w * mv[j].w); }
    const float r = rsqrtf(wave_sum(s) * (1.f / D) + EPS);
#pragma unroll
    for (int j = 0; j < 4; ++j) { const f32x4 w = ((const f32x4*)nw1)[lane + 64 * j], g = ((const f32x4*)g2)[lane + 64 * j], xv = ((const f32x4*)xrow)[lane + 64 * j];
        x1[j] = xv + g * (mv[j] * r * w); }
}

typedef float f32x16 __attribute__((ext_vector_type(16)));
typedef float f32x2_t __attribute__((ext_vector_type(2)));
typedef __bf16 bf16x2_t __attribute__((ext_vector_type(2)));
__device__ __forceinline__ unsigned cvtpk(float lo, float hi) { const f32x2_t v = {lo, hi}; const bf16x2_t b = __builtin_convertvector(v, bf16x2_t); return __builtin_bit_cast(unsigned, b); }
constexpr int HY_PITCH = 8720;
constexpr int HY_TAB0 = 8 * HY_PITCH;
constexpr int HY_TAB1 = HY_TAB0 + 17408 + 64;
__device__ __forceinline__ void conv8(const u32x4 raw, float left, float right, float w0, float w1, float w2, float bias, float (&o)[8]) {
    float in[10]; in[0] = left; in[9] = right;
    in[1] = pg8::bflo(raw.x); in[2] = pg8::bfhi(raw.x); in[3] = pg8::bflo(raw.y); in[4] = pg8::bfhi(raw.y); in[5] = pg8::bflo(raw.z); in[6] = pg8::bfhi(raw.z); in[7] = pg8::bflo(raw.w); in[8] = pg8::bfhi(raw.w);
#pragma unroll
    for (int j = 0; j < 8; ++j) o[j] = bias + w0 * in[j] + w1 * in[j + 1] + w2 * in[j + 2];
}
__device__ __forceinline__ void hyena_channel(LAS unsigned char* lds, int c, bf16_t* PHYT, const bf16_t* GTB, const float* hy_sw, const float* hy_sb) {
    const int tid = threadIdx.x, lane = tid & 63, wave = __builtin_amdgcn_readfirstlane(tid >> 6);
    const bool hl = (tid & 7) != 0, hr = ((tid + 1) & 7) != 0;
    __syncthreads();
    for (int ci = tid; ci < 1088; ci += 512) { u32x4 v = (u32x4){0u, 0u, 0u, 0u};
        if (ci >= 32 && ci < 1056) v = *(const u32x4*)(GTB + (size_t)c * 8192 + (ci - 32) * 8);
        *(LAS u32x4*)(lds + HY_TAB0 + ci * 16) = v; }
    {
        const bf16_t* x1r = PHYT + (size_t)(512 + c) * NT + 8 * tid; const bf16_t* vr = PHYT + (size_t)(1024 + c) * NT + 8 * tid;
        const float xw0 = hy_sw[512 + c], xw1 = hy_sw[1536 + 512 + c], xw2 = hy_sw[3072 + 512 + c], xb = hy_sb[512 + c];
        const float vw0 = hy_sw[1024 + c], vw1 = hy_sw[1536 + 1024 + c], vw2 = hy_sw[3072 + 1024 + c], vb = hy_sb[1024 + c];
        u32x4 xa[8], va[8];
#pragma unroll
        for (int b = 0; b < 8; ++b) { xa[b] = *(const u32x4*)(x1r + (size_t)b * L); va[b] = *(const u32x4*)(vr + (size_t)b * L); }
#pragma unroll
        for (int b = 0; b < 8; ++b) {
            const unsigned xpw = __shfl_up(xa[b].w, 1), xnx = __shfl_down(xa[b].x, 1), vpw = __shfl_up(va[b].w, 1), vnx = __shfl_down(va[b].x, 1);
            const float xl = hl ? pg8::bfhi(xpw) : 0.f, xr = hr ? pg8::bflo(xnx) : 0.f, vl = hl ? pg8::bfhi(vpw) : 0.f, vrr = hr ? pg8::bflo(vnx) : 0.f;
            float cx[8], cv[8]; conv8(xa[b], xl, xr, xw0, xw1, xw2, xb, cx); conv8(va[b], vl, vrr, vw0, vw1, vw2, vb, cv);
            u32x4 w; w.x = cvtpk(cx[0] * cv[0], cx[1] * cv[1]); w.y = cvtpk(cx[2] * cv[2], cx[3] * cv[3]); w.z = cvtpk(cx[4] * cv[4], cx[5] * cv[5]); w.w = cvtpk(cx[6] * cv[6], cx[7] * cv[7]);
            *(LAS u32x4*)(lds + b * HY_PITCH + (128 + 8 * tid) * 2) = w; }
        if (tid < 256) { const int b = tid >> 5, side = (tid >> 4) & 1, k = tid & 15;
            *(LAS u32x4*)(lds + b * HY_PITCH + (side ? (128 + 4096) * 2 : 0) + k * 16) = (u32x4){0u, 0u, 0u, 0u}; }
    }
    __syncthreads();
    for (int ci = tid; ci < 1088; ci += 512) { const u32x4 d = *(const LAS u32x4*)(lds + HY_TAB0 + ci * 16); const unsigned d4 = ci < 1087 ? *(const LAS unsigned*)(lds + HY_TAB0 + ci * 16 + 16) : 0u;
        u32x4 o; o.x = __builtin_amdgcn_alignbit(d.y, d.x, 16); o.y = __builtin_amdgcn_alignbit(d.z, d.y, 16); o.z = __builtin_amdgcn_alignbit(d.w, d.z, 16); o.w = __builtin_amdgcn_alignbit(d4, d.w, 16);
        *(LAS u32x4*)(lds + HY_TAB1 + ci * 16) = o; }
    __syncthreads();
    const int T0 = 512 * wave, r = lane & 31, h = lane >> 5, bb = r >> 2, tb = r & 3;
    f32x16 acc[4];
#pragma unroll
    for (int i = 0; i < 4; ++i)
#pragma unroll
        for (int j = 0; j < 16; ++j) acc[i][j] = 0.f;
    {
        const int Dfirst = T0 - 4080;
        const int e0 = 4351 - Dfirst - r + 8 * h;
        const unsigned aaddr0 = (unsigned)((e0 & 1) ? HY_TAB1 : HY_TAB0) + (unsigned)(e0 & ~1) * 2u;
        const unsigned baddr0 = (unsigned)(bb * HY_PITCH + (128 + T0 + 32 * tb - Dfirst + 8 * h) * 2);
#define HY_LDA(dst, ad) do { u32x4 _t; _t.x = *(const LAS unsigned*)(lds + (ad)); _t.y = *(const LAS unsigned*)(lds + (ad) + 4); _t.z = *(const LAS unsigned*)(lds + (ad) + 8); _t.w = *(const LAS unsigned*)(lds + (ad) + 12); dst = __builtin_bit_cast(pg8::bf16x8, _t); } while (0)
#define HY_LDB(dst, ad) dst = *(const LAS pg8::bf16x8*)(lds + (ad))
#define HY_GENERIC(st_lo, st_hi) do { for (int st = (st_lo); st < (st_hi); ++st) { const int d = -4080 + 16 * st; const unsigned aa = aaddr0 - 32u * (unsigned)st, ba = baddr0 - 32u * (unsigned)st; pg8::bf16x8 A; HY_LDA(A, aa); \
            if (d <= 96) { pg8::bf16x8 B; HY_LDB(B, ba); acc[0] = __builtin_amdgcn_mfma_f32_32x32x16_bf16(A, B, acc[0], 0, 0, 0); } \
            if (d >= -3952 && d <= 224) { pg8::bf16x8 B; HY_LDB(B, ba + 256); acc[1] = __builtin_amdgcn_mfma_f32_32x32x16_bf16(A, B, acc[1], 0, 0, 0); } \
            if (d >= -3824 && d <= 352) { pg8::bf16x8 B; HY_LDB(B, ba + 512); acc[2] = __builtin_amdgcn_mfma_f32_32x32x16_bf16(A, B, acc[2], 0, 0, 0); } \
            if (d >= -3696) { pg8::bf16x8 B; HY_LDB(B, ba + 768); acc[3] = __builtin_amdgcn_mfma_f32_32x32x16_bf16(A, B, acc[3], 0, 0, 0); } } } while (0)
#define HY_LOAD5(A, B0, B1, B2, B3, aa, ba) do { HY_LDA(A, aa); HY_LDB(B0, ba); HY_LDB(B1, (ba) + 256); HY_LDB(B2, (ba) + 512); HY_LDB(B3, (ba) + 768); } while (0)
#define HY_MMA4(A, B0, B1, B2, B3) do { acc[0] = __builtin_amdgcn_mfma_f32_32x32x16_bf16(A, B0, acc[0], 0, 0, 0); acc[1] = __builtin_amdgcn_mfma_f32_32x32x16_bf16(A, B1, acc[1], 0, 0, 0); \
            acc[2] = __builtin_amdgcn_mfma_f32_32x32x16_bf16(A, B2, acc[2], 0, 0, 0); acc[3] = __builtin_amdgcn_mfma_f32_32x32x16_bf16(A, B3, acc[3], 0, 0, 0); } while (0)
        HY_GENERIC(0, 24);
        {
            unsigned aa = aaddr0 - 32u * 24u, ba = baddr0 - 32u * 24u;
            pg8::bf16x8 Aa, Ba0, Ba1, Ba2, Ba3, Ab, Bb0, Bb1, Bb2, Bb3;
            HY_LOAD5(Aa, Ba0, Ba1, Ba2, Ba3, aa, ba);
#pragma unroll 1
            for (int it = 0; it < 118; ++it) {
                HY_LOAD5(Ab, Bb0, Bb1, Bb2, Bb3, aa - 32u, ba - 32u); __builtin_amdgcn_sched_barrier(0);
                HY_MMA4(Aa, Ba0, Ba1, Ba2, Ba3); __builtin_amdgcn_sched_barrier(0);
                HY_LOAD5(Aa, Ba0, Ba1, Ba2, Ba3, aa - 64u, ba - 64u); __builtin_amdgcn_sched_barrier(0);
                HY_MMA4(Ab, Bb0, Bb1, Bb2, Bb3); __builtin_amdgcn_sched_barrier(0);
                aa -= 64u; ba -= 64u;
            }
            HY_LOAD5(Ab, Bb0, Bb1, Bb2, Bb3, aa - 32u, ba - 32u);
            HY_MMA4(Aa, Ba0, Ba1, Ba2, Ba3);
            HY_MMA4(Ab, Bb0, Bb1, Bb2, Bb3);
        }
        HY_GENERIC(262, 286);
#undef HY_LDA
#undef HY_LDB
#undef HY_GENERIC
#undef HY_LOAD5
#undef HY_MMA4
    }
    __syncthreads();
    {
        const bf16_t* x0r = PHYT + (size_t)c * NT + 8 * tid; u32x4 xa[8];
#pragma unroll
        for (int b = 0; b < 8; ++b) xa[b] = *(const u32x4*)(x0r + (size_t)b * L);
#pragma unroll
        for (int i = 0; i < 4; ++i)
#pragma unroll
            for (int g = 0; g < 4; ++g) { const int t = T0 + 128 * i + 32 * tb + 8 * g + 4 * h;
                pg8::u32x2 w; w.x = cvtpk(acc[i][4 * g], acc[i][4 * g + 1]); w.y = cvtpk(acc[i][4 * g + 2], acc[i][4 * g + 3]);
                *(LAS pg8::u32x2*)(lds + bb * HY_PITCH + (128 + t) * 2) = w; }
        __syncthreads();
        bf16_t* yr = PHYT + (size_t)(1024 + c) * NT + 8 * tid;
        const float w0 = hy_sw[c], w1 = hy_sw[1536 + c], w2 = hy_sw[3072 + c], bs = hy_sb[c];
#pragma unroll
        for (int b = 0; b < 8; ++b) {
            const unsigned xpw = __shfl_up(xa[b].w, 1), xnx = __shfl_down(xa[b].x, 1);
            const float xl = hl ? pg8::bfhi(xpw) : 0.f, xr = hr ? pg8::bflo(xnx) : 0.f;
            float cx[8]; conv8(xa[b], xl, xr, w0, w1, w2, bs, cx);
            const u32x4 y = *(const LAS u32x4*)(lds + b * HY_PITCH + (128 + 8 * tid) * 2);
            u32x4 w; w.x = cvtpk(cx[0] * pg8::bflo(y.x), cx[1] * pg8::bfhi(y.x)); w.y = cvtpk(cx[2] * pg8::bflo(y.y), cx[3] * pg8::bfhi(y.y));
            w.z = cvtpk(cx[4] * pg8::bflo(y.z), cx[5] * pg8::bfhi(y.z)); w.w = cvtpk(cx[6] * pg8::bflo(y.w), cx[7] * pg8::bfhi(y.w));
            *(u32x4*)(yr + (size_t)b * L) = w; }
    }
}

constexpr int HG_QE = 0, HG_KE = 17408, HG_KDT = 34816, HG_VT = 53248, HG_DEC = 71680, HG_BUF = 72192;

#define HG_RD2(ptr_a, ptr_b) __builtin_bit_cast(pg8::bf16x8, (u32x4){(*(const LAS u32x2*)(ptr_a)).x, (*(const LAS u32x2*)(ptr_a)).y, (*(const LAS u32x2*)(ptr_b)).x, (*(const LAS u32x2*)(ptr_b)).y})
#define HG_MFMA(a, b, c) __builtin_amdgcn_mfma_f32_16x16x32_bf16(a, b, c, 0, 0, 0)
#define HG_SB() __builtin_amdgcn_sched_barrier(0)
__device__ __forceinline__ pg8::bf16x8 hg_pack2(const f32x4& a, const f32x4& b) { u32x4 t; t.x = cvtpk(a[0], a[1]); t.y = cvtpk(a[2], a[3]); t.z = cvtpk(b[0], b[1]); t.w = cvtpk(b[2], b[3]); return __builtin_bit_cast(pg8::bf16x8, t); }
template <bool HAS_Q>
__device__ __forceinline__ void hgrn_consume(LAS unsigned char* Bf, f32x4 (&S)[2][8], int base, int dir, int h, int cw, int fr, int kg, float* o_out, int dbg) {
    const f32x4 z4 = (f32x4){0.f, 0.f, 0.f, 0.f};
    pg8::bf16x8 Bv[2][2];
#pragma unroll
    for (int sl = 0; sl < 2; ++sl)
#pragma unroll
        for (int ks = 0; ks < 2; ++ks) { LAS unsigned char* const vp = Bf + HG_VT + (32 * cw + 16 * sl + fr) * 144 + (32 * ks + 4 * kg) * 2; Bv[sl][ks] = HG_RD2(vp, vp + 32); }
    if (HAS_Q) {
        f32x4 st[10];
#pragma unroll
        for (int i = 0; i < 10; ++i) st[i] = z4;
        pg8::bf16x8 Kf[2][4], Qf[2][4];
        LAS unsigned char* const kbase = Bf + HG_KE + fr * 272 + 8 * kg * 2; LAS unsigned char* const qbase = Bf + HG_QE + fr * 272 + 8 * kg * 2;
#pragma unroll
        for (int b4 = 0; b4 < 4; ++b4) { Kf[0][b4] = *(const LAS pg8::bf16x8*)(kbase + b4 * 16 * 272); Qf[0][b4] = *(const LAS pg8::bf16x8*)(qbase + b4 * 16 * 272); }
#pragma unroll
        for (int ks = 0; ks < 4; ++ks) {
            if (ks < 3) {
#pragma unroll
                for (int b4 = 0; b4 < 4; ++b4) { Kf[(ks + 1) & 1][b4] = *(const LAS pg8::bf16x8*)(kbase + b4 * 16 * 272 + (ks + 1) * 64); Qf[(ks + 1) & 1][b4] = *(const LAS pg8::bf16x8*)(qbase + b4 * 16 * 272 + (ks + 1) * 64); } }
            HG_SB();
#pragma unroll
            for (int cb = 0; cb < 4; ++cb)
#pragma unroll
                for (int sb = 0; sb <= cb; ++sb) st[cb * (cb + 1) / 2 + sb] = HG_MFMA(Kf[ks & 1][sb], Qf[ks & 1][cb], st[cb * (cb + 1) / 2 + sb]);
            HG_SB();
        }
#pragma unroll
        for (int cb = 0; cb < 4; ++cb)
#pragma unroll
            for (int r = 0; r < 4; ++r) st[cb * (cb + 1) / 2 + cb][r] = (4 * kg + r <= fr) ? st[cb * (cb + 1) / 2 + cb][r] : 0.f;
        pg8::bf16x8 Af[4][2];
        Af[0][0] = hg_pack2(st[0], z4); Af[1][0] = hg_pack2(st[1], st[2]); Af[2][0] = hg_pack2(st[3], st[4]); Af[2][1] = hg_pack2(st[5], z4); Af[3][0] = hg_pack2(st[6], st[7]); Af[3][1] = hg_pack2(st[8], st[9]);
        pg8::bf16x8 Bs[2][4];
#pragma unroll
        for (int sl = 0; sl < 2; ++sl)
#pragma unroll
            for (int kp = 0; kp < 4; ++kp) Bs[sl][kp] = hg_pack2(S[sl][2 * kp], S[sl][2 * kp + 1]);
        pg8::bf16x8 Aq[2][4];
        LAS unsigned char* const qp0 = Bf + HG_QE + fr * 272 + 4 * kg * 2;
#pragma unroll
        for (int kp = 0; kp < 4; ++kp) Aq[0][kp] = HG_RD2(qp0 + kp * 64, qp0 + kp * 64 + 32);
#pragma unroll
        for (int cb = 0; cb < 4; ++cb) {
            if (cb < 3) {
#pragma unroll
                for (int kp = 0; kp < 4; ++kp) Aq[(cb + 1) & 1][kp] = HG_RD2(qp0 + (cb + 1) * 16 * 272 + kp * 64, qp0 + (cb + 1) * 16 * 272 + kp * 64 + 32); }
            HG_SB();
            f32x4 o0 = z4, o1 = z4;
            o0 = HG_MFMA(Af[cb][0], Bv[0][0], o0); o1 = HG_MFMA(Af[cb][0], Bv[1][0], o1);
            if (cb >= 2) { o0 = HG_MFMA(Af[cb][1], Bv[0][1], o0); o1 = HG_MFMA(Af[cb][1], Bv[1][1], o1); }
#pragma unroll
            for (int kp = 0; kp < 4; ++kp) { o0 = HG_MFMA(Aq[cb & 1][kp], Bs[0][kp], o0); o1 = HG_MFMA(Aq[cb & 1][kp], Bs[1][kp], o1); }
            HG_SB();
#pragma unroll
            for (int r = 0; r < 4; ++r) { const int cp = 16 * cb + 4 * kg + r; const int t = base + (dir ? 63 - cp : cp); float* op = o_out + (size_t)t * HW + h * 128 + 32 * cw + fr;
                if (!(dbg & 1)) { op[0] = o0[r]; op[16] = o1[r]; } else asm volatile("" :: "v"(o0[r]), "v"(o1[r])); }
        }
    }
    pg8::bf16x8 Ak[2][2][2]; f32x4 dc[2][2];
    LAS unsigned char* const kdp = Bf + HG_KDT + fr * 144 + 4 * kg * 2; LAS unsigned char* const dcp = Bf + HG_DEC + 4 * kg * 4;
#pragma unroll
    for (int u = 0; u < 2; ++u) { dc[0][u] = *(const LAS f32x4*)(dcp + u * 64);
#pragma unroll
        for (int ks = 0; ks < 2; ++ks) Ak[0][u][ks] = HG_RD2(kdp + u * 16 * 144 + ks * 64, kdp + u * 16 * 144 + ks * 64 + 32); }
#pragma unroll
    for (int bp = 0; bp < 4; ++bp) {
        if (bp < 3) {
#pragma unroll
            for (int u = 0; u < 2; ++u) { const int blk = 2 * (bp + 1) + u; dc[(bp + 1) & 1][u] = *(const LAS f32x4*)(dcp + blk * 64);
#pragma unroll
                for (int ks = 0; ks < 2; ++ks) Ak[(bp + 1) & 1][u][ks] = HG_RD2(kdp + blk * 16 * 144 + ks * 64, kdp + blk * 16 * 144 + ks * 64 + 32); } }
        HG_SB();
#pragma unroll
        for (int u = 0; u < 2; ++u) { const int blk = 2 * bp + u; f32x4 s0 = S[0][blk] * dc[bp & 1][u], s1 = S[1][blk] * dc[bp & 1][u];
#pragma unroll
            for (int ks = 0; ks < 2; ++ks) { s0 = HG_MFMA(Ak[bp & 1][u][ks], Bv[0][ks], s0); s1 = HG_MFMA(Ak[bp & 1][u][ks], Bv[1][ks], s1); }
            S[0][blk] = s0; S[1][blk] = s1; }
        HG_SB();
    }
}
#undef HG_RD2
#undef HG_MFMA
#undef HG_SB

template <bool HAS_Q>
__device__ __forceinline__ void hgrn_chain_mfma(LAS unsigned char* lds, const bf16_t* pi, int ldi, const bf16_t* pz, int ldz, const bf16_t* pq, int ldq, int Lseq, int h, int dir,
                                                const float* lb, const float* s_in, float* s_out, float* o_out, int dbg = 0) {
    const int tid = threadIdx.x, lane = tid & 63, wave = __builtin_amdgcn_readfirstlane(tid >> 6);
    const int nch = Lseq / 64;
    const bool producer = wave < 4;
#define HG_BAR() do { asm volatile("s_waitcnt lgkmcnt(0)" ::: "memory"); __builtin_amdgcn_s_barrier(); asm volatile("" ::: "memory"); } while (0)
    const int pw = wave & 3, dp = lane & 15, rq = lane >> 4, ch0 = 32 * pw + 2 * dp;
    const float lb0 = lb[h * 128 + ch0], lb1 = lb[h * 128 + ch0 + 1];
    unsigned offZ[16], offI[16];
#pragma unroll
    for (int i = 0; i < 16; ++i) { const int cp = 16 * rq + i, ro = dir ? 63 - cp : cp; offZ[i] = (unsigned)(ro * ldz + h * 128 + ch0) * 2u; offI[i] = (unsigned)(ro * ldi + h * 128 + ch0) * 2u; }
    const __amdgpu_buffer_rsrc_t rsZ = __builtin_amdgcn_make_buffer_rsrc((void*)pz, 0, Lseq * ldz * 2, 0x00020000);
    const __amdgpu_buffer_rsrc_t rsI = __builtin_amdgcn_make_buffer_rsrc((void*)pi, 0, Lseq * ldi * 2, 0x00020000);
    const __amdgpu_buffer_rsrc_t rsQ = __builtin_amdgcn_make_buffer_rsrc((void*)(HAS_Q ? pq : pi), 0, Lseq * (HAS_Q ? ldq : ldi) * 2, 0x00020000);
#define HG_LOAD(n, Z, Q, V) do { const int _n = (dbg & 2) ? 0 : (n); const int _base = dir ? (Lseq - 64 * (_n + 1)) : 64 * _n; \
        _Pragma("unroll") for (int i = 0; i < 16; ++i) { Z[i] = __builtin_amdgcn_raw_buffer_load_b32(rsZ, offZ[i], _base * ldz * 2, 0); V[i] = __builtin_amdgcn_raw_buffer_load_b32(rsI, offI[i], _base * ldi * 2, 0); \
            if (HAS_Q) Q[i] = __builtin_amdgcn_raw_buffer_load_b32(rsQ, offI[i], _base * ldq * 2, 0); } } while (0)
#define HG_PRODUCE(Z, Q, V, boff) do { LAS unsigned char* const Bf = lds + (boff); \
        float f0[16], f1[16]; float p0 = 1.f, p1 = 1.f; \
        _Pragma("unroll") for (int i = 0; i < 16; ++i) { f0[i] = lb0 + (1.f - lb0) * pg8::sigm(pg8::bflo(Z[i])); f1[i] = lb1 + (1.f - lb1) * pg8::sigm(pg8::bfhi(Z[i])); p0 *= f0[i]; p1 *= f1[i]; } \
        float run0 = 1.f, run1 = 1.f, fl0 = 1.f, fl1 = 1.f; \
        _Pragma("unroll") for (int qq = 0; qq < 4; ++qq) { const float t0 = __shfl(p0, dp + 16 * qq), t1 = __shfl(p1, dp + 16 * qq); fl0 *= t0; fl1 *= t1; if (qq < rq) { run0 *= t0; run1 *= t1; } } \
        unsigned kdw0[8], kdw1[8]; \
        _Pragma("unroll") for (int i2 = 0; i2 < 8; ++i2) { float kda[2], kdb[2]; \
            _Pragma("unroll") for (int u = 0; u < 2; ++u) { const int i = 2 * i2 + u; run0 *= f0[i]; run1 *= f1[i]; const float ia = __builtin_amdgcn_rcpf(run0), ib = __builtin_amdgcn_rcpf(run1); \
                const float kea = (1.f - f0[i]) * ia, keb = (1.f - f1[i]) * ib; const int cp = 16 * rq + i; \
                if (HAS_Q) { *(LAS unsigned*)(Bf + HG_QE + cp * 272 + ch0 * 2) = cvtpk(pg8::bflo(Q[i]) * run0, pg8::bfhi(Q[i]) * run1); \
                             *(LAS unsigned*)(Bf + HG_KE + cp * 272 + ch0 * 2) = cvtpk(kea, keb); } \
                kda[u] = kea * fl0; kdb[u] = keb * fl1; } \
            kdw0[i2] = cvtpk(kda[0], kda[1]); kdw1[i2] = cvtpk(kdb[0], kdb[1]); } \
        *(LAS u32x4*)(Bf + HG_KDT + ch0 * 144 + 32 * rq) = (u32x4){kdw0[0], kdw0[1], kdw0[2], kdw0[3]}; *(LAS u32x4*)(Bf + HG_KDT + ch0 * 144 + 32 * rq + 16) = (u32x4){kdw0[4], kdw0[5], kdw0[6], kdw0[7]}; \
        *(LAS u32x4*)(Bf + HG_KDT + (ch0 + 1) * 144 + 32 * rq) = (u32x4){kdw1[0], kdw1[1], kdw1[2], kdw1[3]}; *(LAS u32x4*)(Bf + HG_KDT + (ch0 + 1) * 144 + 32 * rq + 16) = (u32x4){kdw1[4], kdw1[5], kdw1[6], kdw1[7]}; \
        { u32x4 lo0, lo1, hi0, hi1; \
          lo0.x = (V[0] & 0xffffu) | (V[1] << 16); lo0.y = (V[2] & 0xffffu) | (V[3] << 16); lo0.z = (V[4] & 0xffffu) | (V[5] << 16); lo0.w = (V[6] & 0xffffu) | (V[7] << 16); \
          lo1.x = (V[8] & 0xffffu) | (V[9] << 16); lo1.y = (V[10] & 0xffffu) | (V[11] << 16); lo1.z = (V[12] & 0xffffu) | (V[13] << 16); lo1.w = (V[14] & 0xffffu) | (V[15] << 16); \
          hi0.x = (V[0] >> 16) | (V[1] & 0xffff0000u); hi0.y = (V[2] >> 16) | (V[3] & 0xffff0000u); hi0.z = (V[4] >> 16) | (V[5] & 0xffff0000u); hi0.w = (V[6] >> 16) | (V[7] & 0xffff0000u); \
          hi1.x = (V[8] >> 16) | (V[9] & 0xffff0000u); hi1.y = (V[10] >> 16) | (V[11] & 0xffff0000u); hi1.z = (V[12] >> 16) | (V[13] & 0xffff0000u); hi1.w = (V[14] >> 16) | (V[15] & 0xffff0000u); \
          *(LAS u32x4*)(Bf + HG_VT + ch0 * 144 + 32 * rq) = lo0; *(LAS u32x4*)(Bf + HG_VT + ch0 * 144 + 32 * rq + 16) = lo1; \
          *(LAS u32x4*)(Bf + HG_VT + (ch0 + 1) * 144 + 32 * rq) = hi0; *(LAS u32x4*)(Bf + HG_VT + (ch0 + 1) * 144 + 32 * rq + 16) = hi1; } \
        if (rq == 0) *(LAS f32x2_t*)(Bf + HG_DEC + ch0 * 4) = (f32x2_t){fl0, fl1}; } while (0)
#define HG_CONSUME(m, boff) hgrn_consume<HAS_Q>(lds + (boff), S, dir ? (Lseq - 64 * ((m) + 1)) : 64 * (m), dir, h, cw, fr, kg, o_out, dbg)

    __syncthreads();
    if (producer) {
        unsigned zA[16], qA[16], vA[16], zB[16], qB[16], vB[16];
        HG_LOAD(0, zA, qA, vA);
        if (1 < nch) HG_LOAD(1, zB, qB, vB);
        for (int n = 0; n <= nch; n += 2) {
            if (n < nch && !(dbg & 4)) HG_PRODUCE(zA, qA, vA, 0);
            if (n + 2 < nch) HG_LOAD(n + 2, zA, qA, vA);
            HG_BAR();
            if (n + 1 < nch && !(dbg & 4)) HG_PRODUCE(zB, qB, vB, HG_BUF);
            if (n + 3 < nch) HG_LOAD(n + 3, zB, qB, vB);
            HG_BAR();
        }
    } else {
        const int cw = wave & 3, fr = lane & 15, kg = lane >> 4;
        f32x4 S[2][8];
#pragma unroll
        for (int sl = 0; sl < 2; ++sl)
#pragma unroll
            for (int blk = 0; blk < 8; ++blk)
#pragma unroll
                for (int r = 0; r < 4; ++r) S[sl][blk][r] = s_in ? s_in[(size_t)(16 * blk + 4 * kg + r) * 128 + 32 * cw + 16 * sl + fr] : 0.f;
        for (int n = 0; n <= nch; n += 2) {
            if (n >= 1 && !(dbg & 8)) HG_CONSUME(n - 1, HG_BUF);
            HG_BAR();
            if (n < nch && !(dbg & 8)) HG_CONSUME(n, 0);
            HG_BAR();
        }
        if (dbg) {
#pragma unroll
            for (int sl = 0; sl < 2; ++sl)
#pragma unroll
                for (int blk = 0; blk < 8; ++blk) asm volatile("" :: "v"(S[sl][blk][0]), "v"(S[sl][blk][1]), "v"(S[sl][blk][2]), "v"(S[sl][blk][3]));
        }
        if (s_out) {
#pragma unroll
            for (int sl = 0; sl < 2; ++sl)
#pragma unroll
                for (int blk = 0; blk < 8; ++blk)
#pragma unroll
                    for (int r = 0; r < 4; ++r) s_out[(size_t)(16 * blk + 4 * kg + r) * 128 + 32 * cw + 16 * sl + fr] = S[sl][blk][r];
        }
    }
#undef HG_LOAD
#undef HG_PRODUCE
#undef HG_CONSUME
#undef HG_BAR
    __syncthreads();
}

__global__ void __launch_bounds__(512, 2) mega(Params P) {
    extern __shared__ __attribute__((aligned(16))) unsigned char lds_raw[];
    cg::grid_group grid = cg::this_grid();
    LAS unsigned char* lds = (LAS unsigned char*)lds_raw;
    const int tid = threadIdx.x, lane = tid & 63, wave = __builtin_amdgcn_readfirstlane(tid >> 6);
    const int G = gridDim.x, bx = blockIdx.x;
    const int vcu = (G % 8 == 0) ? (bx % 8) * (G / 8) + bx / 8 : bx;
    const int gw = vcu * 8 + wave, NGW = G * 8;
    unsigned char* ws = P.ws;
    const float* x = P.in[0]; const float* cvec = P.in[1]; const float* ctx = P.in[2]; const float* c_ctx = P.in[3];
    const float* w_ada = P.in[4]; const float* b_ada = P.in[5]; const float* norm_w = P.in[6]; const float* w_in = P.in[7];
    const float* lb_param = P.in[8]; const float* g_norm = P.in[9]; const float* hy_sw = P.in[10]; const float* hy_sb = P.in[11];
    const float* f_w1 = P.in[12]; const float* f_b1 = P.in[13]; const float* f_w2 = P.in[14]; const float* f_b2 = P.in[15];
    const float* f_w3 = P.in[16]; const float* f_freq = P.in[17]; const float* hy_d = P.in[18]; const float* w_pa = P.in[19];
    const float* w_pb = P.in[20]; const float* w_out = P.in[21]; const float* w_mlp1 = P.in[22]; const float* w_mlp2 = P.in[23];
    float* MOD = (float*)(ws + WS_MOD); float* LB = (float*)(ws + WS_LB); bf16_t* GTB = (bf16_t*)(ws + WS_GT);
    bf16_t* WIN = (bf16_t*)(ws + WS_WIN); bf16_t* WPAB = (bf16_t*)(ws + WS_WPAB); bf16_t* WOUT = (bf16_t*)(ws + WS_WOUT); bf16_t* W1 = (bf16_t*)(ws + WS_W1); bf16_t* W2 = (bf16_t*)(ws + WS_W2);
    bf16_t* HCTX = (bf16_t*)(ws + WS_HCTX); bf16_t* PCTX = (bf16_t*)(ws + WS_PCTX); float* SCTX = (float*)(ws + WS_SCTX);
    bf16_t* HLAT = (bf16_t*)(ws + WS_HLAT); bf16_t* PI = (bf16_t*)(ws + WS_PI); bf16_t* PZ = (bf16_t*)(ws + WS_PZ); bf16_t* PQ = (bf16_t*)(ws + WS_PQ);
    bf16_t* PG = (bf16_t*)(ws + WS_PG); bf16_t* GATES = (bf16_t*)(ws + WS_GATES); bf16_t* PHYT = (bf16_t*)(ws + WS_PHYT);
    bf16_t* AY = (bf16_t*)(ws + WS_AY2); bf16_t* MERGED = (bf16_t*)(ws + WS_MERGED); bf16_t* MIX = (bf16_t*)(ws + WS_MIX);
    bf16_t* MLP = (bf16_t*)(ws + WS_MLP); bf16_t* H1 = (bf16_t*)(ws + WS_H1); bf16_t* HL = (bf16_t*)(ws + WS_HL);
    float* O2 = P.out;

    volatile LAS unsigned* MISC = (volatile LAS unsigned*)(lds + LDS_BYTES - 128);
    if (tid < 16) MISC[tid] = 0u;
    __syncthreads();
    const XcdBarrier xbar = xcd_barrier_post((unsigned*)ws, MISC);
#define SEAM_RAW(k) do { if ((k) == 0) grid.sync(); else xcd_barrier(xbar); } while (0)
#if PROBE_MASK
    unsigned long long t_prev = __builtin_amdgcn_s_memrealtime(), t_spin = 0ull;
#ifndef PROBE_BUSY_PHASE
#define PROBE_BUSY_PHASE -1
#define PROBE_BUSY_BLOCK 0
#endif
#define SEAM(k) do { if ((k) == PROBE_BUSY_PHASE && bx == PROBE_BUSY_BLOCK && tid == 0) *(volatile unsigned long long*)(ws + 32768) = __builtin_amdgcn_s_memrealtime() - t_prev; \
    SEAM_RAW(k); { const unsigned long long _t = __builtin_amdgcn_s_memrealtime(); if ((PROBE_MASK >> (k)) & 1) t_spin += _t - t_prev; \
    if ((k) == PROBE_BUSY_PHASE) t_spin += *(volatile unsigned long long*)(ws + 32768); t_prev = _t; } } while (0)
#else
#define SEAM(k) SEAM_RAW(k)
#endif
    {
        if (bx < 192) {
            const int cgp = bx % 96, kh = bx / 96;
            LAS float* sc = (LAS float*)lds;
            LAS float* ps = (LAS float*)(lds + 20480);
            for (int i = tid; i < 9 * 512; i += 512) { const int r = i >> 9, k = kh * 512 + (i & 511); sc[i] = siluf_(r < 8 ? cvec[r * D + k] : c_ctx[k]); }
            __syncthreads();
            const int j = cgp * 64 + lane; float a9[9];
#pragma unroll
            for (int r = 0; r < 9; ++r) a9[r] = 0.f;
            const float* wp = w_ada + (size_t)(kh * 512 + wave * 64) * INC + j;
#pragma unroll 1
            for (int kk = 0; kk < 64; kk += 16) { float w[16];
#pragma unroll
                for (int u = 0; u < 16; ++u) w[u] = wp[(size_t)(kk + u) * INC];
#pragma unroll
                for (int u = 0; u < 16; ++u)
#pragma unroll
                    for (int r = 0; r < 9; ++r) a9[r] += sc[r * 512 + wave * 64 + kk + u] * w[u]; }
#pragma unroll
            for (int r = 0; r < 9; ++r) ps[(wave * 9 + r) * 64 + lane] = a9[r];
            __syncthreads();
            for (int i = tid; i < 9 * 64; i += 512) { const int r = i >> 6, l = i & 63; float s = kh == 0 ? b_ada[cgp * 64 + l] : 0.f;
#pragma unroll
                for (int w = 0; w < 8; ++w) s += ps[(w * 9 + r) * 64 + l];
                atomicAdd(&MOD[r * INC + cgp * 64 + l], s); }
            __syncthreads();
        }
        if (bx == G - 1) { const float a = lb_param[tid], b = lb_param[HW + tid], m = fmaxf(a, b); const float ea = expf(a - m), eb = expf(b - m); LB[tid] = ea / (ea + eb); }
        {   LAS float* scr = (LAS float*)(lds + wave * 16384);
            for (int it = gw; it < 16 * 192; it += NGW) transpose_item(w_in, INC, WIN, D, 0, 1, scr, it, lane); }
        for (int tb = bx; tb < 256; tb += G) {
            __syncthreads();
            LAS float* zf = (LAS float*)lds; LAS float* h1 = zf + 17 * 36; LAS float* h2 = h1 + 17 * 64;
            for (int i = tid; i < 17 * 33; i += 512) { const int p = i / 33, k = i - 33 * p, t = 16 * tb + p; float val;
                if (k == 0) val = (float)t / (float)(L - 1);
                else { const int bi = (k - 1) & 15; const float band = 1e-4f + (float)bi * ((15.f - 1e-4f) / 15.f);
                    const float w = 2.0f * 3.14159265358979323846f * (float)t / (float)L; const float ang = w * band;
                    val = (k <= 16) ? cosf(ang) : -sinf(ang); }
                zf[p * 36 + k] = val; }
            __syncthreads();
            for (int i = tid; i < 17 * 64; i += 512) { const int p = i >> 6, k = i & 63; float acc = f_b1[k];
#pragma unroll 11
                for (int q = 0; q < 33; ++q) acc += zf[p * 36 + q] * f_w1[q * 64 + k];
                h1[i] = sinf(f_freq[k] * acc); }
            __syncthreads();
            for (int i = tid; i < 17 * 64; i += 512) { const int p = i >> 6, k = i & 63; float acc = f_b2[k];
#pragma unroll 16
                for (int q = 0; q < 64; ++q) acc += h1[p * 64 + q] * f_w2[q * 64 + k];
                h2[i] = sinf(f_freq[k] * acc); }
            __syncthreads();
            const int c = tid; float af[16], ab[16];
#pragma unroll
            for (int p = 0; p < 16; ++p) { af[p] = 0.f; ab[p] = 0.f; }
#pragma unroll 4
            for (int k = 0; k < 64; ++k) { const float wf = f_w3[k * 1024 + c], wb = f_w3[k * 1024 + 512 + c]; float hv[17];
#pragma unroll
                for (int p = 0; p < 17; ++p) hv[p] = h2[p * 64 + k];
#pragma unroll
                for (int p = 0; p < 16; ++p) { af[p] += hv[p] * wf; ab[p] += hv[p + 1] * wb; } }
            const float mind = logf(1e-2f) / 1.5f, maxd = logf(1e-2f) / 0.3f;
            const float delta = fabsf(mind + (maxd - mind) * ((float)c / 511.f));
            unsigned short of[16], ob[16];
#pragma unroll
            for (int p = 0; p < 16; ++p) { const int tf = 16 * tb + p, tbk = tf + 1;
                float vf = af[p] * expf(-((float)tf / (float)(L - 1)) * delta); if (tf == 0) vf += hy_d[c];
                float vb = ab[p] * expf(-((float)tbk / (float)(L - 1)) * delta); if (tbk >= L) vb = 0.f;
                of[15 - p] = (unsigned short)f2bf(vf); ob[p] = (unsigned short)f2bf(vb); }
            bf16_t* gf = GTB + (size_t)c * 8192 + (4080 - 16 * tb); bf16_t* gb = GTB + (size_t)c * 8192 + (4096 + 16 * tb);
            u32x4 w0, w1;
            w0.x = of[0] | ((unsigned)of[1] << 16); w0.y = of[2] | ((unsigned)of[3] << 16); w0.z = of[4] | ((unsigned)of[5] << 16); w0.w = of[6] | ((unsigned)of[7] << 16);
            w1.x = of[8] | ((unsigned)of[9] << 16); w1.y = of[10] | ((unsigned)of[11] << 16); w1.z = of[12] | ((unsigned)of[13] << 16); w1.w = of[14] | ((unsigned)of[15] << 16);
            *(u32x4*)gf = w0; *(u32x4*)(gf + 8) = w1;
            w0.x = ob[0] | ((unsigned)ob[1] << 16); w0.y = ob[2] | ((unsigned)ob[3] << 16); w0.z = ob[4] | ((unsigned)ob[5] << 16); w0.w = ob[6] | ((unsigned)ob[7] << 16);
            w1.x = ob[8] | ((unsigned)ob[9] << 16); w1.y = ob[10] | ((unsigned)ob[11] << 16); w1.z = ob[12] | ((unsigned)ob[13] << 16); w1.w = ob[14] | ((unsigned)ob[15] << 16);
            *(u32x4*)gb = w0; *(u32x4*)(gb + 8) = w1;
        }
    }
    SEAM(0);
    for (int m0 = gw; m0 < NT + NCX; m0 += 4 * NGW) {
        f32x4 v[4][4];
#pragma unroll
        for (int r = 0; r < 4; ++r) { const int m = m0 + r * NGW; if (m < NT + NCX) { const f32x4* xr = (const f32x4*)(m < NT ? x + (size_t)m * D : ctx + (size_t)(m - NT) * D) + lane;
#pragma unroll
                for (int j = 0; j < 4; ++j) v[r][j] = xr[64 * j]; } }
#pragma unroll
        for (int r = 0; r < 4; ++r) { const int m = m0 + r * NGW; if (m < NT + NCX) {
                const float* mb = MOD + (size_t)(m < NT ? (m >> 12) : 8) * INC; bf16_t* orow = m < NT ? HLAT + (size_t)m * D : HCTX + (size_t)(m - NT) * D;
                float s = 0.f;
#pragma unroll
                for (int j = 0; j < 4; ++j) s += (v[r][j].x * v[r][j].x + v[r][j].y * v[r][j].y) + (v[r][j].z * v[r][j].z + v[r][j].w * v[r][j].w);
                const float rs = rsqrtf(wave_sum(s) * (1.f / D) + EPS);
                unsigned long long* o8 = (unsigned long long*)orow + lane;
#pragma unroll
                for (int j = 0; j < 4; ++j) { const f32x4 w = ((const f32x4*)norm_w)[lane + 64 * j], sc = ((const f32x4*)mb)[lane + 64 * j], sh = ((const f32x4*)(mb + D))[lane + 64 * j];
                    const f32x4 o = v[r][j] * rs * w * (1.f + sc) + sh;
                    o8[64 * j] = (unsigned long long)cvtpk(o.x, o.y) | ((unsigned long long)cvtpk(o.z, o.w) << 32); } } }
    }
    SEAM(1);
    {
        { pg8::Gemm g{HLAT, WIN, D, D, D}; pg8::StaticOrder S; S.init(NT, 4608, G, bx); pg8::EpiG1 E{PI, PZ, PQ, PG, GATES};
          pg8::gemm_phase(lds, g, S, E); }
        { pg8::Gemm g{WIN + (size_t)4608 * D, HLAT, D, D, D}; pg8::StaticOrder S; S.init(1536, NT, G, bx); pg8::EpiBf16<0> E{PHYT, NT};
          pg8::gemm_phase(lds, g, S, E); }
        { pg8::Gemm g{HCTX, WIN, D, D, D}; pg8::StaticOrder S; S.init(NCX, 1536, G, bx); pg8::EpiBf16<0> E{PCTX, 1536};
          pg8::gemm_phase(lds, g, S, E); }
    }
    SEAM(2);
    if (bx < 64) { const int b = bx >> 3, h = (bx >> 1) & 3, dir = bx & 1;
        hgrn_chain_mfma<false>(lds, PCTX + (size_t)b * LC * 1536, 1536, PCTX + (size_t)b * LC * 1536 + (dir ? 1024 : 512), 1536, nullptr, 0, LC, h, dir, LB,
                   nullptr, SCTX + (size_t)((b * 2 + dir) * 4 + h) * 16384, nullptr); }
    else {
        LAS float* scr = (LAS float*)(lds + wave * 16384);
        constexpr int I_PA = 8 * 32, I_OUT = 16 * 32, I_1 = 16 * 128, I_2 = 64 * 32;
        for (int it = (bx - 64) * 8 + wave; it < 2 * I_PA + I_OUT + I_1 + I_2; it += (G - 64) * 8) {
            int r = it;
            if (r < I_PA) { transpose_item(w_pa, D, WPAB, D, 0, 0, scr, r, lane); continue; } r -= I_PA;
            if (r < I_PA) { transpose_item(w_pb, D, WPAB, D, 512, 0, scr, r, lane); continue; } r -= I_PA;
            if (r < I_OUT) { transpose_item(w_out, D, WOUT, D, 0, 0, scr, r, lane); continue; } r -= I_OUT;
            if (r < I_1) { transpose_item(w_mlp1, FF, W1, D, 0, 0, scr, r, lane); continue; } r -= I_1;
            transpose_item(w_mlp2, D, W2, FF, 0, 0, scr, r, lane);
        }
    }
    SEAM(3);
    if (bx < 64) { const int b = bx >> 3, h = (bx >> 1) & 3, dir = bx & 1;
        hgrn_chain_mfma<true>(lds, PI + (size_t)b * L * 512, 512, PZ + (size_t)b * L * 1024 + (dir ? 512 : 0), 1024, PQ + (size_t)b * L * 512, 512, L, h, dir, LB,
                   SCTX + (size_t)((b * 2 + dir) * 4 + h) * 16384, nullptr, O2 + ((size_t)dir * NT + (size_t)b * L) * HW);
#ifdef PROBE_SCAN2
        hgrn_chain_mfma<true>(lds, PI + (size_t)b * L * 512, 512, PZ + (size_t)b * L * 1024 + (dir ? 512 : 0), 1024, PQ + (size_t)b * L * 512, 512, L, h, dir, LB,
                   SCTX + (size_t)((b * 2 + dir) * 4 + h) * 16384, nullptr, O2 + ((size_t)dir * NT + (size_t)b * L) * HW, PROBE_SCAN2);
#endif
    }
    else {
        for (int c = bx - 64; c < HW; c += G - 64) hyena_channel(lds, c, PHYT, GTB, hy_sw, hy_sb);
    }
    SEAM(4);
    {
        const f32x4 gn0 = ((const f32x4*)g_norm)[(2 * lane) & 31], gn1 = ((const f32x4*)g_norm)[(2 * lane + 1) & 31];
        for (int t0 = gw; t0 < NT; t0 += 2 * NGW) {
            f32x4 of[2][2], ob[2][2]; u32x4 pg[2];
#pragma unroll
            for (int r = 0; r < 2; ++r) { const int t = t0 + r * NGW; if (t < NT) {
                    of[r][0] = ((const f32x4*)(O2 + (size_t)t * HW))[2 * lane]; of[r][1] = ((const f32x4*)(O2 + (size_t)t * HW))[2 * lane + 1];
                    ob[r][0] = ((const f32x4*)(O2 + ((size_t)NT + t) * HW))[2 * lane]; ob[r][1] = ((const f32x4*)(O2 + ((size_t)NT + t) * HW))[2 * lane + 1];
                    pg[r] = ((const u32x4*)(PG + (size_t)t * 512))[lane]; } }
#pragma unroll
            for (int r = 0; r < 2; ++r) { const int t = t0 + r * NGW; if (t < NT) {
                    const f32x4 a0 = of[r][0] + ob[r][0], a1 = of[r][1] + ob[r][1];
                    float s = (a0.x * a0.x + a0.y * a0.y) + (a0.z * a0.z + a0.w * a0.w) + (a1.x * a1.x + a1.y * a1.y) + (a1.z * a1.z + a1.w * a1.w);
                    s += __shfl_xor(s, 1); s += __shfl_xor(s, 2); s += __shfl_xor(s, 4); s += __shfl_xor(s, 8);
                    const float rs = rsqrtf(s * (1.f / 128.f) + EPS);
                    u32x4 o;
                    o.x = cvtpk(a0.x * rs * gn0.x * pg8::bflo(pg[r].x), a0.y * rs * gn0.y * pg8::bfhi(pg[r].x)); o.y = cvtpk(a0.z * rs * gn0.z * pg8::bflo(pg[r].y), a0.w * rs * gn0.w * pg8::bfhi(pg[r].y));
                    o.z = cvtpk(a1.x * rs * gn1.x * pg8::bflo(pg[r].z), a1.y * rs * gn1.y * pg8::bfhi(pg[r].z)); o.w = cvtpk(a1.z * rs * gn1.z * pg8::bflo(pg[r].w), a1.w * rs * gn1.w * pg8::bfhi(pg[r].w));
                    *(u32x4*)(AY + (size_t)t * 1024 + 8 * lane) = o; } }
        }
    }
    {
        LAS bf16_t* tl = (LAS bf16_t*)(lds + wave * 16384);
        for (int it = gw; it < 8 * 512; it += NGW) { const int c0 = (it & 7) * 64, tok0 = (it >> 3) * 64;
#pragma unroll
            for (int i = 0; i < 8; ++i) { const int ch = lane + 64 * i, rr = ch >> 3, cc = (ch & 7) * 8;
                const u32x4 v = *(const u32x4*)(PHYT + (size_t)(1024 + c0 + rr) * NT + tok0 + cc);
                LAS unsigned* d = (LAS unsigned*)(tl + rr * 66 + cc); d[0] = v.x; d[1] = v.y; d[2] = v.z; d[3] = v.w; }
            LDS_WAIT();
#pragma unroll
            for (int i = 0; i < 8; ++i) { const int ch = lane + 64 * i, tt = ch >> 3, cc = (ch & 7) * 8; unsigned o[4];
#pragma unroll
                for (int q = 0; q < 4; ++q) o[q] = (unsigned)tl[(cc + 2 * q) * 66 + tt] | ((unsigned)tl[(cc + 2 * q + 1) * 66 + tt] << 16);
                *(u32x4*)(AY + (size_t)(tok0 + tt) * 1024 + 512 + c0 + cc) = (u32x4){o[0], o[1], o[2], o[3]}; }
            LDS_WAIT();
        }
    }
    SEAM(5);
    {
        { pg8::Gemm g{AY, WPAB, D, D, 512}; pg8::StaticOrder S; S.init(NT, D, G, bx); pg8::EpiMerge<0> E{MERGED, GATES, 0}; pg8::gemm_phase(lds, g, S, E); }
        { pg8::Gemm g{AY + 512, WPAB + 512, D, D, 512}; pg8::StaticOrder S; S.init(NT, D, G, bx); pg8::EpiMerge<1> E{MERGED, GATES, 1024}; pg8::gemm_phase(lds, g, S, E); }
    }
    SEAM(6);
    { pg8::Gemm g{MERGED, WOUT, D, D, D}; pg8::StaticOrder S; S.init(NT, D, G, bx); pg8::EpiBf16<0> E{MIX, D}; pg8::gemm_phase(lds, g, S, E); }
    SEAM(7);
    for (int m0 = gw; m0 < NT; m0 += 2 * NGW) {
        f32x4 xv[2][4]; u32x2 mx[2][4];
#pragma unroll
        for (int r = 0; r < 2; ++r) { const int m = m0 + r * NGW; if (m < NT) {
#pragma unroll
                for (int j = 0; j < 4; ++j) { xv[r][j] = ((const f32x4*)(x + (size_t)m * D))[lane + 64 * j]; mx[r][j] = *(const u32x2*)(MIX + (size_t)m * D + 4 * lane + 256 * j); } } }
#pragma unroll
        for (int r = 0; r < 2; ++r) { const int m = m0 + r * NGW; if (m < NT) { const float* mb = MOD + (size_t)(m >> 12) * INC;
                f32x4 mv[4], x1[4]; float s = 0.f;
#pragma unroll
                for (int j = 0; j < 4; ++j) { mv[j] = (f32x4){pg8::bflo(mx[r][j].x), pg8::bfhi(mx[r][j].x), pg8::bflo(mx[r][j].y), pg8::bfhi(mx[r][j].y)}; s += (mv[j].x * mv[j].x + mv[j].y * mv[j].y) + (mv[j].z * mv[j].z + mv[j].w * mv[j].w); }
                const float r1 = rsqrtf(wave_sum(s) * (1.f / D) + EPS); float s2 = 0.f;
#pragma unroll
                for (int j = 0; j < 4; ++j) { const f32x4 w = ((const f32x4*)(norm_w + D))[lane + 64 * j], g = ((const f32x4*)(mb + 2 * D))[lane + 64 * j];
                    x1[j] = xv[r][j] + g * (mv[j] * r1 * w); s2 += (x1[j].x * x1[j].x + x1[j].y * x1[j].y) + (x1[j].z * x1[j].z + x1[j].w * x1[j].w); }
                const float r2 = rsqrtf(wave_sum(s2) * (1.f / D) + EPS);
                unsigned long long* o8 = (unsigned long long*)(HL + (size_t)m * D) + lane;
#pragma unroll
                for (int j = 0; j < 4; ++j) { const f32x4 w = ((const f32x4*)(norm_w + 2 * D))[lane + 64 * j], sc = ((const f32x4*)(mb + 3 * D))[lane + 64 * j], sh = ((const f32x4*)(mb + 4 * D))[lane + 64 * j];
                    const f32x4 o = x1[j] * r2 * w * (1.f + sc) + sh;
                    o8[64 * j] = (unsigned long long)cvtpk(o.x, o.y) | ((unsigned long long)cvtpk(o.z, o.w) << 32); } } }
    }
    SEAM(8);
    { pg8::Gemm g{HL, W1, D, D, D}; pg8::StaticOrder S; S.init(NT, FF, G, bx); pg8::EpiBf16<3> E{H1, FF}; pg8::gemm_phase(lds, g, S, E); }
    SEAM(9);
    { pg8::Gemm g{H1, W2, FF, FF, FF}; pg8::StaticOrder S; S.init(NT, D, G, bx); pg8::EpiBf16<0> E{MLP, D}; pg8::gemm_phase(lds, g, S, E); }
    SEAM(10);
    for (int m0 = gw; m0 < NT; m0 += 2 * NGW) {
        f32x4 xv[2][4]; u32x2 mx[2][4], ml[2][4];
#pragma unroll
        for (int r = 0; r < 2; ++r) { const int m = m0 + r * NGW; if (m < NT) {
#pragma unroll
                for (int j = 0; j < 4; ++j) { xv[r][j] = ((const f32x4*)(x + (size_t)m * D))[lane + 64 * j]; mx[r][j] = *(const u32x2*)(MIX + (size_t)m * D + 4 * lane + 256 * j);
                    ml[r][j] = *(const u32x2*)(MLP + (size_t)m * D + 4 * lane + 256 * j); } } }
#pragma unroll
        for (int r = 0; r < 2; ++r) { const int m = m0 + r * NGW; if (m < NT) { const float* mb = MOD + (size_t)(m >> 12) * INC;
                f32x4 mv[4], lv[4]; float s = 0.f, s3 = 0.f;
#pragma unroll
                for (int j = 0; j < 4; ++j) { mv[j] = (f32x4){pg8::bflo(mx[r][j].x), pg8::bfhi(mx[r][j].x), pg8::bflo(mx[r][j].y), pg8::bfhi(mx[r][j].y)}; s += (mv[j].x * mv[j].x + mv[j].y * mv[j].y) + (mv[j].z * mv[j].z + mv[j].w * mv[j].w);
                    lv[j] = (f32x4){pg8::bflo(ml[r][j].x), pg8::bfhi(ml[r][j].x), pg8::bflo(ml[r][j].y), pg8::bfhi(ml[r][j].y)}; s3 += (lv[j].x * lv[j].x + lv[j].y * lv[j].y) + (lv[j].z * lv[j].z + lv[j].w * lv[j].w); }
                const float r1 = rsqrtf(wave_sum(s) * (1.f / D) + EPS), r3 = rsqrtf(wave_sum(s3) * (1.f / D) + EPS);
#pragma unroll
                for (int j = 0; j < 4; ++j) { const f32x4 w1 = ((const f32x4*)(norm_w + D))[lane + 64 * j], g2 = ((const f32x4*)(mb + 2 * D))[lane + 64 * j];
                    const f32x4 w3 = ((const f32x4*)(norm_w + 3 * D))[lane + 64 * j], g5 = ((const f32x4*)(mb + 5 * D))[lane + 64 * j];
                    const f32x4 x1 = xv[r][j] + g2 * (mv[j] * r1 * w1);
                    ((f32x4*)(P.out + (size_t)m * D))[lane + 64 * j] = x1 + g5 * (lv[j] * r3 * w3); } } }
    }
#if PROBE_MASK
    { const unsigned long long _t = __builtin_amdgcn_s_memrealtime(); if ((PROBE_MASK >> 11) & 1) t_spin += _t - t_prev;
      if (bx == 0) { const unsigned long long t0 = __builtin_amdgcn_s_memrealtime(); while (__builtin_amdgcn_s_memrealtime() - t0 < t_spin) __builtin_amdgcn_s_sleep(8); } }
#endif
#if PROBE_XSYNC
    for (int i = 0; i < PROBE_XSYNC; ++i) grid.sync();
#endif
}
}

extern "C" void kernel_launch(void* const* d_in, const int* in_sizes, int n_in, void* d_out, int out_size, void* d_ws, size_t ws_size, hipStream_t stream) {
    static int grid = 0;
    if (grid == 0) {
        if (n_in != 24 || ws_size < WS_END) { fprintf(stderr, "kernel_launch: unexpected n_in %d / ws_size %zu\n", n_in, ws_size); grid = -1; return; }
        int dev = 0, cus = 0, per_cu = 0;
        hipGetDevice(&dev); hipDeviceGetAttribute(&cus, hipDeviceAttributeMultiprocessorCount, dev);
        hipFuncSetAttribute((const void*)mega, hipFuncAttributeMaxDynamicSharedMemorySize, LDS_BYTES);
        hipOccupancyMaxActiveBlocksPerMultiprocessor(&per_cu, (const void*)mega, 512, LDS_BYTES);
        if (per_cu < 1) { fprintf(stderr, "kernel_launch: occupancy query says %d blocks per CU\n", per_cu); grid = -1; return; }
        grid = cus;
    }
    if (grid < 0) return;
    if (hipMemsetAsync(d_ws, 0, 327680, stream) != hipSuccess) { fprintf(stderr, "kernel_launch: memset failed\n"); return; }
    Params p{};
    for (int i = 0; i < 24; ++i) p.in[i] = (const float*)d_in[i];
    p.out = (float*)d_out; p.ws = (unsigned char*)d_ws;
    void* args[] = {&p};
    hipError_t e = hipLaunchCooperativeKernel((const void*)mega, dim3(grid), dim3(512), args, LDS_BYTES, stream);
    if (e != hipSuccess) fprintf(stderr, "cooperative launch failed: %s (grid %d)\n", hipGetErrorString(e), grid);
}
```

```cpp
#include <hip/hip_runtime.h>
#include <hip/hip_cooperative_groups.h>
#include <cstdio>
#include <math.h>
namespace cg = cooperative_groups;
#ifndef PROBE_MASK
#define PROBE_MASK 0
#endif
#ifndef PROBE_XSYNC
#define PROBE_XSYNC 0
#endif

namespace pg8 {
#define PG8_LAS __attribute__((address_space(3)))
typedef unsigned short bf16_t;
typedef short bf16x8 __attribute__((ext_vector_type(8)));
typedef float f32x4 __attribute__((ext_vector_type(4)));
typedef unsigned u32x4 __attribute__((ext_vector_type(4)));
typedef unsigned u32x2 __attribute__((ext_vector_type(2)));
constexpr int BM = 256, BK = 64, HALF = 128, HTB = HALF * BK * 2, STAGE_BYTES = 8 * HTB, NXCD = 8, WGM = 8;

__device__ __forceinline__ int lds_byte(int r, int c) { const int st = (r >> 4) * 2 + (c >> 5), rr = r & 15, cc = c & 31, ob = rr * 64 + cc * 2; return st * 1024 + (ob ^ (((ob >> 9) & 1) << 5)); }
__device__ __forceinline__ void stage_rc(int b, int& R, int& C) { const int st = b / 1024, sb = b % 1024, swz = sb ^ (((sb >> 9) & 1) << 5); R = (st >> 1) * 16 + swz / 64; C = (st & 1) * 32 + (swz % 64) / 2; }
__device__ __forceinline__ int perm32(int rho) { const int n = rho >> 4, i = rho & 15; return 8 * (i >> 2) + 4 * n + (i & 3); }

struct Unit { int pm, pn; };
struct Gemm { const bf16_t* A; const bf16_t* Bt; int lda, ldb, K; };

struct StaticOrder {
    int nM, nN, nwg, G, c;
    __device__ void init(int M, int N, int G_, int c_) { nM = M / BM; nN = N / BM; nwg = nM * nN; G = G_; c = c_; }
    __device__ bool next(int i, Unit& u) const {
        const long L = (long)i * G + c; if (L >= nwg) return false;
        int wgid = (int)L; { const int q = nwg / NXCD, r = nwg % NXCD, xcd = wgid % NXCD, off = wgid / NXCD; wgid = (xcd < r ? xcd * (q + 1) : r * (q + 1) + (xcd - r) * q) + off; }
        const int nig = WGM * nN, gid = wgid / nig, fm = gid * WGM, gsz = (nM - fm) < WGM ? (nM - fm) : WGM;
        u.pm = fm + ((wgid % nig) % gsz); u.pn = (wgid % nig) / gsz; return true;
    }
};

__device__ __forceinline__ unsigned cvt_pk_bf16(float lo, float hi) { unsigned r; asm volatile("v_cvt_pk_bf16_f32 %0, %1, %2" : "=v"(r) : "v"(lo), "v"(hi)); return r; }
__device__ __forceinline__ float sigm(float x) { return __builtin_amdgcn_rcpf(1.0f + __builtin_amdgcn_exp2f(-1.4426950408889634f * x)); }
__device__ __forceinline__ float bflo(unsigned u) { return __uint_as_float(u << 16); }
__device__ __forceinline__ float bfhi(unsigned u) { return __uint_as_float(u & 0xffff0000u); }

template <int ACT  > struct EpiBf16 {
    static constexpr bool PERM = true;
    bf16_t* O; int ldc;
    __device__ __forceinline__ void operator()(const f32x4 (&acc)[2][2][4][2], const Unit& u, int wr, int wc, int fr, int fq) const {
        const int row0 = u.pm * BM + wr * 64 + fr, col0 = u.pn * BM + wc * 32 + 8 * fq;
#pragma unroll
        for (int ai = 0; ai < 2; ++ai)
#pragma unroll
            for (int m = 0; m < 4; ++m) { bf16_t* rowp = O + (size_t)(row0 + ai * HALF + m * 16) * ldc + col0;
#pragma unroll
                for (int bj = 0; bj < 2; ++bj) { f32x4 v0 = acc[ai][bj][m][0], v1 = acc[ai][bj][m][1];
                    if (ACT == 3) {
#pragma unroll
                        for (int j = 0; j < 4; ++j) { const float a = fmaxf(v0[j], 0.f), b = fmaxf(v1[j], 0.f); v0[j] = a * a; v1[j] = b * b; } }
                    u32x4 w; w.x = cvt_pk_bf16(v0[0], v0[1]); w.y = cvt_pk_bf16(v0[2], v0[3]); w.z = cvt_pk_bf16(v1[0], v1[1]); w.w = cvt_pk_bf16(v1[2], v1[3]);
                    *(u32x4*)(rowp + bj * HALF) = w; } }
    }
};
struct EpiG1 {
    static constexpr bool PERM = true;
    bf16_t *PI, *PZ, *PQ, *PG, *GATES;
    __device__ __forceinline__ void operator()(const f32x4 (&acc)[2][2][4][2], const Unit& u, int wr, int wc, int fr, int fq) const {
        const int pn = u.pn; bf16_t* base; int ld, cb, act;
        if (pn < 2) { base = PI; ld = 512; cb = pn * 256; act = 0; }
        else if (pn < 6) { base = PZ; ld = 1024; cb = (pn - 2) * 256; act = 0; }
        else if (pn < 8) { base = PQ; ld = 512; cb = (pn - 6) * 256; act = 1; }
        else if (pn < 10) { base = PG; ld = 512; cb = (pn - 8) * 256; act = 1; }
        else { base = GATES; ld = 2048; cb = (pn - 10) * 256; act = 2; }
        const int row0 = u.pm * BM + wr * 64 + fr, col0 = cb + wc * 32 + 8 * fq;
#pragma unroll
        for (int ai = 0; ai < 2; ++ai)
#pragma unroll
            for (int m = 0; m < 4; ++m) { bf16_t* rowp = base + (size_t)(row0 + ai * HALF + m * 16) * ld + col0;
#pragma unroll
                for (int bj = 0; bj < 2; ++bj) { f32x4 v0 = acc[ai][bj][m][0], v1 = acc[ai][bj][m][1];
                    if (act != 0) {
#pragma unroll
                        for (int j = 0; j < 4; ++j) { const float s0 = sigm(v0[j]), s1 = sigm(v1[j]); v0[j] = act == 1 ? v0[j] * s0 : s0; v1[j] = act == 1 ? v1[j] * s1 : s1; } }
                    u32x4 w; w.x = cvt_pk_bf16(v0[0], v0[1]); w.y = cvt_pk_bf16(v0[2], v0[3]); w.z = cvt_pk_bf16(v1[0], v1[1]); w.w = cvt_pk_bf16(v1[2], v1[3]);
                    *(u32x4*)(rowp + bj * HALF) = w; } }
    }
};
template <int PASS> struct EpiMerge {
    static constexpr bool PERM = true;
    bf16_t* O; const bf16_t* GATES; int goff;
    __device__ __forceinline__ void operator()(const f32x4 (&acc)[2][2][4][2], const Unit& u, int wr, int wc, int fr, int fq) const {
        const int row0 = u.pm * BM + wr * 64 + fr, col0 = u.pn * BM + wc * 32 + 8 * fq;
#pragma unroll
        for (int ai = 0; ai < 2; ++ai)
#pragma unroll
            for (int m = 0; m < 4; ++m) { const size_t r = (size_t)(row0 + ai * HALF + m * 16);
#pragma unroll
                for (int bj = 0; bj < 2; ++bj) { f32x4 v0 = acc[ai][bj][m][0], v1 = acc[ai][bj][m][1];
                    const u32x4 g = *(const u32x4*)(GATES + r * 2048 + goff + col0 + bj * HALF);
                    v0[0] *= bflo(g.x); v0[1] *= bfhi(g.x); v0[2] *= bflo(g.y); v0[3] *= bfhi(g.y); v1[0] *= bflo(g.z); v1[1] *= bfhi(g.z); v1[2] *= bflo(g.w); v1[3] *= bfhi(g.w);
                    bf16_t* op = O + r * 1024 + col0 + bj * HALF;
                    if (PASS == 1) { const u32x4 o = *(const u32x4*)op;
                        v0[0] += bflo(o.x); v0[1] += bfhi(o.x); v0[2] += bflo(o.y); v0[3] += bfhi(o.y); v1[0] += bflo(o.z); v1[1] += bfhi(o.z); v1[2] += bflo(o.w); v1[3] += bfhi(o.w); }
                    u32x4 w; w.x = cvt_pk_bf16(v0[0], v0[1]); w.y = cvt_pk_bf16(v0[2], v0[3]); w.z = cvt_pk_bf16(v1[0], v1[1]); w.w = cvt_pk_bf16(v1[2], v1[3]);
                    *(u32x4*)op = w; } }
    }
};

#ifndef PG8_SP2
#define PG8_SP2 true
#endif
#ifndef PG8_ALIGN
#define PG8_ALIGN true
#endif
template <class Epi, class Sched, bool ALIGN_EPI = PG8_ALIGN, bool SP2 = PG8_SP2>
__device__ __forceinline__ void gemm_phase(PG8_LAS unsigned char* lds, const Gemm g, const Sched& S, const Epi& E) {
    const int tid = threadIdx.x, wid = __builtin_amdgcn_readfirstlane(tid >> 6), lane = tid & 63, wr = wid >> 2, wc = wid & 3, fr = lane & 15, fq = lane >> 4;
    const int nt = g.K / BK;
    unsigned voffA[2], voffB[2];
#pragma unroll
    for (int i = 0; i < 2; ++i) { int R, C; stage_rc(tid * 16 + i * 8192, R, C); const int Rb = Epi::PERM ? ((R & ~31) + perm32(R & 31)) : R;
        voffA[i] = (unsigned)(R * g.lda + C) * 2u; voffB[i] = (unsigned)(Rb * g.ldb + C) * 2u; }
    const size_t kstep = (size_t)(BK * 2);
    const size_t hstepA = (size_t)HALF * g.lda * 2, hstepB = (size_t)HALF * g.ldb * 2;
    const size_t tstepA = 2 * hstepA, tstepB = 2 * hstepB;
    const unsigned ldsw = (unsigned)wid * 1024u;
    const int aoff = lds_byte(wr * 64 + fr, fq * 8), boff = lds_byte(wc * 32 + fr, fq * 8);
#define PG8_SA(b, h) (((b) * 2 + (h)) * HTB)
#define PG8_SB(b, h) ((4 + (b) * 2 + (h)) * HTB)
#define PG8_STAGE(bufoff, gbase, voff) do { _Pragma("unroll") for (int _i = 0; _i < 2; ++_i) \
        __builtin_amdgcn_global_load_lds((const unsigned*)((const char*)(gbase) + (voff)[_i]), (PG8_LAS unsigned*)(lds + (bufoff) + ldsw + _i * 8192), 16, 0, 0); } while (0)
#define PG8_LDA(dst, b, h) do { _Pragma("unroll") for (int m = 0; m < 4; ++m) _Pragma("unroll") for (int k = 0; k < 2; ++k) dst[m][k] = *(const PG8_LAS bf16x8*)(lds + PG8_SA(b, h) + aoff + m * 2048 + k * 1024); } while (0)
#define PG8_LDB(dst, b, h) do { _Pragma("unroll") for (int n = 0; n < 2; ++n) _Pragma("unroll") for (int k = 0; k < 2; ++k) dst[n][k] = *(const PG8_LAS bf16x8*)(lds + PG8_SB(b, h) + boff + n * 2048 + k * 1024); } while (0)
#define PG8_MMA(ai, bj, At, Bt) do { __builtin_amdgcn_s_setprio(1); _Pragma("unroll") for (int m = 0; m < 4; ++m) _Pragma("unroll") for (int n = 0; n < 2; ++n) _Pragma("unroll") for (int k = 0; k < 2; ++k) \
        acc[ai][bj][m][n] = __builtin_amdgcn_mfma_f32_16x16x32_bf16(Bt[n][k], At[m][k], acc[ai][bj][m][n], 0, 0, 0); __builtin_amdgcn_s_setprio(0); } while (0)
#define PG8_WAIT_V(n) asm volatile("s_waitcnt vmcnt(" #n ")" ::: "memory")
#define PG8_WAIT_L(n) asm volatile("s_waitcnt lgkmcnt(" #n ")" ::: "memory")
#define PG8_BAR __builtin_amdgcn_s_barrier()
#define PG8_SCHED __builtin_amdgcn_sched_barrier(0)
    Unit cur, nxt; int ui = 0;
    if (!S.next(0, cur)) return;
    f32x4 acc[2][2][4][2];
#pragma unroll
    for (int a = 0; a < 2; ++a)
#pragma unroll
        for (int b = 0; b < 2; ++b)
#pragma unroll
            for (int m = 0; m < 4; ++m)
#pragma unroll
                for (int n = 0; n < 2; ++n) acc[a][b][m][n] = (f32x4){0.f, 0.f, 0.f, 0.f};
    bf16x8 At[4][2], B0[2][2], B1[2][2];
    const char* cA = (const char*)g.A + (size_t)cur.pm * tstepA; const char* cB = (const char*)g.Bt + (size_t)cur.pn * tstepB;
    if constexpr (SP2) {
        PG8_STAGE(PG8_SB(0, 0), cB, voffB); PG8_STAGE(PG8_SB(0, 1), cB + hstepB, voffB); PG8_STAGE(PG8_SA(0, 0), cA, voffA); PG8_STAGE(PG8_SA(0, 1), cA + hstepA, voffA);
        if (wr == 1) PG8_BAR;
        PG8_WAIT_V(2); PG8_BAR;
        PG8_STAGE(PG8_SB(1, 0), cB + kstep, voffB); PG8_STAGE(PG8_SA(1, 0), cA + kstep, voffA); PG8_STAGE(PG8_SB(1, 1), cB + hstepB + kstep, voffB);
        PG8_WAIT_V(6); PG8_BAR;
    } else {
        PG8_STAGE(PG8_SB(0, 0), cB, voffB); PG8_STAGE(PG8_SA(0, 0), cA, voffA); PG8_STAGE(PG8_SB(0, 1), cB + hstepB, voffB); PG8_STAGE(PG8_SA(0, 1), cA + hstepA, voffA);
        if (wr == 1) PG8_BAR;
        PG8_WAIT_V(4); PG8_BAR;
        PG8_STAGE(PG8_SB(1, 0), cB + kstep, voffB); PG8_STAGE(PG8_SA(1, 0), cA + kstep, voffA); PG8_STAGE(PG8_SB(1, 1), cB + hstepB + kstep, voffB);
        PG8_WAIT_V(6); PG8_BAR;
    }
    for (;;) {
        const bool has_next = S.next(ui + 1, nxt);
        const char* nA = has_next ? (const char*)g.A + (size_t)nxt.pm * tstepA : cA; const char* nB = has_next ? (const char*)g.Bt + (size_t)nxt.pn * tstepB : cB;
        for (int t = 0; t < nt; t += 2) {
            const bool last = (t == nt - 2);
            const char* a1 = cA + (size_t)(t + 1) * kstep;
            const char* a2 = last ? nA : cA + (size_t)(t + 2) * kstep; const char* b2 = last ? nB : cB + (size_t)(t + 2) * kstep;
            const char* a3 = a2 + kstep; const char* b3 = b2 + kstep;
            if constexpr (SP2) {
            PG8_LDB(B0, 0, 0); PG8_LDB(B1, 0, 1); PG8_SCHED; PG8_LDA(At, 0, 0); PG8_STAGE(PG8_SA(1, 1), a1 + hstepA, voffA);
            PG8_WAIT_V(8); PG8_WAIT_L(0); PG8_BAR; PG8_MMA(0, 0, At, B0); PG8_MMA(0, 1, At, B1); PG8_BAR; PG8_SCHED;
            PG8_LDA(At, 0, 1); PG8_STAGE(PG8_SB(0, 0), b2, voffB); PG8_STAGE(PG8_SB(0, 1), b2 + hstepB, voffB); PG8_STAGE(PG8_SA(0, 0), a2, voffA);
            PG8_WAIT_V(8); PG8_WAIT_L(0); PG8_BAR; PG8_MMA(1, 0, At, B0); PG8_MMA(1, 1, At, B1); PG8_BAR; PG8_SCHED;
            PG8_LDB(B0, 1, 0); PG8_LDB(B1, 1, 1); PG8_SCHED; PG8_LDA(At, 1, 0); PG8_STAGE(PG8_SA(0, 1), a2 + hstepA, voffA);
            PG8_WAIT_V(8); PG8_WAIT_L(0); PG8_BAR; PG8_MMA(0, 0, At, B0); PG8_MMA(0, 1, At, B1); PG8_BAR; PG8_SCHED;
            PG8_LDA(At, 1, 1); PG8_STAGE(PG8_SB(1, 0), b3, voffB); PG8_STAGE(PG8_SB(1, 1), b3 + hstepB, voffB); PG8_STAGE(PG8_SA(1, 0), a3, voffA);
            PG8_WAIT_V(8); PG8_WAIT_L(0); PG8_BAR; PG8_MMA(1, 0, At, B0); PG8_MMA(1, 1, At, B1); PG8_BAR; PG8_SCHED;
            } else {
            PG8_LDB(B0, 0, 0); PG8_SCHED; PG8_LDA(At, 0, 0); PG8_STAGE(PG8_SA(1, 1), a1 + hstepA, voffA);
            PG8_WAIT_L(8); PG8_BAR; PG8_WAIT_L(0); PG8_MMA(0, 0, At, B0); PG8_BAR; PG8_SCHED;
            PG8_LDB(B1, 0, 1); PG8_STAGE(PG8_SB(0, 0), b2, voffB);
            PG8_BAR; PG8_WAIT_L(0); PG8_MMA(0, 1, At, B1); PG8_BAR;
            PG8_LDA(At, 0, 1); PG8_STAGE(PG8_SA(0, 0), a2, voffA);
            PG8_BAR; PG8_WAIT_L(0); PG8_MMA(1, 0, At, B0); PG8_BAR; PG8_SCHED;
            PG8_STAGE(PG8_SB(0, 1), b2 + hstepB, voffB);
            PG8_WAIT_V(6); PG8_BAR; PG8_MMA(1, 1, At, B1); PG8_BAR;
            PG8_LDB(B0, 1, 0); PG8_SCHED; PG8_LDA(At, 1, 0); PG8_STAGE(PG8_SA(0, 1), a2 + hstepA, voffA);
            PG8_WAIT_L(8); PG8_BAR; PG8_WAIT_L(0); PG8_MMA(0, 0, At, B0); PG8_BAR; PG8_SCHED;
            PG8_LDB(B1, 1, 1); PG8_STAGE(PG8_SB(1, 0), b3, voffB);
            PG8_BAR; PG8_WAIT_L(0); PG8_MMA(0, 1, At, B1); PG8_BAR;
            PG8_LDA(At, 1, 1); PG8_STAGE(PG8_SA(1, 0), a3, voffA);
            PG8_BAR; PG8_WAIT_L(0); PG8_MMA(1, 0, At, B0); PG8_BAR; PG8_SCHED;
            PG8_STAGE(PG8_SB(1, 1), b3 + hstepB, voffB);
            PG8_WAIT_V(6); PG8_BAR; PG8_MMA(1, 1, At, B1); PG8_BAR;
                    }
        }
        if constexpr (ALIGN_EPI) { if (wr == 0) PG8_BAR; }
        E(acc, cur, wr, wc, fr, fq);
        if (!has_next) break;
#pragma unroll
        for (int a = 0; a < 2; ++a)
#pragma unroll
            for (int b = 0; b < 2; ++b)
#pragma unroll
                for (int m = 0; m < 4; ++m)
#pragma unroll
                    for (int n = 0; n < 2; ++n) acc[a][b][m][n] = (f32x4){0.f, 0.f, 0.f, 0.f};
        cur = nxt; cA = nA; cB = nB; ++ui;
        if constexpr (ALIGN_EPI) { if (wr == 1) PG8_BAR; }
    }
    PG8_WAIT_V(0);
    if constexpr (!ALIGN_EPI) { if (wr == 0) PG8_BAR; }
    PG8_BAR;
#undef PG8_SA
#undef PG8_SB
#undef PG8_STAGE
#undef PG8_LDA
#undef PG8_LDB
#undef PG8_MMA
#undef PG8_WAIT_V
#undef PG8_WAIT_L
#undef PG8_BAR
#undef PG8_SCHED
}
}

namespace {
using pg8::bf16_t; using pg8::f32x4; using pg8::u32x4; using pg8::u32x2;
#define LAS __attribute__((address_space(3)))
constexpr int D = 1024, NB = 8, L = 4096, LC = 256, INC = 6144, FF = 4096, HW = 512;
constexpr int NT = NB * L, NCX = NB * LC;
constexpr float EPS = 1e-6f;
constexpr size_t MiB = 1u << 20;
constexpr size_t WS_MOD = 64 * 1024, WS_LB = 512 * 1024, WS_GT = 2 * MiB  ;
constexpr size_t WS_WIN = 18 * MiB, WS_WPAB = 30 * MiB, WS_WOUT = 32 * MiB, WS_W1 = 34 * MiB, WS_W2 = 42 * MiB;
constexpr size_t WS_STATE = 10 * MiB  , WS_HCTX = 50 * MiB, WS_PCTX = 54 * MiB, WS_SCTX = 60 * MiB;
constexpr size_t WS_HLAT = 64 * MiB;
constexpr size_t WS_PI = 128 * MiB, WS_PZ = 160 * MiB, WS_PQ = 224 * MiB, WS_PG = 256 * MiB, WS_GATES = 288 * MiB, WS_PHYT = 416 * MiB;
constexpr size_t WS_AY = 160 * MiB;
constexpr size_t WS_AY2 = 64 * MiB;
constexpr size_t WS_MERGED = 128 * MiB;
constexpr size_t WS_MIX = 448 * MiB, WS_MLP = 384 * MiB, WS_H1 = 128 * MiB, WS_HL = 64 * MiB;
constexpr size_t WS_END = 512 * MiB;
constexpr int LDS_BYTES = 163840;

__device__ __forceinline__ float bf2f(bf16_t h) { return __uint_as_float(((unsigned)h) << 16); }
__device__ __forceinline__ unsigned f2bf(float f) { unsigned u = __float_as_uint(f); return (u + 0x7fffu + ((u >> 16) & 1u)) >> 16; }
__device__ __forceinline__ unsigned pk2(float lo, float hi) { return f2bf(lo) | (f2bf(hi) << 16); }
__device__ __forceinline__ float sigmoidf_(float x) { return 1.f / (1.f + expf(-x)); }
__device__ __forceinline__ float siluf_(float x) { return x / (1.f + expf(-x)); }
__device__ __forceinline__ float wave_sum(float v) {
#pragma unroll
    for (int o = 1; o < 64; o <<= 1) v += __shfl_xor(v, o);
    return v;
}
#define LDS_WAIT() asm volatile("s_waitcnt lgkmcnt(0)" ::: "memory")

struct Params { const float* in[24]; float* out; unsigned char* ws; };

#define XB_TMO      128
#define XB_XCNT(j)  (256  + 64 * (j))
#define XB_XSUB(j)  (1280 + 64 * (j))
#define XB_XGEN(j)  (2304 + 64 * (j))
#define XB_TOP      3328
#define XB_TOPGEN   3392
#define XCD_BAR_WORDS 3456
#define XB_SPIN_CAP (1u << 18)

__device__ __forceinline__ unsigned xb_ld(unsigned* p)              { return __hip_atomic_load(p, __ATOMIC_RELAXED, __HIP_MEMORY_SCOPE_AGENT); }
__device__ __forceinline__ unsigned xb_add(unsigned* p, unsigned v) { return __hip_atomic_fetch_add(p, v, __ATOMIC_RELAXED, __HIP_MEMORY_SCOPE_AGENT); }
__device__ __forceinline__ unsigned xb_xcc_id() { return (unsigned)__builtin_amdgcn_s_getreg((3 << 11) | 20) & 0xFu; }
#define XB_SPIN(cond, bar) do { unsigned _sp = 0; while (cond) { __builtin_amdgcn_s_sleep(1); \
    if ((++_sp & 255u) == 0u) { if (xb_ld(&(bar)[XB_TMO])) break; if (_sp > XB_SPIN_CAP) { atomicAdd(&(bar)[XB_TMO], 1u); break; } } } } while (0)

struct XcdBarrier {
    unsigned* bar; unsigned x;
    volatile LAS unsigned* st;
};

__device__ __forceinline__ XcdBarrier xcd_barrier_post(unsigned* bar, volatile LAS unsigned* st) {
    XcdBarrier b; b.bar = bar; b.x = xb_xcc_id(); b.st = st;
    if (threadIdx.x == 0) (void)xb_add(&bar[XB_XCNT(b.x)], 1u);
    return b;
}
__device__ __forceinline__ void xcd_barrier_complete(unsigned* bar, unsigned x, unsigned& nloc, unsigned& nx) {
    const unsigned G = gridDim.x * gridDim.y * gridDim.z;
    unsigned sum, cnt, mine, sp = 0u;
    for (;;) {
        sum = 0u; cnt = 0u; mine = 0u;
#pragma unroll
        for (unsigned j = 0; j < 16; ++j) { const unsigned c = xb_ld(&bar[XB_XCNT(j)]); sum += c; cnt += (c > 0u) ? 1u : 0u; mine = (j == x) ? c : mine; }
        if (sum == G) break;
        __builtin_amdgcn_s_sleep(1);
        if ((++sp & 255u) == 0u) { if (xb_ld(&bar[XB_TMO])) break; if (sp > XB_SPIN_CAP) { atomicAdd(&bar[XB_TMO], 1u); break; } }
    }
    nloc = mine > 0u ? mine : 1u; nx = cnt > 0u ? cnt : 1u;
}

__device__ __forceinline__ void xcd_barrier(const XcdBarrier& b) {
    asm volatile("s_waitcnt vmcnt(0)" ::: "memory");
    __syncthreads();
    if (threadIdx.x == 0) {
        unsigned* bar = b.bar;
        __builtin_amdgcn_s_waitcnt(0);
        unsigned nloc = b.st[0], nx = b.st[1];
        if (nloc == 0u) { xcd_barrier_complete(bar, b.x, nloc, nx); b.st[0] = nloc; b.st[1] = nx; }
        const unsigned old = xb_add(&bar[XB_XSUB(b.x)], 1u);
        const unsigned gen = old / nloc;
        if (old + 1u == (gen + 1u) * nloc) {
            __builtin_amdgcn_fence(__ATOMIC_RELEASE, "agent");
            asm volatile("s_waitcnt vmcnt(0)" ::: "memory");
            const unsigned og = xb_add(&bar[XB_TOP], 1u);
            const unsigned tg = og / nx;
            if (og + 1u == (tg + 1u) * nx) xb_add(&bar[XB_TOPGEN], 1u);
            else XB_SPIN(xb_ld(&bar[XB_TOPGEN]) == tg, bar);
            __builtin_amdgcn_fence(__ATOMIC_ACQUIRE, "agent");
            xb_add(&bar[XB_XGEN(b.x)], 1u);
            asm volatile("s_waitcnt vmcnt(0)" ::: "memory");
        } else {
            XB_SPIN(xb_ld(&bar[XB_XGEN(b.x)]) == gen, bar);
            __builtin_amdgcn_fence(__ATOMIC_ACQUIRE, "agent");
            asm volatile("s_waitcnt vmcnt(0)" ::: "memory");
        }
    }
    __syncthreads();
}


__device__ __forceinline__ void transpose_item(const float* W, int N, bf16_t* WT, int ldk, int koff, int remap, LAS float* scr, int item, int lane) {
    const int nblk = N / 32, kb = item / nblk, nb = item % nblk, k0 = 64 * kb, n0 = 32 * nb;
    int rbase = n0;
    if (remap) rbase = n0 < 2560 ? n0 : (n0 < 4096 ? n0 + 2048 : n0 - 1536);
#pragma unroll 8
    for (int i = 0; i < 32; ++i) { const int kk = 2 * i + (lane >> 5); scr[kk * 33 + (lane & 31)] = W[(size_t)(k0 + kk) * N + n0 + (lane & 31)]; }
    LDS_WAIT();
    const int c = lane & 7;
#pragma unroll
    for (int j = 0; j < 4; ++j) { const int n = (lane >> 3) + 8 * j; const LAS float* s = scr + (8 * c) * 33 + n;
        u32x4 o; o.x = pk2(s[0 * 33], s[1 * 33]); o.y = pk2(s[2 * 33], s[3 * 33]); o.z = pk2(s[4 * 33], s[5 * 33]); o.w = pk2(s[6 * 33], s[7 * 33]);
        *(u32x4*)(WT + (size_t)(rbase + n) * ldk + koff + k0 + 8 * c) = o; }
    LDS_WAIT();
}

__device__ __forceinline__ void row_norm_mod_bf16(const float* xrow, const float* nw, const float* scale, const float* shift, bf16_t* orow, int lane) {
    const f32x4* xr = (const f32x4*)xrow + lane; f32x4 v[4]; float s = 0.f;
#pragma unroll
    for (int j = 0; j < 4; ++j) { v[j] = xr[64 * j]; s += (v[j].x * v[j].x + v[j].y * v[j].y) + (v[j].z * v[j].z + v[j].w * v[j].w); }
    const float r = rsqrtf(wave_sum(s) * (1.f / D) + EPS);
    unsigned long long* o8 = (unsigned long long*)orow + lane;
#pragma unroll
    for (int j = 0; j < 4; ++j) { const f32x4 w = ((const f32x4*)nw)[lane + 64 * j], sc = ((const f32x4*)scale)[lane + 64 * j], sh = ((const f32x4*)shift)[lane + 64 * j];
        const f32x4 o = v[j] * r * w * (1.f + sc) + sh;
        o8[64 * j] = (unsigned long long)pk2(o.x, o.y) | ((unsigned long long)pk2(o.z, o.w) << 32); }
}
__device__ __forceinline__ f32x4 ld_bf4(const bf16_t* p) { const u32x2 u = *(const u32x2*)p; return (f32x4){pg8::bflo(u.x), pg8::bfhi(u.x), pg8::bflo(u.y), pg8::bfhi(u.y)}; }
__device__ __forceinline__ void row_x1(const float* xrow, const bf16_t* mixrow, const float* nw1, const float* g2, f32x4 (&x1)[4], int lane) {
    f32x4 mv[4]; float s = 0.f;
#pragma unroll
    for (int j = 0; j < 4; ++j) { mv[j] = ld_bf4(mixrow + 4 * lane + 256 * j); s += (mv[j].x * mv[j].x + mv[j].y * mv[j].y) + (mv[j].z * mv[j].z + mv[j].w * mv[j].w); }
    const float r = rsqrtf(wave_sum(s) * (1.f / D) + EPS);
#pragma unroll
    for (int j = 0; j < 4; ++j) { const f32x4 w = ((const f32x4*)nw1)[lane + 64 * j], g = ((const f32x4*)g2)[lane + 64 * j], xv = ((const f32x4*)xrow)[lane + 64 * j];
        x1[j] = xv + g * (mv[j] * r * w); }
}

typedef float f32x16 __attribute__((ext_vector_type(16)));
typedef float f32x2_t __attribute__((ext_vector_type(2)));
typedef __bf16 bf16x2_t __attribute__((ext_vector_type(2)));
__device__ __forceinline__ unsigned cvtpk(float lo, float hi) { const f32x2_t v = {lo, hi}; const bf16x2_t b = __builtin_convertvector(v, bf16x2_t); return __builtin_bit_cast(unsigned, b); }
constexpr int HY_PITCH = 8720;
constexpr int HY_TAB0 = 8 * HY_PITCH;
constexpr int HY_TAB1 = HY_TAB0 + 17408 + 64;
__device__ __forceinline__ void conv8(const u32x4 raw, float left, float right, float w0, float w1, float w2, float bias, float (&o)[8]) {
    float in[10]; in[0] = left; in[9] = right;
    in[1] = pg8::bflo(raw.x); in[2] = pg8::bfhi(raw.x); in[3] = pg8::bflo(raw.y); in[4] = pg8::bfhi(raw.y); in[5] = pg8::bflo(raw.z); in[6] = pg8::bfhi(raw.z); in[7] = pg8::bflo(raw.w); in[8] = pg8::bfhi(raw.w);
#pragma unroll
    for (int j = 0; j < 8; ++j) o[j] = bias + w0 * in[j] + w1 * in[j + 1] + w2 * in[j + 2];
}
__device__ __forceinline__ void hyena_channel(LAS unsigned char* lds, int c, bf16_t* PHYT, const bf16_t* GTB, const float* hy_sw, const float* hy_sb) {
    const int tid = threadIdx.x, lane = tid & 63, wave = __builtin_amdgcn_readfirstlane(tid >> 6);
    const bool hl = (tid & 7) != 0, hr = ((tid + 1) & 7) != 0;
    __syncthreads();
    for (int ci = tid; ci < 1088; ci += 512) { u32x4 v = (u32x4){0u, 0u, 0u, 0u};
        if (ci >= 32 && ci < 1056) v = *(const u32x4*)(GTB + (size_t)c * 8192 + (ci - 32) * 8);
        *(LAS u32x4*)(lds + HY_TAB0 + ci * 16) = v; }
    {
        const bf16_t* x1r = PHYT + (size_t)(512 + c) * NT + 8 * tid; const bf16_t* vr = PHYT + (size_t)(1024 + c) * NT + 8 * tid;
        const float xw0 = hy_sw[512 + c], xw1 = hy_sw[1536 + 512 + c], xw2 = hy_sw[3072 + 512 + c], xb = hy_sb[512 + c];
        const float vw0 = hy_sw[1024 + c], vw1 = hy_sw[1536 + 1024 + c], vw2 = hy_sw[3072 + 1024 + c], vb = hy_sb[1024 + c];
        u32x4 xa[8], va[8];
#pragma unroll
        for (int b = 0; b < 8; ++b) { xa[b] = *(const u32x4*)(x1r + (size_t)b * L); va[b] = *(const u32x4*)(vr + (size_t)b * L); }
#pragma unroll
        for (int b = 0; b < 8; ++b) {
            const unsigned xpw = __shfl_up(xa[b].w, 1), xnx = __shfl_down(xa[b].x, 1), vpw = __shfl_up(va[b].w, 1), vnx = __shfl_down(va[b].x, 1);
            const float xl = hl ? pg8::bfhi(xpw) : 0.f, xr = hr ? pg8::bflo(xnx) : 0.f, vl = hl ? pg8::bfhi(vpw) : 0.f, vrr = hr ? pg8::bflo(vnx) : 0.f;
            float cx[8], cv[8]; conv8(xa[b], xl, xr, xw0, xw1, xw2, xb, cx); conv8(va[b], vl, vrr, vw0, vw1, vw2, vb, cv);
            u32x4 w; w.x = cvtpk(cx[0] * cv[0], cx[1] * cv[1]); w.y = cvtpk(cx[2] * cv[2], cx[3] * cv[3]); w.z = cvtpk(cx[4] * cv[4], cx[5] * cv[5]); w.w = cvtpk(cx[6] * cv[6], cx[7] * cv[7]);
            *(LAS u32x4*)(lds + b * HY_PITCH + (128 + 8 * tid) * 2) = w; }
        if (tid < 256) { const int b = tid >> 5, side = (tid >> 4) & 1, k = tid & 15;
            *(LAS u32x4*)(lds + b * HY_PITCH + (side ? (128 + 4096) * 2 : 0) + k * 16) = (u32x4){0u, 0u, 0u, 0u}; }
    }
    __syncthreads();
    for (int ci = tid; ci < 1088; ci += 512) { const u32x4 d = *(const LAS u32x4*)(lds + HY_TAB0 + ci * 16); const unsigned d4 = ci < 1087 ? *(const LAS unsigned*)(lds + HY_TAB0 + ci * 16 + 16) : 0u;
        u32x4 o; o.x = __builtin_amdgcn_alignbit(d.y, d.x, 16); o.y = __builtin_amdgcn_alignbit(d.z, d.y, 16); o.z = __builtin_amdgcn_alignbit(d.w, d.z, 16); o.w = __builtin_amdgcn_alignbit(d4, d.w, 16);
        *(LAS u32x4*)(lds + HY_TAB1 + ci * 16) = o; }
    __syncthreads();
    const int T0 = 512 * wave, r = lane & 31, h = lane >> 5, bb = r >> 2, tb = r & 3;
    f32x16 acc[4];
#pragma unroll
    for (int i = 0; i < 4; ++i)
#pragma unroll
        for (int j = 0; j < 16; ++j) acc[i][j] = 0.f;
    {
        const int Dfirst = T0 - 4080;
        const int e0 = 4351 - Dfirst - r + 8 * h;
        const unsigned aaddr0 = (unsigned)((e0 & 1) ? HY_TAB1 : HY_TAB0) + (unsigned)(e0 & ~1) * 2u;
        const unsigned baddr0 = (unsigned)(bb * HY_PITCH + (128 + T0 + 32 * tb - Dfirst + 8 * h) * 2);
#define HY_LDA(dst, ad) do { u32x4 _t; _t.x = *(const LAS unsigned*)(lds + (ad)); _t.y = *(const LAS unsigned*)(lds + (ad) + 4); _t.z = *(const LAS unsigned*)(lds + (ad) + 8); _t.w = *(const LAS unsigned*)(lds + (ad) + 12); dst = __builtin_bit_cast(pg8::bf16x8, _t); } while (0)
#define HY_LDB(dst, ad) dst = *(const LAS pg8::bf16x8*)(lds + (ad))
#define HY_GENERIC(st_lo, st_hi) do { for (int st = (st_lo); st < (st_hi); ++st) { const int d = -4080 + 16 * st; const unsigned aa = aaddr0 - 32u * (unsigned)st, ba = baddr0 - 32u * (unsigned)st; pg8::bf16x8 A; HY_LDA(A, aa); \
            if (d <= 96) { pg8::bf16x8 B; HY_LDB(B, ba); acc[0] = __builtin_amdgcn_mfma_f32_32x32x16_bf16(A, B, acc[0], 0, 0, 0); } \
            if (d >= -3952 && d <= 224) { pg8::bf16x8 B; HY_LDB(B, ba + 256); acc[1] = __builtin_amdgcn_mfma_f32_32x32x16_bf16(A, B, acc[1], 0, 0, 0); } \
            if (d >= -3824 && d <= 352) { pg8::bf16x8 B; HY_LDB(B, ba + 512); acc[2] = __builtin_amdgcn_mfma_f32_32x32x16_bf16(A, B, acc[2], 0, 0, 0); } \
            if (d >= -3696) { pg8::bf16x8 B; HY_LDB(B, ba + 768); acc[3] = __builtin_amdgcn_mfma_f32_32x32x16_bf16(A, B, acc[3], 0, 0, 0); } } } while (0)
#define HY_LOAD5(A, B0, B1, B2, B3, aa, ba) do { HY_LDA(A, aa); HY_LDB(B0, ba); HY_LDB(B1, (ba) + 256); HY_LDB(B2, (ba) + 512); HY_LDB(B3, (ba) + 768); } while (0)
#define HY_MMA4(A, B0, B1, B2, B3) do { acc[0] = __builtin_amdgcn_mfma_f32_32x32x16_bf16(A, B0, acc[0], 0, 0, 0); acc[1] = __builtin_amdgcn_mfma_f32_32x32x16_bf16(A, B1, acc[1], 0, 0, 0); \
            acc[2] = __builtin_amdgcn_mfma_f32_32x32x16_bf16(A, B2, acc[2], 0, 0, 0); acc[3] = __builtin_amdgcn_mfma_f32_32x32x16_bf16(A, B3, acc[3], 0, 0, 0); } while (0)
        HY_GENERIC(0, 24);
        {
            unsigned aa = aaddr0 - 32u * 24u, ba = baddr0 - 32u * 24u;
            pg8::bf16x8 Aa, Ba0, Ba1, Ba2, Ba3, Ab, Bb0, Bb1, Bb2, Bb3;
            HY_LOAD5(Aa, Ba0, Ba1, Ba2, Ba3, aa, ba);
#pragma unroll 1
            for (int it = 0; it < 118; ++it) {
                HY_LOAD5(Ab, Bb0, Bb1, Bb2, Bb3, aa - 32u, ba - 32u); __builtin_amdgcn_sched_barrier(0);
                HY_MMA4(Aa, Ba0, Ba1, Ba2, Ba3); __builtin_amdgcn_sched_barrier(0);
                HY_LOAD5(Aa, Ba0, Ba1, Ba2, Ba3, aa - 64u, ba - 64u); __builtin_amdgcn_sched_barrier(0);
                HY_MMA4(Ab, Bb0, Bb1, Bb2, Bb3); __builtin_amdgcn_sched_barrier(0);
                aa -= 64u; ba -= 64u;
            }
            HY_LOAD5(Ab, Bb0, Bb1, Bb2, Bb3, aa - 32u, ba - 32u);
            HY_MMA4(Aa, Ba0, Ba1, Ba2, Ba3);
            HY_MMA4(Ab, Bb0, Bb1, Bb2, Bb3);
        }
        HY_GENERIC(262, 286);
#undef HY_LDA
#undef HY_LDB
#undef HY_GENERIC
#undef HY_LOAD5
#undef HY_MMA4
    }
    __syncthreads();
    {
        const bf16_t* x0r = PHYT + (size_t)c * NT + 8 * tid; u32x4 xa[8];
#pragma unroll
        for (int b = 0; b < 8; ++b) xa[b] = *(const u32x4*)(x0r + (size_t)b * L);
#pragma unroll
        for (int i = 0; i < 4; ++i)
#pragma unroll
            for (int g = 0; g < 4; ++g) { const int t = T0 + 128 * i + 32 * tb + 8 * g + 4 * h;
                pg8::u32x2 w; w.x = cvtpk(acc[i][4 * g], acc[i][4 * g + 1]); w.y = cvtpk(acc[i][4 * g + 2], acc[i][4 * g + 3]);
                *(LAS pg8::u32x2*)(lds + bb * HY_PITCH + (128 + t) * 2) = w; }
        __syncthreads();
        bf16_t* yr = PHYT + (size_t)(1024 + c) * NT + 8 * tid;
        const float w0 = hy_sw[c], w1 = hy_sw[1536 + c], w2 = hy_sw[3072 + c], bs = hy_sb[c];
#pragma unroll
        for (int b = 0; b < 8; ++b) {
            const unsigned xpw = __shfl_up(xa[b].w, 1), xnx = __shfl_down(xa[b].x, 1);
            const float xl = hl ? pg8::bfhi(xpw) : 0.f, xr = hr ? pg8::bflo(xnx) : 0.f;
            float cx[8]; conv8(xa[b], xl, xr, w0, w1, w2, bs, cx);
            const u32x4 y = *(const LAS u32x4*)(lds + b * HY_PITCH + (128 + 8 * tid) * 2);
            u32x4 w; w.x = cvtpk(cx[0] * pg8::bflo(y.x), cx[1] * pg8::bfhi(y.x)); w.y = cvtpk(cx[2] * pg8::bflo(y.y), cx[3] * pg8::bfhi(y.y));
            w.z = cvtpk(cx[4] * pg8::bflo(y.z), cx[5] * pg8::bfhi(y.z)); w.w = cvtpk(cx[6] * pg8::bflo(y.w), cx[7] * pg8::bfhi(y.w));
            *(u32x4*)(yr + (size_t)b * L) = w; }
    }
}

constexpr int HG_QE = 0, HG_KE = 17408, HG_KDT = 34816, HG_VT = 53248, HG_DEC = 71680, HG_BUF = 72192;

#define HG_RD2(ptr_a, ptr_b) __builtin_bit_cast(pg8::bf16x8, (u32x4){(*(const LAS u32x2*)(ptr_a)).x, (*(const LAS u32x2*)(ptr_a)).y, (*(const LAS u32x2*)(ptr_b)).x, (*(const LAS u32x2*)(ptr_b)).y})
#define HG_MFMA(a, b, c) __builtin_amdgcn_mfma_f32_16x16x32_bf16(a, b, c, 0, 0, 0)
#define HG_SB() __builtin_amdgcn_sched_barrier(0)
__device__ __forceinline__ pg8::bf16x8 hg_pack2(const f32x4& a, const f32x4& b) { u32x4 t; t.x = cvtpk(a[0], a[1]); t.y = cvtpk(a[2], a[3]); t.z = cvtpk(b[0], b[1]); t.w = cvtpk(b[2], b[3]); return __builtin_bit_cast(pg8::bf16x8, t); }
template <bool HAS_Q>
__device__ __forceinline__ void hgrn_consume(LAS unsigned char* Bf, f32x4 (&S)[2][8], int base, int dir, int h, int cw, int fr, int kg, float* o_out, int dbg) {
    const f32x4 z4 = (f32x4){0.f, 0.f, 0.f, 0.f};
    pg8::bf16x8 Bv[2][2];
#pragma unroll
    for (int sl = 0; sl < 2; ++sl)
#pragma unroll
        for (int ks = 0; ks < 2; ++ks) { LAS unsigned char* const vp = Bf + HG_VT + (32 * cw + 16 * sl + fr) * 144 + (32 * ks + 4 * kg) * 2; Bv[sl][ks] = HG_RD2(vp, vp + 32); }
    if (HAS_Q) {
        f32x4 st[10];
#pragma unroll
        for (int i = 0; i < 10; ++i) st[i] = z4;
        pg8::bf16x8 Kf[2][4], Qf[2][4];
        LAS unsigned char* const kbase = Bf + HG_KE + fr * 272 + 8 * kg * 2; LAS unsigned char* const qbase = Bf + HG_QE + fr * 272 + 8 * kg * 2;
#pragma unroll
        for (int b4 = 0; b4 < 4; ++b4) { Kf[0][b4] = *(const LAS pg8::bf16x8*)(kbase + b4 * 16 * 272); Qf[0][b4] = *(const LAS pg8::bf16x8*)(qbase + b4 * 16 * 272); }
#pragma unroll
        for (int ks = 0; ks < 4; ++ks) {
            if (ks < 3) {
#pragma unroll
                for (int b4 = 0; b4 < 4; ++b4) { Kf[(ks + 1) & 1][b4] = *(const LAS pg8::bf16x8*)(kbase + b4 * 16 * 272 + (ks + 1) * 64); Qf[(ks + 1) & 1][b4] = *(const LAS pg8::bf16x8*)(qbase + b4 * 16 * 272 + (ks + 1) * 64); } }
            HG_SB();
#pragma unroll
            for (int cb = 0; cb < 4; ++cb)
#pragma unroll
                for (int sb = 0; sb <= cb; ++sb) st[cb * (cb + 1) / 2 + sb] = HG_MFMA(Kf[ks & 1][sb], Qf[ks & 1][cb], st[cb * (cb + 1) / 2 + sb]);
            HG_SB();
        }
#pragma unroll
        for (int cb = 0; cb < 4; ++cb)
#pragma unroll
            for (int r = 0; r < 4; ++r) st[cb * (cb + 1) / 2 + cb][r] = (4 * kg + r <= fr) ? st[cb * (cb + 1) / 2 + cb][r] : 0.f;
        pg8::bf16x8 Af[4][2];
        Af[0][0] = hg_pack2(st[0], z4); Af[1][0] = hg_pack2(st[1], st[2]); Af[2][0] = hg_pack2(st[3], st[4]); Af[2][1] = hg_pack2(st[5], z4); Af[3][0] = hg_pack2(st[6], st[7]); Af[3][1] = hg_pack2(st[8], st[9]);
        pg8::bf16x8 Bs[2][4];
#pragma unroll
        for (int sl = 0; sl < 2; ++sl)
#pragma unroll
            for (int kp = 0; kp < 4; ++kp) Bs[sl][kp] = hg_pack2(S[sl][2 * kp], S[sl][2 * kp + 1]);
        pg8::bf16x8 Aq[2][4];
        LAS unsigned char* const qp0 = Bf + HG_QE + fr * 272 + 4 * kg * 2;
#pragma unroll
        for (int kp = 0; kp < 4; ++kp) Aq[0][kp] = HG_RD2(qp0 + kp * 64, qp0 + kp * 64 + 32);
#pragma unroll
        for (int cb = 0; cb < 4; ++cb) {
            if (cb < 3) {
#pragma unroll
                for (int kp = 0; kp < 4; ++kp) Aq[(cb + 1) & 1][kp] = HG_RD2(qp0 + (cb + 1) * 16 * 272 + kp * 64, qp0 + (cb + 1) * 16 * 272 + kp * 64 + 32); }
            HG_SB();
            f32x4 o0 = z4, o1 = z4;
            o0 = HG_MFMA(Af[cb][0], Bv[0][0], o0); o1 = HG_MFMA(Af[cb][0], Bv[1][0], o1);
            if (cb >= 2) { o0 = HG_MFMA(Af[cb][1], Bv[0][1], o0); o1 = HG_MFMA(Af[cb][1], Bv[1][1], o1); }
#pragma unroll
            for (int kp = 0; kp < 4; ++kp) { o0 = HG_MFMA(Aq[cb & 1][kp], Bs[0][kp], o0); o1 = HG_MFMA(Aq[cb & 1][kp], Bs[1][kp], o1); }
            HG_SB();
#pragma unroll
            for (int r = 0; r < 4; ++r) { const int cp = 16 * cb + 4 * kg + r; const int t = base + (dir ? 63 - cp : cp); float* op = o_out + (size_t)t * HW + h * 128 + 32 * cw + fr;
                if (!(dbg & 1)) { op[0] = o0[r]; op[16] = o1[r]; } else asm volatile("" :: "v"(o0[r]), "v"(o1[r])); }
        }
    }
    pg8::bf16x8 Ak[2][2][2]; f32x4 dc[2][2];
    LAS unsigned char* const kdp = Bf + HG_KDT + fr * 144 + 4 * kg * 2; LAS unsigned char* const dcp = Bf + HG_DEC + 4 * kg * 4;
#pragma unroll
    for (int u = 0; u < 2; ++u) { dc[0][u] = *(const LAS f32x4*)(dcp + u * 64);
#pragma unroll
        for (int ks = 0; ks < 2; ++ks) Ak[0][u][ks] = HG_RD2(kdp + u * 16 * 144 + ks * 64, kdp + u * 16 * 144 + ks * 64 + 32); }
#pragma unroll
    for (int bp = 0; bp < 4; ++bp) {
        if (bp < 3) {
#pragma unroll
            for (int u = 0; u < 2; ++u) { const int blk = 2 * (bp + 1) + u; dc[(bp + 1) & 1][u] = *(const LAS f32x4*)(dcp + blk * 64);
#pragma unroll
                for (int ks = 0; ks < 2; ++ks) Ak[(bp + 1) & 1][u][ks] = HG_RD2(kdp + blk * 16 * 144 + ks * 64, kdp + blk * 16 * 144 + ks * 64 + 32); } }
        HG_SB();
#pragma unroll
        for (int u = 0; u < 2; ++u) { const int blk = 2 * bp + u; f32x4 s0 = S[0][blk] * dc[bp & 1][u], s1 = S[1][blk] * dc[bp & 1][u];
#pragma unroll
            for (int ks = 0; ks < 2; ++ks) { s0 = HG_MFMA(Ak[bp & 1][u][ks], Bv[0][ks], s0); s1 = HG_MFMA(Ak[bp & 1][u][ks], Bv[1][ks], s1); }
            S[0][blk] = s0; S[1][blk] = s1; }
        HG_SB();
    }
}
#undef HG_RD2
#undef HG_MFMA
#undef HG_SB

template <bool HAS_Q>
__device__ __forceinline__ void hgrn_chain_mfma(LAS unsigned char* lds, const bf16_t* pi, int ldi, const bf16_t* pz, int ldz, const bf16_t* pq, int ldq, int Lseq, int h, int dir,
                                                const float* lb, const float* s_in, float* s_out, float* o_out, int n_begin, int nch  , int dbg = 0) {
    const int tid = threadIdx.x, lane = tid & 63, wave = __builtin_amdgcn_readfirstlane(tid >> 6);
    const bool producer = wave < 4;
#define HG_BAR() do { asm volatile("s_waitcnt lgkmcnt(0)" ::: "memory"); __builtin_amdgcn_s_barrier(); asm volatile("" ::: "memory"); } while (0)
    const int pw = wave & 3, dp = lane & 15, rq = lane >> 4, ch0 = 32 * pw + 2 * dp;
    const float lb0 = lb[h * 128 + ch0], lb1 = lb[h * 128 + ch0 + 1];
    const int rowmin = dir ? 48 - 16 * rq : 16 * rq;
    const unsigned voZ = (unsigned)(rowmin * ldz + h * 128 + ch0) * 2u, voI = (unsigned)(rowmin * ldi + h * 128 + ch0) * 2u, voQ = (unsigned)(rowmin * (HAS_Q ? ldq : ldi) + h * 128 + ch0) * 2u;
    const __amdgpu_buffer_rsrc_t rsZ = __builtin_amdgcn_make_buffer_rsrc((void*)pz, 0, Lseq * ldz * 2, 0x00020000);
    const __amdgpu_buffer_rsrc_t rsI = __builtin_amdgcn_make_buffer_rsrc((void*)pi, 0, Lseq * ldi * 2, 0x00020000);
    const __amdgpu_buffer_rsrc_t rsQ = __builtin_amdgcn_make_buffer_rsrc((void*)(HAS_Q ? pq : pi), 0, Lseq * (HAS_Q ? ldq : ldi) * 2, 0x00020000);
#define HG_LOAD(n, Z, Q, V) do { const int _n = (dbg & 2) ? 0 : (n); const int _base = dir ? (Lseq - 64 * (_n + 1)) : 64 * _n; \
        _Pragma("unroll") for (int i = 0; i < 16; ++i) { const int _r = _base + (dir ? 15 - i : i); \
            Z[i] = __builtin_amdgcn_raw_buffer_load_b32(rsZ, voZ, _r * ldz * 2, 0); V[i] = __builtin_amdgcn_raw_buffer_load_b32(rsI, voI, _r * ldi * 2, 0); \
            if (HAS_Q) Q[i] = __builtin_amdgcn_raw_buffer_load_b32(rsQ, voQ, _r * ldq * 2, 0); } } while (0)
#define HG_PRODUCE(Z, Q, V, boff) do { LAS unsigned char* const Bf = lds + (boff); \
        float f0[16], f1[16]; float p0 = 1.f, p1 = 1.f; \
        _Pragma("unroll") for (int i = 0; i < 16; ++i) { f0[i] = lb0 + (1.f - lb0) * pg8::sigm(pg8::bflo(Z[i])); f1[i] = lb1 + (1.f - lb1) * pg8::sigm(pg8::bfhi(Z[i])); p0 *= f0[i]; p1 *= f1[i]; } \
        float run0 = 1.f, run1 = 1.f, fl0 = 1.f, fl1 = 1.f; \
        _Pragma("unroll") for (int qq = 0; qq < 4; ++qq) { const float t0 = __shfl(p0, dp + 16 * qq), t1 = __shfl(p1, dp + 16 * qq); fl0 *= t0; fl1 *= t1; if (qq < rq) { run0 *= t0; run1 *= t1; } } \
        unsigned kdw0[8], kdw1[8]; \
        _Pragma("unroll") for (int i2 = 0; i2 < 8; ++i2) { float kda[2], kdb[2]; \
            _Pragma("unroll") for (int u = 0; u < 2; ++u) { const int i = 2 * i2 + u; run0 *= f0[i]; run1 *= f1[i]; const float ia = __builtin_amdgcn_rcpf(run0), ib = __builtin_amdgcn_rcpf(run1); \
                const float kea = (1.f - f0[i]) * ia, keb = (1.f - f1[i]) * ib; const int cp = 16 * rq + i; \
                if (HAS_Q) { *(LAS unsigned*)(Bf + HG_QE + cp * 272 + ch0 * 2) = cvtpk(pg8::bflo(Q[i]) * run0, pg8::bfhi(Q[i]) * run1); \
                             *(LAS unsigned*)(Bf + HG_KE + cp * 272 + ch0 * 2) = cvtpk(kea, keb); } \
                kda[u] = kea * fl0; kdb[u] = keb * fl1; } \
            kdw0[i2] = cvtpk(kda[0], kda[1]); kdw1[i2] = cvtpk(kdb[0], kdb[1]); } \
        *(LAS u32x4*)(Bf + HG_KDT + ch0 * 144 + 32 * rq) = (u32x4){kdw0[0], kdw0[1], kdw0[2], kdw0[3]}; *(LAS u32x4*)(Bf + HG_KDT + ch0 * 144 + 32 * rq + 16) = (u32x4){kdw0[4], kdw0[5], kdw0[6], kdw0[7]}; \
        *(LAS u32x4*)(Bf + HG_KDT + (ch0 + 1) * 144 + 32 * rq) = (u32x4){kdw1[0], kdw1[1], kdw1[2], kdw1[3]}; *(LAS u32x4*)(Bf + HG_KDT + (ch0 + 1) * 144 + 32 * rq + 16) = (u32x4){kdw1[4], kdw1[5], kdw1[6], kdw1[7]}; \
        { u32x4 lo0, lo1, hi0, hi1; \
          lo0.x = (V[0] & 0xffffu) | (V[1] << 16); lo0.y = (V[2] & 0xffffu) | (V[3] << 16); lo0.z = (V[4] & 0xffffu) | (V[5] << 16); lo0.w = (V[6] & 0xffffu) | (V[7] << 16); \
          lo1.x = (V[8] & 0xffffu) | (V[9] << 16); lo1.y = (V[10] & 0xffffu) | (V[11] << 16); lo1.z = (V[12] & 0xffffu) | (V[13] << 16); lo1.w = (V[14] & 0xffffu) | (V[15] << 16); \
          hi0.x = (V[0] >> 16) | (V[1] & 0xffff0000u); hi0.y = (V[2] >> 16) | (V[3] & 0xffff0000u); hi0.z = (V[4] >> 16) | (V[5] & 0xffff0000u); hi0.w = (V[6] >> 16) | (V[7] & 0xffff0000u); \
          hi1.x = (V[8] >> 16) | (V[9] & 0xffff0000u); hi1.y = (V[10] >> 16) | (V[11] & 0xffff0000u); hi1.z = (V[12] >> 16) | (V[13] & 0xffff0000u); hi1.w = (V[14] >> 16) | (V[15] & 0xffff0000u); \
          *(LAS u32x4*)(Bf + HG_VT + ch0 * 144 + 32 * rq) = lo0; *(LAS u32x4*)(Bf + HG_VT + ch0 * 144 + 32 * rq + 16) = lo1; \
          *(LAS u32x4*)(Bf + HG_VT + (ch0 + 1) * 144 + 32 * rq) = hi0; *(LAS u32x4*)(Bf + HG_VT + (ch0 + 1) * 144 + 32 * rq + 16) = hi1; } \
        if (rq == 0) *(LAS f32x2_t*)(Bf + HG_DEC + ch0 * 4) = (f32x2_t){fl0, fl1}; } while (0)
#define HG_CONSUME(m, boff) hgrn_consume<HAS_Q>(lds + (boff), S, dir ? (Lseq - 64 * ((m) + 1)) : 64 * (m), dir, h, cw, fr, kg, o_out, dbg)

    __syncthreads();
    if (producer) {
        unsigned zA[16], qA[16], vA[16], zB[16], qB[16], vB[16];
        HG_LOAD(n_begin, zA, qA, vA);
        if (n_begin + 1 < nch) HG_LOAD(n_begin + 1, zB, qB, vB);
        for (int n = n_begin; n <= nch; n += 2) {
            if (n < nch && !(dbg & 4)) HG_PRODUCE(zA, qA, vA, 0);
            if (n + 2 < nch) HG_LOAD(n + 2, zA, qA, vA);
            HG_BAR();
            if (n + 1 < nch && !(dbg & 4)) HG_PRODUCE(zB, qB, vB, HG_BUF);
            if (n + 3 < nch) HG_LOAD(n + 3, zB, qB, vB);
            HG_BAR();
        }
    } else {
        const int cw = wave & 3, fr = lane & 15, kg = lane >> 4;
        f32x4 S[2][8];
#pragma unroll
        for (int sl = 0; sl < 2; ++sl)
#pragma unroll
            for (int blk = 0; blk < 8; ++blk)
#pragma unroll
                for (int r = 0; r < 4; ++r) S[sl][blk][r] = s_in ? s_in[(size_t)(16 * blk + 4 * kg + r) * 128 + 32 * cw + 16 * sl + fr] : 0.f;
        for (int n = n_begin; n <= nch; n += 2) {
            if (n > n_begin && !(dbg & 8)) HG_CONSUME(n - 1, HG_BUF);
            HG_BAR();
            if (n < nch && !(dbg & 8)) HG_CONSUME(n, 0);
            HG_BAR();
        }
        if (dbg) {
#pragma unroll
            for (int sl = 0; sl < 2; ++sl)
#pragma unroll
                for (int blk = 0; blk < 8; ++blk) asm volatile("" :: "v"(S[sl][blk][0]), "v"(S[sl][blk][1]), "v"(S[sl][blk][2]), "v"(S[sl][blk][3]));
        }
        if (s_out) {
#pragma unroll
            for (int sl = 0; sl < 2; ++sl)
#pragma unroll
                for (int blk = 0; blk < 8; ++blk)
#pragma unroll
                    for (int r = 0; r < 4; ++r) s_out[(size_t)(16 * blk + 4 * kg + r) * 128 + 32 * cw + 16 * sl + fr] = S[sl][blk][r];
        }
    }
#undef HG_LOAD
#undef HG_PRODUCE
#undef HG_CONSUME
#undef HG_BAR
    __syncthreads();
}

__global__ void __launch_bounds__(512, 2) mega(Params P) {
    extern __shared__ __attribute__((aligned(16))) unsigned char lds_raw[];
    cg::grid_group grid = cg::this_grid();
    LAS unsigned char* lds = (LAS unsigned char*)lds_raw;
    const int tid = threadIdx.x, lane = tid & 63, wave = __builtin_amdgcn_readfirstlane(tid >> 6);
    const int G = gridDim.x, bx = blockIdx.x;
    const int vcu = (G % 8 == 0) ? (bx % 8) * (G / 8) + bx / 8 : bx;
    const int gw = vcu * 8 + wave, NGW = G * 8;
    unsigned char* ws = P.ws;
    const float* x = P.in[0]; const float* cvec = P.in[1]; const float* ctx = P.in[2]; const float* c_ctx = P.in[3];
    const float* w_ada = P.in[4]; const float* b_ada = P.in[5]; const float* norm_w = P.in[6]; const float* w_in = P.in[7];
    const float* lb_param = P.in[8]; const float* g_norm = P.in[9]; const float* hy_sw = P.in[10]; const float* hy_sb = P.in[11];
    const float* f_w1 = P.in[12]; const float* f_b1 = P.in[13]; const float* f_w2 = P.in[14]; const float* f_b2 = P.in[15];
    const float* f_w3 = P.in[16]; const float* f_freq = P.in[17]; const float* hy_d = P.in[18]; const float* w_pa = P.in[19];
    const float* w_pb = P.in[20]; const float* w_out = P.in[21]; const float* w_mlp1 = P.in[22]; const float* w_mlp2 = P.in[23];
    float* MOD = (float*)(ws + WS_MOD); float* LB = (float*)(ws + WS_LB); bf16_t* GTB = (bf16_t*)(ws + WS_GT);
    bf16_t* WIN = (bf16_t*)(ws + WS_WIN); bf16_t* WPAB = (bf16_t*)(ws + WS_WPAB); bf16_t* WOUT = (bf16_t*)(ws + WS_WOUT); bf16_t* W1 = (bf16_t*)(ws + WS_W1); bf16_t* W2 = (bf16_t*)(ws + WS_W2);
    bf16_t* HCTX = (bf16_t*)(ws + WS_HCTX); bf16_t* PCTX = (bf16_t*)(ws + WS_PCTX); float* SCTX = (float*)(ws + WS_SCTX);
    bf16_t* HLAT = (bf16_t*)(ws + WS_HLAT); bf16_t* PI = (bf16_t*)(ws + WS_PI); bf16_t* PZ = (bf16_t*)(ws + WS_PZ); bf16_t* PQ = (bf16_t*)(ws + WS_PQ);
    bf16_t* PG = (bf16_t*)(ws + WS_PG); bf16_t* GATES = (bf16_t*)(ws + WS_GATES); bf16_t* PHYT = (bf16_t*)(ws + WS_PHYT);
    bf16_t* AY = (bf16_t*)(ws + WS_AY2); bf16_t* MERGED = (bf16_t*)(ws + WS_MERGED); bf16_t* MIX = (bf16_t*)(ws + WS_MIX);
    bf16_t* MLP = (bf16_t*)(ws + WS_MLP); bf16_t* H1 = (bf16_t*)(ws + WS_H1); bf16_t* HL = (bf16_t*)(ws + WS_HL);
    float* O2 = P.out;

    volatile LAS unsigned* MISC = (volatile LAS unsigned*)(lds + LDS_BYTES - 128);
    if (tid < 16) MISC[tid] = 0u;
    __syncthreads();
    const XcdBarrier xbar = xcd_barrier_post((unsigned*)ws, MISC);
#define SEAM_RAW(k) do { if ((k) == 0) grid.sync(); else xcd_barrier(xbar); } while (0)
#if PROBE_MASK
    unsigned long long t_prev = __builtin_amdgcn_s_memrealtime(), t_spin = 0ull;
#ifndef PROBE_BUSY_PHASE
#define PROBE_BUSY_PHASE -1
#define PROBE_BUSY_BLOCK 0
#endif
#define SEAM(k) do { if ((k) == PROBE_BUSY_PHASE && bx == PROBE_BUSY_BLOCK && tid == 0) *(volatile unsigned long long*)(ws + 32768) = __builtin_amdgcn_s_memrealtime() - t_prev; \
    SEAM_RAW(k); { const unsigned long long _t = __builtin_amdgcn_s_memrealtime(); if ((PROBE_MASK >> (k)) & 1) t_spin += _t - t_prev; \
    if ((k) == PROBE_BUSY_PHASE) t_spin += *(volatile unsigned long long*)(ws + 32768); t_prev = _t; } } while (0)
#else
#define SEAM(k) SEAM_RAW(k)
#endif
    {
        if (bx < 192) {
            const int cgp = bx % 96, kh = bx / 96;
            LAS float* sc = (LAS float*)lds;
            LAS float* ps = (LAS float*)(lds + 20480);
            for (int i = tid; i < 9 * 512; i += 512) { const int r = i >> 9, k = kh * 512 + (i & 511); sc[i] = siluf_(r < 8 ? cvec[r * D + k] : c_ctx[k]); }
            __syncthreads();
            const int j = cgp * 64 + lane; float a9[9];
#pragma unroll
            for (int r = 0; r < 9; ++r) a9[r] = 0.f;
            const float* wp = w_ada + (size_t)(kh * 512 + wave * 64) * INC + j;
#pragma unroll 1
            for (int kk = 0; kk < 64; kk += 16) { float w[16];
#pragma unroll
                for (int u = 0; u < 16; ++u) w[u] = wp[(size_t)(kk + u) * INC];
#pragma unroll
                for (int u = 0; u < 16; ++u)
#pragma unroll
                    for (int r = 0; r < 9; ++r) a9[r] += sc[r * 512 + wave * 64 + kk + u] * w[u]; }
#pragma unroll
            for (int r = 0; r < 9; ++r) ps[(wave * 9 + r) * 64 + lane] = a9[r];
            __syncthreads();
            for (int i = tid; i < 9 * 64; i += 512) { const int r = i >> 6, l = i & 63; float s = kh == 0 ? b_ada[cgp * 64 + l] : 0.f;
#pragma unroll
                for (int w = 0; w < 8; ++w) s += ps[(w * 9 + r) * 64 + l];
                atomicAdd(&MOD[r * INC + cgp * 64 + l], s); }
            __syncthreads();
        }
        if (bx == G - 1) { const float a = lb_param[tid], b = lb_param[HW + tid], m = fmaxf(a, b); const float ea = expf(a - m), eb = expf(b - m); LB[tid] = ea / (ea + eb); }
        {   LAS float* scr = (LAS float*)(lds + wave * 16384);
            for (int it = gw; it < 16 * 192; it += NGW) transpose_item(w_in, INC, WIN, D, 0, 1, scr, it, lane); }
        for (int tb = bx; tb < 256; tb += G) {
            __syncthreads();
            LAS float* zf = (LAS float*)lds; LAS float* h1 = zf + 17 * 36; LAS float* h2 = h1 + 17 * 64;
            for (int i = tid; i < 17 * 33; i += 512) { const int p = i / 33, k = i - 33 * p, t = 16 * tb + p; float val;
                if (k == 0) val = (float)t / (float)(L - 1);
                else { const int bi = (k - 1) & 15; const float band = 1e-4f + (float)bi * ((15.f - 1e-4f) / 15.f);
                    const float w = 2.0f * 3.14159265358979323846f * (float)t / (float)L; const float ang = w * band;
                    val = (k <= 16) ? cosf(ang) : -sinf(ang); }
                zf[p * 36 + k] = val; }
            __syncthreads();
            for (int i = tid; i < 17 * 64; i += 512) { const int p = i >> 6, k = i & 63; float acc = f_b1[k];
#pragma unroll 11
                for (int q = 0; q < 33; ++q) acc += zf[p * 36 + q] * f_w1[q * 64 + k];
                h1[i] = sinf(f_freq[k] * acc); }
            __syncthreads();
            for (int i = tid; i < 17 * 64; i += 512) { const int p = i >> 6, k = i & 63; float acc = f_b2[k];
#pragma unroll 16
                for (int q = 0; q < 64; ++q) acc += h1[p * 64 + q] * f_w2[q * 64 + k];
                h2[i] = sinf(f_freq[k] * acc); }
            __syncthreads();
            const int c = tid; float af[16], ab[16];
#pragma unroll
            for (int p = 0; p < 16; ++p) { af[p] = 0.f; ab[p] = 0.f; }
#pragma unroll 4
            for (int k = 0; k < 64; ++k) { const float wf = f_w3[k * 1024 + c], wb = f_w3[k * 1024 + 512 + c]; float hv[17];
#pragma unroll
                for (int p = 0; p < 17; ++p) hv[p] = h2[p * 64 + k];
#pragma unroll
                for (int p = 0; p < 16; ++p) { af[p] += hv[p] * wf; ab[p] += hv[p + 1] * wb; } }
            const float mind = logf(1e-2f) / 1.5f, maxd = logf(1e-2f) / 0.3f;
            const float delta = fabsf(mind + (maxd - mind) * ((float)c / 511.f));
            unsigned short of[16], ob[16];
#pragma unroll
            for (int p = 0; p < 16; ++p) { const int tf = 16 * tb + p, tbk = tf + 1;
                float vf = af[p] * expf(-((float)tf / (float)(L - 1)) * delta); if (tf == 0) vf += hy_d[c];
                float vb = ab[p] * expf(-((float)tbk / (float)(L - 1)) * delta); if (tbk >= L) vb = 0.f;
                of[15 - p] = (unsigned short)f2bf(vf); ob[p] = (unsigned short)f2bf(vb); }
            bf16_t* gf = GTB + (size_t)c * 8192 + (4080 - 16 * tb); bf16_t* gb = GTB + (size_t)c * 8192 + (4096 + 16 * tb);
            u32x4 w0, w1;
            w0.x = of[0] | ((unsigned)of[1] << 16); w0.y = of[2] | ((unsigned)of[3] << 16); w0.z = of[4] | ((unsigned)of[5] << 16); w0.w = of[6] | ((unsigned)of[7] << 16);
            w1.x = of[8] | ((unsigned)of[9] << 16); w1.y = of[10] | ((unsigned)of[11] << 16); w1.z = of[12] | ((unsigned)of[13] << 16); w1.w = of[14] | ((unsigned)of[15] << 16);
            *(u32x4*)gf = w0; *(u32x4*)(gf + 8) = w1;
            w0.x = ob[0] | ((unsigned)ob[1] << 16); w0.y = ob[2] | ((unsigned)ob[3] << 16); w0.z = ob[4] | ((unsigned)ob[5] << 16); w0.w = ob[6] | ((unsigned)ob[7] << 16);
            w1.x = ob[8] | ((unsigned)ob[9] << 16); w1.y = ob[10] | ((unsigned)ob[11] << 16); w1.z = ob[12] | ((unsigned)ob[13] << 16); w1.w = ob[14] | ((unsigned)ob[15] << 16);
            *(u32x4*)gb = w0; *(u32x4*)(gb + 8) = w1;
        }
    }
    SEAM(0);
    for (int m0 = gw; m0 < NT + NCX; m0 += 4 * NGW) {
        f32x4 v[4][4];
#pragma unroll
        for (int r = 0; r < 4; ++r) { const int m = m0 + r * NGW; if (m < NT + NCX) { const f32x4* xr = (const f32x4*)(m < NT ? x + (size_t)m * D : ctx + (size_t)(m - NT) * D) + lane;
#pragma unroll
                for (int j = 0; j < 4; ++j) v[r][j] = xr[64 * j]; } }
#pragma unroll
        for (int r = 0; r < 4; ++r) { const int m = m0 + r * NGW; if (m < NT + NCX) {
                const float* mb = MOD + (size_t)(m < NT ? (m >> 12) : 8) * INC; bf16_t* orow = m < NT ? HLAT + (size_t)m * D : HCTX + (size_t)(m - NT) * D;
                float s = 0.f;
#pragma unroll
                for (int j = 0; j < 4; ++j) s += (v[r][j].x * v[r][j].x + v[r][j].y * v[r][j].y) + (v[r][j].z * v[r][j].z + v[r][j].w * v[r][j].w);
                const float rs = rsqrtf(wave_sum(s) * (1.f / D) + EPS);
                unsigned long long* o8 = (unsigned long long*)orow + lane;
#pragma unroll
                for (int j = 0; j < 4; ++j) { const f32x4 w = ((const f32x4*)norm_w)[lane + 64 * j], sc = ((const f32x4*)mb)[lane + 64 * j], sh = ((const f32x4*)(mb + D))[lane + 64 * j];
                    const f32x4 o = v[r][j] * rs * w * (1.f + sc) + sh;
                    o8[64 * j] = (unsigned long long)cvtpk(o.x, o.y) | ((unsigned long long)cvtpk(o.z, o.w) << 32); } } }
    }
    SEAM(1);
    {
        { pg8::Gemm g{HLAT, WIN, D, D, D}; pg8::StaticOrder S; S.init(NT, 4608, G, bx); pg8::EpiG1 E{PI, PZ, PQ, PG, GATES};
          pg8::gemm_phase(lds, g, S, E); }
        { pg8::Gemm g{WIN + (size_t)4608 * D, HLAT, D, D, D}; pg8::StaticOrder S; S.init(1536, NT, G, bx); pg8::EpiBf16<0> E{PHYT, NT};
          pg8::gemm_phase(lds, g, S, E); }
        { pg8::Gemm g{HCTX, WIN, D, D, D}; pg8::StaticOrder S; S.init(NCX, 1536, G, bx); pg8::EpiBf16<0> E{PCTX, 1536};
          pg8::gemm_phase(lds, g, S, E); }
    }
    SEAM(2);
    {
        float* STATE = (float*)(ws + WS_STATE);
        if (bx < 128) { const int chain = bx >> 1, seg = bx & 1, b = chain >> 3, h = (chain >> 1) & 3, dir = chain & 1; float* st = STATE + (size_t)bx * 16384;
            hgrn_chain_mfma<false>(lds, PCTX + (size_t)b * LC * 1536, 1536, PCTX + (size_t)b * LC * 1536 + (dir ? 1024 : 512), 1536, nullptr, 0, LC, h, dir, LB, nullptr, st, nullptr, 0, LC / 64);
            if (seg) hgrn_chain_mfma<false>(lds, PI + (size_t)b * L * 512, 512, PZ + (size_t)b * L * 1024 + (dir ? 512 : 0), 1024, nullptr, 0, L, h, dir, LB, st, st, nullptr, 0, 32);
            hgrn_chain_mfma<true>(lds, PI + (size_t)b * L * 512, 512, PZ + (size_t)b * L * 1024 + (dir ? 512 : 0), 1024, PQ + (size_t)b * L * 512, 512, L, h, dir, LB,
                                  st, nullptr, O2 + ((size_t)dir * NT + (size_t)b * L) * HW, 32 * seg, 32 * seg + 32);
#ifdef PROBE_SCAN2
            hgrn_chain_mfma<true>(lds, PI + (size_t)b * L * 512, 512, PZ + (size_t)b * L * 1024 + (dir ? 512 : 0), 1024, PQ + (size_t)b * L * 512, 512, L, h, dir, LB,
                                  st, nullptr, O2 + ((size_t)dir * NT + (size_t)b * L) * HW, 32 * seg, 32 * seg + 32, PROBE_SCAN2);
#endif
        } else {
            LAS float* scr = (LAS float*)(lds + wave * 16384);
            constexpr int I_PA = 8 * 32, I_OUT = 16 * 32, I_1 = 16 * 128, I_2 = 64 * 32;
            for (int it = (bx - 128) * 8 + wave; it < 2 * I_PA + I_OUT + I_1 + I_2; it += (G - 128) * 8) {
                int r = it;
                if (r < I_PA) { transpose_item(w_pa, D, WPAB, D, 0, 0, scr, r, lane); continue; } r -= I_PA;
                if (r < I_PA) { transpose_item(w_pb, D, WPAB, D, 512, 0, scr, r, lane); continue; } r -= I_PA;
                if (r < I_OUT) { transpose_item(w_out, D, WOUT, D, 0, 0, scr, r, lane); continue; } r -= I_OUT;
                if (r < I_1) { transpose_item(w_mlp1, FF, W1, D, 0, 0, scr, r, lane); continue; } r -= I_1;
                transpose_item(w_mlp2, D, W2, FF, 0, 0, scr, r, lane);
            }
        }
        unsigned* hctr = (unsigned*)(ws + 36864);
        for (;;) {
            __syncthreads();
            if (tid == 0) MISC[4] = atomicAdd(hctr, 1u);
            __syncthreads();
            const int c = (int)MISC[4];
            if (c >= HW) break;
            hyena_channel(lds, c, PHYT, GTB, hy_sw, hy_sb);
        }
    }
    SEAM(4);
    {
        const f32x4 gn0 = ((const f32x4*)g_norm)[(2 * lane) & 31], gn1 = ((const f32x4*)g_norm)[(2 * lane + 1) & 31];
        for (int t0 = gw; t0 < NT; t0 += 2 * NGW) {
            f32x4 of[2][2], ob[2][2]; u32x4 pg[2];
#pragma unroll
            for (int r = 0; r < 2; ++r) { const int t = t0 + r * NGW; if (t < NT) {
                    of[r][0] = ((const f32x4*)(O2 + (size_t)t * HW))[2 * lane]; of[r][1] = ((const f32x4*)(O2 + (size_t)t * HW))[2 * lane + 1];
                    ob[r][0] = ((const f32x4*)(O2 + ((size_t)NT + t) * HW))[2 * lane]; ob[r][1] = ((const f32x4*)(O2 + ((size_t)NT + t) * HW))[2 * lane + 1];
                    pg[r] = ((const u32x4*)(PG + (size_t)t * 512))[lane]; } }
#pragma unroll
            for (int r = 0; r < 2; ++r) { const int t = t0 + r * NGW; if (t < NT) {
                    const f32x4 a0 = of[r][0] + ob[r][0], a1 = of[r][1] + ob[r][1];
                    float s = (a0.x * a0.x + a0.y * a0.y) + (a0.z * a0.z + a0.w * a0.w) + (a1.x * a1.x + a1.y * a1.y) + (a1.z * a1.z + a1.w * a1.w);
                    s += __shfl_xor(s, 1); s += __shfl_xor(s, 2); s += __shfl_xor(s, 4); s += __shfl_xor(s, 8);
                    const float rs = rsqrtf(s * (1.f / 128.f) + EPS);
                    u32x4 o;
                    o.x = cvtpk(a0.x * rs * gn0.x * pg8::bflo(pg[r].x), a0.y * rs * gn0.y * pg8::bfhi(pg[r].x)); o.y = cvtpk(a0.z * rs * gn0.z * pg8::bflo(pg[r].y), a0.w * rs * gn0.w * pg8::bfhi(pg[r].y));
                    o.z = cvtpk(a1.x * rs * gn1.x * pg8::bflo(pg[r].z), a1.y * rs * gn1.y * pg8::bfhi(pg[r].z)); o.w = cvtpk(a1.z * rs * gn1.z * pg8::bflo(pg[r].w), a1.w * rs * gn1.w * pg8::bfhi(pg[r].w));
                    *(u32x4*)(AY + (size_t)t * 1024 + 8 * lane) = o; } }
        }
    }
    {
        LAS bf16_t* tl = (LAS bf16_t*)(lds + wave * 16384);
        for (int it = gw; it < 8 * 512; it += NGW) { const int c0 = (it & 7) * 64, tok0 = (it >> 3) * 64;
#pragma unroll
            for (int i = 0; i < 8; ++i) { const int ch = lane + 64 * i, rr = ch >> 3, cc = (ch & 7) * 8;
                const u32x4 v = *(const u32x4*)(PHYT + (size_t)(1024 + c0 + rr) * NT + tok0 + cc);
                LAS unsigned* d = (LAS unsigned*)(tl + rr * 66 + cc); d[0] = v.x; d[1] = v.y; d[2] = v.z; d[3] = v.w; }
            LDS_WAIT();
#pragma unroll
            for (int i = 0; i < 8; ++i) { const int ch = lane + 64 * i, tt = ch >> 3, cc = (ch & 7) * 8; unsigned o[4];
#pragma unroll
                for (int q = 0; q < 4; ++q) o[q] = (unsigned)tl[(cc + 2 * q) * 66 + tt] | ((unsigned)tl[(cc + 2 * q + 1) * 66 + tt] << 16);
                *(u32x4*)(AY + (size_t)(tok0 + tt) * 1024 + 512 + c0 + cc) = (u32x4){o[0], o[1], o[2], o[3]}; }
            LDS_WAIT();
        }
    }
    SEAM(5);
    {
        { pg8::Gemm g{AY, WPAB, D, D, 512}; pg8::StaticOrder S; S.init(NT, D, G, bx); pg8::EpiMerge<0> E{MERGED, GATES, 0}; pg8::gemm_phase(lds, g, S, E); }
        { pg8::Gemm g{AY + 512, WPAB + 512, D, D, 512}; pg8::StaticOrder S; S.init(NT, D, G, bx); pg8::EpiMerge<1> E{MERGED, GATES, 1024}; pg8::gemm_phase(lds, g, S, E); }
    }
    SEAM(6);
    { pg8::Gemm g{MERGED, WOUT, D, D, D}; pg8::StaticOrder S; S.init(NT, D, G, bx); pg8::EpiBf16<0> E{MIX, D}; pg8::gemm_phase(lds, g, S, E); }
    SEAM(7);
    for (int m0 = gw; m0 < NT; m0 += 2 * NGW) {
        f32x4 xv[2][4]; u32x2 mx[2][4];
#pragma unroll
        for (int r = 0; r < 2; ++r) { const int m = m0 + r * NGW; if (m < NT) {
#pragma unroll
                for (int j = 0; j < 4; ++j) { xv[r][j] = ((const f32x4*)(x + (size_t)m * D))[lane + 64 * j]; mx[r][j] = *(const u32x2*)(MIX + (size_t)m * D + 4 * lane + 256 * j); } } }
#pragma unroll
        for (int r = 0; r < 2; ++r) { const int m = m0 + r * NGW; if (m < NT) { const float* mb = MOD + (size_t)(m >> 12) * INC;
                f32x4 mv[4], x1[4]; float s = 0.f;
#pragma unroll
                for (int j = 0; j < 4; ++j) { mv[j] = (f32x4){pg8::bflo(mx[r][j].x), pg8::bfhi(mx[r][j].x), pg8::bflo(mx[r][j].y), pg8::bfhi(mx[r][j].y)}; s += (mv[j].x * mv[j].x + mv[j].y * mv[j].y) + (mv[j].z * mv[j].z + mv[j].w * mv[j].w); }
                const float r1 = rsqrtf(wave_sum(s) * (1.f / D) + EPS); float s2 = 0.f;
#pragma unroll
                for (int j = 0; j < 4; ++j) { const f32x4 w = ((const f32x4*)(norm_w + D))[lane + 64 * j], g = ((const f32x4*)(mb + 2 * D))[lane + 64 * j];
                    x1[j] = xv[r][j] + g * (mv[j] * r1 * w); s2 += (x1[j].x * x1[j].x + x1[j].y * x1[j].y) + (x1[j].z * x1[j].z + x1[j].w * x1[j].w); }
                const float r2 = rsqrtf(wave_sum(s2) * (1.f / D) + EPS);
                unsigned long long* o8 = (unsigned long long*)(HL + (size_t)m * D) + lane;
#pragma unroll
                for (int j = 0; j < 4; ++j) { const f32x4 w = ((const f32x4*)(norm_w + 2 * D))[lane + 64 * j], sc = ((const f32x4*)(mb + 3 * D))[lane + 64 * j], sh = ((const f32x4*)(mb + 4 * D))[lane + 64 * j];
                    const f32x4 o = x1[j] * r2 * w * (1.f + sc) + sh;
                    o8[64 * j] = (unsigned long long)cvtpk(o.x, o.y) | ((unsigned long long)cvtpk(o.z, o.w) << 32); } } }
    }
    SEAM(8);
    { pg8::Gemm g{HL, W1, D, D, D}; pg8::StaticOrder S; S.init(NT, FF, G, bx); pg8::EpiBf16<3> E{H1, FF}; pg8::gemm_phase(lds, g, S, E); }
    SEAM(9);
    { pg8::Gemm g{H1, W2, FF, FF, FF}; pg8::StaticOrder S; S.init(NT, D, G, bx); pg8::EpiBf16<0> E{MLP, D}; pg8::gemm_phase(lds, g, S, E); }
    SEAM(10);
    for (int m0 = gw; m0 < NT; m0 += 2 * NGW) {
        f32x4 xv[2][4]; u32x2 mx[2][4], ml[2][4];
#pragma unroll
        for (int r = 0; r < 2; ++r) { const int m = m0 + r * NGW; if (m < NT) {
#pragma unroll
                for (int j = 0; j < 4; ++j) { xv[r][j] = ((const f32x4*)(x + (size_t)m * D))[lane + 64 * j]; mx[r][j] = *(const u32x2*)(MIX + (size_t)m * D + 4 * lane + 256 * j);
                    ml[r][j] = *(const u32x2*)(MLP + (size_t)m * D + 4 * lane + 256 * j); } } }
#pragma unroll
        for (int r = 0; r < 2; ++r) { const int m = m0 + r * NGW; if (m < NT) { const float* mb = MOD + (size_t)(m >> 12) * INC;
                f32x4 mv[4], lv[4]; float s = 0.f, s3 = 0.f;
#pragma unroll
                for (int j = 0; j < 4; ++j) { mv[j] = (f32x4){pg8::bflo(mx[r][j].x), pg8::bfhi(mx[r][j].x), pg8::bflo(mx[r][j].y), pg8::bfhi(mx[r][j].y)}; s += (mv[j].x * mv[j].x + mv[j].y * mv[j].y) + (mv[j].z * mv[j].z + mv[j].w * mv[j].w);
                    lv[j] = (f32x4){pg8::bflo(ml[r][j].x), pg8::bfhi(ml[r][j].x), pg8::bflo(ml[r][j].y), pg8::bfhi(ml[r][j].y)}; s3 += (lv[j].x * lv[j].x + lv[j].y * lv[j].y) + (lv[j].z * lv[j].z + lv[j].w * lv[j].w); }
                const float r1 = rsqrtf(wave_sum(s) * (1.f / D) + EPS), r3 = rsqrtf(wave_sum(s3) * (1.f / D) + EPS);
#pragma unroll
                for (int j = 0; j < 4; ++j) { const f32x4 w1 = ((const f32x4*)(norm_w + D))[lane + 64 * j], g2 = ((const f32x4*)(mb + 2 * D))[lane + 64 * j];
                    const f32x4 w3 = ((const f32x4*)(norm_w + 3 * D))[lane + 64 * j], g5 = ((const f32x4*)(mb + 5 * D))[lane + 64 * j];
                    const f32x4 x1 = xv[r][j] + g2 * (mv[j] * r1 * w1);
                    ((f32x4*)(P.out + (size_t)m * D))[lane + 64 * j] = x1 + g5 * (lv[j] * r3 * w3); } } }
    }
#if PROBE_MASK
    { const unsigned long long _t = __builtin_amdgcn_s_memrealtime(); if ((PROBE_MASK >> 11) & 1) t_spin += _t - t_prev;
      if (bx == 0) { const unsigned long long t0 = __builtin_amdgcn_s_memrealtime(); while (__builtin_amdgcn_s_memrealtime() - t0 < t_spin) __builtin_amdgcn_s_sleep(8); } }
#endif
#if PROBE_XSYNC
    for (int i = 0; i < PROBE_XSYNC; ++i) grid.sync();
#endif
}
}

extern "C" void kernel_launch(void* const* d_in, const int* in_sizes, int n_in, void* d_out, int out_size, void* d_ws, size_t ws_size, hipStream_t stream) {
    static int grid = 0;
    if (grid == 0) {
        if (n_in != 24 || ws_size < WS_END) { fprintf(stderr, "kernel_launch: unexpected n_in %d / ws_size %zu\n", n_in, ws_size); grid = -1; return; }
        int dev = 0, cus = 0, per_cu = 0;
        hipGetDevice(&dev); hipDeviceGetAttribute(&cus, hipDeviceAttributeMultiprocessorCount, dev);
        hipFuncSetAttribute((const void*)mega, hipFuncAttributeMaxDynamicSharedMemorySize, LDS_BYTES);
        hipOccupancyMaxActiveBlocksPerMultiprocessor(&per_cu, (const void*)mega, 512, LDS_BYTES);
        if (per_cu < 1) { fprintf(stderr, "kernel_launch: occupancy query says %d blocks per CU\n", per_cu); grid = -1; return; }
        grid = cus;
    }
    if (grid < 0) return;
    if (hipMemsetAsync(d_ws, 0, 327680, stream) != hipSuccess) { fprintf(stderr, "kernel_launch: memset failed\n"); return; }
    Params p{};
    for (int i = 0; i < 24; ++i) p.in[i] = (const float*)d_in[i];
    p.out = (float*)d_out; p.ws = (unsigned char*)d_ws;
    void* args[] = {&p};
    hipError_t e = hipLaunchCooperativeKernel((const void*)mega, dim3(grid), dim3(512), args, LDS_BYTES, stream);
    if (e != hipSuccess) fprintf(stderr, "cooperative launch failed: %s (grid %d)\n", hipGetErrorString(e), grid);
}
```

```cpp
#include <hip/hip_runtime.h>
#include <hip/hip_cooperative_groups.h>
#include <cstdio>
#include <math.h>
namespace cg = cooperative_groups;
#ifndef PROBE_MASK
#define PROBE_MASK 0
#endif
#ifndef PROBE_XSYNC
#define PROBE_XSYNC 0
#endif

namespace pg8 {
#define PG8_LAS __attribute__((address_space(3)))
typedef unsigned short bf16_t;
typedef short bf16x8 __attribute__((ext_vector_type(8)));
typedef float f32x4 __attribute__((ext_vector_type(4)));
typedef unsigned u32x4 __attribute__((ext_vector_type(4)));
typedef unsigned u32x2 __attribute__((ext_vector_type(2)));
constexpr int BM = 256, BK = 64, HALF = 128, HTB = HALF * BK * 2, STAGE_BYTES = 8 * HTB, NXCD = 8, WGM = 8;

__device__ __forceinline__ int lds_byte(int r, int c) { const int st = (r >> 4) * 2 + (c >> 5), rr = r & 15, cc = c & 31, ob = rr * 64 + cc * 2; return st * 1024 + (ob ^ (((ob >> 9) & 1) << 5)); }
__device__ __forceinline__ void stage_rc(int b, int& R, int& C) { const int st = b / 1024, sb = b % 1024, swz = sb ^ (((sb >> 9) & 1) << 5); R = (st >> 1) * 16 + swz / 64; C = (st & 1) * 32 + (swz % 64) / 2; }
__device__ __forceinline__ int perm32(int rho) { const int n = rho >> 4, i = rho & 15; return 8 * (i >> 2) + 4 * n + (i & 3); }

struct Unit { int pm, pn, kb, pass; };
struct Gemm { const bf16_t* A; const bf16_t* Bt; int lda, ldb, K; };

struct StaticOrder {
    int nM, nN, nwg, G, c;
    __device__ void init(int M, int N, int G_, int c_) { nM = M / BM; nN = N / BM; nwg = nM * nN; G = G_; c = c_; }
    __device__ bool next(int i, Unit& u) const {
        const long L = (long)i * G + c; if (L >= nwg) return false;
        int wgid = (int)L; { const int q = nwg / NXCD, r = nwg % NXCD, xcd = wgid % NXCD, off = wgid / NXCD; wgid = (xcd < r ? xcd * (q + 1) : r * (q + 1) + (xcd - r) * q) + off; }
        const int nig = WGM * nN, gid = wgid / nig, fm = gid * WGM, gsz = (nM - fm) < WGM ? (nM - fm) : WGM;
        u.pm = fm + ((wgid % nig) % gsz); u.pn = (wgid % nig) / gsz; u.kb = 0; u.pass = 0; return true;
    }
};

struct TwoPassOrder {
    StaticOrder base; int kbytes;
    __device__ bool next(int i, Unit& u) const { if (!base.next(i >> 1, u)) return false; u.pass = i & 1; u.kb = (i & 1) * kbytes; return true; }
};
__device__ __forceinline__ unsigned cvt_pk_bf16(float lo, float hi) { unsigned r; asm volatile("v_cvt_pk_bf16_f32 %0, %1, %2" : "=v"(r) : "v"(lo), "v"(hi)); return r; }
__device__ __forceinline__ float sigm(float x) { return __builtin_amdgcn_rcpf(1.0f + __builtin_amdgcn_exp2f(-1.4426950408889634f * x)); }
__device__ __forceinline__ float bflo(unsigned u) { return __uint_as_float(u << 16); }
__device__ __forceinline__ float bfhi(unsigned u) { return __uint_as_float(u & 0xffff0000u); }

template <int ACT  > struct EpiBf16 {
    static constexpr bool PERM = true;
    bf16_t* O; int ldc;
    __device__ __forceinline__ void operator()(const f32x4 (&acc)[2][2][4][2], const Unit& u, int wr, int wc, int fr, int fq) const {
        const int row0 = u.pm * BM + wr * 64 + fr, col0 = u.pn * BM + wc * 32 + 8 * fq;
#pragma unroll
        for (int ai = 0; ai < 2; ++ai)
#pragma unroll
            for (int m = 0; m < 4; ++m) { bf16_t* rowp = O + (size_t)(row0 + ai * HALF + m * 16) * ldc + col0;
#pragma unroll
                for (int bj = 0; bj < 2; ++bj) { f32x4 v0 = acc[ai][bj][m][0], v1 = acc[ai][bj][m][1];
                    if (ACT == 3) {
#pragma unroll
                        for (int j = 0; j < 4; ++j) { const float a = fmaxf(v0[j], 0.f), b = fmaxf(v1[j], 0.f); v0[j] = a * a; v1[j] = b * b; } }
                    u32x4 w; w.x = cvt_pk_bf16(v0[0], v0[1]); w.y = cvt_pk_bf16(v0[2], v0[3]); w.z = cvt_pk_bf16(v1[0], v1[1]); w.w = cvt_pk_bf16(v1[2], v1[3]);
                    *(u32x4*)(rowp + bj * HALF) = w; } }
    }
};
struct EpiG1 {
    static constexpr bool PERM = true;
    bf16_t *PI, *PZ, *PQ, *PG, *GATES; const float* LBv; int ctx;
    __device__ __forceinline__ void operator()(const f32x4 (&acc)[2][2][4][2], const Unit& u, int wr, int wc, int fr, int fq) const {
        const int pn = u.pn; bf16_t* base; int ld, cb, act;
        if (ctx) { base = PI; ld = 1536; cb = pn * 256; act = pn < 2 ? 0 : 3; }
        else if (pn < 2) { base = PI; ld = 512; cb = pn * 256; act = 0; }
        else if (pn < 6) { base = PZ; ld = 1024; cb = (pn - 2) * 256; act = 3; }
        else if (pn < 8) { base = PQ; ld = 512; cb = (pn - 6) * 256; act = 1; }
        else if (pn < 10) { base = PG; ld = 512; cb = (pn - 8) * 256; act = 1; }
        else { base = GATES; ld = 2048; cb = (pn - 10) * 128; act = 2; }
        const int row0 = u.pm * BM + wr * 64 + fr, col0 = cb + wc * 32 + 8 * fq;
        if (act == 2) {
#pragma unroll
            for (int ai = 0; ai < 2; ++ai)
#pragma unroll
                for (int m = 0; m < 4; ++m) { bf16_t* rowp = base + (size_t)(row0 + ai * HALF + m * 16) * ld + col0; f32x4 rh[2], gb[2];
#pragma unroll
                    for (int n = 0; n < 2; ++n)
#pragma unroll
                        for (int j = 0; j < 4; ++j) { const float eA = __builtin_amdgcn_exp2f(-1.4426950408889634f * acc[ai][0][m][n][j]), eB = __builtin_amdgcn_exp2f(-1.4426950408889634f * acc[ai][1][m][n][j]);
                            gb[n][j] = __builtin_amdgcn_rcpf(1.0f + eB); rh[n][j] = (1.0f + eB) * __builtin_amdgcn_rcpf(1.0f + eA); }
                    u32x4 w; w.x = cvt_pk_bf16(rh[0][0], rh[0][1]); w.y = cvt_pk_bf16(rh[0][2], rh[0][3]); w.z = cvt_pk_bf16(rh[1][0], rh[1][1]); w.w = cvt_pk_bf16(rh[1][2], rh[1][3]);
                    *(u32x4*)rowp = w;
                    w.x = cvt_pk_bf16(gb[0][0], gb[0][1]); w.y = cvt_pk_bf16(gb[0][2], gb[0][3]); w.z = cvt_pk_bf16(gb[1][0], gb[1][1]); w.w = cvt_pk_bf16(gb[1][2], gb[1][3]);
                    *(u32x4*)(rowp + 1024) = w; }
            return;
        }
        f32x4 om[2][2];
        if (act == 3) {
#pragma unroll
            for (int bj = 0; bj < 2; ++bj)
#pragma unroll
                for (int n = 0; n < 2; ++n) { const f32x4 l = *(const f32x4*)(LBv + ((col0 + bj * HALF + 4 * n) & 511)); om[bj][n] = (f32x4){1.f - l.x, 1.f - l.y, 1.f - l.z, 1.f - l.w}; } }
#pragma unroll
        for (int ai = 0; ai < 2; ++ai)
#pragma unroll
            for (int m = 0; m < 4; ++m) { bf16_t* rowp = base + (size_t)(row0 + ai * HALF + m * 16) * ld + col0;
#pragma unroll
                for (int bj = 0; bj < 2; ++bj) { f32x4 v0 = acc[ai][bj][m][0], v1 = acc[ai][bj][m][1];
                    if (act == 3) {
#pragma unroll
                        for (int j = 0; j < 4; ++j) { v0[j] = om[bj][0][j] * sigm(-v0[j]); v1[j] = om[bj][1][j] * sigm(-v1[j]); } }
                    else if (act != 0) {
#pragma unroll
                        for (int j = 0; j < 4; ++j) { const float s0 = sigm(v0[j]), s1 = sigm(v1[j]); v0[j] = act == 1 ? v0[j] * s0 : s0; v1[j] = act == 1 ? v1[j] * s1 : s1; } }
                    u32x4 w; w.x = cvt_pk_bf16(v0[0], v0[1]); w.y = cvt_pk_bf16(v0[2], v0[3]); w.z = cvt_pk_bf16(v1[0], v1[1]); w.w = cvt_pk_bf16(v1[2], v1[3]);
                    *(u32x4*)(rowp + bj * HALF) = w; } }
    }
};
struct EpiMerge2 {
    static constexpr bool PERM = true;
    bf16_t* O; const bf16_t* RG;
    __device__ __forceinline__ void operator()(f32x4 (&acc)[2][2][4][2], const Unit& u, int wr, int wc, int fr, int fq) const {
        const int row0 = u.pm * BM + wr * 64 + fr, col0 = u.pn * BM + wc * 32 + 8 * fq; const int goff = u.pass ? 1024 : 0;
#pragma unroll
        for (int ai = 0; ai < 2; ++ai)
#pragma unroll
            for (int m = 0; m < 4; ++m) { const size_t r = (size_t)(row0 + ai * HALF + m * 16);
#pragma unroll
                for (int bj = 0; bj < 2; ++bj) { f32x4 v0 = acc[ai][bj][m][0], v1 = acc[ai][bj][m][1];
                    const u32x4 g = *(const u32x4*)(RG + r * 2048 + goff + col0 + bj * HALF);
                    v0[0] *= bflo(g.x); v0[1] *= bfhi(g.x); v0[2] *= bflo(g.y); v0[3] *= bfhi(g.y); v1[0] *= bflo(g.z); v1[1] *= bfhi(g.z); v1[2] *= bflo(g.w); v1[3] *= bfhi(g.w);
                    if (u.pass == 0) { acc[ai][bj][m][0] = v0; acc[ai][bj][m][1] = v1; }
                    else { u32x4 w; w.x = cvt_pk_bf16(v0[0], v0[1]); w.y = cvt_pk_bf16(v0[2], v0[3]); w.z = cvt_pk_bf16(v1[0], v1[1]); w.w = cvt_pk_bf16(v1[2], v1[3]);
                        *(u32x4*)(O + r * 1024 + col0 + bj * HALF) = w; } } }
    }
};

#ifndef PG8_SP2
#define PG8_SP2 true
#endif
#ifndef PG8_ALIGN
#define PG8_ALIGN true
#endif
template <class Epi, class Sched, bool ALIGN_EPI = PG8_ALIGN, bool SP2 = PG8_SP2>
__device__ __forceinline__ void gemm_phase(PG8_LAS unsigned char* lds, const Gemm g, const Sched& S, const Epi& E) {
    const int tid = threadIdx.x, wid = __builtin_amdgcn_readfirstlane(tid >> 6), lane = tid & 63, wr = wid >> 2, wc = wid & 3, fr = lane & 15, fq = lane >> 4;
    const int nt = g.K / BK;
    unsigned voffA[2], voffB[2];
#pragma unroll
    for (int i = 0; i < 2; ++i) { int R, C; stage_rc(tid * 16 + i * 8192, R, C); const int Rb = Epi::PERM ? ((R & ~31) + perm32(R & 31)) : R;
        voffA[i] = (unsigned)(R * g.lda + C) * 2u; voffB[i] = (unsigned)(Rb * g.ldb + C) * 2u; }
    const size_t kstep = (size_t)(BK * 2);
    const size_t hstepA = (size_t)HALF * g.lda * 2, hstepB = (size_t)HALF * g.ldb * 2;
    const size_t tstepA = 2 * hstepA, tstepB = 2 * hstepB;
    const unsigned ldsw = (unsigned)wid * 1024u;
    const int aoff = lds_byte(wr * 64 + fr, fq * 8), boff = lds_byte(wc * 32 + fr, fq * 8);
#define PG8_SA(b, h) (((b) * 2 + (h)) * HTB)
#define PG8_SB(b, h) ((4 + (b) * 2 + (h)) * HTB)
#define PG8_STAGE(bufoff, gbase, voff) do { _Pragma("unroll") for (int _i = 0; _i < 2; ++_i) \
        __builtin_amdgcn_global_load_lds((const unsigned*)((const char*)(gbase) + (voff)[_i]), (PG8_LAS unsigned*)(lds + (bufoff) + ldsw + _i * 8192), 16, 0, 0); } while (0)
#define PG8_LDA(dst, b, h) do { _Pragma("unroll") for (int m = 0; m < 4; ++m) _Pragma("unroll") for (int k = 0; k < 2; ++k) dst[m][k] = *(const PG8_LAS bf16x8*)(lds + PG8_SA(b, h) + aoff + m * 2048 + k * 1024); } while (0)
#define PG8_LDB(dst, b, h) do { _Pragma("unroll") for (int n = 0; n < 2; ++n) _Pragma("unroll") for (int k = 0; k < 2; ++k) dst[n][k] = *(const PG8_LAS bf16x8*)(lds + PG8_SB(b, h) + boff + n * 2048 + k * 1024); } while (0)
#define PG8_MMA(ai, bj, At, Bt) do { __builtin_amdgcn_s_setprio(1); _Pragma("unroll") for (int m = 0; m < 4; ++m) _Pragma("unroll") for (int n = 0; n < 2; ++n) _Pragma("unroll") for (int k = 0; k < 2; ++k) \
        acc[ai][bj][m][n] = __builtin_amdgcn_mfma_f32_16x16x32_bf16(Bt[n][k], At[m][k], acc[ai][bj][m][n], 0, 0, 0); __builtin_amdgcn_s_setprio(0); } while (0)
#define PG8_WAIT_V(n) asm volatile("s_waitcnt vmcnt(" #n ")" ::: "memory")
#define PG8_WAIT_L(n) asm volatile("s_waitcnt lgkmcnt(" #n ")" ::: "memory")
#define PG8_BAR __builtin_amdgcn_s_barrier()
#define PG8_SCHED __builtin_amdgcn_sched_barrier(0)
    Unit cur, nxt; int ui = 0;
    if (!S.next(0, cur)) return;
    f32x4 acc[2][2][4][2];
#pragma unroll
    for (int a = 0; a < 2; ++a)
#pragma unroll
        for (int b = 0; b < 2; ++b)
#pragma unroll
            for (int m = 0; m < 4; ++m)
#pragma unroll
                for (int n = 0; n < 2; ++n) acc[a][b][m][n] = (f32x4){0.f, 0.f, 0.f, 0.f};
    bf16x8 At[4][2], B0[2][2], B1[2][2];
    const char* cA = (const char*)g.A + (size_t)cur.pm * tstepA + cur.kb; const char* cB = (const char*)g.Bt + (size_t)cur.pn * tstepB + cur.kb;
    if constexpr (SP2) {
        PG8_STAGE(PG8_SB(0, 0), cB, voffB); PG8_STAGE(PG8_SB(0, 1), cB + hstepB, voffB); PG8_STAGE(PG8_SA(0, 0), cA, voffA); PG8_STAGE(PG8_SA(0, 1), cA + hstepA, voffA);
        if (wr == 1) PG8_BAR;
        PG8_WAIT_V(2); PG8_BAR;
        PG8_STAGE(PG8_SB(1, 0), cB + kstep, voffB); PG8_STAGE(PG8_SA(1, 0), cA + kstep, voffA); PG8_STAGE(PG8_SB(1, 1), cB + hstepB + kstep, voffB);
        PG8_WAIT_V(6); PG8_BAR;
    } else {
        PG8_STAGE(PG8_SB(0, 0), cB, voffB); PG8_STAGE(PG8_SA(0, 0), cA, voffA); PG8_STAGE(PG8_SB(0, 1), cB + hstepB, voffB); PG8_STAGE(PG8_SA(0, 1), cA + hstepA, voffA);
        if (wr == 1) PG8_BAR;
        PG8_WAIT_V(4); PG8_BAR;
        PG8_STAGE(PG8_SB(1, 0), cB + kstep, voffB); PG8_STAGE(PG8_SA(1, 0), cA + kstep, voffA); PG8_STAGE(PG8_SB(1, 1), cB + hstepB + kstep, voffB);
        PG8_WAIT_V(6); PG8_BAR;
    }
    for (;;) {
        const bool has_next = S.next(ui + 1, nxt);
        const char* nA = has_next ? (const char*)g.A + (size_t)nxt.pm * tstepA + nxt.kb : cA; const char* nB = has_next ? (const char*)g.Bt + (size_t)nxt.pn * tstepB + nxt.kb : cB;
        for (int t = 0; t < nt; t += 2) {
            const bool last = (t == nt - 2);
            const char* a1 = cA + (size_t)(t + 1) * kstep;
            const char* a2 = last ? nA : cA + (size_t)(t + 2) * kstep; const char* b2 = last ? nB : cB + (size_t)(t + 2) * kstep;
            const char* a3 = a2 + kstep; const char* b3 = b2 + kstep;
            if constexpr (SP2) {
            PG8_LDB(B0, 0, 0); PG8_LDB(B1, 0, 1); PG8_SCHED; PG8_LDA(At, 0, 0); PG8_STAGE(PG8_SA(1, 1), a1 + hstepA, voffA);
            PG8_WAIT_V(8); PG8_WAIT_L(0); PG8_BAR; PG8_MMA(0, 0, At, B0); PG8_MMA(0, 1, At, B1); PG8_BAR; PG8_SCHED;
            PG8_LDA(At, 0, 1); PG8_STAGE(PG8_SB(0, 0), b2, voffB); PG8_STAGE(PG8_SB(0, 1), b2 + hstepB, voffB); PG8_STAGE(PG8_SA(0, 0), a2, voffA);
            PG8_WAIT_V(8); PG8_WAIT_L(0); PG8_BAR; PG8_MMA(1, 0, At, B0); PG8_MMA(1, 1, At, B1); PG8_BAR; PG8_SCHED;
            PG8_LDB(B0, 1, 0); PG8_LDB(B1, 1, 1); PG8_SCHED; PG8_LDA(At, 1, 0); PG8_STAGE(PG8_SA(0, 1), a2 + hstepA, voffA);
            PG8_WAIT_V(8); PG8_WAIT_L(0); PG8_BAR; PG8_MMA(0, 0, At, B0); PG8_MMA(0, 1, At, B1); PG8_BAR; PG8_SCHED;
            PG8_LDA(At, 1, 1); PG8_STAGE(PG8_SB(1, 0), b3, voffB); PG8_STAGE(PG8_SB(1, 1), b3 + hstepB, voffB); PG8_STAGE(PG8_SA(1, 0), a3, voffA);
            PG8_WAIT_V(8); PG8_WAIT_L(0); PG8_BAR; PG8_MMA(1, 0, At, B0); PG8_MMA(1, 1, At, B1); PG8_BAR; PG8_SCHED;
            } else {
            PG8_LDB(B0, 0, 0); PG8_SCHED; PG8_LDA(At, 0, 0); PG8_STAGE(PG8_SA(1, 1), a1 + hstepA, voffA);
            PG8_WAIT_L(8); PG8_BAR; PG8_WAIT_L(0); PG8_MMA(0, 0, At, B0); PG8_BAR; PG8_SCHED;
            PG8_LDB(B1, 0, 1); PG8_STAGE(PG8_SB(0, 0), b2, voffB);
            PG8_BAR; PG8_WAIT_L(0); PG8_MMA(0, 1, At, B1); PG8_BAR;
            PG8_LDA(At, 0, 1); PG8_STAGE(PG8_SA(0, 0), a2, voffA);
            PG8_BAR; PG8_WAIT_L(0); PG8_MMA(1, 0, At, B0); PG8_BAR; PG8_SCHED;
            PG8_STAGE(PG8_SB(0, 1), b2 + hstepB, voffB);
            PG8_WAIT_V(6); PG8_BAR; PG8_MMA(1, 1, At, B1); PG8_BAR;
            PG8_LDB(B0, 1, 0); PG8_SCHED; PG8_LDA(At, 1, 0); PG8_STAGE(PG8_SA(0, 1), a2 + hstepA, voffA);
            PG8_WAIT_L(8); PG8_BAR; PG8_WAIT_L(0); PG8_MMA(0, 0, At, B0); PG8_BAR; PG8_SCHED;
            PG8_LDB(B1, 1, 1); PG8_STAGE(PG8_SB(1, 0), b3, voffB);
            PG8_BAR; PG8_WAIT_L(0); PG8_MMA(0, 1, At, B1); PG8_BAR;
            PG8_LDA(At, 1, 1); PG8_STAGE(PG8_SA(1, 0), a3, voffA);
            PG8_BAR; PG8_WAIT_L(0); PG8_MMA(1, 0, At, B0); PG8_BAR; PG8_SCHED;
            PG8_STAGE(PG8_SB(1, 1), b3 + hstepB, voffB);
            PG8_WAIT_V(6); PG8_BAR; PG8_MMA(1, 1, At, B1); PG8_BAR;
                    }
        }
        if constexpr (ALIGN_EPI) { if (wr == 0) PG8_BAR; }
        E(acc, cur, wr, wc, fr, fq);
        if (!has_next) break;
        if (nxt.pass == 0) {
#pragma unroll
        for (int a = 0; a < 2; ++a)
#pragma unroll
            for (int b = 0; b < 2; ++b)
#pragma unroll
                for (int m = 0; m < 4; ++m)
#pragma unroll
                    for (int n = 0; n < 2; ++n) acc[a][b][m][n] = (f32x4){0.f, 0.f, 0.f, 0.f};
        }
        cur = nxt; cA = nA; cB = nB; ++ui;
        if constexpr (ALIGN_EPI) { if (wr == 1) PG8_BAR; }
    }
    PG8_WAIT_V(0);
    if constexpr (!ALIGN_EPI) { if (wr == 0) PG8_BAR; }
    PG8_BAR;
#undef PG8_SA
#undef PG8_SB
#undef PG8_STAGE
#undef PG8_LDA
#undef PG8_LDB
#undef PG8_MMA
#undef PG8_WAIT_V
#undef PG8_WAIT_L
#undef PG8_BAR
#undef PG8_SCHED
}
}

namespace {
using pg8::bf16_t; using pg8::f32x4; using pg8::u32x4; using pg8::u32x2;
#define LAS __attribute__((address_space(3)))
constexpr int D = 1024, NB = 8, L = 4096, LC = 256, INC = 6144, FF = 4096, HW = 512;
constexpr int NT = NB * L, NCX = NB * LC;
constexpr float EPS = 1e-6f;
constexpr size_t MiB = 1u << 20;
constexpr size_t WS_MOD = 64 * 1024, WS_LB = 512 * 1024, WS_GT = 2 * MiB  ;
constexpr size_t WS_WIN = 18 * MiB, WS_WPAB = 30 * MiB, WS_WOUT = 32 * MiB, WS_W1 = 34 * MiB, WS_W2 = 42 * MiB;
constexpr size_t WS_STATE = 10 * MiB  , WS_HCTX = 50 * MiB, WS_PCTX = 54 * MiB, WS_SCTX = 60 * MiB;
constexpr size_t WS_HLAT = 64 * MiB;
constexpr size_t WS_PI = 128 * MiB, WS_PZ = 160 * MiB, WS_PQ = 224 * MiB, WS_PG = 256 * MiB, WS_GATES = 288 * MiB, WS_PHYT = 416 * MiB;
constexpr size_t WS_AY = 160 * MiB;
constexpr size_t WS_AY2 = 64 * MiB;
constexpr size_t WS_MERGED = 128 * MiB;
constexpr size_t WS_MIX = 448 * MiB, WS_MLP = 384 * MiB, WS_H1 = 128 * MiB, WS_HL = 64 * MiB;
constexpr size_t WS_END = 512 * MiB;
constexpr int LDS_BYTES = 163840;

__device__ __forceinline__ float bf2f(bf16_t h) { return __uint_as_float(((unsigned)h) << 16); }
__device__ __forceinline__ unsigned f2bf(float f) { unsigned u = __float_as_uint(f); return (u + 0x7fffu + ((u >> 16) & 1u)) >> 16; }
__device__ __forceinline__ unsigned pk2(float lo, float hi) { return f2bf(lo) | (f2bf(hi) << 16); }
__device__ __forceinline__ float sigmoidf_(float x) { return 1.f / (1.f + expf(-x)); }
__device__ __forceinline__ float siluf_(float x) { return x / (1.f + expf(-x)); }
__device__ __forceinline__ float wave_sum(float v) {
#pragma unroll
    for (int o = 1; o < 64; o <<= 1) v += __shfl_xor(v, o);
    return v;
}
#define LDS_WAIT() asm volatile("s_waitcnt lgkmcnt(0)" ::: "memory")

struct Params { const float* in[24]; float* out; unsigned char* ws; };

#define XB_TMO      128
#define XB_XCNT(j)  (256  + 64 * (j))
#define XB_XSUB(j)  (1280 + 64 * (j))
#define XB_XGEN(j)  (2304 + 64 * (j))
#define XB_TOP      3328
#define XB_TOPGEN   3392
#define XCD_BAR_WORDS 3456
#define XB_SPIN_CAP (1u << 18)

__device__ __forceinline__ unsigned xb_ld(unsigned* p)              { return __hip_atomic_load(p, __ATOMIC_RELAXED, __HIP_MEMORY_SCOPE_AGENT); }
__device__ __forceinline__ unsigned xb_add(unsigned* p, unsigned v) { return __hip_atomic_fetch_add(p, v, __ATOMIC_RELAXED, __HIP_MEMORY_SCOPE_AGENT); }
__device__ __forceinline__ unsigned xb_xcc_id() { return (unsigned)__builtin_amdgcn_s_getreg((3 << 11) | 20) & 0xFu; }
#define XB_SPIN(cond, bar) do { unsigned _sp = 0; while (cond) { __builtin_amdgcn_s_sleep(1); \
    if ((++_sp & 255u) == 0u) { if (xb_ld(&(bar)[XB_TMO])) break; if (_sp > XB_SPIN_CAP) { atomicAdd(&(bar)[XB_TMO], 1u); break; } } } } while (0)

struct XcdBarrier {
    unsigned* bar; unsigned x;
    volatile LAS unsigned* st;
};

__device__ __forceinline__ XcdBarrier xcd_barrier_post(unsigned* bar, volatile LAS unsigned* st) {
    XcdBarrier b; b.bar = bar; b.x = xb_xcc_id(); b.st = st;
    if (threadIdx.x == 0) (void)xb_add(&bar[XB_XCNT(b.x)], 1u);
    return b;
}
__device__ __forceinline__ void xcd_barrier_complete(unsigned* bar, unsigned x, unsigned& nloc, unsigned& nx) {
    const unsigned G = gridDim.x * gridDim.y * gridDim.z;
    unsigned sum, cnt, mine, sp = 0u;
    for (;;) {
        sum = 0u; cnt = 0u; mine = 0u;
#pragma unroll
        for (unsigned j = 0; j < 16; ++j) { const unsigned c = xb_ld(&bar[XB_XCNT(j)]); sum += c; cnt += (c > 0u) ? 1u : 0u; mine = (j == x) ? c : mine; }
        if (sum == G) break;
        __builtin_amdgcn_s_sleep(1);
        if ((++sp & 255u) == 0u) { if (xb_ld(&bar[XB_TMO])) break; if (sp > XB_SPIN_CAP) { atomicAdd(&bar[XB_TMO], 1u); break; } }
    }
    nloc = mine > 0u ? mine : 1u; nx = cnt > 0u ? cnt : 1u;
}

__device__ __forceinline__ void xcd_barrier(const XcdBarrier& b) {
    asm volatile("s_waitcnt vmcnt(0)" ::: "memory");
    __syncthreads();
    if (threadIdx.x == 0) {
        unsigned* bar = b.bar;
        __builtin_amdgcn_s_waitcnt(0);
        unsigned nloc = b.st[0], nx = b.st[1];
        if (nloc == 0u) { xcd_barrier_complete(bar, b.x, nloc, nx); b.st[0] = nloc; b.st[1] = nx; }
        const unsigned old = xb_add(&bar[XB_XSUB(b.x)], 1u);
        const unsigned gen = old / nloc;
        if (old + 1u == (gen + 1u) * nloc) {
            __builtin_amdgcn_fence(__ATOMIC_RELEASE, "agent");
            asm volatile("s_waitcnt vmcnt(0)" ::: "memory");
            const unsigned og = xb_add(&bar[XB_TOP], 1u);
            const unsigned tg = og / nx;
            if (og + 1u == (tg + 1u) * nx) xb_add(&bar[XB_TOPGEN], 1u);
            else XB_SPIN(xb_ld(&bar[XB_TOPGEN]) == tg, bar);
            __builtin_amdgcn_fence(__ATOMIC_ACQUIRE, "agent");
            xb_add(&bar[XB_XGEN(b.x)], 1u);
            asm volatile("s_waitcnt vmcnt(0)" ::: "memory");
        } else {
            XB_SPIN(xb_ld(&bar[XB_XGEN(b.x)]) == gen, bar);
            __builtin_amdgcn_fence(__ATOMIC_ACQUIRE, "agent");
            asm volatile("s_waitcnt vmcnt(0)" ::: "memory");
        }
    }
    __syncthreads();
}


__device__ __forceinline__ void transpose_item(const float* W, int N, bf16_t* WT, int ldk, int koff, int remap, LAS float* scr, int item, int lane) {
    const int nblk = N / 32, kb = item / nblk, nb = item % nblk, k0 = 64 * kb, n0 = 32 * nb;
    int rbase = n0;
    if (remap) { if (n0 < 2560) rbase = n0; else if (n0 < 4096) rbase = n0 + 2048;
        else { const int g = n0 - 4096, nn = g & 1023; rbase = 2560 + 256 * (nn >> 7) + (g >= 1024 ? 128 : 0) + (nn & 127); } }
#pragma unroll 8
    for (int i = 0; i < 32; ++i) { const int kk = 2 * i + (lane >> 5); scr[kk * 33 + (lane & 31)] = W[(size_t)(k0 + kk) * N + n0 + (lane & 31)]; }
    LDS_WAIT();
    const int c = lane & 7;
#pragma unroll
    for (int j = 0; j < 4; ++j) { const int n = (lane >> 3) + 8 * j; const LAS float* s = scr + (8 * c) * 33 + n;
        u32x4 o; o.x = pk2(s[0 * 33], s[1 * 33]); o.y = pk2(s[2 * 33], s[3 * 33]); o.z = pk2(s[4 * 33], s[5 * 33]); o.w = pk2(s[6 * 33], s[7 * 33]);
        *(u32x4*)(WT + (size_t)(rbase + n) * ldk + koff + k0 + 8 * c) = o; }
    LDS_WAIT();
}

__device__ __forceinline__ void row_norm_mod_bf16(const float* xrow, const float* nw, const float* scale, const float* shift, bf16_t* orow, int lane) {
    const f32x4* xr = (const f32x4*)xrow + lane; f32x4 v[4]; float s = 0.f;
#pragma unroll
    for (int j = 0; j < 4; ++j) { v[j] = xr[64 * j]; s += (v[j].x * v[j].x + v[j].y * v[j].y) + (v[j].z * v[j].z + v[j].w * v[j].w); }
    const float r = rsqrtf(wave_sum(s) * (1.f / D) + EPS);
    unsigned long long* o8 = (unsigned long long*)orow + lane;
#pragma unroll
    for (int j = 0; j < 4; ++j) { const f32x4 w = ((const f32x4*)nw)[lane + 64 * j], sc = ((const f32x4*)scale)[lane + 64 * j], sh = ((const f32x4*)shift)[lane + 64 * j];
        const f32x4 o = v[j] * r * w * (1.f + sc) + sh;
        o8[64 * j] = (unsigned long long)pk2(o.x, o.y) | ((unsigned long long)pk2(o.z, o.w) << 32); }
}
__device__ __forceinline__ f32x4 ld_bf4(const bf16_t* p) { const u32x2 u = *(const u32x2*)p; return (f32x4){pg8::bflo(u.x), pg8::bfhi(u.x), pg8::bflo(u.y), pg8::bfhi(u.y)}; }
__device__ __forceinline__ void row_x1(const float* xrow, const bf16_t* mixrow, const float* nw1, const float* g2, f32x4 (&x1)[4], int lane) {
    f32x4 mv[4]; float s = 0.f;
#pragma unroll
    for (int j = 0; j < 4; ++j) { mv[j] = ld_bf4(mixrow + 4 * lane + 256 * j); s += (mv[j].x * mv[j].x + mv[j].y * mv[j].y) + (mv[j].z * mv[j].z + mv[j].w * mv[j].w); }
    const float r = rsqrtf(wave_sum(s) * (1.f / D) + EPS);
#pragma unroll
    for (int j = 0; j < 4; ++j) { const f32x4 w = ((const f32x4*)nw1)[lane + 64 * j], g = ((const f32x4*)g2)[lane + 64 * j], xv = ((const f32x4*)xrow)[lane + 64 * j];
        x1[j] = xv + g * (mv[j] * r * w); }
}

typedef float f32x16 __attribute__((ext_vector_type(16)));
typedef float f32x2_t __attribute__((ext_vector_type(2)));
typedef __bf16 bf16x2_t __attribute__((ext_vector_type(2)));
__device__ __forceinline__ unsigned cvtpk(float lo, float hi) { const f32x2_t v = {lo, hi}; const bf16x2_t b = __builtin_convertvector(v, bf16x2_t); return __builtin_bit_cast(unsigned, b); }
constexpr int HY_PITCH = 8720;
constexpr int HY_TAB0 = 8 * HY_PITCH;
constexpr int HY_TAB1 = HY_TAB0 + 17408 + 64;
__device__ __forceinline__ void conv8(const u32x4 raw, float left, float right, float w0, float w1, float w2, float bias, float (&o)[8]) {
    float in[10]; in[0] = left; in[9] = right;
    in[1] = pg8::bflo(raw.x); in[2] = pg8::bfhi(raw.x); in[3] = pg8::bflo(raw.y); in[4] = pg8::bfhi(raw.y); in[5] = pg8::bflo(raw.z); in[6] = pg8::bfhi(raw.z); in[7] = pg8::bflo(raw.w); in[8] = pg8::bfhi(raw.w);
#pragma unroll
    for (int j = 0; j < 8; ++j) o[j] = bias + w0 * in[j] + w1 * in[j + 1] + w2 * in[j + 2];
}
__device__ __forceinline__ void hyena_channel(LAS unsigned char* lds, int c, bf16_t* PHYT, const bf16_t* GTB, const float* hy_sw, const float* hy_sb) {
    const int tid = threadIdx.x, lane = tid & 63, wave = __builtin_amdgcn_readfirstlane(tid >> 6);
    const bool hl = (tid & 7) != 0, hr = ((tid + 1) & 7) != 0;
    __syncthreads();
    for (int ci = tid; ci < 1088; ci += 512) { u32x4 v = (u32x4){0u, 0u, 0u, 0u};
        if (ci >= 32 && ci < 1056) v = *(const u32x4*)(GTB + (size_t)c * 8192 + (ci - 32) * 8);
        *(LAS u32x4*)(lds + HY_TAB0 + ci * 16) = v; }
    {
        const bf16_t* x1r = PHYT + (size_t)(512 + c) * NT + 8 * tid; const bf16_t* vr = PHYT + (size_t)(1024 + c) * NT + 8 * tid;
        const float xw0 = hy_sw[512 + c], xw1 = hy_sw[1536 + 512 + c], xw2 = hy_sw[3072 + 512 + c], xb = hy_sb[512 + c];
        const float vw0 = hy_sw[1024 + c], vw1 = hy_sw[1536 + 1024 + c], vw2 = hy_sw[3072 + 1024 + c], vb = hy_sb[1024 + c];
        u32x4 xa[8], va[8];
#pragma unroll
        for (int b = 0; b < 8; ++b) { xa[b] = *(const u32x4*)(x1r + (size_t)b * L); va[b] = *(const u32x4*)(vr + (size_t)b * L); }
#pragma unroll
        for (int b = 0; b < 8; ++b) {
            const unsigned xpw = __shfl_up(xa[b].w, 1), xnx = __shfl_down(xa[b].x, 1), vpw = __shfl_up(va[b].w, 1), vnx = __shfl_down(va[b].x, 1);
            const float xl = hl ? pg8::bfhi(xpw) : 0.f, xr = hr ? pg8::bflo(xnx) : 0.f, vl = hl ? pg8::bfhi(vpw) : 0.f, vrr = hr ? pg8::bflo(vnx) : 0.f;
            float cx[8], cv[8]; conv8(xa[b], xl, xr, xw0, xw1, xw2, xb, cx); conv8(va[b], vl, vrr, vw0, vw1, vw2, vb, cv);
            u32x4 w; w.x = cvtpk(cx[0] * cv[0], cx[1] * cv[1]); w.y = cvtpk(cx[2] * cv[2], cx[3] * cv[3]); w.z = cvtpk(cx[4] * cv[4], cx[5] * cv[5]); w.w = cvtpk(cx[6] * cv[6], cx[7] * cv[7]);
            *(LAS u32x4*)(lds + b * HY_PITCH + (128 + 8 * tid) * 2) = w; }
        if (tid < 256) { const int b = tid >> 5, side = (tid >> 4) & 1, k = tid & 15;
            *(LAS u32x4*)(lds + b * HY_PITCH + (side ? (128 + 4096) * 2 : 0) + k * 16) = (u32x4){0u, 0u, 0u, 0u}; }
    }
    __syncthreads();
    for (int ci = tid; ci < 1088; ci += 512) { const u32x4 d = *(const LAS u32x4*)(lds + HY_TAB0 + ci * 16); const unsigned d4 = ci < 1087 ? *(const LAS unsigned*)(lds + HY_TAB0 + ci * 16 + 16) : 0u;
        u32x4 o; o.x = __builtin_amdgcn_alignbit(d.y, d.x, 16); o.y = __builtin_amdgcn_alignbit(d.z, d.y, 16); o.z = __builtin_amdgcn_alignbit(d.w, d.z, 16); o.w = __builtin_amdgcn_alignbit(d4, d.w, 16);
        *(LAS u32x4*)(lds + HY_TAB1 + ci * 16) = o; }
    __syncthreads();
    const int T0 = 512 * wave, r = lane & 31, h = lane >> 5, bb = r >> 2, tb = r & 3;
    f32x16 acc[4];
#pragma unroll
    for (int i = 0; i < 4; ++i)
#pragma unroll
        for (int j = 0; j < 16; ++j) acc[i][j] = 0.f;
    {
        const int Dfirst = T0 - 4080;
        const int e0 = 4351 - Dfirst - r + 8 * h;
        const unsigned aaddr0 = (unsigned)((e0 & 1) ? HY_TAB1 : HY_TAB0) + (unsigned)(e0 & ~1) * 2u;
        const unsigned baddr0 = (unsigned)(bb * HY_PITCH + (128 + T0 + 32 * tb - Dfirst + 8 * h) * 2);
#define HY_LDA(dst, ad) do { u32x4 _t; _t.x = *(const LAS unsigned*)(lds + (ad)); _t.y = *(const LAS unsigned*)(lds + (ad) + 4); _t.z = *(const LAS unsigned*)(lds + (ad) + 8); _t.w = *(const LAS unsigned*)(lds + (ad) + 12); dst = __builtin_bit_cast(pg8::bf16x8, _t); } while (0)
#define HY_LDB(dst, ad) dst = *(const LAS pg8::bf16x8*)(lds + (ad))
#define HY_GENERIC(st_lo, st_hi) do { for (int st = (st_lo); st < (st_hi); ++st) { const int d = -4080 + 16 * st; const unsigned aa = aaddr0 - 32u * (unsigned)st, ba = baddr0 - 32u * (unsigned)st; pg8::bf16x8 A; HY_LDA(A, aa); \
            if (d <= 96) { pg8::bf16x8 B; HY_LDB(B, ba); acc[0] = __builtin_amdgcn_mfma_f32_32x32x16_bf16(A, B, acc[0], 0, 0, 0); } \
            if (d >= -3952 && d <= 224) { pg8::bf16x8 B; HY_LDB(B, ba + 256); acc[1] = __builtin_amdgcn_mfma_f32_32x32x16_bf16(A, B, acc[1], 0, 0, 0); } \
            if (d >= -3824 && d <= 352) { pg8::bf16x8 B; HY_LDB(B, ba + 512); acc[2] = __builtin_amdgcn_mfma_f32_32x32x16_bf16(A, B, acc[2], 0, 0, 0); } \
            if (d >= -3696) { pg8::bf16x8 B; HY_LDB(B, ba + 768); acc[3] = __builtin_amdgcn_mfma_f32_32x32x16_bf16(A, B, acc[3], 0, 0, 0); } } } while (0)
#define HY_LOAD5(A, B0, B1, B2, B3, aa, ba) do { HY_LDA(A, aa); HY_LDB(B0, ba); HY_LDB(B1, (ba) + 256); HY_LDB(B2, (ba) + 512); HY_LDB(B3, (ba) + 768); } while (0)
#define HY_MMA4(A, B0, B1, B2, B3) do { acc[0] = __builtin_amdgcn_mfma_f32_32x32x16_bf16(A, B0, acc[0], 0, 0, 0); acc[1] = __builtin_amdgcn_mfma_f32_32x32x16_bf16(A, B1, acc[1], 0, 0, 0); \
            acc[2] = __builtin_amdgcn_mfma_f32_32x32x16_bf16(A, B2, acc[2], 0, 0, 0); acc[3] = __builtin_amdgcn_mfma_f32_32x32x16_bf16(A, B3, acc[3], 0, 0, 0); } while (0)
        HY_GENERIC(0, 24);
        {
            unsigned aa = aaddr0 - 32u * 24u, ba = baddr0 - 32u * 24u;
            pg8::bf16x8 Aa, Ba0, Ba1, Ba2, Ba3, Ab, Bb0, Bb1, Bb2, Bb3;
            HY_LOAD5(Aa, Ba0, Ba1, Ba2, Ba3, aa, ba);
#pragma unroll 1
            for (int it = 0; it < 118; ++it) {
                HY_LOAD5(Ab, Bb0, Bb1, Bb2, Bb3, aa - 32u, ba - 32u); __builtin_amdgcn_sched_barrier(0);
                HY_MMA4(Aa, Ba0, Ba1, Ba2, Ba3); __builtin_amdgcn_sched_barrier(0);
                HY_LOAD5(Aa, Ba0, Ba1, Ba2, Ba3, aa - 64u, ba - 64u); __builtin_amdgcn_sched_barrier(0);
                HY_MMA4(Ab, Bb0, Bb1, Bb2, Bb3); __builtin_amdgcn_sched_barrier(0);
                aa -= 64u; ba -= 64u;
            }
            HY_LOAD5(Ab, Bb0, Bb1, Bb2, Bb3, aa - 32u, ba - 32u);
            HY_MMA4(Aa, Ba0, Ba1, Ba2, Ba3);
            HY_MMA4(Ab, Bb0, Bb1, Bb2, Bb3);
        }
        HY_GENERIC(262, 286);
#undef HY_LDA
#undef HY_LDB
#undef HY_GENERIC
#undef HY_LOAD5
#undef HY_MMA4
    }
    __syncthreads();
    {
        const bf16_t* x0r = PHYT + (size_t)c * NT + 8 * tid; u32x4 xa[8];
#pragma unroll
        for (int b = 0; b < 8; ++b) xa[b] = *(const u32x4*)(x0r + (size_t)b * L);
#pragma unroll
        for (int i = 0; i < 4; ++i)
#pragma unroll
            for (int g = 0; g < 4; ++g) { const int t = T0 + 128 * i + 32 * tb + 8 * g + 4 * h;
                pg8::u32x2 w; w.x = cvtpk(acc[i][4 * g], acc[i][4 * g + 1]); w.y = cvtpk(acc[i][4 * g + 2], acc[i][4 * g + 3]);
                *(LAS pg8::u32x2*)(lds + bb * HY_PITCH + (128 + t) * 2) = w; }
        __syncthreads();
        bf16_t* yr = PHYT + (size_t)(1024 + c) * NT + 8 * tid;
        const float w0 = hy_sw[c], w1 = hy_sw[1536 + c], w2 = hy_sw[3072 + c], bs = hy_sb[c];
#pragma unroll
        for (int b = 0; b < 8; ++b) {
            const unsigned xpw = __shfl_up(xa[b].w, 1), xnx = __shfl_down(xa[b].x, 1);
            const float xl = hl ? pg8::bfhi(xpw) : 0.f, xr = hr ? pg8::bflo(xnx) : 0.f;
            float cx[8]; conv8(xa[b], xl, xr, w0, w1, w2, bs, cx);
            const u32x4 y = *(const LAS u32x4*)(lds + b * HY_PITCH + (128 + 8 * tid) * 2);
            u32x4 w; w.x = cvtpk(cx[0] * pg8::bflo(y.x), cx[1] * pg8::bfhi(y.x)); w.y = cvtpk(cx[2] * pg8::bflo(y.y), cx[3] * pg8::bfhi(y.y));
            w.z = cvtpk(cx[4] * pg8::bflo(y.z), cx[5] * pg8::bfhi(y.z)); w.w = cvtpk(cx[6] * pg8::bflo(y.w), cx[7] * pg8::bfhi(y.w));
            *(u32x4*)(yr + (size_t)b * L) = w; }
    }
}

constexpr int HG_QE = 0, HG_KE = 17408, HG_KDT = 34816, HG_VT = 53248, HG_DEC = 71680, HG_BUF = 72192;

#define HG_RD2(ptr_a, ptr_b) __builtin_bit_cast(pg8::bf16x8, (u32x4){(*(const LAS u32x2*)(ptr_a)).x, (*(const LAS u32x2*)(ptr_a)).y, (*(const LAS u32x2*)(ptr_b)).x, (*(const LAS u32x2*)(ptr_b)).y})
#define HG_MFMA(a, b, c) __builtin_amdgcn_mfma_f32_16x16x32_bf16(a, b, c, 0, 0, 0)
#define HG_SB() __builtin_amdgcn_sched_barrier(0)
__device__ __forceinline__ pg8::bf16x8 hg_pack2(const f32x4& a, const f32x4& b) { u32x4 t; t.x = cvtpk(a[0], a[1]); t.y = cvtpk(a[2], a[3]); t.z = cvtpk(b[0], b[1]); t.w = cvtpk(b[2], b[3]); return __builtin_bit_cast(pg8::bf16x8, t); }
template <bool HAS_Q>
__device__ __forceinline__ void hgrn_consume(LAS unsigned char* Bf, f32x4 (&S)[2][8], int base, int dir, int h, int cw, int fr, int kg, float* o_out, int dbg) {
    const f32x4 z4 = (f32x4){0.f, 0.f, 0.f, 0.f};
    pg8::bf16x8 Bv[2][2];
#pragma unroll
    for (int sl = 0; sl < 2; ++sl)
#pragma unroll
        for (int ks = 0; ks < 2; ++ks) { LAS unsigned char* const vp = Bf + HG_VT + (32 * cw + 16 * sl + fr) * 144 + (32 * ks + 4 * kg) * 2; Bv[sl][ks] = HG_RD2(vp, vp + 32); }
    if (HAS_Q) {
        f32x4 st[10];
#pragma unroll
        for (int i = 0; i < 10; ++i) st[i] = z4;
        pg8::bf16x8 Kf[2][4], Qf[2][4];
        LAS unsigned char* const kbase = Bf + HG_KE + fr * 272 + 8 * kg * 2; LAS unsigned char* const qbase = Bf + HG_QE + fr * 272 + 8 * kg * 2;
#pragma unroll
        for (int b4 = 0; b4 < 4; ++b4) { Kf[0][b4] = *(const LAS pg8::bf16x8*)(kbase + b4 * 16 * 272); Qf[0][b4] = *(const LAS pg8::bf16x8*)(qbase + b4 * 16 * 272); }
#pragma unroll
        for (int ks = 0; ks < 4; ++ks) {
            if (ks < 3) {
#pragma unroll
                for (int b4 = 0; b4 < 4; ++b4) { Kf[(ks + 1) & 1][b4] = *(const LAS pg8::bf16x8*)(kbase + b4 * 16 * 272 + (ks + 1) * 64); Qf[(ks + 1) & 1][b4] = *(const LAS pg8::bf16x8*)(qbase + b4 * 16 * 272 + (ks + 1) * 64); } }
            HG_SB();
#pragma unroll
            for (int cb = 0; cb < 4; ++cb)
#pragma unroll
                for (int sb = 0; sb <= cb; ++sb) st[cb * (cb + 1) / 2 + sb] = HG_MFMA(Kf[ks & 1][sb], Qf[ks & 1][cb], st[cb * (cb + 1) / 2 + sb]);
            HG_SB();
        }
#pragma unroll
        for (int cb = 0; cb < 4; ++cb)
#pragma unroll
            for (int r = 0; r < 4; ++r) st[cb * (cb + 1) / 2 + cb][r] = (4 * kg + r <= fr) ? st[cb * (cb + 1) / 2 + cb][r] : 0.f;
        pg8::bf16x8 Af[4][2];
        Af[0][0] = hg_pack2(st[0], z4); Af[1][0] = hg_pack2(st[1], st[2]); Af[2][0] = hg_pack2(st[3], st[4]); Af[2][1] = hg_pack2(st[5], z4); Af[3][0] = hg_pack2(st[6], st[7]); Af[3][1] = hg_pack2(st[8], st[9]);
        pg8::bf16x8 Bs[2][4];
#pragma unroll
        for (int sl = 0; sl < 2; ++sl)
#pragma unroll
            for (int kp = 0; kp < 4; ++kp) Bs[sl][kp] = hg_pack2(S[sl][2 * kp], S[sl][2 * kp + 1]);
        pg8::bf16x8 Aq[2][4];
        LAS unsigned char* const qp0 = Bf + HG_QE + fr * 272 + 4 * kg * 2;
#pragma unroll
        for (int kp = 0; kp < 4; ++kp) Aq[0][kp] = HG_RD2(qp0 + kp * 64, qp0 + kp * 64 + 32);
#pragma unroll
        for (int cb = 0; cb < 4; ++cb) {
            if (cb < 3) {
#pragma unroll
                for (int kp = 0; kp < 4; ++kp) Aq[(cb + 1) & 1][kp] = HG_RD2(qp0 + (cb + 1) * 16 * 272 + kp * 64, qp0 + (cb + 1) * 16 * 272 + kp * 64 + 32); }
            HG_SB();
            f32x4 o0 = z4, o1 = z4;
            o0 = HG_MFMA(Af[cb][0], Bv[0][0], o0); o1 = HG_MFMA(Af[cb][0], Bv[1][0], o1);
            if (cb >= 2) { o0 = HG_MFMA(Af[cb][1], Bv[0][1], o0); o1 = HG_MFMA(Af[cb][1], Bv[1][1], o1); }
#pragma unroll
            for (int kp = 0; kp < 4; ++kp) { o0 = HG_MFMA(Aq[cb & 1][kp], Bs[0][kp], o0); o1 = HG_MFMA(Aq[cb & 1][kp], Bs[1][kp], o1); }
            HG_SB();
#pragma unroll
            for (int r = 0; r < 4; ++r) { const int cp = 16 * cb + 4 * kg + r; const int t = base + (dir ? 63 - cp : cp); float* op = o_out + (size_t)t * HW + h * 128 + 32 * cw + fr;
                if (!(dbg & 1)) { op[0] = o0[r]; op[16] = o1[r]; } else asm volatile("" :: "v"(o0[r]), "v"(o1[r])); }
        }
    }
    pg8::bf16x8 Ak[2][2][2]; f32x4 dc[2][2];
    LAS unsigned char* const kdp = Bf + HG_KDT + fr * 144 + 4 * kg * 2; LAS unsigned char* const dcp = Bf + HG_DEC + 4 * kg * 4;
#pragma unroll
    for (int u = 0; u < 2; ++u) { dc[0][u] = *(const LAS f32x4*)(dcp + u * 64);
#pragma unroll
        for (int ks = 0; ks < 2; ++ks) Ak[0][u][ks] = HG_RD2(kdp + u * 16 * 144 + ks * 64, kdp + u * 16 * 144 + ks * 64 + 32); }
#pragma unroll
    for (int bp = 0; bp < 4; ++bp) {
        if (bp < 3) {
#pragma unroll
            for (int u = 0; u < 2; ++u) { const int blk = 2 * (bp + 1) + u; dc[(bp + 1) & 1][u] = *(const LAS f32x4*)(dcp + blk * 64);
#pragma unroll
                for (int ks = 0; ks < 2; ++ks) Ak[(bp + 1) & 1][u][ks] = HG_RD2(kdp + blk * 16 * 144 + ks * 64, kdp + blk * 16 * 144 + ks * 64 + 32); } }
        HG_SB();
#pragma unroll
        for (int u = 0; u < 2; ++u) { const int blk = 2 * bp + u; f32x4 s0 = S[0][blk] * dc[bp & 1][u], s1 = S[1][blk] * dc[bp & 1][u];
#pragma unroll
            for (int ks = 0; ks < 2; ++ks) { s0 = HG_MFMA(Ak[bp & 1][u][ks], Bv[0][ks], s0); s1 = HG_MFMA(Ak[bp & 1][u][ks], Bv[1][ks], s1); }
            S[0][blk] = s0; S[1][blk] = s1; }
        HG_SB();
    }
}
#undef HG_RD2
#undef HG_MFMA
#undef HG_SB

template <bool HAS_Q>
__device__ __forceinline__ void hgrn_chain_mfma(LAS unsigned char* lds, const bf16_t* pi, int ldi, const bf16_t* pz, int ldz, const bf16_t* pq, int ldq, int Lseq, int h, int dir,
                                                const float* lb, const float* s_in, float* s_out, float* o_out, int n_begin, int nch  , int dbg = 0, unsigned char* dbgp = nullptr) {
    const int tid = threadIdx.x, lane = tid & 63, wave = __builtin_amdgcn_readfirstlane(tid >> 6);
    const bool producer = wave < 4;
#if PROBE_MASK
    unsigned long long bar_wait = 0ull;
#define HG_BAR() do { asm volatile("s_waitcnt lgkmcnt(0)" ::: "memory"); const unsigned long long _b0 = __builtin_amdgcn_s_memrealtime(); __builtin_amdgcn_s_barrier(); bar_wait += __builtin_amdgcn_s_memrealtime() - _b0; asm volatile("" ::: "memory"); } while (0)
#else
#define HG_BAR() do { asm volatile("s_waitcnt lgkmcnt(0)" ::: "memory"); __builtin_amdgcn_s_barrier(); asm volatile("" ::: "memory"); } while (0)
#endif
    const int pw = wave & 3, dp = lane & 15, rq = lane >> 4, ch0 = 32 * pw + 2 * dp;
    const int rowmin = dir ? 48 - 16 * rq : 16 * rq;
    const unsigned voZ = (unsigned)(rowmin * ldz + h * 128 + ch0) * 2u, voI = (unsigned)(rowmin * ldi + h * 128 + ch0) * 2u, voQ = (unsigned)(rowmin * (HAS_Q ? ldq : ldi) + h * 128 + ch0) * 2u;
    const __amdgpu_buffer_rsrc_t rsZ = __builtin_amdgcn_make_buffer_rsrc((void*)pz, 0, Lseq * ldz * 2, 0x00020000);
    const __amdgpu_buffer_rsrc_t rsI = __builtin_amdgcn_make_buffer_rsrc((void*)pi, 0, Lseq * ldi * 2, 0x00020000);
    const __amdgpu_buffer_rsrc_t rsQ = __builtin_amdgcn_make_buffer_rsrc((void*)(HAS_Q ? pq : pi), 0, Lseq * (HAS_Q ? ldq : ldi) * 2, 0x00020000);
#define HG_LOAD(n, Z, Q, V) do { const int _n = (dbg & 2) ? 0 : (n); const int _base = dir ? (Lseq - 64 * (_n + 1)) : 64 * _n; \
        _Pragma("unroll") for (int i = 0; i < 16; ++i) { const int _r = _base + (dir ? 15 - i : i); \
            Z[i] = __builtin_amdgcn_raw_buffer_load_b32(rsZ, voZ, _r * ldz * 2, 0); V[i] = __builtin_amdgcn_raw_buffer_load_b32(rsI, voI, _r * ldi * 2, 0); \
            if (HAS_Q) Q[i] = __builtin_amdgcn_raw_buffer_load_b32(rsQ, voQ, _r * ldq * 2, 0); } } while (0)
#define HG_PRODUCE(Z, Q, V, boff) do { LAS unsigned char* const Bf = lds + (boff); \
        float f0[16], f1[16]; float p0 = 1.f, p1 = 1.f; \
        _Pragma("unroll") for (int i = 0; i < 16; ++i) { f0[i] = 1.f - pg8::bflo(Z[i]); f1[i] = 1.f - pg8::bfhi(Z[i]); p0 *= f0[i]; p1 *= f1[i]; } \
        float run0 = 1.f, run1 = 1.f, fl0 = 1.f, fl1 = 1.f, suf0 = 1.f, suf1 = 1.f; \
        _Pragma("unroll") for (int qq = 0; qq < 4; ++qq) { const float t0 = __shfl(p0, dp + 16 * qq), t1 = __shfl(p1, dp + 16 * qq); fl0 *= t0; fl1 *= t1; if (qq < rq) { run0 *= t0; run1 *= t1; } if (qq > rq) { suf0 *= t0; suf1 *= t1; } } \
        unsigned kdw0[8], kdw1[8]; \
        if (HAS_Q) { \
            _Pragma("unroll") for (int i2 = 0; i2 < 8; ++i2) { float kda[2], kdb[2]; \
                _Pragma("unroll") for (int u = 0; u < 2; ++u) { const int i = 2 * i2 + u; run0 *= f0[i]; run1 *= f1[i]; const float ia = __builtin_amdgcn_rcpf(run0), ib = __builtin_amdgcn_rcpf(run1); \
                    const float kea = pg8::bflo(Z[i]) * ia, keb = pg8::bfhi(Z[i]) * ib; const int cp = 16 * rq + i; \
                    *(LAS unsigned*)(Bf + HG_QE + cp * 272 + ch0 * 2) = cvtpk(pg8::bflo(Q[i]) * run0, pg8::bfhi(Q[i]) * run1); \
                    *(LAS unsigned*)(Bf + HG_KE + cp * 272 + ch0 * 2) = cvtpk(kea, keb); \
                    kda[u] = kea * fl0; kdb[u] = keb * fl1; } \
                kdw0[i2] = cvtpk(kda[0], kda[1]); kdw1[i2] = cvtpk(kdb[0], kdb[1]); } \
        } else { \
            _Pragma("unroll") for (int i2 = 7; i2 >= 0; --i2) { float kda[2], kdb[2]; \
                _Pragma("unroll") for (int u = 1; u >= 0; --u) { const int i = 2 * i2 + u; kda[u] = pg8::bflo(Z[i]) * suf0; kdb[u] = pg8::bfhi(Z[i]) * suf1; suf0 *= f0[i]; suf1 *= f1[i]; } \
                kdw0[i2] = cvtpk(kda[0], kda[1]); kdw1[i2] = cvtpk(kdb[0], kdb[1]); } \
        } \
        *(LAS u32x4*)(Bf + HG_KDT + ch0 * 144 + 32 * rq) = (u32x4){kdw0[0], kdw0[1], kdw0[2], kdw0[3]}; *(LAS u32x4*)(Bf + HG_KDT + ch0 * 144 + 32 * rq + 16) = (u32x4){kdw0[4], kdw0[5], kdw0[6], kdw0[7]}; \
        *(LAS u32x4*)(Bf + HG_KDT + (ch0 + 1) * 144 + 32 * rq) = (u32x4){kdw1[0], kdw1[1], kdw1[2], kdw1[3]}; *(LAS u32x4*)(Bf + HG_KDT + (ch0 + 1) * 144 + 32 * rq + 16) = (u32x4){kdw1[4], kdw1[5], kdw1[6], kdw1[7]}; \
        { u32x4 lo0, lo1, hi0, hi1; \
          lo0.x = (V[0] & 0xffffu) | (V[1] << 16); lo0.y = (V[2] & 0xffffu) | (V[3] << 16); lo0.z = (V[4] & 0xffffu) | (V[5] << 16); lo0.w = (V[6] & 0xffffu) | (V[7] << 16); \
          lo1.x = (V[8] & 0xffffu) | (V[9] << 16); lo1.y = (V[10] & 0xffffu) | (V[11] << 16); lo1.z = (V[12] & 0xffffu) | (V[13] << 16); lo1.w = (V[14] & 0xffffu) | (V[15] << 16); \
          hi0.x = (V[0] >> 16) | (V[1] & 0xffff0000u); hi0.y = (V[2] >> 16) | (V[3] & 0xffff0000u); hi0.z = (V[4] >> 16) | (V[5] & 0xffff0000u); hi0.w = (V[6] >> 16) | (V[7] & 0xffff0000u); \
          hi1.x = (V[8] >> 16) | (V[9] & 0xffff0000u); hi1.y = (V[10] >> 16) | (V[11] & 0xffff0000u); hi1.z = (V[12] >> 16) | (V[13] & 0xffff0000u); hi1.w = (V[14] >> 16) | (V[15] & 0xffff0000u); \
          *(LAS u32x4*)(Bf + HG_VT + ch0 * 144 + 32 * rq) = lo0; *(LAS u32x4*)(Bf + HG_VT + ch0 * 144 + 32 * rq + 16) = lo1; \
          *(LAS u32x4*)(Bf + HG_VT + (ch0 + 1) * 144 + 32 * rq) = hi0; *(LAS u32x4*)(Bf + HG_VT + (ch0 + 1) * 144 + 32 * rq + 16) = hi1; } \
        if (rq == 0) *(LAS f32x2_t*)(Bf + HG_DEC + ch0 * 4) = (f32x2_t){fl0, fl1}; } while (0)
#define HG_CONSUME(m, boff) hgrn_consume<HAS_Q>(lds + (boff), S, dir ? (Lseq - 64 * ((m) + 1)) : 64 * (m), dir, h, cw, fr, kg, o_out, dbg)

    __syncthreads();
    if (producer) {
        unsigned zA[16], qA[16], vA[16], zB[16], qB[16], vB[16];
        HG_LOAD(n_begin, zA, qA, vA);
        if (n_begin + 1 < nch) HG_LOAD(n_begin + 1, zB, qB, vB);
        for (int n = n_begin; n <= nch; n += 2) {
            if (n < nch && !(dbg & 4)) HG_PRODUCE(zA, qA, vA, 0);
            if (n + 2 < nch) HG_LOAD(n + 2, zA, qA, vA);
            HG_BAR();
            if (n + 1 < nch && !(dbg & 4)) HG_PRODUCE(zB, qB, vB, HG_BUF);
            if (n + 3 < nch) HG_LOAD(n + 3, zB, qB, vB);
            HG_BAR();
        }
    } else {
        const int cw = wave & 3, fr = lane & 15, kg = lane >> 4;
        __builtin_amdgcn_s_setprio(3);
        f32x4 S[2][8];
#pragma unroll
        for (int sl = 0; sl < 2; ++sl)
#pragma unroll
            for (int blk = 0; blk < 8; ++blk)
#pragma unroll
                for (int r = 0; r < 4; ++r) S[sl][blk][r] = s_in ? s_in[(size_t)(16 * blk + 4 * kg + r) * 128 + 32 * cw + 16 * sl + fr] : 0.f;
        for (int n = n_begin; n <= nch; n += 2) {
            if (n > n_begin && !(dbg & 8)) HG_CONSUME(n - 1, HG_BUF);
            HG_BAR();
            if (n < nch && !(dbg & 8)) HG_CONSUME(n, 0);
            HG_BAR();
        }
        if (dbg) {
#pragma unroll
            for (int sl = 0; sl < 2; ++sl)
#pragma unroll
                for (int blk = 0; blk < 8; ++blk) asm volatile("" :: "v"(S[sl][blk][0]), "v"(S[sl][blk][1]), "v"(S[sl][blk][2]), "v"(S[sl][blk][3]));
        }
        if (s_out) {
#pragma unroll
            for (int sl = 0; sl < 2; ++sl)
#pragma unroll
                for (int blk = 0; blk < 8; ++blk)
#pragma unroll
                    for (int r = 0; r < 4; ++r) s_out[(size_t)(16 * blk + 4 * kg + r) * 128 + 32 * cw + 16 * sl + fr] = S[sl][blk][r];
        }
        __builtin_amdgcn_s_setprio(0);
    }
#if PROBE_MASK
    if (HAS_Q && blockIdx.x == PROBE_BUSY_BLOCK && (tid == 0 || tid == 256) && dbg == 0) *(volatile unsigned long long*)(dbgp + (tid ? 8 : 0)) = bar_wait;
#endif
#undef HG_LOAD
#undef HG_PRODUCE
#undef HG_CONSUME
#undef HG_BAR
    __syncthreads();
}

__global__ void __launch_bounds__(512, 2) mega(Params P) {
    extern __shared__ __attribute__((aligned(16))) unsigned char lds_raw[];
    cg::grid_group grid = cg::this_grid();
    LAS unsigned char* lds = (LAS unsigned char*)lds_raw;
    const int tid = threadIdx.x, lane = tid & 63, wave = __builtin_amdgcn_readfirstlane(tid >> 6);
    const int G = gridDim.x, bx = blockIdx.x;
    const int vcu = (G % 8 == 0) ? (bx % 8) * (G / 8) + bx / 8 : bx;
    const int gw = vcu * 8 + wave, NGW = G * 8;
    unsigned char* ws = P.ws;
    const float* x = P.in[0]; const float* cvec = P.in[1]; const float* ctx = P.in[2]; const float* c_ctx = P.in[3];
    const float* w_ada = P.in[4]; const float* b_ada = P.in[5]; const float* norm_w = P.in[6]; const float* w_in = P.in[7];
    const float* lb_param = P.in[8]; const float* g_norm = P.in[9]; const float* hy_sw = P.in[10]; const float* hy_sb = P.in[11];
    const float* f_w1 = P.in[12]; const float* f_b1 = P.in[13]; const float* f_w2 = P.in[14]; const float* f_b2 = P.in[15];
    const float* f_w3 = P.in[16]; const float* f_freq = P.in[17]; const float* hy_d = P.in[18]; const float* w_pa = P.in[19];
    const float* w_pb = P.in[20]; const float* w_out = P.in[21]; const float* w_mlp1 = P.in[22]; const float* w_mlp2 = P.in[23];
    float* MOD = (float*)(ws + WS_MOD); float* LB = (float*)(ws + WS_LB); bf16_t* GTB = (bf16_t*)(ws + WS_GT);
    bf16_t* WIN = (bf16_t*)(ws + WS_WIN); bf16_t* WPAB = (bf16_t*)(ws + WS_WPAB); bf16_t* WOUT = (bf16_t*)(ws + WS_WOUT); bf16_t* W1 = (bf16_t*)(ws + WS_W1); bf16_t* W2 = (bf16_t*)(ws + WS_W2);
    bf16_t* HCTX = (bf16_t*)(ws + WS_HCTX); bf16_t* PCTX = (bf16_t*)(ws + WS_PCTX); float* SCTX = (float*)(ws + WS_SCTX);
    bf16_t* HLAT = (bf16_t*)(ws + WS_HLAT); bf16_t* PI = (bf16_t*)(ws + WS_PI); bf16_t* PZ = (bf16_t*)(ws + WS_PZ); bf16_t* PQ = (bf16_t*)(ws + WS_PQ);
    bf16_t* PG = (bf16_t*)(ws + WS_PG); bf16_t* GATES = (bf16_t*)(ws + WS_GATES); bf16_t* PHYT = (bf16_t*)(ws + WS_PHYT);
    bf16_t* AY = (bf16_t*)(ws + WS_AY2); bf16_t* MERGED = (bf16_t*)(ws + WS_MERGED); bf16_t* MIX = (bf16_t*)(ws + WS_MIX);
    bf16_t* MLP = (bf16_t*)(ws + WS_MLP); bf16_t* H1 = (bf16_t*)(ws + WS_H1); bf16_t* HL = (bf16_t*)(ws + WS_HL);
    float* O2 = P.out;

    volatile LAS unsigned* MISC = (volatile LAS unsigned*)(lds + LDS_BYTES - 128);
    if (tid < 16) MISC[tid] = 0u;
    __syncthreads();
    const XcdBarrier xbar = xcd_barrier_post((unsigned*)ws, MISC);
#define SEAM_RAW(k) do { if ((k) == 0) grid.sync(); else xcd_barrier(xbar); } while (0)
#if PROBE_MASK
    unsigned long long t_prev = __builtin_amdgcn_s_memrealtime(), t_spin = 0ull;
#ifndef PROBE_BUSY_PHASE
#define PROBE_BUSY_PHASE -1
#define PROBE_BUSY_BLOCK 0
#endif
#define SEAM(k) do { if ((k) == PROBE_BUSY_PHASE && bx == PROBE_BUSY_BLOCK && tid == 0) *(volatile unsigned long long*)(ws + 32768) = __builtin_amdgcn_s_memrealtime() - t_prev; \
    SEAM_RAW(k); { const unsigned long long _t = __builtin_amdgcn_s_memrealtime(); if ((PROBE_MASK >> (k)) & 1) t_spin += _t - t_prev; \
    if ((k) == PROBE_BUSY_PHASE) t_spin += *(volatile unsigned long long*)(ws + 32768); t_prev = _t; } } while (0)
#else
#define SEAM(k) SEAM_RAW(k)
#endif
    {
        if (bx < 192) {
            const int cgp = bx % 96, kh = bx / 96;
            LAS float* sc = (LAS float*)lds;
            LAS float* ps = (LAS float*)(lds + 20480);
            for (int i = tid; i < 9 * 512; i += 512) { const int r = i >> 9, k = kh * 512 + (i & 511); sc[i] = siluf_(r < 8 ? cvec[r * D + k] : c_ctx[k]); }
            __syncthreads();
            const int j = cgp * 64 + lane; float a9[9];
#pragma unroll
            for (int r = 0; r < 9; ++r) a9[r] = 0.f;
            const float* wp = w_ada + (size_t)(kh * 512 + wave * 64) * INC + j;
#pragma unroll 1
            for (int kk = 0; kk < 64; kk += 16) { float w[16];
#pragma unroll
                for (int u = 0; u < 16; ++u) w[u] = wp[(size_t)(kk + u) * INC];
#pragma unroll
                for (int u = 0; u < 16; ++u)
#pragma unroll
                    for (int r = 0; r < 9; ++r) a9[r] += sc[r * 512 + wave * 64 + kk + u] * w[u]; }
#pragma unroll
            for (int r = 0; r < 9; ++r) ps[(wave * 9 + r) * 64 + lane] = a9[r];
            __syncthreads();
            for (int i = tid; i < 9 * 64; i += 512) { const int r = i >> 6, l = i & 63; float s = kh == 0 ? b_ada[cgp * 64 + l] : 0.f;
#pragma unroll
                for (int w = 0; w < 8; ++w) s += ps[(w * 9 + r) * 64 + l];
                atomicAdd(&MOD[r * INC + cgp * 64 + l], s); }
            __syncthreads();
        }
        if (bx == G - 1) { const float a = lb_param[tid], b = lb_param[HW + tid], m = fmaxf(a, b); const float ea = expf(a - m), eb = expf(b - m); LB[tid] = ea / (ea + eb); }
        {   LAS float* scr = (LAS float*)(lds + wave * 16384);
            for (int it = gw; it < 16 * 192; it += NGW) transpose_item(w_in, INC, WIN, D, 0, 1, scr, it, lane); }
        for (int tb = bx; tb < 256; tb += G) {
            __syncthreads();
            LAS float* zf = (LAS float*)lds; LAS float* h1 = zf + 17 * 36; LAS float* h2 = h1 + 17 * 64;
            for (int i = tid; i < 17 * 33; i += 512) { const int p = i / 33, k = i - 33 * p, t = 16 * tb + p; float val;
                if (k == 0) val = (float)t / (float)(L - 1);
                else { const int bi = (k - 1) & 15; const float band = 1e-4f + (float)bi * ((15.f - 1e-4f) / 15.f);
                    const float w = 2.0f * 3.14159265358979323846f * (float)t / (float)L; const float ang = w * band;
                    val = (k <= 16) ? cosf(ang) : -sinf(ang); }
                zf[p * 36 + k] = val; }
            __syncthreads();
            for (int i = tid; i < 17 * 64; i += 512) { const int p = i >> 6, k = i & 63; float acc = f_b1[k];
#pragma unroll 11
                for (int q = 0; q < 33; ++q) acc += zf[p * 36 + q] * f_w1[q * 64 + k];
                h1[i] = sinf(f_freq[k] * acc); }
            __syncthreads();
            for (int i = tid; i < 17 * 64; i += 512) { const int p = i >> 6, k = i & 63; float acc = f_b2[k];
#pragma unroll 16
                for (int q = 0; q < 64; ++q) acc += h1[p * 64 + q] * f_w2[q * 64 + k];
                h2[i] = sinf(f_freq[k] * acc); }
            __syncthreads();
            const int c = tid; float af[16], ab[16];
#pragma unroll
            for (int p = 0; p < 16; ++p) { af[p] = 0.f; ab[p] = 0.f; }
#pragma unroll 4
            for (int k = 0; k < 64; ++k) { const float wf = f_w3[k * 1024 + c], wb = f_w3[k * 1024 + 512 + c]; float hv[17];
#pragma unroll
                for (int p = 0; p < 17; ++p) hv[p] = h2[p * 64 + k];
#pragma unroll
                for (int p = 0; p < 16; ++p) { af[p] += hv[p] * wf; ab[p] += hv[p + 1] * wb; } }
            const float mind = logf(1e-2f) / 1.5f, maxd = logf(1e-2f) / 0.3f;
            const float delta = fabsf(mind + (maxd - mind) * ((float)c / 511.f));
            unsigned short of[16], ob[16];
#pragma unroll
            for (int p = 0; p < 16; ++p) { const int tf = 16 * tb + p, tbk = tf + 1;
                float vf = af[p] * expf(-((float)tf / (float)(L - 1)) * delta); if (tf == 0) vf += hy_d[c];
                float vb = ab[p] * expf(-((float)tbk / (float)(L - 1)) * delta); if (tbk >= L) vb = 0.f;
                of[15 - p] = (unsigned short)f2bf(vf); ob[p] = (unsigned short)f2bf(vb); }
            bf16_t* gf = GTB + (size_t)c * 8192 + (4080 - 16 * tb); bf16_t* gb = GTB + (size_t)c * 8192 + (4096 + 16 * tb);
            u32x4 w0, w1;
            w0.x = of[0] | ((unsigned)of[1] << 16); w0.y = of[2] | ((unsigned)of[3] << 16); w0.z = of[4] | ((unsigned)of[5] << 16); w0.w = of[6] | ((unsigned)of[7] << 16);
            w1.x = of[8] | ((unsigned)of[9] << 16); w1.y = of[10] | ((unsigned)of[11] << 16); w1.z = of[12] | ((unsigned)of[13] << 16); w1.w = of[14] | ((unsigned)of[15] << 16);
            *(u32x4*)gf = w0; *(u32x4*)(gf + 8) = w1;
            w0.x = ob[0] | ((unsigned)ob[1] << 16); w0.y = ob[2] | ((unsigned)ob[3] << 16); w0.z = ob[4] | ((unsigned)ob[5] << 16); w0.w = ob[6] | ((unsigned)ob[7] << 16);
            w1.x = ob[8] | ((unsigned)ob[9] << 16); w1.y = ob[10] | ((unsigned)ob[11] << 16); w1.z = ob[12] | ((unsigned)ob[13] << 16); w1.w = ob[14] | ((unsigned)ob[15] << 16);
            *(u32x4*)gb = w0; *(u32x4*)(gb + 8) = w1;
        }
    }
    SEAM(0);
    for (int m0 = gw; m0 < NT + NCX; m0 += 4 * NGW) {
        f32x4 v[4][4];
#pragma unroll
        for (int r = 0; r < 4; ++r) { const int m = m0 + r * NGW; if (m < NT + NCX) { const f32x4* xr = (const f32x4*)(m < NT ? x + (size_t)m * D : ctx + (size_t)(m - NT) * D) + lane;
#pragma unroll
                for (int j = 0; j < 4; ++j) v[r][j] = xr[64 * j]; } }
#pragma unroll
        for (int r = 0; r < 4; ++r) { const int m = m0 + r * NGW; if (m < NT + NCX) {
                const float* mb = MOD + (size_t)(m < NT ? (m >> 12) : 8) * INC; bf16_t* orow = m < NT ? HLAT + (size_t)m * D : HCTX + (size_t)(m - NT) * D;
                float s = 0.f;
#pragma unroll
                for (int j = 0; j < 4; ++j) s += (v[r][j].x * v[r][j].x + v[r][j].y * v[r][j].y) + (v[r][j].z * v[r][j].z + v[r][j].w * v[r][j].w);
                const float rs = rsqrtf(wave_sum(s) * (1.f / D) + EPS);
                unsigned long long* o8 = (unsigned long long*)orow + lane;
#pragma unroll
                for (int j = 0; j < 4; ++j) { const f32x4 w = ((const f32x4*)norm_w)[lane + 64 * j], sc = ((const f32x4*)mb)[lane + 64 * j], sh = ((const f32x4*)(mb + D))[lane + 64 * j];
                    const f32x4 o = v[r][j] * rs * w * (1.f + sc) + sh;
                    o8[64 * j] = (unsigned long long)cvtpk(o.x, o.y) | ((unsigned long long)cvtpk(o.z, o.w) << 32); } } }
    }
    SEAM(1);
    {
        { pg8::Gemm g{HLAT, WIN, D, D, D}; pg8::StaticOrder S; S.init(NT, 4608, G, bx); pg8::EpiG1 E{PI, PZ, PQ, PG, GATES, LB, 0};
          pg8::gemm_phase(lds, g, S, E); }
        { pg8::Gemm g{WIN + (size_t)4608 * D, HLAT, D, D, D}; pg8::StaticOrder S; S.init(1536, NT, G, bx); pg8::EpiBf16<0> E{PHYT, NT};
          pg8::gemm_phase(lds, g, S, E); }
        { pg8::Gemm g{HCTX, WIN, D, D, D}; pg8::StaticOrder S; S.init(NCX, 1536, G, bx); pg8::EpiG1 E{PCTX, nullptr, nullptr, nullptr, nullptr, LB, 1};
          pg8::gemm_phase(lds, g, S, E); }
    }
    SEAM(2);
    {
        float* STATE = (float*)(ws + WS_STATE);
        if (bx < 128) { const int chain = bx >> 1, seg = bx & 1, b = chain >> 3, h = (chain >> 1) & 3, dir = chain & 1; float* st = STATE + (size_t)bx * 16384;
            hgrn_chain_mfma<false>(lds, PCTX + (size_t)b * LC * 1536, 1536, PCTX + (size_t)b * LC * 1536 + (dir ? 1024 : 512), 1536, nullptr, 0, LC, h, dir, LB, nullptr, st, nullptr, 0, LC / 64);
            if (seg) hgrn_chain_mfma<false>(lds, PI + (size_t)b * L * 512, 512, PZ + (size_t)b * L * 1024 + (dir ? 512 : 0), 1024, nullptr, 0, L, h, dir, LB, st, st, nullptr, 0, 32);
            hgrn_chain_mfma<true>(lds, PI + (size_t)b * L * 512, 512, PZ + (size_t)b * L * 1024 + (dir ? 512 : 0), 1024, PQ + (size_t)b * L * 512, 512, L, h, dir, LB,
                                  st, nullptr, O2 + ((size_t)dir * NT + (size_t)b * L) * HW, 32 * seg, 32 * seg + 32, 0, ws + 32768 + 128);
#ifdef PROBE_SCAN2
            hgrn_chain_mfma<true>(lds, PI + (size_t)b * L * 512, 512, PZ + (size_t)b * L * 1024 + (dir ? 512 : 0), 1024, PQ + (size_t)b * L * 512, 512, L, h, dir, LB,
                                  st, nullptr, O2 + ((size_t)dir * NT + (size_t)b * L) * HW, 32 * seg, 32 * seg + 32, PROBE_SCAN2);
#endif
#if PROBE_MASK
            if (PROBE_BUSY_PHASE == 20 && bx == PROBE_BUSY_BLOCK && tid == 0) *(volatile unsigned long long*)(ws + 32768 + 64) = __builtin_amdgcn_s_memrealtime() - t_prev;
#endif
        } else {
            LAS float* scr = (LAS float*)(lds + wave * 16384);
            constexpr int I_PA = 8 * 32, I_OUT = 16 * 32, I_1 = 16 * 128, I_2 = 64 * 32;
            for (int it = (bx - 128) * 8 + wave; it < 2 * I_PA + I_OUT + I_1 + I_2; it += (G - 128) * 8) {
                int r = it;
                if (r < I_PA) { transpose_item(w_pa, D, WPAB, D, 0, 0, scr, r, lane); continue; } r -= I_PA;
                if (r < I_PA) { transpose_item(w_pb, D, WPAB, D, 512, 0, scr, r, lane); continue; } r -= I_PA;
                if (r < I_OUT) { transpose_item(w_out, D, WOUT, D, 0, 0, scr, r, lane); continue; } r -= I_OUT;
                if (r < I_1) { transpose_item(w_mlp1, FF, W1, D, 0, 0, scr, r, lane); continue; } r -= I_1;
                transpose_item(w_mlp2, D, W2, FF, 0, 0, scr, r, lane);
            }
        }
        unsigned* hctr = (unsigned*)(ws + 36864);
        for (;;) {
            __syncthreads();
            if (tid == 0) MISC[4] = atomicAdd(hctr, 1u);
            __syncthreads();
            const int c = (int)MISC[4];
            if (c >= HW) break;
            hyena_channel(lds, c, PHYT, GTB, hy_sw, hy_sb);
        }
    }
    SEAM(4);
#if PROBE_MASK
    if (PROBE_BUSY_PHASE == 20) t_spin += *(volatile unsigned long long*)(ws + 32768 + 64);
    if (PROBE_BUSY_PHASE == 21) t_spin += *(volatile unsigned long long*)(ws + 32768 + 128);
    if (PROBE_BUSY_PHASE == 22) t_spin += *(volatile unsigned long long*)(ws + 32768 + 136);
#endif
    {
        const f32x4 gn0 = ((const f32x4*)g_norm)[(2 * lane) & 31], gn1 = ((const f32x4*)g_norm)[(2 * lane + 1) & 31];
        for (int t0 = gw; t0 < NT; t0 += 2 * NGW) {
            f32x4 of[2][2], ob[2][2]; u32x4 pg[2];
#pragma unroll
            for (int r = 0; r < 2; ++r) { const int t = t0 + r * NGW; if (t < NT) {
                    of[r][0] = ((const f32x4*)(O2 + (size_t)t * HW))[2 * lane]; of[r][1] = ((const f32x4*)(O2 + (size_t)t * HW))[2 * lane + 1];
                    ob[r][0] = ((const f32x4*)(O2 + ((size_t)NT + t) * HW))[2 * lane]; ob[r][1] = ((const f32x4*)(O2 + ((size_t)NT + t) * HW))[2 * lane + 1];
                    pg[r] = ((const u32x4*)(PG + (size_t)t * 512))[lane]; } }
#pragma unroll
            for (int r = 0; r < 2; ++r) { const int t = t0 + r * NGW; if (t < NT) {
                    const f32x4 a0 = of[r][0] + ob[r][0], a1 = of[r][1] + ob[r][1];
                    float s = (a0.x * a0.x + a0.y * a0.y) + (a0.z * a0.z + a0.w * a0.w) + (a1.x * a1.x + a1.y * a1.y) + (a1.z * a1.z + a1.w * a1.w);
                    s += __shfl_xor(s, 1); s += __shfl_xor(s, 2); s += __shfl_xor(s, 4); s += __shfl_xor(s, 8);
                    const float rs = rsqrtf(s * (1.f / 128.f) + EPS);
                    u32x4 o;
                    o.x = cvtpk(a0.x * rs * gn0.x * pg8::bflo(pg[r].x), a0.y * rs * gn0.y * pg8::bfhi(pg[r].x)); o.y = cvtpk(a0.z * rs * gn0.z * pg8::bflo(pg[r].y), a0.w * rs * gn0.w * pg8::bfhi(pg[r].y));
                    o.z = cvtpk(a1.x * rs * gn1.x * pg8::bflo(pg[r].z), a1.y * rs * gn1.y * pg8::bfhi(pg[r].z)); o.w = cvtpk(a1.z * rs * gn1.z * pg8::bflo(pg[r].w), a1.w * rs * gn1.w * pg8::bfhi(pg[r].w));
                    *(u32x4*)(AY + (size_t)t * 1024 + 8 * lane) = o; } }
        }
    }
    {
        LAS bf16_t* tl = (LAS bf16_t*)(lds + wave * 16384);
        for (int it = gw; it < 8 * 512; it += NGW) { const int c0 = (it & 7) * 64, tok0 = (it >> 3) * 64;
#pragma unroll
            for (int i = 0; i < 8; ++i) { const int ch = lane + 64 * i, rr = ch >> 3, cc = (ch & 7) * 8;
                const u32x4 v = *(const u32x4*)(PHYT + (size_t)(1024 + c0 + rr) * NT + tok0 + cc);
                LAS unsigned* d = (LAS unsigned*)(tl + rr * 66 + cc); d[0] = v.x; d[1] = v.y; d[2] = v.z; d[3] = v.w; }
            LDS_WAIT();
#pragma unroll
            for (int i = 0; i < 8; ++i) { const int ch = lane + 64 * i, tt = ch >> 3, cc = (ch & 7) * 8; unsigned o[4];
#pragma unroll
                for (int q = 0; q < 4; ++q) o[q] = (unsigned)tl[(cc + 2 * q) * 66 + tt] | ((unsigned)tl[(cc + 2 * q + 1) * 66 + tt] << 16);
                *(u32x4*)(AY + (size_t)(tok0 + tt) * 1024 + 512 + c0 + cc) = (u32x4){o[0], o[1], o[2], o[3]}; }
            LDS_WAIT();
        }
    }
    SEAM(5);
    { pg8::Gemm g{AY, WPAB, D, D, 512}; pg8::TwoPassOrder S; S.base.init(NT, D, G, bx); S.kbytes = 1024; pg8::EpiMerge2 E{MERGED, GATES}; pg8::gemm_phase(lds, g, S, E); }
    SEAM(6);
    { pg8::Gemm g{MERGED, WOUT, D, D, D}; pg8::StaticOrder S; S.init(NT, D, G, bx); pg8::EpiBf16<0> E{MIX, D}; pg8::gemm_phase(lds, g, S, E); }
    SEAM(7);
    for (int m0 = gw; m0 < NT; m0 += 2 * NGW) {
        f32x4 xv[2][4]; u32x2 mx[2][4];
#pragma unroll
        for (int r = 0; r < 2; ++r) { const int m = m0 + r * NGW; if (m < NT) {
#pragma unroll
                for (int j = 0; j < 4; ++j) { xv[r][j] = ((const f32x4*)(x + (size_t)m * D))[lane + 64 * j]; mx[r][j] = *(const u32x2*)(MIX + (size_t)m * D + 4 * lane + 256 * j); } } }
#pragma unroll
        for (int r = 0; r < 2; ++r) { const int m = m0 + r * NGW; if (m < NT) { const float* mb = MOD + (size_t)(m >> 12) * INC;
                f32x4 mv[4], x1[4]; float s = 0.f;
#pragma unroll
                for (int j = 0; j < 4; ++j) { mv[j] = (f32x4){pg8::bflo(mx[r][j].x), pg8::bfhi(mx[r][j].x), pg8::bflo(mx[r][j].y), pg8::bfhi(mx[r][j].y)}; s += (mv[j].x * mv[j].x + mv[j].y * mv[j].y) + (mv[j].z * mv[j].z + mv[j].w * mv[j].w); }
                const float r1 = rsqrtf(wave_sum(s) * (1.f / D) + EPS); float s2 = 0.f;
#pragma unroll
                for (int j = 0; j < 4; ++j) { const f32x4 w = ((const f32x4*)(norm_w + D))[lane + 64 * j], g = ((const f32x4*)(mb + 2 * D))[lane + 64 * j];
                    x1[j] = xv[r][j] + g * (mv[j] * r1 * w); s2 += (x1[j].x * x1[j].x + x1[j].y * x1[j].y) + (x1[j].z * x1[j].z + x1[j].w * x1[j].w); }
                const float r2 = rsqrtf(wave_sum(s2) * (1.f / D) + EPS);
                unsigned long long* o8 = (unsigned long long*)(HL + (size_t)m * D) + lane;
#pragma unroll
                for (int j = 0; j < 4; ++j) { const f32x4 w = ((const f32x4*)(norm_w + 2 * D))[lane + 64 * j], sc = ((const f32x4*)(mb + 3 * D))[lane + 64 * j], sh = ((const f32x4*)(mb + 4 * D))[lane + 64 * j];
                    const f32x4 o = x1[j] * r2 * w * (1.f + sc) + sh;
                    o8[64 * j] = (unsigned long long)cvtpk(o.x, o.y) | ((unsigned long long)cvtpk(o.z, o.w) << 32); } } }
    }
    SEAM(8);
    { pg8::Gemm g{HL, W1, D, D, D}; pg8::StaticOrder S; S.init(NT, FF, G, bx); pg8::EpiBf16<3> E{H1, FF}; pg8::gemm_phase(lds, g, S, E); }
    SEAM(9);
    { pg8::Gemm g{H1, W2, FF, FF, FF}; pg8::StaticOrder S; S.init(NT, D, G, bx); pg8::EpiBf16<0> E{MLP, D}; pg8::gemm_phase(lds, g, S, E); }
    SEAM(10);
    for (int m0 = gw; m0 < NT; m0 += 2 * NGW) {
        f32x4 xv[2][4]; u32x2 mx[2][4], ml[2][4];
#pragma unroll
        for (int r = 0; r < 2; ++r) { const int m = m0 + r * NGW; if (m < NT) {
#pragma unroll
                for (int j = 0; j < 4; ++j) { xv[r][j] = ((const f32x4*)(x + (size_t)m * D))[lane + 64 * j]; mx[r][j] = *(const u32x2*)(MIX + (size_t)m * D + 4 * lane + 256 * j);
                    ml[r][j] = *(const u32x2*)(MLP + (size_t)m * D + 4 * lane + 256 * j); } } }
#pragma unroll
        for (int r = 0; r < 2; ++r) { const int m = m0 + r * NGW; if (m < NT) { const float* mb = MOD + (size_t)(m >> 12) * INC;
                f32x4 mv[4], lv[4]; float s = 0.f, s3 = 0.f;
#pragma unroll
                for (int j = 0; j < 4; ++j) { mv[j] = (f32x4){pg8::bflo(mx[r][j].x), pg8::bfhi(mx[r][j].x), pg8::bflo(mx[r][j].y), pg8::bfhi(mx[r][j].y)}; s += (mv[j].x * mv[j].x + mv[j].y * mv[j].y) + (mv[j].z * mv[j].z + mv[j].w * mv[j].w);
                    lv[j] = (f32x4){pg8::bflo(ml[r][j].x), pg8::bfhi(ml[r][j].x), pg8::bflo(ml[r][j].y), pg8::bfhi(ml[r][j].y)}; s3 += (lv[j].x * lv[j].x + lv[j].y * lv[j].y) + (lv[j].z * lv[j].z + lv[j].w * lv[j].w); }
                const float r1 = rsqrtf(wave_sum(s) * (1.f / D) + EPS), r3 = rsqrtf(wave_sum(s3) * (1.f / D) + EPS);
#pragma unroll
                for (int j = 0; j < 4; ++j) { const f32x4 w1 = ((const f32x4*)(norm_w + D))[lane + 64 * j], g2 = ((const f32x4*)(mb + 2 * D))[lane + 64 * j];
                    const f32x4 w3 = ((const f32x4*)(norm_w + 3 * D))[lane + 64 * j], g5 = ((const f32x4*)(mb + 5 * D))[lane + 64 * j];
                    const f32x4 x1 = xv[r][j] + g2 * (mv[j] * r1 * w1);
                    ((f32x4*)(P.out + (size_t)m * D))[lane + 64 * j] = x1 + g5 * (lv[j] * r3 * w3); } } }
    }
#if PROBE_MASK
    { const unsigned long long _t = __builtin_amdgcn_s_memrealtime(); if ((PROBE_MASK >> 11) & 1) t_spin += _t - t_prev;
      if (bx == 0) { const unsigned long long t0 = __builtin_amdgcn_s_memrealtime(); while (__builtin_amdgcn_s_memrealtime() - t0 < t_spin) __builtin_amdgcn_s_sleep(8); } }
#endif
#if PROBE_XSYNC
    for (int i = 0; i < PROBE_XSYNC; ++i) grid.sync();
#endif
}
}

extern "C" void kernel_launch(void* const* d_in, const int* in_sizes, int n_in, void* d_out, int out_size, void* d_ws, size_t ws_size, hipStream_t stream) {
    static int grid = 0;
    if (grid == 0) {
        if (n_in != 24 || ws_size < WS_END) { fprintf(stderr, "kernel_launch: unexpected n_in %d / ws_size %zu\n", n_in, ws_size); grid = -1; return; }
        int dev = 0, cus = 0, per_cu = 0;
        hipGetDevice(&dev); hipDeviceGetAttribute(&cus, hipDeviceAttributeMultiprocessorCount, dev);
        hipFuncSetAttribute((const void*)mega, hipFuncAttributeMaxDynamicSharedMemorySize, LDS_BYTES);
        hipOccupancyMaxActiveBlocksPerMultiprocessor(&per_cu, (const void*)mega, 512, LDS_BYTES);
        if (per_cu < 1) { fprintf(stderr, "kernel_launch: occupancy query says %d blocks per CU\n", per_cu); grid = -1; return; }
        grid = cus;
    }
    if (grid < 0) return;
    if (hipMemsetAsync(d_ws, 0, 327680, stream) != hipSuccess) { fprintf(stderr, "kernel_launch: memset failed\n"); return; }
    Params p{};
    for (int i = 0; i < 24; ++i) p.in[i] = (const float*)d_in[i];
    p.out = (float*)d_out; p.ws = (unsigned char*)d_ws;
    void* args[] = {&p};
    hipError_t e = hipLaunchCooperativeKernel((const void*)mega, dim3(grid), dim3(512), args, LDS_BYTES, stream);
    if (e != hipSuccess) fprintf(stderr, "cooperative launch failed: %s (grid %d)\n", hipGetErrorString(e), grid);
}
```

```cpp
#include <hip/hip_runtime.h>
#include <hip/hip_cooperative_groups.h>
#include <cstdio>
#include <math.h>
namespace cg = cooperative_groups;
#ifndef PROBE_MASK
#define PROBE_MASK 0
#endif
#ifndef PROBE_XSYNC
#define PROBE_XSYNC 0
#endif
#ifndef PROBE_BUSY_PHASE
#define PROBE_BUSY_PHASE -1
#define PROBE_BUSY_BLOCK 0
#endif

namespace pg8 {
#define PG8_LAS __attribute__((address_space(3)))
typedef unsigned short bf16_t;
typedef short bf16x8 __attribute__((ext_vector_type(8)));
typedef float f32x4 __attribute__((ext_vector_type(4)));
typedef unsigned u32x4 __attribute__((ext_vector_type(4)));
typedef unsigned u32x2 __attribute__((ext_vector_type(2)));
constexpr int BM = 256, BK = 64, HALF = 128, HTB = HALF * BK * 2, STAGE_BYTES = 8 * HTB, NXCD = 8, WGM = 8;

__device__ __forceinline__ int lds_byte(int r, int c) { const int st = (r >> 4) * 2 + (c >> 5), rr = r & 15, cc = c & 31, ob = rr * 64 + cc * 2; return st * 1024 + (ob ^ (((ob >> 9) & 1) << 5)); }
__device__ __forceinline__ void stage_rc(int b, int& R, int& C) { const int st = b / 1024, sb = b % 1024, swz = sb ^ (((sb >> 9) & 1) << 5); R = (st >> 1) * 16 + swz / 64; C = (st & 1) * 32 + (swz % 64) / 2; }
__device__ __forceinline__ int perm32(int rho) { const int n = rho >> 4, i = rho & 15; return 8 * (i >> 2) + 4 * n + (i & 3); }

struct Unit { int pm, pn, kb, pass; };
struct Gemm { const bf16_t* A; const bf16_t* Bt; int lda, ldb, K; };

struct StaticOrder {
    int nM, nN, nwg, G, c;
    __device__ void init(int M, int N, int G_, int c_) { nM = M / BM; nN = N / BM; nwg = nM * nN; G = G_; c = c_; }
    __device__ bool next(int i, Unit& u) const {
        const long L = (long)i * G + c; if (L >= nwg) return false;
        int wgid = (int)L; { const int q = nwg / NXCD, r = nwg % NXCD, xcd = wgid % NXCD, off = wgid / NXCD; wgid = (xcd < r ? xcd * (q + 1) : r * (q + 1) + (xcd - r) * q) + off; }
        const int nig = WGM * nN, gid = wgid / nig, fm = gid * WGM, gsz = (nM - fm) < WGM ? (nM - fm) : WGM;
        u.pm = fm + ((wgid % nig) % gsz); u.pn = (wgid % nig) / gsz; u.kb = 0; u.pass = 0; return true;
    }
};

struct TwoPassOrder {
    StaticOrder base; int kbytes;
    __device__ bool next(int i, Unit& u) const { if (!base.next(i >> 1, u)) return false; u.pass = i & 1; u.kb = (i & 1) * kbytes; return true; }
};
__device__ __forceinline__ unsigned cvt_pk_bf16(float lo, float hi) { unsigned r; asm volatile("v_cvt_pk_bf16_f32 %0, %1, %2" : "=v"(r) : "v"(lo), "v"(hi)); return r; }
__device__ __forceinline__ float sigm(float x) { return __builtin_amdgcn_rcpf(1.0f + __builtin_amdgcn_exp2f(-1.4426950408889634f * x)); }
__device__ __forceinline__ float bflo(unsigned u) { return __uint_as_float(u << 16); }
__device__ __forceinline__ float bfhi(unsigned u) { return __uint_as_float(u & 0xffff0000u); }

template <int ACT  > struct EpiBf16 {
    static constexpr bool PERM = true;
    bf16_t* O; int ldc;
    __device__ __forceinline__ void operator()(const f32x4 (&acc)[2][2][4][2], const Unit& u, int wr, int wc, int fr, int fq) const {
        const int row0 = u.pm * BM + wr * 64 + fr, col0 = u.pn * BM + wc * 32 + 8 * fq;
#pragma unroll
        for (int ai = 0; ai < 2; ++ai)
#pragma unroll
            for (int m = 0; m < 4; ++m) { bf16_t* rowp = O + (size_t)(row0 + ai * HALF + m * 16) * ldc + col0;
#pragma unroll
                for (int bj = 0; bj < 2; ++bj) { f32x4 v0 = acc[ai][bj][m][0], v1 = acc[ai][bj][m][1];
                    if (ACT == 3) {
#pragma unroll
                        for (int j = 0; j < 4; ++j) { const float a = fmaxf(v0[j], 0.f), b = fmaxf(v1[j], 0.f); v0[j] = a * a; v1[j] = b * b; } }
                    u32x4 w; w.x = cvt_pk_bf16(v0[0], v0[1]); w.y = cvt_pk_bf16(v0[2], v0[3]); w.z = cvt_pk_bf16(v1[0], v1[1]); w.w = cvt_pk_bf16(v1[2], v1[3]);
                    *(u32x4*)(rowp + bj * HALF) = w; } }
    }
};
struct EpiG1 {
    static constexpr bool PERM = true;
    bf16_t *PI, *PZ, *PQ, *PG, *GATES; const float* LBv; int ctx;
    __device__ __forceinline__ void operator()(const f32x4 (&acc)[2][2][4][2], const Unit& u, int wr, int wc, int fr, int fq) const {
        const int pn = u.pn; bf16_t* base; int ld, cb, act;
        if (ctx) { base = PI; ld = 1536; cb = pn * 256; act = pn < 2 ? 0 : 3; }
        else if (pn < 2) { base = PI; ld = 512; cb = pn * 256; act = 0; }
        else if (pn < 6) { base = PZ; ld = 1024; cb = (pn - 2) * 256; act = 3; }
        else if (pn < 8) { base = PQ; ld = 512; cb = (pn - 6) * 256; act = 1; }
        else if (pn < 10) { base = PG; ld = 512; cb = (pn - 8) * 256; act = 1; }
        else { base = GATES; ld = 2048; cb = (pn - 10) * 128; act = 2; }
        const int row0 = u.pm * BM + wr * 64 + fr, col0 = cb + wc * 32 + 8 * fq;
        if (act == 2) {
#pragma unroll
            for (int ai = 0; ai < 2; ++ai)
#pragma unroll
                for (int m = 0; m < 4; ++m) { bf16_t* rowp = base + (size_t)(row0 + ai * HALF + m * 16) * ld + col0; f32x4 rh[2], gb[2];
#pragma unroll
                    for (int n = 0; n < 2; ++n)
#pragma unroll
                        for (int j = 0; j < 4; ++j) { const float eA = __builtin_amdgcn_exp2f(-1.4426950408889634f * acc[ai][0][m][n][j]), eB = __builtin_amdgcn_exp2f(-1.4426950408889634f * acc[ai][1][m][n][j]);
                            gb[n][j] = __builtin_amdgcn_rcpf(1.0f + eB); rh[n][j] = (1.0f + eB) * __builtin_amdgcn_rcpf(1.0f + eA); }
                    u32x4 w; w.x = cvt_pk_bf16(rh[0][0], rh[0][1]); w.y = cvt_pk_bf16(rh[0][2], rh[0][3]); w.z = cvt_pk_bf16(rh[1][0], rh[1][1]); w.w = cvt_pk_bf16(rh[1][2], rh[1][3]);
                    *(u32x4*)rowp = w;
                    w.x = cvt_pk_bf16(gb[0][0], gb[0][1]); w.y = cvt_pk_bf16(gb[0][2], gb[0][3]); w.z = cvt_pk_bf16(gb[1][0], gb[1][1]); w.w = cvt_pk_bf16(gb[1][2], gb[1][3]);
                    *(u32x4*)(rowp + 1024) = w; }
            return;
        }
        f32x4 om[2][2];
        if (act == 3) {
#pragma unroll
            for (int bj = 0; bj < 2; ++bj)
#pragma unroll
                for (int n = 0; n < 2; ++n) { const f32x4 l = *(const f32x4*)(LBv + ((col0 + bj * HALF + 4 * n) & 511)); om[bj][n] = (f32x4){1.f - l.x, 1.f - l.y, 1.f - l.z, 1.f - l.w}; } }
#pragma unroll
        for (int ai = 0; ai < 2; ++ai)
#pragma unroll
            for (int m = 0; m < 4; ++m) { bf16_t* rowp = base + (size_t)(row0 + ai * HALF + m * 16) * ld + col0;
#pragma unroll
                for (int bj = 0; bj < 2; ++bj) { f32x4 v0 = acc[ai][bj][m][0], v1 = acc[ai][bj][m][1];
                    if (act == 3) {
#pragma unroll
                        for (int j = 0; j < 4; ++j) { v0[j] = om[bj][0][j] * sigm(-v0[j]); v1[j] = om[bj][1][j] * sigm(-v1[j]); } }
                    else if (act != 0) {
#pragma unroll
                        for (int j = 0; j < 4; ++j) { const float s0 = sigm(v0[j]), s1 = sigm(v1[j]); v0[j] = act == 1 ? v0[j] * s0 : s0; v1[j] = act == 1 ? v1[j] * s1 : s1; } }
                    u32x4 w; w.x = cvt_pk_bf16(v0[0], v0[1]); w.y = cvt_pk_bf16(v0[2], v0[3]); w.z = cvt_pk_bf16(v1[0], v1[1]); w.w = cvt_pk_bf16(v1[2], v1[3]);
                    *(u32x4*)(rowp + bj * HALF) = w; } }
    }
};
struct EpiMerge2 {
    static constexpr bool PERM = true;
    bf16_t* O; const bf16_t* RG;
    __device__ __forceinline__ void operator()(f32x4 (&acc)[2][2][4][2], const Unit& u, int wr, int wc, int fr, int fq) const {
        const int row0 = u.pm * BM + wr * 64 + fr, col0 = u.pn * BM + wc * 32 + 8 * fq; const int goff = u.pass ? 1024 : 0;
#pragma unroll
        for (int ai = 0; ai < 2; ++ai)
#pragma unroll
            for (int m = 0; m < 4; ++m) { const size_t r = (size_t)(row0 + ai * HALF + m * 16);
#pragma unroll
                for (int bj = 0; bj < 2; ++bj) { f32x4 v0 = acc[ai][bj][m][0], v1 = acc[ai][bj][m][1];
                    const u32x4 g = *(const u32x4*)(RG + r * 2048 + goff + col0 + bj * HALF);
                    v0[0] *= bflo(g.x); v0[1] *= bfhi(g.x); v0[2] *= bflo(g.y); v0[3] *= bfhi(g.y); v1[0] *= bflo(g.z); v1[1] *= bfhi(g.z); v1[2] *= bflo(g.w); v1[3] *= bfhi(g.w);
                    if (u.pass == 0) { acc[ai][bj][m][0] = v0; acc[ai][bj][m][1] = v1; }
                    else { u32x4 w; w.x = cvt_pk_bf16(v0[0], v0[1]); w.y = cvt_pk_bf16(v0[2], v0[3]); w.z = cvt_pk_bf16(v1[0], v1[1]); w.w = cvt_pk_bf16(v1[2], v1[3]);
                        *(u32x4*)(O + r * 1024 + col0 + bj * HALF) = w; } } }
    }
};

#ifndef PG8_SP2
#define PG8_SP2 true
#endif
#ifndef PG8_ALIGN
#define PG8_ALIGN true
#endif
template <class Epi, class Sched, bool ALIGN_EPI = PG8_ALIGN, bool SP2 = PG8_SP2>
__device__ __forceinline__ void gemm_phase(PG8_LAS unsigned char* lds, const Gemm g, const Sched& S, const Epi& E) {
    const int tid = threadIdx.x, wid = __builtin_amdgcn_readfirstlane(tid >> 6), lane = tid & 63, wr = wid >> 2, wc = wid & 3, fr = lane & 15, fq = lane >> 4;
    const int nt = g.K / BK;
    unsigned voffA[2], voffB[2];
#pragma unroll
    for (int i = 0; i < 2; ++i) { int R, C; stage_rc(tid * 16 + i * 8192, R, C); const int Rb = Epi::PERM ? ((R & ~31) + perm32(R & 31)) : R;
        voffA[i] = (unsigned)(R * g.lda + C) * 2u; voffB[i] = (unsigned)(Rb * g.ldb + C) * 2u; }
    const size_t kstep = (size_t)(BK * 2);
    const size_t hstepA = (size_t)HALF * g.lda * 2, hstepB = (size_t)HALF * g.ldb * 2;
    const size_t tstepA = 2 * hstepA, tstepB = 2 * hstepB;
    const unsigned ldsw = (unsigned)wid * 1024u;
    const int aoff = lds_byte(wr * 64 + fr, fq * 8), boff = lds_byte(wc * 32 + fr, fq * 8);
#define PG8_SA(b, h) (((b) * 2 + (h)) * HTB)
#define PG8_SB(b, h) ((4 + (b) * 2 + (h)) * HTB)
#define PG8_STAGE(bufoff, gbase, voff) do { _Pragma("unroll") for (int _i = 0; _i < 2; ++_i) \
        __builtin_amdgcn_global_load_lds((const unsigned*)((const char*)(gbase) + (voff)[_i]), (PG8_LAS unsigned*)(lds + (bufoff) + ldsw + _i * 8192), 16, 0, 0); } while (0)
#define PG8_LDA(dst, b, h) do { _Pragma("unroll") for (int m = 0; m < 4; ++m) _Pragma("unroll") for (int k = 0; k < 2; ++k) dst[m][k] = *(const PG8_LAS bf16x8*)(lds + PG8_SA(b, h) + aoff + m * 2048 + k * 1024); } while (0)
#define PG8_LDB(dst, b, h) do { _Pragma("unroll") for (int n = 0; n < 2; ++n) _Pragma("unroll") for (int k = 0; k < 2; ++k) dst[n][k] = *(const PG8_LAS bf16x8*)(lds + PG8_SB(b, h) + boff + n * 2048 + k * 1024); } while (0)
#define PG8_MMA(ai, bj, At, Bt) do { __builtin_amdgcn_s_setprio(1); _Pragma("unroll") for (int m = 0; m < 4; ++m) _Pragma("unroll") for (int n = 0; n < 2; ++n) _Pragma("unroll") for (int k = 0; k < 2; ++k) \
        acc[ai][bj][m][n] = __builtin_amdgcn_mfma_f32_16x16x32_bf16(Bt[n][k], At[m][k], acc[ai][bj][m][n], 0, 0, 0); __builtin_amdgcn_s_setprio(0); } while (0)
#define PG8_WAIT_V(n) asm volatile("s_waitcnt vmcnt(" #n ")" ::: "memory")
#define PG8_WAIT_L(n) asm volatile("s_waitcnt lgkmcnt(" #n ")" ::: "memory")
#define PG8_BAR __builtin_amdgcn_s_barrier()
#define PG8_SCHED __builtin_amdgcn_sched_barrier(0)
    Unit cur, nxt; int ui = 0;
    if (!S.next(0, cur)) return;
    f32x4 acc[2][2][4][2];
#pragma unroll
    for (int a = 0; a < 2; ++a)
#pragma unroll
        for (int b = 0; b < 2; ++b)
#pragma unroll
            for (int m = 0; m < 4; ++m)
#pragma unroll
                for (int n = 0; n < 2; ++n) acc[a][b][m][n] = (f32x4){0.f, 0.f, 0.f, 0.f};
    bf16x8 At[4][2], B0[2][2], B1[2][2];
    const char* cA = (const char*)g.A + (size_t)cur.pm * tstepA + cur.kb; const char* cB = (const char*)g.Bt + (size_t)cur.pn * tstepB + cur.kb;
    if constexpr (SP2) {
        PG8_STAGE(PG8_SB(0, 0), cB, voffB); PG8_STAGE(PG8_SB(0, 1), cB + hstepB, voffB); PG8_STAGE(PG8_SA(0, 0), cA, voffA); PG8_STAGE(PG8_SA(0, 1), cA + hstepA, voffA);
        if (wr == 1) PG8_BAR;
        PG8_WAIT_V(2); PG8_BAR;
        PG8_STAGE(PG8_SB(1, 0), cB + kstep, voffB); PG8_STAGE(PG8_SA(1, 0), cA + kstep, voffA); PG8_STAGE(PG8_SB(1, 1), cB + hstepB + kstep, voffB);
        PG8_WAIT_V(6); PG8_BAR;
    } else {
        PG8_STAGE(PG8_SB(0, 0), cB, voffB); PG8_STAGE(PG8_SA(0, 0), cA, voffA); PG8_STAGE(PG8_SB(0, 1), cB + hstepB, voffB); PG8_STAGE(PG8_SA(0, 1), cA + hstepA, voffA);
        if (wr == 1) PG8_BAR;
        PG8_WAIT_V(4); PG8_BAR;
        PG8_STAGE(PG8_SB(1, 0), cB + kstep, voffB); PG8_STAGE(PG8_SA(1, 0), cA + kstep, voffA); PG8_STAGE(PG8_SB(1, 1), cB + hstepB + kstep, voffB);
        PG8_WAIT_V(6); PG8_BAR;
    }
    for (;;) {
        const bool has_next = S.next(ui + 1, nxt);
        const char* nA = has_next ? (const char*)g.A + (size_t)nxt.pm * tstepA + nxt.kb : cA; const char* nB = has_next ? (const char*)g.Bt + (size_t)nxt.pn * tstepB + nxt.kb : cB;
        for (int t = 0; t < nt; t += 2) {
            const bool last = (t == nt - 2);
            const char* a1 = cA + (size_t)(t + 1) * kstep;
            const char* a2 = last ? nA : cA + (size_t)(t + 2) * kstep; const char* b2 = last ? nB : cB + (size_t)(t + 2) * kstep;
            const char* a3 = a2 + kstep; const char* b3 = b2 + kstep;
            if constexpr (SP2) {
            PG8_LDB(B0, 0, 0); PG8_LDB(B1, 0, 1); PG8_SCHED; PG8_LDA(At, 0, 0); PG8_STAGE(PG8_SA(1, 1), a1 + hstepA, voffA);
            PG8_WAIT_V(8); PG8_WAIT_L(0); PG8_BAR; PG8_MMA(0, 0, At, B0); PG8_MMA(0, 1, At, B1); PG8_BAR; PG8_SCHED;
            PG8_LDA(At, 0, 1); PG8_STAGE(PG8_SB(0, 0), b2, voffB); PG8_STAGE(PG8_SB(0, 1), b2 + hstepB, voffB); PG8_STAGE(PG8_SA(0, 0), a2, voffA);
            PG8_WAIT_V(8); PG8_WAIT_L(0); PG8_BAR; PG8_MMA(1, 0, At, B0); PG8_MMA(1, 1, At, B1); PG8_BAR; PG8_SCHED;
            PG8_LDB(B0, 1, 0); PG8_LDB(B1, 1, 1); PG8_SCHED; PG8_LDA(At, 1, 0); PG8_STAGE(PG8_SA(0, 1), a2 + hstepA, voffA);
            PG8_WAIT_V(8); PG8_WAIT_L(0); PG8_BAR; PG8_MMA(0, 0, At, B0); PG8_MMA(0, 1, At, B1); PG8_BAR; PG8_SCHED;
            PG8_LDA(At, 1, 1); PG8_STAGE(PG8_SB(1, 0), b3, voffB); PG8_STAGE(PG8_SB(1, 1), b3 + hstepB, voffB); PG8_STAGE(PG8_SA(1, 0), a3, voffA);
            PG8_WAIT_V(8); PG8_WAIT_L(0); PG8_BAR; PG8_MMA(1, 0, At, B0); PG8_MMA(1, 1, At, B1); PG8_BAR; PG8_SCHED;
            } else {
            PG8_LDB(B0, 0, 0); PG8_SCHED; PG8_LDA(At, 0, 0); PG8_STAGE(PG8_SA(1, 1), a1 + hstepA, voffA);
            PG8_WAIT_L(8); PG8_BAR; PG8_WAIT_L(0); PG8_MMA(0, 0, At, B0); PG8_BAR; PG8_SCHED;
            PG8_LDB(B1, 0, 1); PG8_STAGE(PG8_SB(0, 0), b2, voffB);
            PG8_BAR; PG8_WAIT_L(0); PG8_MMA(0, 1, At, B1); PG8_BAR;
            PG8_LDA(At, 0, 1); PG8_STAGE(PG8_SA(0, 0), a2, voffA);
            PG8_BAR; PG8_WAIT_L(0); PG8_MMA(1, 0, At, B0); PG8_BAR; PG8_SCHED;
            PG8_STAGE(PG8_SB(0, 1), b2 + hstepB, voffB);
            PG8_WAIT_V(6); PG8_BAR; PG8_MMA(1, 1, At, B1); PG8_BAR;
            PG8_LDB(B0, 1, 0); PG8_SCHED; PG8_LDA(At, 1, 0); PG8_STAGE(PG8_SA(0, 1), a2 + hstepA, voffA);
            PG8_WAIT_L(8); PG8_BAR; PG8_WAIT_L(0); PG8_MMA(0, 0, At, B0); PG8_BAR; PG8_SCHED;
            PG8_LDB(B1, 1, 1); PG8_STAGE(PG8_SB(1, 0), b3, voffB);
            PG8_BAR; PG8_WAIT_L(0); PG8_MMA(0, 1, At, B1); PG8_BAR;
            PG8_LDA(At, 1, 1); PG8_STAGE(PG8_SA(1, 0), a3, voffA);
            PG8_BAR; PG8_WAIT_L(0); PG8_MMA(1, 0, At, B0); PG8_BAR; PG8_SCHED;
            PG8_STAGE(PG8_SB(1, 1), b3 + hstepB, voffB);
            PG8_WAIT_V(6); PG8_BAR; PG8_MMA(1, 1, At, B1); PG8_BAR;
                    }
        }
        if constexpr (ALIGN_EPI) { if (wr == 0) PG8_BAR; }
        E(acc, cur, wr, wc, fr, fq);
        if (!has_next) break;
        if (nxt.pass == 0) {
#pragma unroll
        for (int a = 0; a < 2; ++a)
#pragma unroll
            for (int b = 0; b < 2; ++b)
#pragma unroll
                for (int m = 0; m < 4; ++m)
#pragma unroll
                    for (int n = 0; n < 2; ++n) acc[a][b][m][n] = (f32x4){0.f, 0.f, 0.f, 0.f};
        }
        cur = nxt; cA = nA; cB = nB; ++ui;
        if constexpr (ALIGN_EPI) { if (wr == 1) PG8_BAR; }
    }
    PG8_WAIT_V(0);
    if constexpr (!ALIGN_EPI) { if (wr == 0) PG8_BAR; }
    PG8_BAR;
#undef PG8_SA
#undef PG8_SB
#undef PG8_STAGE
#undef PG8_LDA
#undef PG8_LDB
#undef PG8_MMA
#undef PG8_WAIT_V
#undef PG8_WAIT_L
#undef PG8_BAR
#undef PG8_SCHED
}
}

namespace {
using pg8::bf16_t; using pg8::f32x4; using pg8::u32x4; using pg8::u32x2;
#define LAS __attribute__((address_space(3)))
constexpr int D = 1024, NB = 8, L = 4096, LC = 256, INC = 6144, FF = 4096, HW = 512;
constexpr int NT = NB * L, NCX = NB * LC;
constexpr float EPS = 1e-6f;
constexpr size_t MiB = 1u << 20;
constexpr size_t WS_MOD = 64 * 1024, WS_LB = 512 * 1024, WS_GT = 2 * MiB  ;
constexpr size_t WS_WIN = 18 * MiB, WS_WPAB = 30 * MiB, WS_WOUT = 32 * MiB, WS_W1 = 34 * MiB, WS_W2 = 42 * MiB;
constexpr size_t WS_STATE = 10 * MiB  , WS_HCTX = 50 * MiB, WS_PCTX = 54 * MiB, WS_SCTX = 60 * MiB;
constexpr size_t WS_HLAT = 64 * MiB;
constexpr size_t WS_PI = 128 * MiB, WS_PZ = 160 * MiB, WS_PQ = 224 * MiB, WS_PG = 256 * MiB, WS_GATES = 288 * MiB, WS_PHYT = 416 * MiB;
constexpr size_t WS_AY = 160 * MiB;
constexpr size_t WS_AY2 = 64 * MiB;
constexpr size_t WS_MERGED = 128 * MiB;
constexpr size_t WS_MIX = 448 * MiB, WS_MLP = 384 * MiB, WS_H1 = 128 * MiB, WS_HL = 64 * MiB;
constexpr size_t WS_END = 512 * MiB;
constexpr int LDS_BYTES = 163840;

__device__ __forceinline__ float bf2f(bf16_t h) { return __uint_as_float(((unsigned)h) << 16); }
__device__ __forceinline__ unsigned f2bf(float f) { unsigned u = __float_as_uint(f); return (u + 0x7fffu + ((u >> 16) & 1u)) >> 16; }
__device__ __forceinline__ unsigned pk2(float lo, float hi) { return f2bf(lo) | (f2bf(hi) << 16); }
__device__ __forceinline__ float sigmoidf_(float x) { return 1.f / (1.f + expf(-x)); }
__device__ __forceinline__ float siluf_(float x) { return x / (1.f + expf(-x)); }
__device__ __forceinline__ float wave_sum(float v) {
#pragma unroll
    for (int o = 1; o < 64; o <<= 1) v += __shfl_xor(v, o);
    return v;
}
#define LDS_WAIT() asm volatile("s_waitcnt lgkmcnt(0)" ::: "memory")

struct Params { const float* in[24]; float* out; unsigned char* ws; };

#define XB_TMO      128
#define XB_XCNT(j)  (256  + 64 * (j))
#define XB_XSUB(j)  (1280 + 64 * (j))
#define XB_XGEN(j)  (2304 + 64 * (j))
#define XB_TOP      3328
#define XB_TOPGEN   3392
#define XCD_BAR_WORDS 3456
#define XB_SPIN_CAP (1u << 18)

__device__ __forceinline__ unsigned xb_ld(unsigned* p)              { return __hip_atomic_load(p, __ATOMIC_RELAXED, __HIP_MEMORY_SCOPE_AGENT); }
__device__ __forceinline__ unsigned xb_add(unsigned* p, unsigned v) { return __hip_atomic_fetch_add(p, v, __ATOMIC_RELAXED, __HIP_MEMORY_SCOPE_AGENT); }
__device__ __forceinline__ unsigned xb_xcc_id() { return (unsigned)__builtin_amdgcn_s_getreg((3 << 11) | 20) & 0xFu; }
#define XB_SPIN(cond, bar) do { unsigned _sp = 0; while (cond) { __builtin_amdgcn_s_sleep(1); \
    if ((++_sp & 255u) == 0u) { if (xb_ld(&(bar)[XB_TMO])) break; if (_sp > XB_SPIN_CAP) { atomicAdd(&(bar)[XB_TMO], 1u); break; } } } } while (0)

struct XcdBarrier {
    unsigned* bar; unsigned x;
    volatile LAS unsigned* st;
};

__device__ __forceinline__ XcdBarrier xcd_barrier_post(unsigned* bar, volatile LAS unsigned* st) {
    XcdBarrier b; b.bar = bar; b.x = xb_xcc_id(); b.st = st;
    if (threadIdx.x == 0) (void)xb_add(&bar[XB_XCNT(b.x)], 1u);
    return b;
}
__device__ __forceinline__ void xcd_barrier_complete(unsigned* bar, unsigned x, unsigned& nloc, unsigned& nx) {
    const unsigned G = gridDim.x * gridDim.y * gridDim.z;
    unsigned sum, cnt, mine, sp = 0u;
    for (;;) {
        sum = 0u; cnt = 0u; mine = 0u;
#pragma unroll
        for (unsigned j = 0; j < 16; ++j) { const unsigned c = xb_ld(&bar[XB_XCNT(j)]); sum += c; cnt += (c > 0u) ? 1u : 0u; mine = (j == x) ? c : mine; }
        if (sum == G) break;
        __builtin_amdgcn_s_sleep(1);
        if ((++sp & 255u) == 0u) { if (xb_ld(&bar[XB_TMO])) break; if (sp > XB_SPIN_CAP) { atomicAdd(&bar[XB_TMO], 1u); break; } }
    }
    nloc = mine > 0u ? mine : 1u; nx = cnt > 0u ? cnt : 1u;
}

__device__ __forceinline__ void xcd_barrier(const XcdBarrier& b) {
    asm volatile("s_waitcnt vmcnt(0)" ::: "memory");
    __syncthreads();
    if (threadIdx.x == 0) {
        unsigned* bar = b.bar;
        __builtin_amdgcn_s_waitcnt(0);
        unsigned nloc = b.st[0], nx = b.st[1];
        if (nloc == 0u) { xcd_barrier_complete(bar, b.x, nloc, nx); b.st[0] = nloc; b.st[1] = nx; }
        const unsigned old = xb_add(&bar[XB_XSUB(b.x)], 1u);
        const unsigned gen = old / nloc;
        if (old + 1u == (gen + 1u) * nloc) {
            __builtin_amdgcn_fence(__ATOMIC_RELEASE, "agent");
            asm volatile("s_waitcnt vmcnt(0)" ::: "memory");
            const unsigned og = xb_add(&bar[XB_TOP], 1u);
            const unsigned tg = og / nx;
            if (og + 1u == (tg + 1u) * nx) xb_add(&bar[XB_TOPGEN], 1u);
            else XB_SPIN(xb_ld(&bar[XB_TOPGEN]) == tg, bar);
            __builtin_amdgcn_fence(__ATOMIC_ACQUIRE, "agent");
            xb_add(&bar[XB_XGEN(b.x)], 1u);
            asm volatile("s_waitcnt vmcnt(0)" ::: "memory");
        } else {
            XB_SPIN(xb_ld(&bar[XB_XGEN(b.x)]) == gen, bar);
            __builtin_amdgcn_fence(__ATOMIC_ACQUIRE, "agent");
            asm volatile("s_waitcnt vmcnt(0)" ::: "memory");
        }
    }
    __syncthreads();
}


__device__ __forceinline__ void transpose_item(const float* W, int N, bf16_t* WT, int ldk, int koff, int remap, LAS float* scr, int item, int lane) {
    const int nblk = N / 32, kb = item / nblk, nb = item % nblk, k0 = 64 * kb, n0 = 32 * nb;
    int rbase = n0;
    if (remap) { if (n0 < 2560) rbase = n0; else if (n0 < 4096) rbase = n0 + 2048;
        else { const int g = n0 - 4096, nn = g & 1023; rbase = 2560 + 256 * (nn >> 7) + (g >= 1024 ? 128 : 0) + (nn & 127); } }
#pragma unroll 8
    for (int i = 0; i < 32; ++i) { const int kk = 2 * i + (lane >> 5); scr[kk * 33 + (lane & 31)] = W[(size_t)(k0 + kk) * N + n0 + (lane & 31)]; }
    LDS_WAIT();
    const int c = lane & 7;
#pragma unroll
    for (int j = 0; j < 4; ++j) { const int n = (lane >> 3) + 8 * j; const LAS float* s = scr + (8 * c) * 33 + n;
        u32x4 o; o.x = pk2(s[0 * 33], s[1 * 33]); o.y = pk2(s[2 * 33], s[3 * 33]); o.z = pk2(s[4 * 33], s[5 * 33]); o.w = pk2(s[6 * 33], s[7 * 33]);
        *(u32x4*)(WT + (size_t)(rbase + n) * ldk + koff + k0 + 8 * c) = o; }
    LDS_WAIT();
}

__device__ __forceinline__ void row_norm_mod_bf16(const float* xrow, const float* nw, const float* scale, const float* shift, bf16_t* orow, int lane) {
    const f32x4* xr = (const f32x4*)xrow + lane; f32x4 v[4]; float s = 0.f;
#pragma unroll
    for (int j = 0; j < 4; ++j) { v[j] = xr[64 * j]; s += (v[j].x * v[j].x + v[j].y * v[j].y) + (v[j].z * v[j].z + v[j].w * v[j].w); }
    const float r = rsqrtf(wave_sum(s) * (1.f / D) + EPS);
    unsigned long long* o8 = (unsigned long long*)orow + lane;
#pragma unroll
    for (int j = 0; j < 4; ++j) { const f32x4 w = ((const f32x4*)nw)[lane + 64 * j], sc = ((const f32x4*)scale)[lane + 64 * j], sh = ((const f32x4*)shift)[lane + 64 * j];
        const f32x4 o = v[j] * r * w * (1.f + sc) + sh;
        o8[64 * j] = (unsigned long long)pk2(o.x, o.y) | ((unsigned long long)pk2(o.z, o.w) << 32); }
}
__device__ __forceinline__ f32x4 ld_bf4(const bf16_t* p) { const u32x2 u = *(const u32x2*)p; return (f32x4){pg8::bflo(u.x), pg8::bfhi(u.x), pg8::bflo(u.y), pg8::bfhi(u.y)}; }
__device__ __forceinline__ void row_x1(const float* xrow, const bf16_t* mixrow, const float* nw1, const float* g2, f32x4 (&x1)[4], int lane) {
    f32x4 mv[4]; float s = 0.f;
#pragma unroll
    for (int j = 0; j < 4; ++j) { mv[j] = ld_bf4(mixrow + 4 * lane + 256 * j); s += (mv[j].x * mv[j].x + mv[j].y * mv[j].y) + (mv[j].z * mv[j].z + mv[j].w * mv[j].w); }
    const float r = rsqrtf(wave_sum(s) * (1.f / D) + EPS);
#pragma unroll
    for (int j = 0; j < 4; ++j) { const f32x4 w = ((const f32x4*)nw1)[lane + 64 * j], g = ((const f32x4*)g2)[lane + 64 * j], xv = ((const f32x4*)xrow)[lane + 64 * j];
        x1[j] = xv + g * (mv[j] * r * w); }
}

typedef float f32x16 __attribute__((ext_vector_type(16)));
typedef float f32x2_t __attribute__((ext_vector_type(2)));
typedef __bf16 bf16x2_t __attribute__((ext_vector_type(2)));
__device__ __forceinline__ unsigned cvtpk(float lo, float hi) { const f32x2_t v = {lo, hi}; const bf16x2_t b = __builtin_convertvector(v, bf16x2_t); return __builtin_bit_cast(unsigned, b); }
constexpr int HY_PITCH = 8720;
constexpr int HY_TAB0 = 8 * HY_PITCH;
constexpr int HY_TAB1 = HY_TAB0 + 17408 + 64;
__device__ __forceinline__ void conv8(const u32x4 raw, float left, float right, float w0, float w1, float w2, float bias, float (&o)[8]) {
    float in[10]; in[0] = left; in[9] = right;
    in[1] = pg8::bflo(raw.x); in[2] = pg8::bfhi(raw.x); in[3] = pg8::bflo(raw.y); in[4] = pg8::bfhi(raw.y); in[5] = pg8::bflo(raw.z); in[6] = pg8::bfhi(raw.z); in[7] = pg8::bflo(raw.w); in[8] = pg8::bfhi(raw.w);
#pragma unroll
    for (int j = 0; j < 8; ++j) o[j] = bias + w0 * in[j] + w1 * in[j + 1] + w2 * in[j + 2];
}
__device__ __forceinline__ void hyena_channel(LAS unsigned char* lds, int c, bf16_t* PHYT, const bf16_t* GTB, const float* hy_sw, const float* hy_sb) {
    const int tid = threadIdx.x, lane = tid & 63, wave = __builtin_amdgcn_readfirstlane(tid >> 6);
    const bool hl = (tid & 7) != 0, hr = ((tid + 1) & 7) != 0;
    __syncthreads();
    for (int ci = tid; ci < 1088; ci += 512) { u32x4 v = (u32x4){0u, 0u, 0u, 0u};
        if (ci >= 32 && ci < 1056) v = *(const u32x4*)(GTB + (size_t)c * 8192 + (ci - 32) * 8);
        *(LAS u32x4*)(lds + HY_TAB0 + ci * 16) = v; }
    {
        const bf16_t* x1r = PHYT + (size_t)(512 + c) * NT + 8 * tid; const bf16_t* vr = PHYT + (size_t)(1024 + c) * NT + 8 * tid;
        const float xw0 = hy_sw[512 + c], xw1 = hy_sw[1536 + 512 + c], xw2 = hy_sw[3072 + 512 + c], xb = hy_sb[512 + c];
        const float vw0 = hy_sw[1024 + c], vw1 = hy_sw[1536 + 1024 + c], vw2 = hy_sw[3072 + 1024 + c], vb = hy_sb[1024 + c];
        u32x4 xa[8], va[8];
#pragma unroll
        for (int b = 0; b < 8; ++b) { xa[b] = *(const u32x4*)(x1r + (size_t)b * L); va[b] = *(const u32x4*)(vr + (size_t)b * L); }
#pragma unroll
        for (int b = 0; b < 8; ++b) {
            const unsigned xpw = __shfl_up(xa[b].w, 1), xnx = __shfl_down(xa[b].x, 1), vpw = __shfl_up(va[b].w, 1), vnx = __shfl_down(va[b].x, 1);
            const float xl = hl ? pg8::bfhi(xpw) : 0.f, xr = hr ? pg8::bflo(xnx) : 0.f, vl = hl ? pg8::bfhi(vpw) : 0.f, vrr = hr ? pg8::bflo(vnx) : 0.f;
            float cx[8], cv[8]; conv8(xa[b], xl, xr, xw0, xw1, xw2, xb, cx); conv8(va[b], vl, vrr, vw0, vw1, vw2, vb, cv);
            u32x4 w; w.x = cvtpk(cx[0] * cv[0], cx[1] * cv[1]); w.y = cvtpk(cx[2] * cv[2], cx[3] * cv[3]); w.z = cvtpk(cx[4] * cv[4], cx[5] * cv[5]); w.w = cvtpk(cx[6] * cv[6], cx[7] * cv[7]);
            *(LAS u32x4*)(lds + b * HY_PITCH + (128 + 8 * tid) * 2) = w; }
        if (tid < 256) { const int b = tid >> 5, side = (tid >> 4) & 1, k = tid & 15;
            *(LAS u32x4*)(lds + b * HY_PITCH + (side ? (128 + 4096) * 2 : 0) + k * 16) = (u32x4){0u, 0u, 0u, 0u}; }
    }
    __syncthreads();
    for (int ci = tid; ci < 1088; ci += 512) { const u32x4 d = *(const LAS u32x4*)(lds + HY_TAB0 + ci * 16); const unsigned d4 = ci < 1087 ? *(const LAS unsigned*)(lds + HY_TAB0 + ci * 16 + 16) : 0u;
        u32x4 o; o.x = __builtin_amdgcn_alignbit(d.y, d.x, 16); o.y = __builtin_amdgcn_alignbit(d.z, d.y, 16); o.z = __builtin_amdgcn_alignbit(d.w, d.z, 16); o.w = __builtin_amdgcn_alignbit(d4, d.w, 16);
        *(LAS u32x4*)(lds + HY_TAB1 + ci * 16) = o; }
    __syncthreads();
    const int T0 = 512 * wave, r = lane & 31, h = lane >> 5, bb = r >> 2, tb = r & 3;
    f32x16 acc[4];
#pragma unroll
    for (int i = 0; i < 4; ++i)
#pragma unroll
        for (int j = 0; j < 16; ++j) acc[i][j] = 0.f;
    {
        const int Dfirst = T0 - 4080;
        const int e0 = 4351 - Dfirst - r + 8 * h;
        const unsigned aaddr0 = (unsigned)((e0 & 1) ? HY_TAB1 : HY_TAB0) + (unsigned)(e0 & ~1) * 2u;
        const unsigned baddr0 = (unsigned)(bb * HY_PITCH + (128 + T0 + 32 * tb - Dfirst + 8 * h) * 2);
#define HY_LDA(dst, ad) do { u32x4 _t; _t.x = *(const LAS unsigned*)(lds + (ad)); _t.y = *(const LAS unsigned*)(lds + (ad) + 4); _t.z = *(const LAS unsigned*)(lds + (ad) + 8); _t.w = *(const LAS unsigned*)(lds + (ad) + 12); dst = __builtin_bit_cast(pg8::bf16x8, _t); } while (0)
#define HY_LDB(dst, ad) dst = *(const LAS pg8::bf16x8*)(lds + (ad))
#define HY_GENERIC(st_lo, st_hi) do { for (int st = (st_lo); st < (st_hi); ++st) { const int d = -4080 + 16 * st; const unsigned aa = aaddr0 - 32u * (unsigned)st, ba = baddr0 - 32u * (unsigned)st; pg8::bf16x8 A; HY_LDA(A, aa); \
            if (d <= 96) { pg8::bf16x8 B; HY_LDB(B, ba); acc[0] = __builtin_amdgcn_mfma_f32_32x32x16_bf16(A, B, acc[0], 0, 0, 0); } \
            if (d >= -3952 && d <= 224) { pg8::bf16x8 B; HY_LDB(B, ba + 256); acc[1] = __builtin_amdgcn_mfma_f32_32x32x16_bf16(A, B, acc[1], 0, 0, 0); } \
            if (d >= -3824 && d <= 352) { pg8::bf16x8 B; HY_LDB(B, ba + 512); acc[2] = __builtin_amdgcn_mfma_f32_32x32x16_bf16(A, B, acc[2], 0, 0, 0); } \
            if (d >= -3696) { pg8::bf16x8 B; HY_LDB(B, ba + 768); acc[3] = __builtin_amdgcn_mfma_f32_32x32x16_bf16(A, B, acc[3], 0, 0, 0); } } } while (0)
#define HY_LOAD5(A, B0, B1, B2, B3, aa, ba) do { HY_LDA(A, aa); HY_LDB(B0, ba); HY_LDB(B1, (ba) + 256); HY_LDB(B2, (ba) + 512); HY_LDB(B3, (ba) + 768); } while (0)
#define HY_MMA4(A, B0, B1, B2, B3) do { acc[0] = __builtin_amdgcn_mfma_f32_32x32x16_bf16(A, B0, acc[0], 0, 0, 0); acc[1] = __builtin_amdgcn_mfma_f32_32x32x16_bf16(A, B1, acc[1], 0, 0, 0); \
            acc[2] = __builtin_amdgcn_mfma_f32_32x32x16_bf16(A, B2, acc[2], 0, 0, 0); acc[3] = __builtin_amdgcn_mfma_f32_32x32x16_bf16(A, B3, acc[3], 0, 0, 0); } while (0)
        HY_GENERIC(0, 24);
        {
            unsigned aa = aaddr0 - 32u * 24u, ba = baddr0 - 32u * 24u;
            pg8::bf16x8 Aa, Ba0, Ba1, Ba2, Ba3, Ab, Bb0, Bb1, Bb2, Bb3;
            HY_LOAD5(Aa, Ba0, Ba1, Ba2, Ba3, aa, ba);
#pragma unroll 1
            for (int it = 0; it < 118; ++it) {
                HY_LOAD5(Ab, Bb0, Bb1, Bb2, Bb3, aa - 32u, ba - 32u); __builtin_amdgcn_sched_barrier(0);
                HY_MMA4(Aa, Ba0, Ba1, Ba2, Ba3); __builtin_amdgcn_sched_barrier(0);
                HY_LOAD5(Aa, Ba0, Ba1, Ba2, Ba3, aa - 64u, ba - 64u); __builtin_amdgcn_sched_barrier(0);
                HY_MMA4(Ab, Bb0, Bb1, Bb2, Bb3); __builtin_amdgcn_sched_barrier(0);
                aa -= 64u; ba -= 64u;
            }
            HY_LOAD5(Ab, Bb0, Bb1, Bb2, Bb3, aa - 32u, ba - 32u);
            HY_MMA4(Aa, Ba0, Ba1, Ba2, Ba3);
            HY_MMA4(Ab, Bb0, Bb1, Bb2, Bb3);
        }
        HY_GENERIC(262, 286);
#undef HY_LDA
#undef HY_LDB
#undef HY_GENERIC
#undef HY_LOAD5
#undef HY_MMA4
    }
    __syncthreads();
    {
        const bf16_t* x0r = PHYT + (size_t)c * NT + 8 * tid; u32x4 xa[8];
#pragma unroll
        for (int b = 0; b < 8; ++b) xa[b] = *(const u32x4*)(x0r + (size_t)b * L);
#pragma unroll
        for (int i = 0; i < 4; ++i)
#pragma unroll
            for (int g = 0; g < 4; ++g) { const int t = T0 + 128 * i + 32 * tb + 8 * g + 4 * h;
                pg8::u32x2 w; w.x = cvtpk(acc[i][4 * g], acc[i][4 * g + 1]); w.y = cvtpk(acc[i][4 * g + 2], acc[i][4 * g + 3]);
                *(LAS pg8::u32x2*)(lds + bb * HY_PITCH + (128 + t) * 2) = w; }
        __syncthreads();
        bf16_t* yr = PHYT + (size_t)(1024 + c) * NT + 8 * tid;
        const float w0 = hy_sw[c], w1 = hy_sw[1536 + c], w2 = hy_sw[3072 + c], bs = hy_sb[c];
#pragma unroll
        for (int b = 0; b < 8; ++b) {
            const unsigned xpw = __shfl_up(xa[b].w, 1), xnx = __shfl_down(xa[b].x, 1);
            const float xl = hl ? pg8::bfhi(xpw) : 0.f, xr = hr ? pg8::bflo(xnx) : 0.f;
            float cx[8]; conv8(xa[b], xl, xr, w0, w1, w2, bs, cx);
            const u32x4 y = *(const LAS u32x4*)(lds + b * HY_PITCH + (128 + 8 * tid) * 2);
            u32x4 w; w.x = cvtpk(cx[0] * pg8::bflo(y.x), cx[1] * pg8::bfhi(y.x)); w.y = cvtpk(cx[2] * pg8::bflo(y.y), cx[3] * pg8::bfhi(y.y));
            w.z = cvtpk(cx[4] * pg8::bflo(y.z), cx[5] * pg8::bfhi(y.z)); w.w = cvtpk(cx[6] * pg8::bflo(y.w), cx[7] * pg8::bfhi(y.w));
            *(u32x4*)(yr + (size_t)b * L) = w; }
    }
}

constexpr int HG_QE = 0, HG_KE = 17408, HG_KDT = 34816, HG_VT = 53248, HG_DEC = 71680, HG_BUF = 72192;

#define HG_RD2(ptr_a, ptr_b) __builtin_bit_cast(pg8::bf16x8, (u32x4){(*(const LAS u32x2*)(ptr_a)).x, (*(const LAS u32x2*)(ptr_a)).y, (*(const LAS u32x2*)(ptr_b)).x, (*(const LAS u32x2*)(ptr_b)).y})
typedef short v4i16_t __attribute__((ext_vector_type(4)));
#define HG_TR1(p) __builtin_amdgcn_ds_read_tr16_b64_v4i16((LAS v4i16_t*)(p))
#define HG_TR2(pa, pb) __builtin_bit_cast(pg8::bf16x8, __builtin_shufflevector(HG_TR1(pa), HG_TR1(pb), 0, 1, 2, 3, 4, 5, 6, 7))
#define HG_MFMA(a, b, c) __builtin_amdgcn_mfma_f32_16x16x32_bf16(a, b, c, 0, 0, 0)
#define HG_SB() __builtin_amdgcn_sched_barrier(0)
__device__ __forceinline__ pg8::bf16x8 hg_pack2(const f32x4& a, const f32x4& b) { u32x4 t; t.x = cvtpk(a[0], a[1]); t.y = cvtpk(a[2], a[3]); t.z = cvtpk(b[0], b[1]); t.w = cvtpk(b[2], b[3]); return __builtin_bit_cast(pg8::bf16x8, t); }
template <bool HAS_Q>
__device__ __forceinline__ void hgrn_consume(LAS unsigned char* Bf, f32x4 (&S)[2][8], int base, int dir, int h, int cw, int fr, int kg, float* o_out, int dbg) {
    const f32x4 z4 = (f32x4){0.f, 0.f, 0.f, 0.f};
    const int trq = fr >> 2, trp = fr & 3;
    pg8::bf16x8 Bv[2][2];
#pragma unroll
    for (int sl = 0; sl < 2; ++sl)
#pragma unroll
        for (int ks = 0; ks < 2; ++ks) { LAS unsigned char* const vp = Bf + HG_VT + (32 * ks + 4 * kg + trq) * 288 + (32 * cw + 16 * sl + 4 * trp) * 2; Bv[sl][ks] = HG_TR2(vp, vp + 16 * 288); }
    if (HAS_Q) {
        f32x4 st[10];
#pragma unroll
        for (int i = 0; i < 10; ++i) st[i] = z4;
        pg8::bf16x8 Kf[2][4], Qf[2][4];
        LAS unsigned char* const kbase = Bf + HG_KE + fr * 272 + 8 * kg * 2; LAS unsigned char* const qbase = Bf + HG_QE + fr * 272 + 8 * kg * 2;
#pragma unroll
        for (int b4 = 0; b4 < 4; ++b4) { Kf[0][b4] = *(const LAS pg8::bf16x8*)(kbase + b4 * 16 * 272); Qf[0][b4] = *(const LAS pg8::bf16x8*)(qbase + b4 * 16 * 272); }
#pragma unroll
        for (int ks = 0; ks < 4; ++ks) {
            if (ks < 3) {
#pragma unroll
                for (int b4 = 0; b4 < 4; ++b4) { Kf[(ks + 1) & 1][b4] = *(const LAS pg8::bf16x8*)(kbase + b4 * 16 * 272 + (ks + 1) * 64); Qf[(ks + 1) & 1][b4] = *(const LAS pg8::bf16x8*)(qbase + b4 * 16 * 272 + (ks + 1) * 64); } }
            HG_SB();
#pragma unroll
            for (int cb = 0; cb < 4; ++cb)
#pragma unroll
                for (int sb = 0; sb <= cb; ++sb) st[cb * (cb + 1) / 2 + sb] = HG_MFMA(Kf[ks & 1][sb], Qf[ks & 1][cb], st[cb * (cb + 1) / 2 + sb]);
            HG_SB();
        }
#pragma unroll
        for (int cb = 0; cb < 4; ++cb)
#pragma unroll
            for (int r = 0; r < 4; ++r) st[cb * (cb + 1) / 2 + cb][r] = (4 * kg + r <= fr) ? st[cb * (cb + 1) / 2 + cb][r] : 0.f;
        pg8::bf16x8 Af[4][2];
        Af[0][0] = hg_pack2(st[0], z4); Af[1][0] = hg_pack2(st[1], st[2]); Af[2][0] = hg_pack2(st[3], st[4]); Af[2][1] = hg_pack2(st[5], z4); Af[3][0] = hg_pack2(st[6], st[7]); Af[3][1] = hg_pack2(st[8], st[9]);
        pg8::bf16x8 Bs[2][4];
#pragma unroll
        for (int sl = 0; sl < 2; ++sl)
#pragma unroll
            for (int kp = 0; kp < 4; ++kp) Bs[sl][kp] = hg_pack2(S[sl][2 * kp], S[sl][2 * kp + 1]);
        pg8::bf16x8 Aq[2][4];
        LAS unsigned char* const qp0 = Bf + HG_QE + fr * 272 + 4 * kg * 2;
#pragma unroll
        for (int kp = 0; kp < 4; ++kp) Aq[0][kp] = HG_RD2(qp0 + kp * 64, qp0 + kp * 64 + 32);
#pragma unroll
        for (int cb = 0; cb < 4; ++cb) {
            if (cb < 3) {
#pragma unroll
                for (int kp = 0; kp < 4; ++kp) Aq[(cb + 1) & 1][kp] = HG_RD2(qp0 + (cb + 1) * 16 * 272 + kp * 64, qp0 + (cb + 1) * 16 * 272 + kp * 64 + 32); }
            HG_SB();
            f32x4 o0 = z4, o1 = z4;
            o0 = HG_MFMA(Bv[0][0], Af[cb][0], o0); o1 = HG_MFMA(Bv[1][0], Af[cb][0], o1);
            if (cb >= 2) { o0 = HG_MFMA(Bv[0][1], Af[cb][1], o0); o1 = HG_MFMA(Bv[1][1], Af[cb][1], o1); }
#pragma unroll
            for (int kp = 0; kp < 4; ++kp) { o0 = HG_MFMA(Bs[0][kp], Aq[cb & 1][kp], o0); o1 = HG_MFMA(Bs[1][kp], Aq[cb & 1][kp], o1); }
            HG_SB();
            { const int cp = 16 * cb + fr; const int t = base + (dir ? 63 - cp : cp); float* op = o_out + (size_t)t * 128 + 32 * cw + 4 * kg;
              if (!(dbg & 1)) { *(f32x4*)op = o0; *(f32x4*)(op + 16) = o1; } else asm volatile("" :: "v"(o0), "v"(o1)); }
        }
    }
    pg8::bf16x8 Ak[2][2][2]; f32x4 dc[2][2];
    LAS unsigned char* const kdp = Bf + HG_KDT + (4 * kg + trq) * 288 + 4 * trp * 2; LAS unsigned char* const dcp = Bf + HG_DEC + 4 * kg * 4;
#pragma unroll
    for (int u = 0; u < 2; ++u) { dc[0][u] = *(const LAS f32x4*)(dcp + u * 64);
#pragma unroll
        for (int ks = 0; ks < 2; ++ks) Ak[0][u][ks] = HG_TR2(kdp + u * 32 + ks * 32 * 288, kdp + u * 32 + ks * 32 * 288 + 16 * 288); }
#pragma unroll
    for (int bp = 0; bp < 4; ++bp) {
        if (bp < 3) {
#pragma unroll
            for (int u = 0; u < 2; ++u) { const int blk = 2 * (bp + 1) + u; dc[(bp + 1) & 1][u] = *(const LAS f32x4*)(dcp + blk * 64);
#pragma unroll
                for (int ks = 0; ks < 2; ++ks) Ak[(bp + 1) & 1][u][ks] = HG_TR2(kdp + blk * 32 + ks * 32 * 288, kdp + blk * 32 + ks * 32 * 288 + 16 * 288); } }
        HG_SB();
#pragma unroll
        for (int u = 0; u < 2; ++u) { const int blk = 2 * bp + u; f32x4 s0 = S[0][blk] * dc[bp & 1][u], s1 = S[1][blk] * dc[bp & 1][u];
#pragma unroll
            for (int ks = 0; ks < 2; ++ks) { s0 = HG_MFMA(Ak[bp & 1][u][ks], Bv[0][ks], s0); s1 = HG_MFMA(Ak[bp & 1][u][ks], Bv[1][ks], s1); }
            S[0][blk] = s0; S[1][blk] = s1; }
        HG_SB();
    }
}
#undef HG_RD2
#undef HG_TR1
#undef HG_TR2
#undef HG_MFMA
#undef HG_SB

template <bool HAS_Q>
__device__ __forceinline__ void hgrn_chain_mfma(LAS unsigned char* lds, const bf16_t* pi, int ldi, const bf16_t* pz, int ldz, const bf16_t* pq, int ldq, int Lseq, int h, int dir,
                                                const float* lb, const float* s_in, float* s_out, float* o_out, int n_begin, int nch  , int dbg = 0, unsigned char* dbgp = nullptr) {
    const int tid = threadIdx.x, lane = tid & 63, wave = __builtin_amdgcn_readfirstlane(tid >> 6);
    const bool producer = wave < 4;
#if PROBE_MASK
    unsigned long long bar_wait = 0ull;
#define HG_BAR() do { asm volatile("s_waitcnt lgkmcnt(0)" ::: "memory"); const unsigned long long _b0 = __builtin_amdgcn_s_memrealtime(); __builtin_amdgcn_s_barrier(); bar_wait += __builtin_amdgcn_s_memrealtime() - _b0; asm volatile("" ::: "memory"); } while (0)
#else
#define HG_BAR() do { asm volatile("s_waitcnt lgkmcnt(0)" ::: "memory"); __builtin_amdgcn_s_barrier(); asm volatile("" ::: "memory"); } while (0)
#endif
    const int pw = wave & 3, dp = lane & 15, rq = lane >> 4, ch0 = 32 * pw + 2 * dp;
    const int rowmin = dir ? 48 - 16 * rq : 16 * rq;
    const unsigned voZ = (unsigned)(rowmin * ldz + h * 128 + ch0) * 2u, voI = (unsigned)(rowmin * ldi + h * 128 + ch0) * 2u, voQ = (unsigned)(rowmin * (HAS_Q ? ldq : ldi) + h * 128 + ch0) * 2u;
    const __amdgpu_buffer_rsrc_t rsZ = __builtin_amdgcn_make_buffer_rsrc((void*)pz, 0, Lseq * ldz * 2, 0x00020000);
    const __amdgpu_buffer_rsrc_t rsI = __builtin_amdgcn_make_buffer_rsrc((void*)pi, 0, Lseq * ldi * 2, 0x00020000);
    const __amdgpu_buffer_rsrc_t rsQ = __builtin_amdgcn_make_buffer_rsrc((void*)(HAS_Q ? pq : pi), 0, Lseq * (HAS_Q ? ldq : ldi) * 2, 0x00020000);
#define HG_LOAD(n, Z, Q, V) do { const int _n = (dbg & 2) ? 0 : (n); const int _base = dir ? (Lseq - 64 * (_n + 1)) : 64 * _n; \
        _Pragma("unroll") for (int i = 0; i < 16; ++i) { const int _r = _base + (dir ? 15 - i : i); \
            Z[i] = __builtin_amdgcn_raw_buffer_load_b32(rsZ, voZ, _r * ldz * 2, 0); V[i] = __builtin_amdgcn_raw_buffer_load_b32(rsI, voI, _r * ldi * 2, 0); \
            if (HAS_Q) Q[i] = __builtin_amdgcn_raw_buffer_load_b32(rsQ, voQ, _r * ldq * 2, 0); } } while (0)
#define HG_PRODUCE(Z, Q, V, boff) do { LAS unsigned char* const Bf = lds + (boff); \
        float f0[16], f1[16]; float p0 = 1.f, p1 = 1.f; \
        _Pragma("unroll") for (int i = 0; i < 16; ++i) { f0[i] = 1.f - pg8::bflo(Z[i]); f1[i] = 1.f - pg8::bfhi(Z[i]); p0 *= f0[i]; p1 *= f1[i]; } \
        float run0 = 1.f, run1 = 1.f, fl0 = 1.f, fl1 = 1.f, suf0 = 1.f, suf1 = 1.f; \
        _Pragma("unroll") for (int qq = 0; qq < 4; ++qq) { const float t0 = __shfl(p0, dp + 16 * qq), t1 = __shfl(p1, dp + 16 * qq); fl0 *= t0; fl1 *= t1; if (qq < rq) { run0 *= t0; run1 *= t1; } if (qq > rq) { suf0 *= t0; suf1 *= t1; } } \
        if (HAS_Q) { \
            _Pragma("unroll") for (int i = 0; i < 16; ++i) { run0 *= f0[i]; run1 *= f1[i]; const float ia = __builtin_amdgcn_rcpf(run0), ib = __builtin_amdgcn_rcpf(run1); \
                const float kea = pg8::bflo(Z[i]) * ia, keb = pg8::bfhi(Z[i]) * ib; const int cp = 16 * rq + i; \
                *(LAS unsigned*)(Bf + HG_QE + cp * 272 + ch0 * 2) = cvtpk(pg8::bflo(Q[i]) * run0, pg8::bfhi(Q[i]) * run1); \
                *(LAS unsigned*)(Bf + HG_KE + cp * 272 + ch0 * 2) = cvtpk(kea, keb); \
                *(LAS unsigned*)(Bf + HG_KDT + cp * 288 + ch0 * 2) = cvtpk(kea * fl0, keb * fl1); } \
        } else { \
            _Pragma("unroll") for (int i = 15; i >= 0; --i) { const int cp = 16 * rq + i; \
                *(LAS unsigned*)(Bf + HG_KDT + cp * 288 + ch0 * 2) = cvtpk(pg8::bflo(Z[i]) * suf0, pg8::bfhi(Z[i]) * suf1); suf0 *= f0[i]; suf1 *= f1[i]; } \
        } \
        _Pragma("unroll") for (int i = 0; i < 16; ++i) *(LAS unsigned*)(Bf + HG_VT + (16 * rq + i) * 288 + ch0 * 2) = V[i]; \
        if (rq == 0) *(LAS f32x2_t*)(Bf + HG_DEC + ch0 * 4) = (f32x2_t){fl0, fl1}; } while (0)
#define HG_CONSUME(m, boff) hgrn_consume<HAS_Q>(lds + (boff), S, dir ? (Lseq - 64 * ((m) + 1)) : 64 * (m), dir, h, cw, fr, kg, o_out, dbg)

    __syncthreads();
    if (producer) {
        unsigned zA[16], qA[16], vA[16], zB[16], qB[16], vB[16];
        HG_LOAD(n_begin, zA, qA, vA);
        if (n_begin + 1 < nch) HG_LOAD(n_begin + 1, zB, qB, vB);
        for (int n = n_begin; n <= nch; n += 2) {
            if (n < nch && !(dbg & 4)) HG_PRODUCE(zA, qA, vA, 0);
            if (n + 2 < nch) HG_LOAD(n + 2, zA, qA, vA);
            HG_BAR();
            if (n + 1 < nch && !(dbg & 4)) HG_PRODUCE(zB, qB, vB, HG_BUF);
            if (n + 3 < nch) HG_LOAD(n + 3, zB, qB, vB);
            HG_BAR();
        }
    } else {
        const int cw = wave & 3, fr = lane & 15, kg = lane >> 4;
        __builtin_amdgcn_s_setprio(3);
        f32x4 S[2][8];
#pragma unroll
        for (int sl = 0; sl < 2; ++sl)
#pragma unroll
            for (int blk = 0; blk < 8; ++blk)
#pragma unroll
                for (int r = 0; r < 4; ++r) S[sl][blk][r] = s_in ? s_in[(size_t)(16 * blk + 4 * kg + r) * 128 + 32 * cw + 16 * sl + fr] : 0.f;
        for (int n = n_begin; n <= nch; n += 2) {
            if (n > n_begin && !(dbg & 8)) HG_CONSUME(n - 1, HG_BUF);
            HG_BAR();
            if (n < nch && !(dbg & 8)) HG_CONSUME(n, 0);
            HG_BAR();
        }
        if (dbg) {
#pragma unroll
            for (int sl = 0; sl < 2; ++sl)
#pragma unroll
                for (int blk = 0; blk < 8; ++blk) asm volatile("" :: "v"(S[sl][blk][0]), "v"(S[sl][blk][1]), "v"(S[sl][blk][2]), "v"(S[sl][blk][3]));
        }
        if (s_out) {
#pragma unroll
            for (int sl = 0; sl < 2; ++sl)
#pragma unroll
                for (int blk = 0; blk < 8; ++blk)
#pragma unroll
                    for (int r = 0; r < 4; ++r) s_out[(size_t)(16 * blk + 4 * kg + r) * 128 + 32 * cw + 16 * sl + fr] = S[sl][blk][r];
        }
        __builtin_amdgcn_s_setprio(0);
    }
#if PROBE_MASK
    if (HAS_Q && blockIdx.x == PROBE_BUSY_BLOCK && (tid == 0 || tid == 256) && dbg == 0) *(volatile unsigned long long*)(dbgp + (tid ? 8 : 0)) = bar_wait;
#endif
#undef HG_LOAD
#undef HG_PRODUCE
#undef HG_CONSUME
#undef HG_BAR
    __syncthreads();
}

__global__ void __launch_bounds__(512, 2) mega(Params P) {
    extern __shared__ __attribute__((aligned(16))) unsigned char lds_raw[];
    cg::grid_group grid = cg::this_grid();
    LAS unsigned char* lds = (LAS unsigned char*)lds_raw;
    const int tid = threadIdx.x, lane = tid & 63, wave = __builtin_amdgcn_readfirstlane(tid >> 6);
    const int G = gridDim.x, bx = blockIdx.x;
    const int vcu = (G % 8 == 0) ? (bx % 8) * (G / 8) + bx / 8 : bx;
    const int gw = vcu * 8 + wave, NGW = G * 8;
    unsigned char* ws = P.ws;
    const float* x = P.in[0]; const float* cvec = P.in[1]; const float* ctx = P.in[2]; const float* c_ctx = P.in[3];
    const float* w_ada = P.in[4]; const float* b_ada = P.in[5]; const float* norm_w = P.in[6]; const float* w_in = P.in[7];
    const float* lb_param = P.in[8]; const float* g_norm = P.in[9]; const float* hy_sw = P.in[10]; const float* hy_sb = P.in[11];
    const float* f_w1 = P.in[12]; const float* f_b1 = P.in[13]; const float* f_w2 = P.in[14]; const float* f_b2 = P.in[15];
    const float* f_w3 = P.in[16]; const float* f_freq = P.in[17]; const float* hy_d = P.in[18]; const float* w_pa = P.in[19];
    const float* w_pb = P.in[20]; const float* w_out = P.in[21]; const float* w_mlp1 = P.in[22]; const float* w_mlp2 = P.in[23];
    float* MOD = (float*)(ws + WS_MOD); float* LB = (float*)(ws + WS_LB); bf16_t* GTB = (bf16_t*)(ws + WS_GT);
    bf16_t* WIN = (bf16_t*)(ws + WS_WIN); bf16_t* WPAB = (bf16_t*)(ws + WS_WPAB); bf16_t* WOUT = (bf16_t*)(ws + WS_WOUT); bf16_t* W1 = (bf16_t*)(ws + WS_W1); bf16_t* W2 = (bf16_t*)(ws + WS_W2);
    bf16_t* HCTX = (bf16_t*)(ws + WS_HCTX); bf16_t* PCTX = (bf16_t*)(ws + WS_PCTX); float* SCTX = (float*)(ws + WS_SCTX);
    bf16_t* HLAT = (bf16_t*)(ws + WS_HLAT); bf16_t* PI = (bf16_t*)(ws + WS_PI); bf16_t* PZ = (bf16_t*)(ws + WS_PZ); bf16_t* PQ = (bf16_t*)(ws + WS_PQ);
    bf16_t* PG = (bf16_t*)(ws + WS_PG); bf16_t* GATES = (bf16_t*)(ws + WS_GATES); bf16_t* PHYT = (bf16_t*)(ws + WS_PHYT);
    bf16_t* AY = (bf16_t*)(ws + WS_AY2); bf16_t* MERGED = (bf16_t*)(ws + WS_MERGED); bf16_t* MIX = (bf16_t*)(ws + WS_MIX);
    bf16_t* MLP = (bf16_t*)(ws + WS_MLP); bf16_t* H1 = (bf16_t*)(ws + WS_H1); bf16_t* HL = (bf16_t*)(ws + WS_HL);
    float* O2 = P.out;

    volatile LAS unsigned* MISC = (volatile LAS unsigned*)(lds + LDS_BYTES - 128);
    if (tid < 16) MISC[tid] = 0u;
    __syncthreads();
    const XcdBarrier xbar = xcd_barrier_post((unsigned*)ws, MISC);
#define SEAM_RAW(k) do { if ((k) == 0) grid.sync(); else xcd_barrier(xbar); } while (0)
#if PROBE_MASK
    unsigned long long t_prev = __builtin_amdgcn_s_memrealtime(), t_spin = 0ull;
#define SEAM(k) do { if ((k) == PROBE_BUSY_PHASE && bx == PROBE_BUSY_BLOCK && tid == 0) *(volatile unsigned long long*)(ws + 32768) = __builtin_amdgcn_s_memrealtime() - t_prev; \
    SEAM_RAW(k); { const unsigned long long _t = __builtin_amdgcn_s_memrealtime(); if ((PROBE_MASK >> (k)) & 1) t_spin += _t - t_prev; \
    if ((k) == PROBE_BUSY_PHASE) t_spin += *(volatile unsigned long long*)(ws + 32768); t_prev = _t; } } while (0)
#else
#define SEAM(k) SEAM_RAW(k)
#endif
    {
        if (bx < 192) {
            const int cgp = bx % 96, kh = bx / 96;
            LAS float* sc = (LAS float*)lds;
            LAS float* ps = (LAS float*)(lds + 20480);
            for (int i = tid; i < 9 * 512; i += 512) { const int r = i >> 9, k = kh * 512 + (i & 511); sc[i] = siluf_(r < 8 ? cvec[r * D + k] : c_ctx[k]); }
            __syncthreads();
            const int j = cgp * 64 + lane; float a9[9];
#pragma unroll
            for (int r = 0; r < 9; ++r) a9[r] = 0.f;
            const float* wp = w_ada + (size_t)(kh * 512 + wave * 64) * INC + j;
#pragma unroll 1
            for (int kk = 0; kk < 64; kk += 16) { float w[16];
#pragma unroll
                for (int u = 0; u < 16; ++u) w[u] = wp[(size_t)(kk + u) * INC];
#pragma unroll
                for (int u = 0; u < 16; ++u)
#pragma unroll
                    for (int r = 0; r < 9; ++r) a9[r] += sc[r * 512 + wave * 64 + kk + u] * w[u]; }
#pragma unroll
            for (int r = 0; r < 9; ++r) ps[(wave * 9 + r) * 64 + lane] = a9[r];
            __syncthreads();
            for (int i = tid; i < 9 * 64; i += 512) { const int r = i >> 6, l = i & 63; float s = kh == 0 ? b_ada[cgp * 64 + l] : 0.f;
#pragma unroll
                for (int w = 0; w < 8; ++w) s += ps[(w * 9 + r) * 64 + l];
                atomicAdd(&MOD[r * INC + cgp * 64 + l], s); }
            __syncthreads();
        }
        if (bx == G - 1) { const float a = lb_param[tid], b = lb_param[HW + tid], m = fmaxf(a, b); const float ea = expf(a - m), eb = expf(b - m); LB[tid] = ea / (ea + eb); }
        {   LAS float* scr = (LAS float*)(lds + wave * 16384);
            for (int it = gw; it < 16 * 192; it += NGW) transpose_item(w_in, INC, WIN, D, 0, 1, scr, it, lane); }
        for (int tb = bx; tb < 256; tb += G) {
            __syncthreads();
            LAS float* zf = (LAS float*)lds; LAS float* h1 = zf + 17 * 36; LAS float* h2 = h1 + 17 * 64;
            for (int i = tid; i < 17 * 33; i += 512) { const int p = i / 33, k = i - 33 * p, t = 16 * tb + p; float val;
                if (k == 0) val = (float)t / (float)(L - 1);
                else { const int bi = (k - 1) & 15; const float band = 1e-4f + (float)bi * ((15.f - 1e-4f) / 15.f);
                    const float w = 2.0f * 3.14159265358979323846f * (float)t / (float)L; const float ang = w * band;
                    val = (k <= 16) ? cosf(ang) : -sinf(ang); }
                zf[p * 36 + k] = val; }
            __syncthreads();
            for (int i = tid; i < 17 * 64; i += 512) { const int p = i >> 6, k = i & 63; float acc = f_b1[k];
#pragma unroll 11
                for (int q = 0; q < 33; ++q) acc += zf[p * 36 + q] * f_w1[q * 64 + k];
                h1[i] = sinf(f_freq[k] * acc); }
            __syncthreads();
            for (int i = tid; i < 17 * 64; i += 512) { const int p = i >> 6, k = i & 63; float acc = f_b2[k];
#pragma unroll 16
                for (int q = 0; q < 64; ++q) acc += h1[p * 64 + q] * f_w2[q * 64 + k];
                h2[i] = sinf(f_freq[k] * acc); }
            __syncthreads();
            const int c = tid; float af[16], ab[16];
#pragma unroll
            for (int p = 0; p < 16; ++p) { af[p] = 0.f; ab[p] = 0.f; }
#pragma unroll 4
            for (int k = 0; k < 64; ++k) { const float wf = f_w3[k * 1024 + c], wb = f_w3[k * 1024 + 512 + c]; float hv[17];
#pragma unroll
                for (int p = 0; p < 17; ++p) hv[p] = h2[p * 64 + k];
#pragma unroll
                for (int p = 0; p < 16; ++p) { af[p] += hv[p] * wf; ab[p] += hv[p + 1] * wb; } }
            const float mind = logf(1e-2f) / 1.5f, maxd = logf(1e-2f) / 0.3f;
            const float delta = fabsf(mind + (maxd - mind) * ((float)c / 511.f));
            unsigned short of[16], ob[16];
#pragma unroll
            for (int p = 0; p < 16; ++p) { const int tf = 16 * tb + p, tbk = tf + 1;
                float vf = af[p] * expf(-((float)tf / (float)(L - 1)) * delta); if (tf == 0) vf += hy_d[c];
                float vb = ab[p] * expf(-((float)tbk / (float)(L - 1)) * delta); if (tbk >= L) vb = 0.f;
                of[15 - p] = (unsigned short)f2bf(vf); ob[p] = (unsigned short)f2bf(vb); }
            bf16_t* gf = GTB + (size_t)c * 8192 + (4080 - 16 * tb); bf16_t* gb = GTB + (size_t)c * 8192 + (4096 + 16 * tb);
            u32x4 w0, w1;
            w0.x = of[0] | ((unsigned)of[1] << 16); w0.y = of[2] | ((unsigned)of[3] << 16); w0.z = of[4] | ((unsigned)of[5] << 16); w0.w = of[6] | ((unsigned)of[7] << 16);
            w1.x = of[8] | ((unsigned)of[9] << 16); w1.y = of[10] | ((unsigned)of[11] << 16); w1.z = of[12] | ((unsigned)of[13] << 16); w1.w = of[14] | ((unsigned)of[15] << 16);
            *(u32x4*)gf = w0; *(u32x4*)(gf + 8) = w1;
            w0.x = ob[0] | ((unsigned)ob[1] << 16); w0.y = ob[2] | ((unsigned)ob[3] << 16); w0.z = ob[4] | ((unsigned)ob[5] << 16); w0.w = ob[6] | ((unsigned)ob[7] << 16);
            w1.x = ob[8] | ((unsigned)ob[9] << 16); w1.y = ob[10] | ((unsigned)ob[11] << 16); w1.z = ob[12] | ((unsigned)ob[13] << 16); w1.w = ob[14] | ((unsigned)ob[15] << 16);
            *(u32x4*)gb = w0; *(u32x4*)(gb + 8) = w1;
        }
    }
    SEAM(0);
    for (int m0 = gw; m0 < NT + NCX; m0 += 4 * NGW) {
        f32x4 v[4][4];
#pragma unroll
        for (int r = 0; r < 4; ++r) { const int m = m0 + r * NGW; if (m < NT + NCX) { const f32x4* xr = (const f32x4*)(m < NT ? x + (size_t)m * D : ctx + (size_t)(m - NT) * D) + lane;
#pragma unroll
                for (int j = 0; j < 4; ++j) v[r][j] = xr[64 * j]; } }
#pragma unroll
        for (int r = 0; r < 4; ++r) { const int m = m0 + r * NGW; if (m < NT + NCX) {
                const float* mb = MOD + (size_t)(m < NT ? (m >> 12) : 8) * INC; bf16_t* orow = m < NT ? HLAT + (size_t)m * D : HCTX + (size_t)(m - NT) * D;
                float s = 0.f;
#pragma unroll
                for (int j = 0; j < 4; ++j) s += (v[r][j].x * v[r][j].x + v[r][j].y * v[r][j].y) + (v[r][j].z * v[r][j].z + v[r][j].w * v[r][j].w);
                const float rs = rsqrtf(wave_sum(s) * (1.f / D) + EPS);
                unsigned long long* o8 = (unsigned long long*)orow + lane;
#pragma unroll
                for (int j = 0; j < 4; ++j) { const f32x4 w = ((const f32x4*)norm_w)[lane + 64 * j], sc = ((const f32x4*)mb)[lane + 64 * j], sh = ((const f32x4*)(mb + D))[lane + 64 * j];
                    const f32x4 o = v[r][j] * rs * w * (1.f + sc) + sh;
                    o8[64 * j] = (unsigned long long)cvtpk(o.x, o.y) | ((unsigned long long)cvtpk(o.z, o.w) << 32); } } }
    }
    SEAM(1);
    {
        { pg8::Gemm g{HLAT, WIN, D, D, D}; pg8::StaticOrder S; S.init(NT, 4608, G, bx); pg8::EpiG1 E{PI, PZ, PQ, PG, GATES, LB, 0};
          pg8::gemm_phase(lds, g, S, E); }
        { pg8::Gemm g{WIN + (size_t)4608 * D, HLAT, D, D, D}; pg8::StaticOrder S; S.init(1536, NT, G, bx); pg8::EpiBf16<0> E{PHYT, NT};
          pg8::gemm_phase(lds, g, S, E); }
        { pg8::Gemm g{HCTX, WIN, D, D, D}; pg8::StaticOrder S; S.init(NCX, 1536, G, bx); pg8::EpiG1 E{PCTX, nullptr, nullptr, nullptr, nullptr, LB, 1};
          pg8::gemm_phase(lds, g, S, E); }
    }
    SEAM(2);
    {
        float* STATE = (float*)(ws + WS_STATE);
        if (bx < 128) { const int chain = bx >> 1, seg = bx & 1, b = chain >> 3, h = (chain >> 1) & 3, dir = chain & 1; float* st = STATE + (size_t)bx * 16384;
            hgrn_chain_mfma<false>(lds, PCTX + (size_t)b * LC * 1536, 1536, PCTX + (size_t)b * LC * 1536 + (dir ? 1024 : 512), 1536, nullptr, 0, LC, h, dir, LB, nullptr, st, nullptr, 0, LC / 64);
            if (seg) hgrn_chain_mfma<false>(lds, PI + (size_t)b * L * 512, 512, PZ + (size_t)b * L * 1024 + (dir ? 512 : 0), 1024, nullptr, 0, L, h, dir, LB, st, st, nullptr, 0, 32);
            hgrn_chain_mfma<true>(lds, PI + (size_t)b * L * 512, 512, PZ + (size_t)b * L * 1024 + (dir ? 512 : 0), 1024, PQ + (size_t)b * L * 512, 512, L, h, dir, LB,
                                  st, nullptr, O2 + (size_t)chain * L * 128, 32 * seg, 32 * seg + 32, 0, ws + 32768 + 128);
#ifdef PROBE_SCAN2
            hgrn_chain_mfma<true>(lds, PI + (size_t)b * L * 512, 512, PZ + (size_t)b * L * 1024 + (dir ? 512 : 0), 1024, PQ + (size_t)b * L * 512, 512, L, h, dir, LB,
                                  st, nullptr, O2 + (size_t)chain * L * 128, 32 * seg, 32 * seg + 32, PROBE_SCAN2);
#endif
#if PROBE_MASK
            if (PROBE_BUSY_PHASE == 20 && bx == PROBE_BUSY_BLOCK && tid == 0) *(volatile unsigned long long*)(ws + 32768 + 64) = __builtin_amdgcn_s_memrealtime() - t_prev;
#endif
        } else {
            LAS float* scr = (LAS float*)(lds + wave * 16384);
            constexpr int I_PA = 8 * 32, I_OUT = 16 * 32, I_1 = 16 * 128, I_2 = 64 * 32;
            for (int it = (bx - 128) * 8 + wave; it < 2 * I_PA + I_OUT + I_1 + I_2; it += (G - 128) * 8) {
                int r = it;
                if (r < I_PA) { transpose_item(w_pa, D, WPAB, D, 0, 0, scr, r, lane); continue; } r -= I_PA;
                if (r < I_PA) { transpose_item(w_pb, D, WPAB, D, 512, 0, scr, r, lane); continue; } r -= I_PA;
                if (r < I_OUT) { transpose_item(w_out, D, WOUT, D, 0, 0, scr, r, lane); continue; } r -= I_OUT;
                if (r < I_1) { transpose_item(w_mlp1, FF, W1, D, 0, 0, scr, r, lane); continue; } r -= I_1;
                transpose_item(w_mlp2, D, W2, FF, 0, 0, scr, r, lane);
            }
        }
        unsigned* hctr = (unsigned*)(ws + 36864);
        for (;;) {
            __syncthreads();
            if (tid == 0) MISC[4] = atomicAdd(hctr, 1u);
            __syncthreads();
            const int c = (int)MISC[4];
            if (c >= HW) break;
            hyena_channel(lds, c, PHYT, GTB, hy_sw, hy_sb);
        }
    }
    SEAM(4);
#if PROBE_MASK
    if (PROBE_BUSY_PHASE == 20) t_spin += *(volatile unsigned long long*)(ws + 32768 + 64);
    if (PROBE_BUSY_PHASE == 21) t_spin += *(volatile unsigned long long*)(ws + 32768 + 128);
    if (PROBE_BUSY_PHASE == 22) t_spin += *(volatile unsigned long long*)(ws + 32768 + 136);
#endif
    {
        const f32x4 gn0 = ((const f32x4*)g_norm)[(2 * lane) & 31], gn1 = ((const f32x4*)g_norm)[(2 * lane + 1) & 31];
        for (int t0 = gw; t0 < NT; t0 += 2 * NGW) {
            f32x4 of[2][2], ob[2][2]; u32x4 pg[2];
#pragma unroll
            for (int r = 0; r < 2; ++r) { const int t = t0 + r * NGW; if (t < NT) {
                    { const int bb = t >> 12, hh = lane >> 4; const float* pf = O2 + ((size_t)((bb * 4 + hh) * 2) * L + (t & 4095)) * 128 + 8 * (lane & 15); const float* pb = pf + (size_t)L * 128;
                      of[r][0] = *(const f32x4*)pf; of[r][1] = *(const f32x4*)(pf + 4); ob[r][0] = *(const f32x4*)pb; ob[r][1] = *(const f32x4*)(pb + 4); }
                    pg[r] = ((const u32x4*)(PG + (size_t)t * 512))[lane]; } }
#pragma unroll
            for (int r = 0; r < 2; ++r) { const int t = t0 + r * NGW; if (t < NT) {
                    const f32x4 a0 = of[r][0] + ob[r][0], a1 = of[r][1] + ob[r][1];
                    float s = (a0.x * a0.x + a0.y * a0.y) + (a0.z * a0.z + a0.w * a0.w) + (a1.x * a1.x + a1.y * a1.y) + (a1.z * a1.z + a1.w * a1.w);
                    s += __shfl_xor(s, 1); s += __shfl_xor(s, 2); s += __shfl_xor(s, 4); s += __shfl_xor(s, 8);
                    const float rs = rsqrtf(s * (1.f / 128.f) + EPS);
                    u32x4 o;
                    o.x = cvtpk(a0.x * rs * gn0.x * pg8::bflo(pg[r].x), a0.y * rs * gn0.y * pg8::bfhi(pg[r].x)); o.y = cvtpk(a0.z * rs * gn0.z * pg8::bflo(pg[r].y), a0.w * rs * gn0.w * pg8::bfhi(pg[r].y));
                    o.z = cvtpk(a1.x * rs * gn1.x * pg8::bflo(pg[r].z), a1.y * rs * gn1.y * pg8::bfhi(pg[r].z)); o.w = cvtpk(a1.z * rs * gn1.z * pg8::bflo(pg[r].w), a1.w * rs * gn1.w * pg8::bfhi(pg[r].w));
                    *(u32x4*)(AY + (size_t)t * 1024 + 8 * lane) = o; } }
        }
    }
    {
        LAS bf16_t* tl = (LAS bf16_t*)(lds + wave * 16384);
        for (int it = gw; it < 8 * 512; it += NGW) { const int c0 = (it & 7) * 64, tok0 = (it >> 3) * 64;
#pragma unroll
            for (int i = 0; i < 8; ++i) { const int ch = lane + 64 * i, rr = ch >> 3, cc = (ch & 7) * 8;
                const u32x4 v = *(const u32x4*)(PHYT + (size_t)(1024 + c0 + rr) * NT + tok0 + cc);
                LAS unsigned* d = (LAS unsigned*)(tl + rr * 66 + cc); d[0] = v.x; d[1] = v.y; d[2] = v.z; d[3] = v.w; }
            LDS_WAIT();
#pragma unroll
            for (int i = 0; i < 8; ++i) { const int ch = lane + 64 * i, tt = ch >> 3, cc = (ch & 7) * 8; unsigned o[4];
#pragma unroll
                for (int q = 0; q < 4; ++q) o[q] = (unsigned)tl[(cc + 2 * q) * 66 + tt] | ((unsigned)tl[(cc + 2 * q + 1) * 66 + tt] << 16);
                *(u32x4*)(AY + (size_t)(tok0 + tt) * 1024 + 512 + c0 + cc) = (u32x4){o[0], o[1], o[2], o[3]}; }
            LDS_WAIT();
        }
    }
    SEAM(5);
    { pg8::Gemm g{AY, WPAB, D, D, 512}; pg8::TwoPassOrder S; S.base.init(NT, D, G, bx); S.kbytes = 1024; pg8::EpiMerge2 E{MERGED, GATES}; pg8::gemm_phase(lds, g, S, E); }
    SEAM(6);
    { pg8::Gemm g{MERGED, WOUT, D, D, D}; pg8::StaticOrder S; S.init(NT, D, G, bx); pg8::EpiBf16<0> E{MIX, D}; pg8::gemm_phase(lds, g, S, E); }
    SEAM(7);
    for (int m0 = gw; m0 < NT; m0 += 2 * NGW) {
        f32x4 xv[2][4]; u32x2 mx[2][4];
#pragma unroll
        for (int r = 0; r < 2; ++r) { const int m = m0 + r * NGW; if (m < NT) {
#pragma unroll
                for (int j = 0; j < 4; ++j) { xv[r][j] = ((const f32x4*)(x + (size_t)m * D))[lane + 64 * j]; mx[r][j] = *(const u32x2*)(MIX + (size_t)m * D + 4 * lane + 256 * j); } } }
#pragma unroll
        for (int r = 0; r < 2; ++r) { const int m = m0 + r * NGW; if (m < NT) { const float* mb = MOD + (size_t)(m >> 12) * INC;
                f32x4 mv[4], x1[4]; float s = 0.f;
#pragma unroll
                for (int j = 0; j < 4; ++j) { mv[j] = (f32x4){pg8::bflo(mx[r][j].x), pg8::bfhi(mx[r][j].x), pg8::bflo(mx[r][j].y), pg8::bfhi(mx[r][j].y)}; s += (mv[j].x * mv[j].x + mv[j].y * mv[j].y) + (mv[j].z * mv[j].z + mv[j].w * mv[j].w); }
                const float r1 = rsqrtf(wave_sum(s) * (1.f / D) + EPS); float s2 = 0.f;
#pragma unroll
                for (int j = 0; j < 4; ++j) { const f32x4 w = ((const f32x4*)(norm_w + D))[lane + 64 * j], g = ((const f32x4*)(mb + 2 * D))[lane + 64 * j];
                    x1[j] = xv[r][j] + g * (mv[j] * r1 * w); s2 += (x1[j].x * x1[j].x + x1[j].y * x1[j].y) + (x1[j].z * x1[j].z + x1[j].w * x1[j].w); }
                const float r2 = rsqrtf(wave_sum(s2) * (1.f / D) + EPS);
                unsigned long long* o8 = (unsigned long long*)(HL + (size_t)m * D) + lane;
#pragma unroll
                for (int j = 0; j < 4; ++j) { const f32x4 w = ((const f32x4*)(norm_w + 2 * D))[lane + 64 * j], sc = ((const f32x4*)(mb + 3 * D))[lane + 64 * j], sh = ((const f32x4*)(mb + 4 * D))[lane + 64 * j];
                    const f32x4 o = x1[j] * r2 * w * (1.f + sc) + sh;
                    o8[64 * j] = (unsigned long long)cvtpk(o.x, o.y) | ((unsigned long long)cvtpk(o.z, o.w) << 32); } } }
    }
    SEAM(8);
    { pg8::Gemm g{HL, W1, D, D, D}; pg8::StaticOrder S; S.init(NT, FF, G, bx); pg8::EpiBf16<3> E{H1, FF}; pg8::gemm_phase(lds, g, S, E); }
    SEAM(9);
    { pg8::Gemm g{H1, W2, FF, FF, FF}; pg8::StaticOrder S; S.init(NT, D, G, bx); pg8::EpiBf16<0> E{MLP, D}; pg8::gemm_phase(lds, g, S, E); }
    SEAM(10);
    for (int m0 = gw; m0 < NT; m0 += 2 * NGW) {
        f32x4 xv[2][4]; u32x2 mx[2][4], ml[2][4];
#pragma unroll
        for (int r = 0; r < 2; ++r) { const int m = m0 + r * NGW; if (m < NT) {
#pragma unroll
                for (int j = 0; j < 4; ++j) { xv[r][j] = ((const f32x4*)(x + (size_t)m * D))[lane + 64 * j]; mx[r][j] = *(const u32x2*)(MIX + (size_t)m * D + 4 * lane + 256 * j);
                    ml[r][j] = *(const u32x2*)(MLP + (size_t)m * D + 4 * lane + 256 * j); } } }
#pragma unroll
        for (int r = 0; r < 2; ++r) { const int m = m0 + r * NGW; if (m < NT) { const float* mb = MOD + (size_t)(m >> 12) * INC;
                f32x4 mv[4], lv[4]; float s = 0.f, s3 = 0.f;
#pragma unroll
                for (int j = 0; j < 4; ++j) { mv[j] = (f32x4){pg8::bflo(mx[r][j].x), pg8::bfhi(mx[r][j].x), pg8::bflo(mx[r][j].y), pg8::bfhi(mx[r][j].y)}; s += (mv[j].x * mv[j].x + mv[j].y * mv[j].y) + (mv[j].z * mv[j].z + mv[j].w * mv[j].w);
                    lv[j] = (f32x4){pg8::bflo(ml[r][j].x), pg8::bfhi(ml[r][j].x), pg8::bflo(ml[r][j].y), pg8::bfhi(ml[r][j].y)}; s3 += (lv[j].x * lv[j].x + lv[j].y * lv[j].y) + (lv[j].z * lv[j].z + lv[j].w * lv[j].w); }
                const float r1 = rsqrtf(wave_sum(s) * (1.f / D) + EPS), r3 = rsqrtf(wave_sum(s3) * (1.f / D) + EPS);
#pragma unroll
                for (int j = 0; j < 4; ++j) { const f32x4 w1 = ((const f32x4*)(norm_w + D))[lane + 64 * j], g2 = ((const f32x4*)(mb + 2 * D))[lane + 64 * j];
                    const f32x4 w3 = ((const f32x4*)(norm_w + 3 * D))[lane + 64 * j], g5 = ((const f32x4*)(mb + 5 * D))[lane + 64 * j];
                    const f32x4 x1 = xv[r][j] + g2 * (mv[j] * r1 * w1);
                    ((f32x4*)(P.out + (size_t)m * D))[lane + 64 * j] = x1 + g5 * (lv[j] * r3 * w3); } } }
    }
#if PROBE_MASK
    { const unsigned long long _t = __builtin_amdgcn_s_memrealtime(); if ((PROBE_MASK >> 11) & 1) t_spin += _t - t_prev;
      if (bx == 0) { const unsigned long long t0 = __builtin_amdgcn_s_memrealtime(); while (__builtin_amdgcn_s_memrealtime() - t0 < t_spin) __builtin_amdgcn_s_sleep(8); } }
#endif
#if PROBE_XSYNC
    for (int i = 0; i < PROBE_XSYNC; ++i) grid.sync();
#endif
}
}

extern "C" void kernel_launch(void* const* d_in, const int* in_sizes, int n_in, void* d_out, int out_size, void* d_ws, size_t ws_size, hipStream_t stream) {
    static int grid = 0;
    if (grid == 0) {
        if (n_in != 24 || ws_size < WS_END) { fprintf(stderr, "kernel_launch: unexpected n_in %d / ws_size %zu\n", n_in, ws_size); grid = -1; return; }
        int dev = 0, cus = 0, per_cu = 0;
        hipGetDevice(&dev); hipDeviceGetAttribute(&cus, hipDeviceAttributeMultiprocessorCount, dev);
        hipFuncSetAttribute((const void*)mega, hipFuncAttributeMaxDynamicSharedMemorySize, LDS_BYTES);
        hipOccupancyMaxActiveBlocksPerMultiprocessor(&per_cu, (const void*)mega, 512, LDS_BYTES);
        if (per_cu < 1) { fprintf(stderr, "kernel_launch: occupancy query says %d blocks per CU\n", per_cu); grid = -1; return; }
        grid = cus;
    }
    if (grid < 0) return;
    if (hipMemsetAsync(d_ws, 0, 327680, stream) != hipSuccess) { fprintf(stderr, "kernel_launch: memset failed\n"); return; }
    Params p{};
    for (int i = 0; i < 24; ++i) p.in[i] = (const float*)d_in[i];
    p.out = (float*)d_out; p.ws = (unsigned char*)d_ws;
    void* args[] = {&p};
    hipError_t e = hipLaunchCooperativeKernel((const void*)mega, dim3(grid), dim3(512), args, LDS_BYTES, stream);
    if (e != hipSuccess) fprintf(stderr, "cooperative launch failed: %s (grid %d)\n", hipGetErrorString(e), grid);
}
```

```cpp
#include <hip/hip_runtime.h>
#include <hip/hip_cooperative_groups.h>
#include <cstdio>
#include <math.h>
namespace cg = cooperative_groups;
#ifndef PROBE_MASK
#define PROBE_MASK 0
#endif
#ifndef PROBE_XSYNC
#define PROBE_XSYNC 0
#endif
#ifndef PROBE_BUSY_PHASE
#define PROBE_BUSY_PHASE -1
#define PROBE_BUSY_BLOCK 0
#endif

namespace pg8 {
#define PG8_LAS __attribute__((address_space(3)))
typedef unsigned short bf16_t;
typedef short bf16x8 __attribute__((ext_vector_type(8)));
typedef float f32x4 __attribute__((ext_vector_type(4)));
typedef unsigned u32x4 __attribute__((ext_vector_type(4)));
typedef unsigned u32x2 __attribute__((ext_vector_type(2)));
constexpr int BM = 256, BK = 64, HALF = 128, HTB = HALF * BK * 2, STAGE_BYTES = 8 * HTB, NXCD = 8, WGM = 8;

__device__ __forceinline__ int lds_byte(int r, int c) { const int st = (r >> 4) * 2 + (c >> 5), rr = r & 15, cc = c & 31, ob = rr * 64 + cc * 2; return st * 1024 + (ob ^ (((ob >> 9) & 1) << 5)); }
__device__ __forceinline__ void stage_rc(int b, int& R, int& C) { const int st = b / 1024, sb = b % 1024, swz = sb ^ (((sb >> 9) & 1) << 5); R = (st >> 1) * 16 + swz / 64; C = (st & 1) * 32 + (swz % 64) / 2; }
__device__ __forceinline__ int perm32(int rho) { const int n = rho >> 4, i = rho & 15; return 8 * (i >> 2) + 4 * n + (i & 3); }

struct Unit { int pm, pn, kb, pass; };
struct Gemm { const bf16_t* A; const bf16_t* Bt; int lda, ldb, K; };

struct StaticOrder {
    int nM, nN, nwg, G, c;
    __device__ void init(int M, int N, int G_, int c_) { nM = M / BM; nN = N / BM; nwg = nM * nN; G = G_; c = c_; }
    __device__ bool next(int i, Unit& u) const {
        const long L = (long)i * G + c; if (L >= nwg) return false;
        int wgid = (int)L; { const int q = nwg / NXCD, r = nwg % NXCD, xcd = wgid % NXCD, off = wgid / NXCD; wgid = (xcd < r ? xcd * (q + 1) : r * (q + 1) + (xcd - r) * q) + off; }
        const int nig = WGM * nN, gid = wgid / nig, fm = gid * WGM, gsz = (nM - fm) < WGM ? (nM - fm) : WGM;
        u.pm = fm + ((wgid % nig) % gsz); u.pn = (wgid % nig) / gsz; u.kb = 0; u.pass = 0; return true;
    }
};

struct TwoPassOrder {
    StaticOrder base; int kbytes;
    __device__ bool next(int i, Unit& u) const { if (!base.next(i >> 1, u)) return false; u.pass = i & 1; u.kb = (i & 1) * kbytes; return true; }
};
__device__ __forceinline__ unsigned cvt_pk_bf16(float lo, float hi) { unsigned r; asm volatile("v_cvt_pk_bf16_f32 %0, %1, %2" : "=v"(r) : "v"(lo), "v"(hi)); return r; }
__device__ __forceinline__ float sigm(float x) { return __builtin_amdgcn_rcpf(1.0f + __builtin_amdgcn_exp2f(-1.4426950408889634f * x)); }
__device__ __forceinline__ float bflo(unsigned u) { return __uint_as_float(u << 16); }
__device__ __forceinline__ float bfhi(unsigned u) { return __uint_as_float(u & 0xffff0000u); }

template <int ACT  > struct EpiBf16 {
    static constexpr bool PERM = true;
    bf16_t* O; int ldc;
    __device__ __forceinline__ void operator()(const f32x4 (&acc)[2][2][4][2], const Unit& u, int wr, int wc, int fr, int fq) const {
        const int row0 = u.pm * BM + wr * 64 + fr, col0 = u.pn * BM + wc * 32 + 8 * fq;
#pragma unroll
        for (int ai = 0; ai < 2; ++ai)
#pragma unroll
            for (int m = 0; m < 4; ++m) { bf16_t* rowp = O + (size_t)(row0 + ai * HALF + m * 16) * ldc + col0;
#pragma unroll
                for (int bj = 0; bj < 2; ++bj) { f32x4 v0 = acc[ai][bj][m][0], v1 = acc[ai][bj][m][1];
                    if (ACT == 3) {
#pragma unroll
                        for (int j = 0; j < 4; ++j) { const float a = fmaxf(v0[j], 0.f), b = fmaxf(v1[j], 0.f); v0[j] = a * a; v1[j] = b * b; } }
                    u32x4 w; w.x = cvt_pk_bf16(v0[0], v0[1]); w.y = cvt_pk_bf16(v0[2], v0[3]); w.z = cvt_pk_bf16(v1[0], v1[1]); w.w = cvt_pk_bf16(v1[2], v1[3]);
                    *(u32x4*)(rowp + bj * HALF) = w; } }
    }
};
struct EpiG1 {
    static constexpr bool PERM = true;
    bf16_t *PI, *PZ, *PQ, *PG, *GATES; const float* LBv; int ctx;
    __device__ __forceinline__ void operator()(const f32x4 (&acc)[2][2][4][2], const Unit& u, int wr, int wc, int fr, int fq) const {
        const int pn = u.pn; bf16_t* base; int ld, cb, act;
        if (ctx) { base = PI; ld = 1536; cb = pn * 256; act = pn < 2 ? 0 : 3; }
        else if (pn < 2) { base = PI; ld = 512; cb = pn * 256; act = 0; }
        else if (pn < 6) { base = PZ; ld = 1024; cb = (pn - 2) * 256; act = 3; }
        else if (pn < 8) { base = PQ; ld = 512; cb = (pn - 6) * 256; act = 1; }
        else if (pn < 10) { base = PG; ld = 512; cb = (pn - 8) * 256; act = 1; }
        else { base = GATES; ld = 2048; cb = (pn - 10) * 128; act = 2; }
        const int row0 = u.pm * BM + wr * 64 + fr, col0 = cb + wc * 32 + 8 * fq;
        if (act == 2) {
#pragma unroll
            for (int ai = 0; ai < 2; ++ai)
#pragma unroll
                for (int m = 0; m < 4; ++m) { bf16_t* rowp = base + (size_t)(row0 + ai * HALF + m * 16) * ld + col0; f32x4 rh[2], gb[2];
#pragma unroll
                    for (int n = 0; n < 2; ++n)
#pragma unroll
                        for (int j = 0; j < 4; ++j) { const float eA = __builtin_amdgcn_exp2f(-1.4426950408889634f * acc[ai][0][m][n][j]), eB = __builtin_amdgcn_exp2f(-1.4426950408889634f * acc[ai][1][m][n][j]);
                            gb[n][j] = __builtin_amdgcn_rcpf(1.0f + eB); rh[n][j] = (1.0f + eB) * __builtin_amdgcn_rcpf(1.0f + eA); }
                    u32x4 w; w.x = cvt_pk_bf16(rh[0][0], rh[0][1]); w.y = cvt_pk_bf16(rh[0][2], rh[0][3]); w.z = cvt_pk_bf16(rh[1][0], rh[1][1]); w.w = cvt_pk_bf16(rh[1][2], rh[1][3]);
                    *(u32x4*)rowp = w;
                    w.x = cvt_pk_bf16(gb[0][0], gb[0][1]); w.y = cvt_pk_bf16(gb[0][2], gb[0][3]); w.z = cvt_pk_bf16(gb[1][0], gb[1][1]); w.w = cvt_pk_bf16(gb[1][2], gb[1][3]);
                    *(u32x4*)(rowp + 1024) = w; }
            return;
        }
        f32x4 om[2][2];
        if (act == 3) {
#pragma unroll
            for (int bj = 0; bj < 2; ++bj)
#pragma unroll
                for (int n = 0; n < 2; ++n) { const f32x4 l = *(const f32x4*)(LBv + ((col0 + bj * HALF + 4 * n) & 511)); om[bj][n] = (f32x4){1.f - l.x, 1.f - l.y, 1.f - l.z, 1.f - l.w}; } }
#pragma unroll
        for (int ai = 0; ai < 2; ++ai)
#pragma unroll
            for (int m = 0; m < 4; ++m) { bf16_t* rowp = base + (size_t)(row0 + ai * HALF + m * 16) * ld + col0;
#pragma unroll
                for (int bj = 0; bj < 2; ++bj) { f32x4 v0 = acc[ai][bj][m][0], v1 = acc[ai][bj][m][1];
                    if (act == 3) {
#pragma unroll
                        for (int j = 0; j < 4; ++j) { v0[j] = om[bj][0][j] * sigm(-v0[j]); v1[j] = om[bj][1][j] * sigm(-v1[j]); } }
                    else if (act != 0) {
#pragma unroll
                        for (int j = 0; j < 4; ++j) { const float s0 = sigm(v0[j]), s1 = sigm(v1[j]); v0[j] = act == 1 ? v0[j] * s0 : s0; v1[j] = act == 1 ? v1[j] * s1 : s1; } }
                    u32x4 w; w.x = cvt_pk_bf16(v0[0], v0[1]); w.y = cvt_pk_bf16(v0[2], v0[3]); w.z = cvt_pk_bf16(v1[0], v1[1]); w.w = cvt_pk_bf16(v1[2], v1[3]);
                    *(u32x4*)(rowp + bj * HALF) = w; } }
    }
};
struct EpiMerge2 {
    static constexpr bool PERM = true;
    bf16_t* O; const bf16_t* RG;
    __device__ __forceinline__ void operator()(f32x4 (&acc)[2][2][4][2], const Unit& u, int wr, int wc, int fr, int fq) const {
        const int row0 = u.pm * BM + wr * 64 + fr, col0 = u.pn * BM + wc * 32 + 8 * fq; const int goff = u.pass ? 1024 : 0;
#pragma unroll
        for (int ai = 0; ai < 2; ++ai)
#pragma unroll
            for (int m = 0; m < 4; ++m) { const size_t r = (size_t)(row0 + ai * HALF + m * 16);
#pragma unroll
                for (int bj = 0; bj < 2; ++bj) { f32x4 v0 = acc[ai][bj][m][0], v1 = acc[ai][bj][m][1];
                    const u32x4 g = *(const u32x4*)(RG + r * 2048 + goff + col0 + bj * HALF);
                    v0[0] *= bflo(g.x); v0[1] *= bfhi(g.x); v0[2] *= bflo(g.y); v0[3] *= bfhi(g.y); v1[0] *= bflo(g.z); v1[1] *= bfhi(g.z); v1[2] *= bflo(g.w); v1[3] *= bfhi(g.w);
                    if (u.pass == 0) { acc[ai][bj][m][0] = v0; acc[ai][bj][m][1] = v1; }
                    else { u32x4 w; w.x = cvt_pk_bf16(v0[0], v0[1]); w.y = cvt_pk_bf16(v0[2], v0[3]); w.z = cvt_pk_bf16(v1[0], v1[1]); w.w = cvt_pk_bf16(v1[2], v1[3]);
                        *(u32x4*)(O + r * 1024 + col0 + bj * HALF) = w; } } }
    }
};

#ifndef PG8_SP2
#define PG8_SP2 true
#endif
#ifndef PG8_ALIGN
#define PG8_ALIGN true
#endif
template <class Epi, class Sched, bool ALIGN_EPI = PG8_ALIGN, bool SP2 = PG8_SP2>
__device__ __forceinline__ void gemm_phase(PG8_LAS unsigned char* lds, const Gemm g, const Sched& S, const Epi& E) {
    const int tid = threadIdx.x, wid = __builtin_amdgcn_readfirstlane(tid >> 6), lane = tid & 63, wr = wid >> 2, wc = wid & 3, fr = lane & 15, fq = lane >> 4;
    const int nt = g.K / BK;
    unsigned voffA[2], voffB[2];
#pragma unroll
    for (int i = 0; i < 2; ++i) { int R, C; stage_rc(tid * 16 + i * 8192, R, C); const int Rb = Epi::PERM ? ((R & ~31) + perm32(R & 31)) : R;
        voffA[i] = (unsigned)(R * g.lda + C) * 2u; voffB[i] = (unsigned)(Rb * g.ldb + C) * 2u; }
    const size_t kstep = (size_t)(BK * 2);
    const size_t hstepA = (size_t)HALF * g.lda * 2, hstepB = (size_t)HALF * g.ldb * 2;
    const size_t tstepA = 2 * hstepA, tstepB = 2 * hstepB;
    const unsigned ldsw = (unsigned)wid * 1024u;
    const int aoff = lds_byte(wr * 64 + fr, fq * 8), boff = lds_byte(wc * 32 + fr, fq * 8);
#define PG8_SA(b, h) (((b) * 2 + (h)) * HTB)
#define PG8_SB(b, h) ((4 + (b) * 2 + (h)) * HTB)
#define PG8_STAGE(bufoff, gbase, voff) do { _Pragma("unroll") for (int _i = 0; _i < 2; ++_i) \
        __builtin_amdgcn_global_load_lds((const unsigned*)((const char*)(gbase) + (voff)[_i]), (PG8_LAS unsigned*)(lds + (bufoff) + ldsw + _i * 8192), 16, 0, 0); } while (0)
#define PG8_LDA(dst, b, h) do { _Pragma("unroll") for (int m = 0; m < 4; ++m) _Pragma("unroll") for (int k = 0; k < 2; ++k) dst[m][k] = *(const PG8_LAS bf16x8*)(lds + PG8_SA(b, h) + aoff + m * 2048 + k * 1024); } while (0)
#define PG8_LDB(dst, b, h) do { _Pragma("unroll") for (int n = 0; n < 2; ++n) _Pragma("unroll") for (int k = 0; k < 2; ++k) dst[n][k] = *(const PG8_LAS bf16x8*)(lds + PG8_SB(b, h) + boff + n * 2048 + k * 1024); } while (0)
#define PG8_MMA(ai, bj, At, Bt) do { __builtin_amdgcn_s_setprio(1); _Pragma("unroll") for (int m = 0; m < 4; ++m) _Pragma("unroll") for (int n = 0; n < 2; ++n) _Pragma("unroll") for (int k = 0; k < 2; ++k) \
        acc[ai][bj][m][n] = __builtin_amdgcn_mfma_f32_16x16x32_bf16(Bt[n][k], At[m][k], acc[ai][bj][m][n], 0, 0, 0); __builtin_amdgcn_s_setprio(0); } while (0)
#define PG8_WAIT_V(n) asm volatile("s_waitcnt vmcnt(" #n ")" ::: "memory")
#define PG8_WAIT_L(n) asm volatile("s_waitcnt lgkmcnt(" #n ")" ::: "memory")
#define PG8_BAR __builtin_amdgcn_s_barrier()
#define PG8_SCHED __builtin_amdgcn_sched_barrier(0)
    Unit cur, nxt; int ui = 0;
    if (!S.next(0, cur)) return;
    f32x4 acc[2][2][4][2];
#pragma unroll
    for (int a = 0; a < 2; ++a)
#pragma unroll
        for (int b = 0; b < 2; ++b)
#pragma unroll
            for (int m = 0; m < 4; ++m)
#pragma unroll
                for (int n = 0; n < 2; ++n) acc[a][b][m][n] = (f32x4){0.f, 0.f, 0.f, 0.f};
    bf16x8 At[4][2], B0[2][2], B1[2][2];
    const char* cA = (const char*)g.A + (size_t)cur.pm * tstepA + cur.kb; const char* cB = (const char*)g.Bt + (size_t)cur.pn * tstepB + cur.kb;
    if constexpr (SP2) {
        PG8_STAGE(PG8_SB(0, 0), cB, voffB); PG8_STAGE(PG8_SB(0, 1), cB + hstepB, voffB); PG8_STAGE(PG8_SA(0, 0), cA, voffA); PG8_STAGE(PG8_SA(0, 1), cA + hstepA, voffA);
        if (wr == 1) PG8_BAR;
        PG8_WAIT_V(2); PG8_BAR;
        PG8_STAGE(PG8_SB(1, 0), cB + kstep, voffB); PG8_STAGE(PG8_SA(1, 0), cA + kstep, voffA); PG8_STAGE(PG8_SB(1, 1), cB + hstepB + kstep, voffB);
        PG8_WAIT_V(6); PG8_BAR;
    } else {
        PG8_STAGE(PG8_SB(0, 0), cB, voffB); PG8_STAGE(PG8_SA(0, 0), cA, voffA); PG8_STAGE(PG8_SB(0, 1), cB + hstepB, voffB); PG8_STAGE(PG8_SA(0, 1), cA + hstepA, voffA);
        if (wr == 1) PG8_BAR;
        PG8_WAIT_V(4); PG8_BAR;
        PG8_STAGE(PG8_SB(1, 0), cB + kstep, voffB); PG8_STAGE(PG8_SA(1, 0), cA + kstep, voffA); PG8_STAGE(PG8_SB(1, 1), cB + hstepB + kstep, voffB);
        PG8_WAIT_V(6); PG8_BAR;
    }
    for (;;) {
        const bool has_next = S.next(ui + 1, nxt);
        const char* nA = has_next ? (const char*)g.A + (size_t)nxt.pm * tstepA + nxt.kb : cA; const char* nB = has_next ? (const char*)g.Bt + (size_t)nxt.pn * tstepB + nxt.kb : cB;
        for (int t = 0; t < nt; t += 2) {
            const bool last = (t == nt - 2);
            const char* a1 = cA + (size_t)(t + 1) * kstep;
            const char* a2 = last ? nA : cA + (size_t)(t + 2) * kstep; const char* b2 = last ? nB : cB + (size_t)(t + 2) * kstep;
            const char* a3 = a2 + kstep; const char* b3 = b2 + kstep;
            if constexpr (SP2) {
            PG8_LDB(B0, 0, 0); PG8_LDB(B1, 0, 1); PG8_SCHED; PG8_LDA(At, 0, 0); PG8_STAGE(PG8_SA(1, 1), a1 + hstepA, voffA);
            PG8_WAIT_V(8); PG8_WAIT_L(0); PG8_BAR; PG8_MMA(0, 0, At, B0); PG8_MMA(0, 1, At, B1); PG8_BAR; PG8_SCHED;
            PG8_LDA(At, 0, 1); PG8_STAGE(PG8_SB(0, 0), b2, voffB); PG8_STAGE(PG8_SB(0, 1), b2 + hstepB, voffB); PG8_STAGE(PG8_SA(0, 0), a2, voffA);
            PG8_WAIT_V(8); PG8_WAIT_L(0); PG8_BAR; PG8_MMA(1, 0, At, B0); PG8_MMA(1, 1, At, B1); PG8_BAR; PG8_SCHED;
            PG8_LDB(B0, 1, 0); PG8_LDB(B1, 1, 1); PG8_SCHED; PG8_LDA(At, 1, 0); PG8_STAGE(PG8_SA(0, 1), a2 + hstepA, voffA);
            PG8_WAIT_V(8); PG8_WAIT_L(0); PG8_BAR; PG8_MMA(0, 0, At, B0); PG8_MMA(0, 1, At, B1); PG8_BAR; PG8_SCHED;
            PG8_LDA(At, 1, 1); PG8_STAGE(PG8_SB(1, 0), b3, voffB); PG8_STAGE(PG8_SB(1, 1), b3 + hstepB, voffB); PG8_STAGE(PG8_SA(1, 0), a3, voffA);
            PG8_WAIT_V(8); PG8_WAIT_L(0); PG8_BAR; PG8_MMA(1, 0, At, B0); PG8_MMA(1, 1, At, B1); PG8_BAR; PG8_SCHED;
            } else {
            PG8_LDB(B0, 0, 0); PG8_SCHED; PG8_LDA(At, 0, 0); PG8_STAGE(PG8_SA(1, 1), a1 + hstepA, voffA);
            PG8_WAIT_L(8); PG8_BAR; PG8_WAIT_L(0); PG8_MMA(0, 0, At, B0); PG8_BAR; PG8_SCHED;
            PG8_LDB(B1, 0, 1); PG8_STAGE(PG8_SB(0, 0), b2, voffB);
            PG8_BAR; PG8_WAIT_L(0); PG8_MMA(0, 1, At, B1); PG8_BAR;
            PG8_LDA(At, 0, 1); PG8_STAGE(PG8_SA(0, 0), a2, voffA);
            PG8_BAR; PG8_WAIT_L(0); PG8_MMA(1, 0, At, B0); PG8_BAR; PG8_SCHED;
            PG8_STAGE(PG8_SB(0, 1), b2 + hstepB, voffB);
            PG8_WAIT_V(6); PG8_BAR; PG8_MMA(1, 1, At, B1); PG8_BAR;
            PG8_LDB(B0, 1, 0); PG8_SCHED; PG8_LDA(At, 1, 0); PG8_STAGE(PG8_SA(0, 1), a2 + hstepA, voffA);
            PG8_WAIT_L(8); PG8_BAR; PG8_WAIT_L(0); PG8_MMA(0, 0, At, B0); PG8_BAR; PG8_SCHED;
            PG8_LDB(B1, 1, 1); PG8_STAGE(PG8_SB(1, 0), b3, voffB);
            PG8_BAR; PG8_WAIT_L(0); PG8_MMA(0, 1, At, B1); PG8_BAR;
            PG8_LDA(At, 1, 1); PG8_STAGE(PG8_SA(1, 0), a3, voffA);
            PG8_BAR; PG8_WAIT_L(0); PG8_MMA(1, 0, At, B0); PG8_BAR; PG8_SCHED;
            PG8_STAGE(PG8_SB(1, 1), b3 + hstepB, voffB);
            PG8_WAIT_V(6); PG8_BAR; PG8_MMA(1, 1, At, B1); PG8_BAR;
                    }
        }
        if constexpr (ALIGN_EPI) { if (wr == 0) PG8_BAR; }
        E(acc, cur, wr, wc, fr, fq);
        if (!has_next) break;
        if (nxt.pass == 0) {
#pragma unroll
        for (int a = 0; a < 2; ++a)
#pragma unroll
            for (int b = 0; b < 2; ++b)
#pragma unroll
                for (int m = 0; m < 4; ++m)
#pragma unroll
                    for (int n = 0; n < 2; ++n) acc[a][b][m][n] = (f32x4){0.f, 0.f, 0.f, 0.f};
        }
        cur = nxt; cA = nA; cB = nB; ++ui;
        if constexpr (ALIGN_EPI) { if (wr == 1) PG8_BAR; }
    }
    PG8_WAIT_V(0);
    if constexpr (!ALIGN_EPI) { if (wr == 0) PG8_BAR; }
    PG8_BAR;
#undef PG8_SA
#undef PG8_SB
#undef PG8_STAGE
#undef PG8_LDA
#undef PG8_LDB
#undef PG8_MMA
#undef PG8_WAIT_V
#undef PG8_WAIT_L
#undef PG8_BAR
#undef PG8_SCHED
}
}

namespace {
using pg8::bf16_t; using pg8::f32x4; using pg8::u32x4; using pg8::u32x2;
#define LAS __attribute__((address_space(3)))
constexpr int D = 1024, NB = 8, L = 4096, LC = 256, INC = 6144, FF = 4096, HW = 512;
constexpr int NT = NB * L, NCX = NB * LC;
constexpr float EPS = 1e-6f;
constexpr size_t MiB = 1u << 20;
constexpr size_t WS_MOD = 64 * 1024, WS_LB = 512 * 1024, WS_GT = 2 * MiB  ;
constexpr size_t WS_WIN = 18 * MiB, WS_WPAB = 30 * MiB, WS_WOUT = 32 * MiB, WS_W1 = 34 * MiB, WS_W2 = 42 * MiB;
constexpr size_t WS_STATE = 10 * MiB  , WS_HCTX = 50 * MiB, WS_PCTX = 54 * MiB, WS_SCTX = 60 * MiB;
constexpr size_t WS_HLAT = 64 * MiB;
constexpr size_t WS_PI = 128 * MiB, WS_PZ = 160 * MiB, WS_PQ = 224 * MiB, WS_PG = 256 * MiB, WS_GATES = 288 * MiB, WS_PHYT = 416 * MiB;
constexpr size_t WS_AY = 160 * MiB;
constexpr size_t WS_AY2 = 64 * MiB;
constexpr size_t WS_MERGED = 128 * MiB;
constexpr size_t WS_MIX = 448 * MiB, WS_MLP = 384 * MiB, WS_H1 = 128 * MiB, WS_HL = 64 * MiB;
constexpr size_t WS_END = 512 * MiB;
constexpr int LDS_BYTES = 163840;

__device__ __forceinline__ float bf2f(bf16_t h) { return __uint_as_float(((unsigned)h) << 16); }
__device__ __forceinline__ unsigned f2bf(float f) { unsigned u = __float_as_uint(f); return (u + 0x7fffu + ((u >> 16) & 1u)) >> 16; }
__device__ __forceinline__ unsigned pk2(float lo, float hi) { return f2bf(lo) | (f2bf(hi) << 16); }
__device__ __forceinline__ float sigmoidf_(float x) { return 1.f / (1.f + expf(-x)); }
__device__ __forceinline__ float siluf_(float x) { return x / (1.f + expf(-x)); }
__device__ __forceinline__ float wave_sum(float v) {
#pragma unroll
    for (int o = 1; o < 64; o <<= 1) v += __shfl_xor(v, o);
    return v;
}
#define LDS_WAIT() asm volatile("s_waitcnt lgkmcnt(0)" ::: "memory")

struct Params { const float* in[24]; float* out; unsigned char* ws; };

#define XB_TMO      128
#define XB_XCNT(j)  (256  + 64 * (j))
#define XB_XSUB(j)  (1280 + 64 * (j))
#define XB_XGEN(j)  (2304 + 64 * (j))
#define XB_TOP      3328
#define XB_TOPGEN   3392
#define XCD_BAR_WORDS 3456
#define XB_SPIN_CAP (1u << 18)

__device__ __forceinline__ unsigned xb_ld(unsigned* p)              { return __hip_atomic_load(p, __ATOMIC_RELAXED, __HIP_MEMORY_SCOPE_AGENT); }
__device__ __forceinline__ unsigned xb_add(unsigned* p, unsigned v) { return __hip_atomic_fetch_add(p, v, __ATOMIC_RELAXED, __HIP_MEMORY_SCOPE_AGENT); }
__device__ __forceinline__ unsigned xb_xcc_id() { return (unsigned)__builtin_amdgcn_s_getreg((3 << 11) | 20) & 0xFu; }
#define XB_SPIN(cond, bar) do { unsigned _sp = 0; while (cond) { __builtin_amdgcn_s_sleep(1); \
    if ((++_sp & 255u) == 0u) { if (xb_ld(&(bar)[XB_TMO])) break; if (_sp > XB_SPIN_CAP) { atomicAdd(&(bar)[XB_TMO], 1u); break; } } } } while (0)

struct XcdBarrier {
    unsigned* bar; unsigned x;
    volatile LAS unsigned* st;
};

__device__ __forceinline__ XcdBarrier xcd_barrier_post(unsigned* bar, volatile LAS unsigned* st) {
    XcdBarrier b; b.bar = bar; b.x = xb_xcc_id(); b.st = st;
    if (threadIdx.x == 0) (void)xb_add(&bar[XB_XCNT(b.x)], 1u);
    return b;
}
__device__ __forceinline__ void xcd_barrier_complete(unsigned* bar, unsigned x, unsigned& nloc, unsigned& nx) {
    const unsigned G = gridDim.x * gridDim.y * gridDim.z;
    unsigned sum, cnt, mine, sp = 0u;
    for (;;) {
        sum = 0u; cnt = 0u; mine = 0u;
#pragma unroll
        for (unsigned j = 0; j < 16; ++j) { const unsigned c = xb_ld(&bar[XB_XCNT(j)]); sum += c; cnt += (c > 0u) ? 1u : 0u; mine = (j == x) ? c : mine; }
        if (sum == G) break;
        __builtin_amdgcn_s_sleep(1);
        if ((++sp & 255u) == 0u) { if (xb_ld(&bar[XB_TMO])) break; if (sp > XB_SPIN_CAP) { atomicAdd(&bar[XB_TMO], 1u); break; } }
    }
    nloc = mine > 0u ? mine : 1u; nx = cnt > 0u ? cnt : 1u;
}

__device__ __forceinline__ void xcd_barrier(const XcdBarrier& b) {
    asm volatile("s_waitcnt vmcnt(0)" ::: "memory");
    __syncthreads();
    if (threadIdx.x == 0) {
        unsigned* bar = b.bar;
        __builtin_amdgcn_s_waitcnt(0);
        unsigned nloc = b.st[0], nx = b.st[1];
        if (nloc == 0u) { xcd_barrier_complete(bar, b.x, nloc, nx); b.st[0] = nloc; b.st[1] = nx; }
        const unsigned old = xb_add(&bar[XB_XSUB(b.x)], 1u);
        const unsigned gen = old / nloc;
        if (old + 1u == (gen + 1u) * nloc) {
            __builtin_amdgcn_fence(__ATOMIC_RELEASE, "agent");
            asm volatile("s_waitcnt vmcnt(0)" ::: "memory");
            const unsigned og = xb_add(&bar[XB_TOP], 1u);
            const unsigned tg = og / nx;
            if (og + 1u == (tg + 1u) * nx) xb_add(&bar[XB_TOPGEN], 1u);
            else XB_SPIN(xb_ld(&bar[XB_TOPGEN]) == tg, bar);
            __builtin_amdgcn_fence(__ATOMIC_ACQUIRE, "agent");
            xb_add(&bar[XB_XGEN(b.x)], 1u);
            asm volatile("s_waitcnt vmcnt(0)" ::: "memory");
        } else {
            XB_SPIN(xb_ld(&bar[XB_XGEN(b.x)]) == gen, bar);
            __builtin_amdgcn_fence(__ATOMIC_ACQUIRE, "agent");
            asm volatile("s_waitcnt vmcnt(0)" ::: "memory");
        }
    }
    __syncthreads();
}


__device__ __forceinline__ void transpose_item(const float* W, int N, bf16_t* WT, int ldk, int koff, int remap, LAS float* scr, int item, int lane) {
    const int nblk = N / 32, kb = item / nblk, nb = item % nblk, k0 = 64 * kb, n0 = 32 * nb;
    int rbase = n0;
    if (remap) { if (n0 < 2560) rbase = n0; else if (n0 < 4096) rbase = n0 + 2048;
        else { const int g = n0 - 4096, nn = g & 1023; rbase = 2560 + 256 * (nn >> 7) + (g >= 1024 ? 128 : 0) + (nn & 127); } }
#pragma unroll 8
    for (int i = 0; i < 32; ++i) { const int kk = 2 * i + (lane >> 5); scr[kk * 33 + (lane & 31)] = W[(size_t)(k0 + kk) * N + n0 + (lane & 31)]; }
    LDS_WAIT();
    const int c = lane & 7;
#pragma unroll
    for (int j = 0; j < 4; ++j) { const int n = (lane >> 3) + 8 * j; const LAS float* s = scr + (8 * c) * 33 + n;
        u32x4 o; o.x = pk2(s[0 * 33], s[1 * 33]); o.y = pk2(s[2 * 33], s[3 * 33]); o.z = pk2(s[4 * 33], s[5 * 33]); o.w = pk2(s[6 * 33], s[7 * 33]);
        *(u32x4*)(WT + (size_t)(rbase + n) * ldk + koff + k0 + 8 * c) = o; }
    LDS_WAIT();
}

__device__ __forceinline__ void row_norm_mod_bf16(const float* xrow, const float* nw, const float* scale, const float* shift, bf16_t* orow, int lane) {
    const f32x4* xr = (const f32x4*)xrow + lane; f32x4 v[4]; float s = 0.f;
#pragma unroll
    for (int j = 0; j < 4; ++j) { v[j] = xr[64 * j]; s += (v[j].x * v[j].x + v[j].y * v[j].y) + (v[j].z * v[j].z + v[j].w * v[j].w); }
    const float r = rsqrtf(wave_sum(s) * (1.f / D) + EPS);
    unsigned long long* o8 = (unsigned long long*)orow + lane;
#pragma unroll
    for (int j = 0; j < 4; ++j) { const f32x4 w = ((const f32x4*)nw)[lane + 64 * j], sc = ((const f32x4*)scale)[lane + 64 * j], sh = ((const f32x4*)shift)[lane + 64 * j];
        const f32x4 o = v[j] * r * w * (1.f + sc) + sh;
        o8[64 * j] = (unsigned long long)pk2(o.x, o.y) | ((unsigned long long)pk2(o.z, o.w) << 32); }
}
__device__ __forceinline__ f32x4 ld_bf4(const bf16_t* p) { const u32x2 u = *(const u32x2*)p; return (f32x4){pg8::bflo(u.x), pg8::bfhi(u.x), pg8::bflo(u.y), pg8::bfhi(u.y)}; }
__device__ __forceinline__ void row_x1(const float* xrow, const bf16_t* mixrow, const float* nw1, const float* g2, f32x4 (&x1)[4], int lane) {
    f32x4 mv[4]; float s = 0.f;
#pragma unroll
    for (int j = 0; j < 4; ++j) { mv[j] = ld_bf4(mixrow + 4 * lane + 256 * j); s += (mv[j].x * mv[j].x + mv[j].y * mv[j].y) + (mv[j].z * mv[j].z + mv[j].w * mv[j].w); }
    const float r = rsqrtf(wave_sum(s) * (1.f / D) + EPS);
#pragma unroll
    for (int j = 0; j < 4; ++j) { const f32x4 w = ((const f32x4*)nw1)[lane + 64 * j], g = ((const f32x4*)g2)[lane + 64 * j], xv = ((const f32x4*)xrow)[lane + 64 * j];
        x1[j] = xv + g * (mv[j] * r * w); }
}

typedef float f32x16 __attribute__((ext_vector_type(16)));
typedef float f32x2_t __attribute__((ext_vector_type(2)));
typedef __bf16 bf16x2_t __attribute__((ext_vector_type(2)));
__device__ __forceinline__ unsigned cvtpk(float lo, float hi) { const f32x2_t v = {lo, hi}; const bf16x2_t b = __builtin_convertvector(v, bf16x2_t); return __builtin_bit_cast(unsigned, b); }
constexpr int HY_PAD = 256, HY_PITCH = (HY_PAD + 4096 + HY_PAD) * 2 + 16;
constexpr int HY_TAB0 = 8 * HY_PITCH;
constexpr int HY_TAB1 = HY_TAB0 + 17408 + 64;
__device__ __forceinline__ void conv8(const u32x4 raw, float left, float right, float w0, float w1, float w2, float bias, float (&o)[8]) {
    float in[10]; in[0] = left; in[9] = right;
    in[1] = pg8::bflo(raw.x); in[2] = pg8::bfhi(raw.x); in[3] = pg8::bflo(raw.y); in[4] = pg8::bfhi(raw.y); in[5] = pg8::bflo(raw.z); in[6] = pg8::bfhi(raw.z); in[7] = pg8::bflo(raw.w); in[8] = pg8::bfhi(raw.w);
#pragma unroll
    for (int j = 0; j < 8; ++j) o[j] = bias + w0 * in[j] + w1 * in[j + 1] + w2 * in[j + 2];
}
__device__ __forceinline__ void hyena_channel(LAS unsigned char* lds, int c, bf16_t* PHYT, const bf16_t* GTB, const float* hy_sw, const float* hy_sb) {
    const int tid = threadIdx.x, lane = tid & 63, wave = __builtin_amdgcn_readfirstlane(tid >> 6);
    const bool hl = (tid & 7) != 0, hr = ((tid + 1) & 7) != 0;
    __syncthreads();
    for (int ci = tid; ci < 1088; ci += 512) { u32x4 v = (u32x4){0u, 0u, 0u, 0u};
        if (ci >= 32 && ci < 1056) v = *(const u32x4*)(GTB + (size_t)c * 8192 + (ci - 32) * 8);
        *(LAS u32x4*)(lds + HY_TAB0 + ci * 16) = v; }
    {
        const bf16_t* x1r = PHYT + (size_t)(512 + c) * NT + 8 * tid; const bf16_t* vr = PHYT + (size_t)(1024 + c) * NT + 8 * tid;
        const float xw0 = hy_sw[512 + c], xw1 = hy_sw[1536 + 512 + c], xw2 = hy_sw[3072 + 512 + c], xb = hy_sb[512 + c];
        const float vw0 = hy_sw[1024 + c], vw1 = hy_sw[1536 + 1024 + c], vw2 = hy_sw[3072 + 1024 + c], vb = hy_sb[1024 + c];
        u32x4 xa[8], va[8];
#pragma unroll
        for (int b = 0; b < 8; ++b) { xa[b] = *(const u32x4*)(x1r + (size_t)b * L); va[b] = *(const u32x4*)(vr + (size_t)b * L); }
#pragma unroll
        for (int b = 0; b < 8; ++b) {
            const unsigned xpw = __shfl_up(xa[b].w, 1), xnx = __shfl_down(xa[b].x, 1), vpw = __shfl_up(va[b].w, 1), vnx = __shfl_down(va[b].x, 1);
            const float xl = hl ? pg8::bfhi(xpw) : 0.f, xr = hr ? pg8::bflo(xnx) : 0.f, vl = hl ? pg8::bfhi(vpw) : 0.f, vrr = hr ? pg8::bflo(vnx) : 0.f;
            float cx[8], cv[8]; conv8(xa[b], xl, xr, xw0, xw1, xw2, xb, cx); conv8(va[b], vl, vrr, vw0, vw1, vw2, vb, cv);
            u32x4 w; w.x = cvtpk(cx[0] * cv[0], cx[1] * cv[1]); w.y = cvtpk(cx[2] * cv[2], cx[3] * cv[3]); w.z = cvtpk(cx[4] * cv[4], cx[5] * cv[5]); w.w = cvtpk(cx[6] * cv[6], cx[7] * cv[7]);
            *(LAS u32x4*)(lds + b * HY_PITCH + (HY_PAD + 8 * tid) * 2) = w; }
        { const int b = tid >> 6, side = (tid >> 5) & 1, k = tid & 31;
            *(LAS u32x4*)(lds + b * HY_PITCH + (side ? (HY_PAD + 4096) * 2 : 0) + k * 16) = (u32x4){0u, 0u, 0u, 0u}; }
    }
    __syncthreads();
    for (int ci = tid; ci < 1088; ci += 512) { const u32x4 d = *(const LAS u32x4*)(lds + HY_TAB0 + ci * 16); const unsigned d4 = ci < 1087 ? *(const LAS unsigned*)(lds + HY_TAB0 + ci * 16 + 16) : 0u;
        u32x4 o; o.x = __builtin_amdgcn_alignbit(d.y, d.x, 16); o.y = __builtin_amdgcn_alignbit(d.z, d.y, 16); o.z = __builtin_amdgcn_alignbit(d.w, d.z, 16); o.w = __builtin_amdgcn_alignbit(d4, d.w, 16);
        *(LAS u32x4*)(lds + HY_TAB1 + ci * 16) = o; }
    __syncthreads();
    const int T0 = 512 * wave, r = lane & 31, h = lane >> 5, bb = r & 7, tb = r >> 3;
    f32x16 acc[4];
#pragma unroll
    for (int i = 0; i < 4; ++i)
#pragma unroll
        for (int j = 0; j < 16; ++j) acc[i][j] = 0.f;
    {
        const int Dfirst = T0 - 4080;
        const int e0 = 4351 - Dfirst - r + 8 * h;
        const unsigned aaddr0 = (unsigned)((e0 & 1) ? HY_TAB1 : HY_TAB0) + (unsigned)(e0 & ~1) * 2u;
        const unsigned baddr0 = (unsigned)(bb * HY_PITCH + (HY_PAD + T0 + 64 * tb - Dfirst + 8 * h) * 2);
#define HY_LDA(dst, ad) do { u32x4 _t; _t.x = *(const LAS unsigned*)(lds + (ad)); _t.y = *(const LAS unsigned*)(lds + (ad) + 4); _t.z = *(const LAS unsigned*)(lds + (ad) + 8); _t.w = *(const LAS unsigned*)(lds + (ad) + 12); dst = __builtin_bit_cast(pg8::bf16x8, _t); } while (0)
#define HY_LDB(dst, ad) dst = *(const LAS pg8::bf16x8*)(lds + (ad))
#define HY_MMA(i, A, B) acc[i] = __builtin_amdgcn_mfma_f32_32x32x16_bf16(A, B, acc[i], 0, 0, 0)
#define HY_GENERIC(st_lo, st_hi) do { for (int st = (st_lo); st < (st_hi); ++st) { const unsigned aa = aaddr0 - 32u * (unsigned)st, ba = baddr0 - 32u * (unsigned)st; pg8::bf16x8 A; HY_LDA(A, aa); \
            if (st <= 267) { pg8::bf16x8 B; HY_LDB(B, ba); HY_MMA(0, A, B); } \
            if (st >= 2 && st <= 269) { pg8::bf16x8 B; HY_LDB(B, ba + 64); HY_MMA(1, A, B); } \
            if (st >= 16 && st <= 283) { pg8::bf16x8 B; HY_LDB(B, ba + 512); HY_MMA(2, A, B); } \
            if (st >= 18) { pg8::bf16x8 B; HY_LDB(B, ba + 576); HY_MMA(3, A, B); } } } while (0)
        HY_GENERIC(0, 18);
        {
            unsigned aa = aaddr0 - 32u * 18u, ba = baddr0 - 32u * 18u;
            pg8::bf16x8 Aa, Ab, X0, X1, X2, X3, Y0, Y1, Y2, Y3;
            HY_LDB(X0, ba + 64u); HY_LDB(Y0, ba + 64u + 512u);
            HY_LDB(X1, ba + 32u); HY_LDB(Y1, ba + 32u + 512u);
            HY_LDA(Aa, aa); HY_LDB(X2, ba); HY_LDB(Y2, ba + 512u);
#define HY_STEP(Acur, Anext, Xc, Xo, Xn, Yc, Yo, Yn, k) do { \
                HY_LDA(Anext, aa - 32u * ((k) + 1)); HY_LDB(Xn, ba - 32u * ((k) + 1)); HY_LDB(Yn, ba - 32u * ((k) + 1) + 512u); __builtin_amdgcn_sched_barrier(0); \
                HY_MMA(0, Acur, Xc); HY_MMA(1, Acur, Xo); HY_MMA(2, Acur, Yc); HY_MMA(3, Acur, Yo); __builtin_amdgcn_sched_barrier(0); } while (0)
#pragma unroll 1
            for (int it = 0; it < 62; ++it) {
                HY_STEP(Aa, Ab, X2, X0, X3, Y2, Y0, Y3, 0);
                HY_STEP(Ab, Aa, X3, X1, X0, Y3, Y1, Y0, 1);
                HY_STEP(Aa, Ab, X0, X2, X1, Y0, Y2, Y1, 2);
                HY_STEP(Ab, Aa, X1, X3, X2, Y1, Y3, Y2, 3);
                aa -= 128u; ba -= 128u;
            }
#undef HY_STEP
        }
        HY_GENERIC(266, 286);
#undef HY_LDA
#undef HY_LDB
#undef HY_MMA
#undef HY_GENERIC
    }
    __syncthreads();
    {
        const bf16_t* x0r = PHYT + (size_t)c * NT + 8 * tid; u32x4 xa[8];
#pragma unroll
        for (int b = 0; b < 8; ++b) xa[b] = *(const u32x4*)(x0r + (size_t)b * L);
#pragma unroll
        for (int i = 0; i < 4; ++i)
#pragma unroll
            for (int g = 0; g < 4; ++g) { const int t = T0 + 256 * (i >> 1) + 32 * (i & 1) + 64 * tb + 8 * g + 4 * h;
                pg8::u32x2 w; w.x = cvtpk(acc[i][4 * g], acc[i][4 * g + 1]); w.y = cvtpk(acc[i][4 * g + 2], acc[i][4 * g + 3]);
                *(LAS pg8::u32x2*)(lds + bb * HY_PITCH + (HY_PAD + t) * 2) = w; }
        __syncthreads();
        bf16_t* yr = PHYT + (size_t)(1024 + c) * NT + 8 * tid;
        const float w0 = hy_sw[c], w1 = hy_sw[1536 + c], w2 = hy_sw[3072 + c], bs = hy_sb[c];
#pragma unroll
        for (int b = 0; b < 8; ++b) {
            const unsigned xpw = __shfl_up(xa[b].w, 1), xnx = __shfl_down(xa[b].x, 1);
            const float xl = hl ? pg8::bfhi(xpw) : 0.f, xr = hr ? pg8::bflo(xnx) : 0.f;
            float cx[8]; conv8(xa[b], xl, xr, w0, w1, w2, bs, cx);
            const u32x4 y = *(const LAS u32x4*)(lds + b * HY_PITCH + (HY_PAD + 8 * tid) * 2);
            u32x4 w; w.x = cvtpk(cx[0] * pg8::bflo(y.x), cx[1] * pg8::bfhi(y.x)); w.y = cvtpk(cx[2] * pg8::bflo(y.y), cx[3] * pg8::bfhi(y.y));
            w.z = cvtpk(cx[4] * pg8::bflo(y.z), cx[5] * pg8::bfhi(y.z)); w.w = cvtpk(cx[6] * pg8::bflo(y.w), cx[7] * pg8::bfhi(y.w));
            *(u32x4*)(yr + (size_t)b * L) = w; }
    }
}

constexpr int HG_QE = 0, HG_KE = 17408, HG_KDT = 34816, HG_VT = 53248, HG_DEC = 71680, HG_BUF = 72192;

#define HG_RD2(ptr_a, ptr_b) __builtin_bit_cast(pg8::bf16x8, (u32x4){(*(const LAS u32x2*)(ptr_a)).x, (*(const LAS u32x2*)(ptr_a)).y, (*(const LAS u32x2*)(ptr_b)).x, (*(const LAS u32x2*)(ptr_b)).y})
typedef short v4i16_t __attribute__((ext_vector_type(4)));
#define HG_TR1(p) __builtin_amdgcn_ds_read_tr16_b64_v4i16((LAS v4i16_t*)(p))
#define HG_TR2(pa, pb) __builtin_bit_cast(pg8::bf16x8, __builtin_shufflevector(HG_TR1(pa), HG_TR1(pb), 0, 1, 2, 3, 4, 5, 6, 7))
#define HG_MFMA(a, b, c) __builtin_amdgcn_mfma_f32_16x16x32_bf16(a, b, c, 0, 0, 0)
#define HG_SB() __builtin_amdgcn_sched_barrier(0)
__device__ __forceinline__ pg8::bf16x8 hg_pack2(const f32x4& a, const f32x4& b) { u32x4 t; t.x = cvtpk(a[0], a[1]); t.y = cvtpk(a[2], a[3]); t.z = cvtpk(b[0], b[1]); t.w = cvtpk(b[2], b[3]); return __builtin_bit_cast(pg8::bf16x8, t); }
template <bool HAS_Q>
__device__ __forceinline__ void hgrn_consume(LAS unsigned char* Bf, f32x4 (&S)[2][8], int base, int dir, int h, int cw, int fr, int kg, float* o_out, int dbg) {
    const f32x4 z4 = (f32x4){0.f, 0.f, 0.f, 0.f};
    const int trq = fr >> 2, trp = fr & 3;
    pg8::bf16x8 Bv[2][2];
#pragma unroll
    for (int sl = 0; sl < 2; ++sl)
#pragma unroll
        for (int ks = 0; ks < 2; ++ks) { LAS unsigned char* const vp = Bf + HG_VT + (32 * ks + 4 * kg + trq) * 288 + (32 * cw + 16 * sl + 4 * trp) * 2; Bv[sl][ks] = HG_TR2(vp, vp + 16 * 288); }
    if (HAS_Q) {
        f32x4 st[10];
#pragma unroll
        for (int i = 0; i < 10; ++i) st[i] = z4;
        pg8::bf16x8 Kf[2][4], Qf[2][4];
        LAS unsigned char* const kbase = Bf + HG_KE + fr * 272 + 8 * kg * 2; LAS unsigned char* const qbase = Bf + HG_QE + fr * 272 + 8 * kg * 2;
#pragma unroll
        for (int b4 = 0; b4 < 4; ++b4) { Kf[0][b4] = *(const LAS pg8::bf16x8*)(kbase + b4 * 16 * 272); Qf[0][b4] = *(const LAS pg8::bf16x8*)(qbase + b4 * 16 * 272); }
#pragma unroll
        for (int ks = 0; ks < 4; ++ks) {
            if (ks < 3) {
#pragma unroll
                for (int b4 = 0; b4 < 4; ++b4) { Kf[(ks + 1) & 1][b4] = *(const LAS pg8::bf16x8*)(kbase + b4 * 16 * 272 + (ks + 1) * 64); Qf[(ks + 1) & 1][b4] = *(const LAS pg8::bf16x8*)(qbase + b4 * 16 * 272 + (ks + 1) * 64); } }
            HG_SB();
#pragma unroll
            for (int cb = 0; cb < 4; ++cb)
#pragma unroll
                for (int sb = 0; sb <= cb; ++sb) st[cb * (cb + 1) / 2 + sb] = HG_MFMA(Kf[ks & 1][sb], Qf[ks & 1][cb], st[cb * (cb + 1) / 2 + sb]);
            HG_SB();
        }
#pragma unroll
        for (int cb = 0; cb < 4; ++cb)
#pragma unroll
            for (int r = 0; r < 4; ++r) st[cb * (cb + 1) / 2 + cb][r] = (4 * kg + r <= fr) ? st[cb * (cb + 1) / 2 + cb][r] : 0.f;
        pg8::bf16x8 Af[4][2];
        Af[0][0] = hg_pack2(st[0], z4); Af[1][0] = hg_pack2(st[1], st[2]); Af[2][0] = hg_pack2(st[3], st[4]); Af[2][1] = hg_pack2(st[5], z4); Af[3][0] = hg_pack2(st[6], st[7]); Af[3][1] = hg_pack2(st[8], st[9]);
        pg8::bf16x8 Bs[2][4];
#pragma unroll
        for (int sl = 0; sl < 2; ++sl)
#pragma unroll
            for (int kp = 0; kp < 4; ++kp) Bs[sl][kp] = hg_pack2(S[sl][2 * kp], S[sl][2 * kp + 1]);
        pg8::bf16x8 Aq[2][4];
        LAS unsigned char* const qp0 = Bf + HG_QE + fr * 272 + 4 * kg * 2;
#pragma unroll
        for (int kp = 0; kp < 4; ++kp) Aq[0][kp] = HG_RD2(qp0 + kp * 64, qp0 + kp * 64 + 32);
#pragma unroll
        for (int cb = 0; cb < 4; ++cb) {
            if (cb < 3) {
#pragma unroll
                for (int kp = 0; kp < 4; ++kp) Aq[(cb + 1) & 1][kp] = HG_RD2(qp0 + (cb + 1) * 16 * 272 + kp * 64, qp0 + (cb + 1) * 16 * 272 + kp * 64 + 32); }
            HG_SB();
            f32x4 o0 = z4, o1 = z4;
            o0 = HG_MFMA(Bv[0][0], Af[cb][0], o0); o1 = HG_MFMA(Bv[1][0], Af[cb][0], o1);
            if (cb >= 2) { o0 = HG_MFMA(Bv[0][1], Af[cb][1], o0); o1 = HG_MFMA(Bv[1][1], Af[cb][1], o1); }
#pragma unroll
            for (int kp = 0; kp < 4; ++kp) { o0 = HG_MFMA(Bs[0][kp], Aq[cb & 1][kp], o0); o1 = HG_MFMA(Bs[1][kp], Aq[cb & 1][kp], o1); }
            HG_SB();
            { const int cp = 16 * cb + fr; const int t = base + (dir ? 63 - cp : cp); float* op = o_out + (size_t)t * 128 + 32 * cw + 4 * kg;
              if (!(dbg & 1)) { *(f32x4*)op = o0; *(f32x4*)(op + 16) = o1; } else asm volatile("" :: "v"(o0), "v"(o1)); }
        }
    }
    pg8::bf16x8 Ak[2][2][2]; f32x4 dc[2][2];
    LAS unsigned char* const kdp = Bf + HG_KDT + (4 * kg + trq) * 288 + 4 * trp * 2; LAS unsigned char* const dcp = Bf + HG_DEC + 4 * kg * 4;
#pragma unroll
    for (int u = 0; u < 2; ++u) { dc[0][u] = *(const LAS f32x4*)(dcp + u * 64);
#pragma unroll
        for (int ks = 0; ks < 2; ++ks) Ak[0][u][ks] = HG_TR2(kdp + u * 32 + ks * 32 * 288, kdp + u * 32 + ks * 32 * 288 + 16 * 288); }
#pragma unroll
    for (int bp = 0; bp < 4; ++bp) {
        if (bp < 3) {
#pragma unroll
            for (int u = 0; u < 2; ++u) { const int blk = 2 * (bp + 1) + u; dc[(bp + 1) & 1][u] = *(const LAS f32x4*)(dcp + blk * 64);
#pragma unroll
                for (int ks = 0; ks < 2; ++ks) Ak[(bp + 1) & 1][u][ks] = HG_TR2(kdp + blk * 32 + ks * 32 * 288, kdp + blk * 32 + ks * 32 * 288 + 16 * 288); } }
        HG_SB();
#pragma unroll
        for (int u = 0; u < 2; ++u) { const int blk = 2 * bp + u; f32x4 s0 = S[0][blk] * dc[bp & 1][u], s1 = S[1][blk] * dc[bp & 1][u];
#pragma unroll
            for (int ks = 0; ks < 2; ++ks) { s0 = HG_MFMA(Ak[bp & 1][u][ks], Bv[0][ks], s0); s1 = HG_MFMA(Ak[bp & 1][u][ks], Bv[1][ks], s1); }
            S[0][blk] = s0; S[1][blk] = s1; }
        HG_SB();
    }
}
#undef HG_RD2
#undef HG_TR1
#undef HG_TR2
#undef HG_MFMA
#undef HG_SB

template <bool HAS_Q>
__device__ __forceinline__ void hgrn_chain_mfma(LAS unsigned char* lds, const bf16_t* pi, int ldi, const bf16_t* pz, int ldz, const bf16_t* pq, int ldq, int Lseq, int h, int dir,
                                                const float* lb, const float* s_in, float* s_out, float* o_out, int n_begin, int nch  , int dbg = 0, unsigned char* dbgp = nullptr) {
    const int tid = threadIdx.x, lane = tid & 63, wave = __builtin_amdgcn_readfirstlane(tid >> 6);
    const bool producer = wave < 4;
#if PROBE_MASK
    unsigned long long bar_wait = 0ull;
#define HG_BAR() do { asm volatile("s_waitcnt lgkmcnt(0)" ::: "memory"); const unsigned long long _b0 = __builtin_amdgcn_s_memrealtime(); __builtin_amdgcn_s_barrier(); bar_wait += __builtin_amdgcn_s_memrealtime() - _b0; asm volatile("" ::: "memory"); } while (0)
#else
#define HG_BAR() do { asm volatile("s_waitcnt lgkmcnt(0)" ::: "memory"); __builtin_amdgcn_s_barrier(); asm volatile("" ::: "memory"); } while (0)
#endif
    const int pw = wave & 3, dp = lane & 15, rq = lane >> 4, ch0 = 32 * pw + 2 * dp;
    const int rowmin = dir ? 48 - 16 * rq : 16 * rq;
    const unsigned voZ = (unsigned)(rowmin * ldz + h * 128 + ch0) * 2u, voI = (unsigned)(rowmin * ldi + h * 128 + ch0) * 2u, voQ = (unsigned)(rowmin * (HAS_Q ? ldq : ldi) + h * 128 + ch0) * 2u;
    const __amdgpu_buffer_rsrc_t rsZ = __builtin_amdgcn_make_buffer_rsrc((void*)pz, 0, Lseq * ldz * 2, 0x00020000);
    const __amdgpu_buffer_rsrc_t rsI = __builtin_amdgcn_make_buffer_rsrc((void*)pi, 0, Lseq * ldi * 2, 0x00020000);
    const __amdgpu_buffer_rsrc_t rsQ = __builtin_amdgcn_make_buffer_rsrc((void*)(HAS_Q ? pq : pi), 0, Lseq * (HAS_Q ? ldq : ldi) * 2, 0x00020000);
#define HG_LOAD(n, Z, Q, V) do { const int _n = (dbg & 2) ? 0 : (n); const int _base = dir ? (Lseq - 64 * (_n + 1)) : 64 * _n; \
        _Pragma("unroll") for (int i = 0; i < 16; ++i) { const int _r = _base + (dir ? 15 - i : i); \
            Z[i] = __builtin_amdgcn_raw_buffer_load_b32(rsZ, voZ, _r * ldz * 2, 0); V[i] = __builtin_amdgcn_raw_buffer_load_b32(rsI, voI, _r * ldi * 2, 0); \
            if (HAS_Q) Q[i] = __builtin_amdgcn_raw_buffer_load_b32(rsQ, voQ, _r * ldq * 2, 0); } } while (0)
#define HG_PRODUCE(Z, Q, V, boff) do { LAS unsigned char* const Bf = lds + (boff); \
        float f0[16], f1[16]; float p0 = 1.f, p1 = 1.f; \
        _Pragma("unroll") for (int i = 0; i < 16; ++i) { f0[i] = 1.f - pg8::bflo(Z[i]); f1[i] = 1.f - pg8::bfhi(Z[i]); p0 *= f0[i]; p1 *= f1[i]; } \
        float run0 = 1.f, run1 = 1.f, fl0 = 1.f, fl1 = 1.f, suf0 = 1.f, suf1 = 1.f; \
        _Pragma("unroll") for (int qq = 0; qq < 4; ++qq) { const float t0 = __shfl(p0, dp + 16 * qq), t1 = __shfl(p1, dp + 16 * qq); fl0 *= t0; fl1 *= t1; if (qq < rq) { run0 *= t0; run1 *= t1; } if (qq > rq) { suf0 *= t0; suf1 *= t1; } } \
        if (HAS_Q) { \
            _Pragma("unroll") for (int i = 0; i < 16; ++i) { run0 *= f0[i]; run1 *= f1[i]; const float ia = __builtin_amdgcn_rcpf(run0), ib = __builtin_amdgcn_rcpf(run1); \
                const float kea = pg8::bflo(Z[i]) * ia, keb = pg8::bfhi(Z[i]) * ib; const int cp = 16 * rq + i; \
                *(LAS unsigned*)(Bf + HG_QE + cp * 272 + ch0 * 2) = cvtpk(pg8::bflo(Q[i]) * run0, pg8::bfhi(Q[i]) * run1); \
                *(LAS unsigned*)(Bf + HG_KE + cp * 272 + ch0 * 2) = cvtpk(kea, keb); \
                *(LAS unsigned*)(Bf + HG_KDT + cp * 288 + ch0 * 2) = cvtpk(kea * fl0, keb * fl1); } \
        } else { \
            _Pragma("unroll") for (int i = 15; i >= 0; --i) { const int cp = 16 * rq + i; \
                *(LAS unsigned*)(Bf + HG_KDT + cp * 288 + ch0 * 2) = cvtpk(pg8::bflo(Z[i]) * suf0, pg8::bfhi(Z[i]) * suf1); suf0 *= f0[i]; suf1 *= f1[i]; } \
        } \
        _Pragma("unroll") for (int i = 0; i < 16; ++i) *(LAS unsigned*)(Bf + HG_VT + (16 * rq + i) * 288 + ch0 * 2) = V[i]; \
        if (rq == 0) *(LAS f32x2_t*)(Bf + HG_DEC + ch0 * 4) = (f32x2_t){fl0, fl1}; } while (0)
#define HG_CONSUME(m, boff) hgrn_consume<HAS_Q>(lds + (boff), S, dir ? (Lseq - 64 * ((m) + 1)) : 64 * (m), dir, h, cw, fr, kg, o_out, dbg)

    __syncthreads();
    if (producer) {
        unsigned zA[16], qA[16], vA[16], zB[16], qB[16], vB[16];
        HG_LOAD(n_begin, zA, qA, vA);
        if (n_begin + 1 < nch) HG_LOAD(n_begin + 1, zB, qB, vB);
        for (int n = n_begin; n <= nch; n += 2) {
            if (n < nch && !(dbg & 4)) HG_PRODUCE(zA, qA, vA, 0);
            if (n + 2 < nch) HG_LOAD(n + 2, zA, qA, vA);
            HG_BAR();
            if (n + 1 < nch && !(dbg & 4)) HG_PRODUCE(zB, qB, vB, HG_BUF);
            if (n + 3 < nch) HG_LOAD(n + 3, zB, qB, vB);
            HG_BAR();
        }
    } else {
        const int cw = wave & 3, fr = lane & 15, kg = lane >> 4;
        __builtin_amdgcn_s_setprio(3);
        f32x4 S[2][8];
#pragma unroll
        for (int sl = 0; sl < 2; ++sl)
#pragma unroll
            for (int blk = 0; blk < 8; ++blk)
#pragma unroll
                for (int r = 0; r < 4; ++r) S[sl][blk][r] = s_in ? s_in[(size_t)(16 * blk + 4 * kg + r) * 128 + 32 * cw + 16 * sl + fr] : 0.f;
        for (int n = n_begin; n <= nch; n += 2) {
            if (n > n_begin && !(dbg & 8)) HG_CONSUME(n - 1, HG_BUF);
            HG_BAR();
            if (n < nch && !(dbg & 8)) HG_CONSUME(n, 0);
            HG_BAR();
        }
        if (dbg) {
#pragma unroll
            for (int sl = 0; sl < 2; ++sl)
#pragma unroll
                for (int blk = 0; blk < 8; ++blk) asm volatile("" :: "v"(S[sl][blk][0]), "v"(S[sl][blk][1]), "v"(S[sl][blk][2]), "v"(S[sl][blk][3]));
        }
        if (s_out) {
#pragma unroll
            for (int sl = 0; sl < 2; ++sl)
#pragma unroll
                for (int blk = 0; blk < 8; ++blk)
#pragma unroll
                    for (int r = 0; r < 4; ++r) s_out[(size_t)(16 * blk + 4 * kg + r) * 128 + 32 * cw + 16 * sl + fr] = S[sl][blk][r];
        }
        __builtin_amdgcn_s_setprio(0);
    }
#if PROBE_MASK
    if (HAS_Q && blockIdx.x == PROBE_BUSY_BLOCK && (tid == 0 || tid == 256) && dbg == 0) *(volatile unsigned long long*)(dbgp + (tid ? 8 : 0)) = bar_wait;
#endif
#undef HG_LOAD
#undef HG_PRODUCE
#undef HG_CONSUME
#undef HG_BAR
    __syncthreads();
}

__global__ void __launch_bounds__(512, 2) mega(Params P) {
    extern __shared__ __attribute__((aligned(16))) unsigned char lds_raw[];
    cg::grid_group grid = cg::this_grid();
    LAS unsigned char* lds = (LAS unsigned char*)lds_raw;
    const int tid = threadIdx.x, lane = tid & 63, wave = __builtin_amdgcn_readfirstlane(tid >> 6);
    const int G = gridDim.x, bx = blockIdx.x;
    const int vcu = (G % 8 == 0) ? (bx % 8) * (G / 8) + bx / 8 : bx;
    const int gw = vcu * 8 + wave, NGW = G * 8;
    unsigned char* ws = P.ws;
    const float* x = P.in[0]; const float* cvec = P.in[1]; const float* ctx = P.in[2]; const float* c_ctx = P.in[3];
    const float* w_ada = P.in[4]; const float* b_ada = P.in[5]; const float* norm_w = P.in[6]; const float* w_in = P.in[7];
    const float* lb_param = P.in[8]; const float* g_norm = P.in[9]; const float* hy_sw = P.in[10]; const float* hy_sb = P.in[11];
    const float* f_w1 = P.in[12]; const float* f_b1 = P.in[13]; const float* f_w2 = P.in[14]; const float* f_b2 = P.in[15];
    const float* f_w3 = P.in[16]; const float* f_freq = P.in[17]; const float* hy_d = P.in[18]; const float* w_pa = P.in[19];
    const float* w_pb = P.in[20]; const float* w_out = P.in[21]; const float* w_mlp1 = P.in[22]; const float* w_mlp2 = P.in[23];
    float* MOD = (float*)(ws + WS_MOD); float* LB = (float*)(ws + WS_LB); bf16_t* GTB = (bf16_t*)(ws + WS_GT);
    bf16_t* WIN = (bf16_t*)(ws + WS_WIN); bf16_t* WPAB = (bf16_t*)(ws + WS_WPAB); bf16_t* WOUT = (bf16_t*)(ws + WS_WOUT); bf16_t* W1 = (bf16_t*)(ws + WS_W1); bf16_t* W2 = (bf16_t*)(ws + WS_W2);
    bf16_t* HCTX = (bf16_t*)(ws + WS_HCTX); bf16_t* PCTX = (bf16_t*)(ws + WS_PCTX); float* SCTX = (float*)(ws + WS_SCTX);
    bf16_t* HLAT = (bf16_t*)(ws + WS_HLAT); bf16_t* PI = (bf16_t*)(ws + WS_PI); bf16_t* PZ = (bf16_t*)(ws + WS_PZ); bf16_t* PQ = (bf16_t*)(ws + WS_PQ);
    bf16_t* PG = (bf16_t*)(ws + WS_PG); bf16_t* GATES = (bf16_t*)(ws + WS_GATES); bf16_t* PHYT = (bf16_t*)(ws + WS_PHYT);
    bf16_t* AY = (bf16_t*)(ws + WS_AY2); bf16_t* MERGED = (bf16_t*)(ws + WS_MERGED); bf16_t* MIX = (bf16_t*)(ws + WS_MIX);
    bf16_t* MLP = (bf16_t*)(ws + WS_MLP); bf16_t* H1 = (bf16_t*)(ws + WS_H1); bf16_t* HL = (bf16_t*)(ws + WS_HL);
    float* O2 = P.out;

    volatile LAS unsigned* MISC = (volatile LAS unsigned*)(lds + LDS_BYTES - 128);
    if (tid < 16) MISC[tid] = 0u;
    __syncthreads();
    const XcdBarrier xbar = xcd_barrier_post((unsigned*)ws, MISC);
#define SEAM_RAW(k) do { if ((k) == 0) grid.sync(); else xcd_barrier(xbar); } while (0)
#if PROBE_MASK
    unsigned long long t_prev = __builtin_amdgcn_s_memrealtime(), t_spin = 0ull;
#define SEAM(k) do { if ((k) == PROBE_BUSY_PHASE && bx == PROBE_BUSY_BLOCK && tid == 0) *(volatile unsigned long long*)(ws + 32768) = __builtin_amdgcn_s_memrealtime() - t_prev; \
    SEAM_RAW(k); { const unsigned long long _t = __builtin_amdgcn_s_memrealtime(); if ((PROBE_MASK >> (k)) & 1) t_spin += _t - t_prev; \
    if ((k) == PROBE_BUSY_PHASE) t_spin += *(volatile unsigned long long*)(ws + 32768); t_prev = _t; } } while (0)
#else
#define SEAM(k) SEAM_RAW(k)
#endif
    {
        if (bx < 192) {
            const int cgp = bx % 96, kh = bx / 96;
            LAS float* sc = (LAS float*)lds;
            LAS float* ps = (LAS float*)(lds + 20480);
            for (int i = tid; i < 9 * 512; i += 512) { const int r = i >> 9, k = kh * 512 + (i & 511); sc[i] = siluf_(r < 8 ? cvec[r * D + k] : c_ctx[k]); }
            __syncthreads();
            const int j = cgp * 64 + lane; float a9[9];
#pragma unroll
            for (int r = 0; r < 9; ++r) a9[r] = 0.f;
            const float* wp = w_ada + (size_t)(kh * 512 + wave * 64) * INC + j;
#pragma unroll 1
            for (int kk = 0; kk < 64; kk += 16) { float w[16];
#pragma unroll
                for (int u = 0; u < 16; ++u) w[u] = wp[(size_t)(kk + u) * INC];
#pragma unroll
                for (int u = 0; u < 16; ++u)
#pragma unroll
                    for (int r = 0; r < 9; ++r) a9[r] += sc[r * 512 + wave * 64 + kk + u] * w[u]; }
#pragma unroll
            for (int r = 0; r < 9; ++r) ps[(wave * 9 + r) * 64 + lane] = a9[r];
            __syncthreads();
            for (int i = tid; i < 9 * 64; i += 512) { const int r = i >> 6, l = i & 63; float s = kh == 0 ? b_ada[cgp * 64 + l] : 0.f;
#pragma unroll
                for (int w = 0; w < 8; ++w) s += ps[(w * 9 + r) * 64 + l];
                atomicAdd(&MOD[r * INC + cgp * 64 + l], s); }
            __syncthreads();
        }
        if (bx == G - 1) { const float a = lb_param[tid], b = lb_param[HW + tid], m = fmaxf(a, b); const float ea = expf(a - m), eb = expf(b - m); LB[tid] = ea / (ea + eb); }
        {   LAS float* scr = (LAS float*)(lds + wave * 16384);
            for (int it = gw; it < 16 * 192; it += NGW) transpose_item(w_in, INC, WIN, D, 0, 1, scr, it, lane); }
        for (int tb = bx; tb < 256; tb += G) {
            __syncthreads();
            LAS float* zf = (LAS float*)lds; LAS float* h1 = zf + 17 * 36; LAS float* h2 = h1 + 17 * 64;
            for (int i = tid; i < 17 * 33; i += 512) { const int p = i / 33, k = i - 33 * p, t = 16 * tb + p; float val;
                if (k == 0) val = (float)t / (float)(L - 1);
                else { const int bi = (k - 1) & 15; const float band = 1e-4f + (float)bi * ((15.f - 1e-4f) / 15.f);
                    const float w = 2.0f * 3.14159265358979323846f * (float)t / (float)L; const float ang = w * band;
                    val = (k <= 16) ? cosf(ang) : -sinf(ang); }
                zf[p * 36 + k] = val; }
            __syncthreads();
            for (int i = tid; i < 17 * 64; i += 512) { const int p = i >> 6, k = i & 63; float acc = f_b1[k];
#pragma unroll 11
                for (int q = 0; q < 33; ++q) acc += zf[p * 36 + q] * f_w1[q * 64 + k];
                h1[i] = sinf(f_freq[k] * acc); }
            __syncthreads();
            for (int i = tid; i < 17 * 64; i += 512) { const int p = i >> 6, k = i & 63; float acc = f_b2[k];
#pragma unroll 16
                for (int q = 0; q < 64; ++q) acc += h1[p * 64 + q] * f_w2[q * 64 + k];
                h2[i] = sinf(f_freq[k] * acc); }
            __syncthreads();
            const int c = tid; float af[16], ab[16];
#pragma unroll
            for (int p = 0; p < 16; ++p) { af[p] = 0.f; ab[p] = 0.f; }
#pragma unroll 4
            for (int k = 0; k < 64; ++k) { const float wf = f_w3[k * 1024 + c], wb = f_w3[k * 1024 + 512 + c]; float hv[17];
#pragma unroll
                for (int p = 0; p < 17; ++p) hv[p] = h2[p * 64 + k];
#pragma unroll
                for (int p = 0; p < 16; ++p) { af[p] += hv[p] * wf; ab[p] += hv[p + 1] * wb; } }
            const float mind = logf(1e-2f) / 1.5f, maxd = logf(1e-2f) / 0.3f;
            const float delta = fabsf(mind + (maxd - mind) * ((float)c / 511.f));
            unsigned short of[16], ob[16];
#pragma unroll
            for (int p = 0; p < 16; ++p) { const int tf = 16 * tb + p, tbk = tf + 1;
                float vf = af[p] * expf(-((float)tf / (float)(L - 1)) * delta); if (tf == 0) vf += hy_d[c];
                float vb = ab[p] * expf(-((float)tbk / (float)(L - 1)) * delta); if (tbk >= L) vb = 0.f;
                of[15 - p] = (unsigned short)f2bf(vf); ob[p] = (unsigned short)f2bf(vb); }
            bf16_t* gf = GTB + (size_t)c * 8192 + (4080 - 16 * tb); bf16_t* gb = GTB + (size_t)c * 8192 + (4096 + 16 * tb);
            u32x4 w0, w1;
            w0.x = of[0] | ((unsigned)of[1] << 16); w0.y = of[2] | ((unsigned)of[3] << 16); w0.z = of[4] | ((unsigned)of[5] << 16); w0.w = of[6] | ((unsigned)of[7] << 16);
            w1.x = of[8] | ((unsigned)of[9] << 16); w1.y = of[10] | ((unsigned)of[11] << 16); w1.z = of[12] | ((unsigned)of[13] << 16); w1.w = of[14] | ((unsigned)of[15] << 16);
            *(u32x4*)gf = w0; *(u32x4*)(gf + 8) = w1;
            w0.x = ob[0] | ((unsigned)ob[1] << 16); w0.y = ob[2] | ((unsigned)ob[3] << 16); w0.z = ob[4] | ((unsigned)ob[5] << 16); w0.w = ob[6] | ((unsigned)ob[7] << 16);
            w1.x = ob[8] | ((unsigned)ob[9] << 16); w1.y = ob[10] | ((unsigned)ob[11] << 16); w1.z = ob[12] | ((unsigned)ob[13] << 16); w1.w = ob[14] | ((unsigned)ob[15] << 16);
            *(u32x4*)gb = w0; *(u32x4*)(gb + 8) = w1;
        }
    }
    SEAM(0);
    for (int m0 = gw; m0 < NT + NCX; m0 += 4 * NGW) {
        f32x4 v[4][4];
#pragma unroll
        for (int r = 0; r < 4; ++r) { const int m = m0 + r * NGW; if (m < NT + NCX) { const f32x4* xr = (const f32x4*)(m < NT ? x + (size_t)m * D : ctx + (size_t)(m - NT) * D) + lane;
#pragma unroll
                for (int j = 0; j < 4; ++j) v[r][j] = xr[64 * j]; } }
#pragma unroll
        for (int r = 0; r < 4; ++r) { const int m = m0 + r * NGW; if (m < NT + NCX) {
                const float* mb = MOD + (size_t)(m < NT ? (m >> 12) : 8) * INC; bf16_t* orow = m < NT ? HLAT + (size_t)m * D : HCTX + (size_t)(m - NT) * D;
                float s = 0.f;
#pragma unroll
                for (int j = 0; j < 4; ++j) s += (v[r][j].x * v[r][j].x + v[r][j].y * v[r][j].y) + (v[r][j].z * v[r][j].z + v[r][j].w * v[r][j].w);
                const float rs = rsqrtf(wave_sum(s) * (1.f / D) + EPS);
                unsigned long long* o8 = (unsigned long long*)orow + lane;
#pragma unroll
                for (int j = 0; j < 4; ++j) { const f32x4 w = ((const f32x4*)norm_w)[lane + 64 * j], sc = ((const f32x4*)mb)[lane + 64 * j], sh = ((const f32x4*)(mb + D))[lane + 64 * j];
                    const f32x4 o = v[r][j] * rs * w * (1.f + sc) + sh;
                    o8[64 * j] = (unsigned long long)cvtpk(o.x, o.y) | ((unsigned long long)cvtpk(o.z, o.w) << 32); } } }
    }
    SEAM(1);
    {
        { pg8::Gemm g{HLAT, WIN, D, D, D}; pg8::StaticOrder S; S.init(NT, 4608, G, bx); pg8::EpiG1 E{PI, PZ, PQ, PG, GATES, LB, 0};
          pg8::gemm_phase(lds, g, S, E); }
        { pg8::Gemm g{WIN + (size_t)4608 * D, HLAT, D, D, D}; pg8::StaticOrder S; S.init(1536, NT, G, bx); pg8::EpiBf16<0> E{PHYT, NT};
          pg8::gemm_phase(lds, g, S, E); }
        { pg8::Gemm g{HCTX, WIN, D, D, D}; pg8::StaticOrder S; S.init(NCX, 1536, G, bx); pg8::EpiG1 E{PCTX, nullptr, nullptr, nullptr, nullptr, LB, 1};
          pg8::gemm_phase(lds, g, S, E); }
        if (bx >= 48) {
            LAS float* scr = (LAS float*)(lds + wave * 16384);
            constexpr int I_PA = 8 * 32, I_OUT = 16 * 32, I_1 = 16 * 128, I_2 = 64 * 32;
            __syncthreads();
            for (int it = (bx - 48) * 8 + wave; it < 2 * I_PA + I_OUT + I_1 + I_2; it += (G - 48) * 8) {
                int r = it;
                if (r < I_PA) { transpose_item(w_pa, D, WPAB, D, 0, 0, scr, r, lane); continue; } r -= I_PA;
                if (r < I_PA) { transpose_item(w_pb, D, WPAB, D, 512, 0, scr, r, lane); continue; } r -= I_PA;
                if (r < I_OUT) { transpose_item(w_out, D, WOUT, D, 0, 0, scr, r, lane); continue; } r -= I_OUT;
                if (r < I_1) { transpose_item(w_mlp1, FF, W1, D, 0, 0, scr, r, lane); continue; } r -= I_1;
                transpose_item(w_mlp2, D, W2, FF, 0, 0, scr, r, lane);
            }
        }

    }
    SEAM(2);
    {
        float* STATE = (float*)(ws + WS_HLAT);
        constexpr int NSEG = 4, SEGC = 64 / NSEG;
        if (bx < 64 * NSEG) { const int item = bx;
            const int chain = item / NSEG, seg = item % NSEG, b = chain >> 3, h = (chain >> 1) & 3, dir = chain & 1, n0 = SEGC * seg; float* st = STATE + (size_t)(item & 255) * 16384;
            const bf16_t* pzc = PZ + (size_t)b * L * 1024 + (dir ? 512 : 0);
            int n_start = n0; bool decayed = false;
            if (seg > 0) {
                LAS float* red = (LAS float*)lds;
                float r0 = 1.f, r1 = 1.f;
                while (n_start > 0 && !decayed) {
                    n_start -= 4;
                    const int basec = dir ? (L - 64 * (n_start + 4)) : 64 * n_start;
                    float p0 = 1.f, p1 = 1.f;
#pragma unroll 8
                    for (int i = 0; i < 32; ++i) { const unsigned kk = *(const unsigned*)(pzc + (size_t)(basec + 32 * wave + i) * 1024 + h * 128 + 2 * lane); p0 *= 1.f - pg8::bflo(kk); p1 *= 1.f - pg8::bfhi(kk); }
                    __syncthreads();
                    *(LAS f32x2_t*)(red + wave * 128 + 2 * lane) = (f32x2_t){p0, p1};
                    __syncthreads();
                    if (wave == 0) {
#pragma unroll
                        for (int w = 0; w < 8; ++w) { const f32x2_t t = *(const LAS f32x2_t*)(red + w * 128 + 2 * lane); r0 *= t.x; r1 *= t.y; }
                        float mx = fmaxf(r0, r1);
#pragma unroll
                        for (int o = 1; o < 64; o <<= 1) mx = fmaxf(mx, __shfl_xor(mx, o));
                        if (lane == 0) red[1024] = mx;
                    }
                    __syncthreads();
                    decayed = __builtin_amdgcn_readfirstlane(red[1024] < 1e-10f ? 1 : 0) != 0;
                }
            }
            if (seg == 0 || !decayed)
                hgrn_chain_mfma<false>(lds, PCTX + (size_t)b * LC * 1536, 1536, PCTX + (size_t)b * LC * 1536 + (dir ? 1024 : 512), 1536, nullptr, 0, LC, h, dir, LB, nullptr, st, nullptr, 0, LC / 64);
            if (seg > 0) hgrn_chain_mfma<false>(lds, PI + (size_t)b * L * 512, 512, pzc, 1024, nullptr, 0, L, h, dir, LB, decayed ? nullptr : st, st, nullptr, n_start, n0);
            hgrn_chain_mfma<true>(lds, PI + (size_t)b * L * 512, 512, pzc, 1024, PQ + (size_t)b * L * 512, 512, L, h, dir, LB,
                                  st, nullptr, O2 + (size_t)chain * L * 128, n0, n0 + SEGC, 0, ws + 32768 + 128);
#if PROBE_MASK
            if (PROBE_BUSY_PHASE == 20 && bx == PROBE_BUSY_BLOCK && tid == 0) *(volatile unsigned long long*)(ws + 32768 + 64) = __builtin_amdgcn_s_memrealtime() - t_prev;
#endif
        }
        unsigned* hctr = (unsigned*)(ws + 36864);
        for (;;) {
            __syncthreads();
            if (tid == 0) MISC[4] = atomicAdd(hctr, 1u);
            __syncthreads();
            const int c = (int)MISC[4];
            if (c >= HW) break;
            hyena_channel(lds, c, PHYT, GTB, hy_sw, hy_sb);
        }
    }
    SEAM(4);
#if PROBE_MASK
    if (PROBE_BUSY_PHASE == 20) t_spin += *(volatile unsigned long long*)(ws + 32768 + 64);
    if (PROBE_BUSY_PHASE == 21) t_spin += *(volatile unsigned long long*)(ws + 32768 + 128);
    if (PROBE_BUSY_PHASE == 22) t_spin += *(volatile unsigned long long*)(ws + 32768 + 136);
#endif
    {
        const f32x4 gn0 = ((const f32x4*)g_norm)[(2 * lane) & 31], gn1 = ((const f32x4*)g_norm)[(2 * lane + 1) & 31];
        for (int t0 = gw; t0 < NT; t0 += 2 * NGW) {
            f32x4 of[2][2], ob[2][2]; u32x4 pg[2];
#pragma unroll
            for (int r = 0; r < 2; ++r) { const int t = t0 + r * NGW; if (t < NT) {
                    { const int bb = t >> 12, hh = lane >> 4; const float* pf = O2 + ((size_t)((bb * 4 + hh) * 2) * L + (t & 4095)) * 128 + 8 * (lane & 15); const float* pb = pf + (size_t)L * 128;
                      of[r][0] = *(const f32x4*)pf; of[r][1] = *(const f32x4*)(pf + 4); ob[r][0] = *(const f32x4*)pb; ob[r][1] = *(const f32x4*)(pb + 4); }
                    pg[r] = ((const u32x4*)(PG + (size_t)t * 512))[lane]; } }
#pragma unroll
            for (int r = 0; r < 2; ++r) { const int t = t0 + r * NGW; if (t < NT) {
                    const f32x4 a0 = of[r][0] + ob[r][0], a1 = of[r][1] + ob[r][1];
                    float s = (a0.x * a0.x + a0.y * a0.y) + (a0.z * a0.z + a0.w * a0.w) + (a1.x * a1.x + a1.y * a1.y) + (a1.z * a1.z + a1.w * a1.w);
                    s += __shfl_xor(s, 1); s += __shfl_xor(s, 2); s += __shfl_xor(s, 4); s += __shfl_xor(s, 8);
                    const float rs = rsqrtf(s * (1.f / 128.f) + EPS);
                    u32x4 o;
                    o.x = cvtpk(a0.x * rs * gn0.x * pg8::bflo(pg[r].x), a0.y * rs * gn0.y * pg8::bfhi(pg[r].x)); o.y = cvtpk(a0.z * rs * gn0.z * pg8::bflo(pg[r].y), a0.w * rs * gn0.w * pg8::bfhi(pg[r].y));
                    o.z = cvtpk(a1.x * rs * gn1.x * pg8::bflo(pg[r].z), a1.y * rs * gn1.y * pg8::bfhi(pg[r].z)); o.w = cvtpk(a1.z * rs * gn1.z * pg8::bflo(pg[r].w), a1.w * rs * gn1.w * pg8::bfhi(pg[r].w));
                    *(u32x4*)(AY + (size_t)t * 1024 + 8 * lane) = o; } }
        }
    }
    {
        LAS bf16_t* tl = (LAS bf16_t*)(lds + wave * 16384);
        for (int it = gw; it < 8 * 512; it += NGW) { const int c0 = (it & 7) * 64, tok0 = (it >> 3) * 64;
#pragma unroll
            for (int i = 0; i < 8; ++i) { const int ch = lane + 64 * i, rr = ch >> 3, cc = (ch & 7) * 8;
                const u32x4 v = *(const u32x4*)(PHYT + (size_t)(1024 + c0 + rr) * NT + tok0 + cc);
                LAS unsigned* d = (LAS unsigned*)(tl + rr * 66 + cc); d[0] = v.x; d[1] = v.y; d[2] = v.z; d[3] = v.w; }
            LDS_WAIT();
#pragma unroll
            for (int i = 0; i < 8; ++i) { const int ch = lane + 64 * i, tt = ch >> 3, cc = (ch & 7) * 8; unsigned o[4];
#pragma unroll
                for (int q = 0; q < 4; ++q) o[q] = (unsigned)tl[(cc + 2 * q) * 66 + tt] | ((unsigned)tl[(cc + 2 * q + 1) * 66 + tt] << 16);
                *(u32x4*)(AY + (size_t)(tok0 + tt) * 1024 + 512 + c0 + cc) = (u32x4){o[0], o[1], o[2], o[3]}; }
            LDS_WAIT();
        }
    }
    SEAM(5);
    { pg8::Gemm g{AY, WPAB, D, D, 512}; pg8::TwoPassOrder S; S.base.init(NT, D, G, bx); S.kbytes = 1024; pg8::EpiMerge2 E{MERGED, GATES}; pg8::gemm_phase(lds, g, S, E); }
    SEAM(6);
    { pg8::Gemm g{MERGED, WOUT, D, D, D}; pg8::StaticOrder S; S.init(NT, D, G, bx); pg8::EpiBf16<0> E{MIX, D}; pg8::gemm_phase(lds, g, S, E); }
    SEAM(7);
    for (int m0 = gw; m0 < NT; m0 += 2 * NGW) {
        f32x4 xv[2][4]; u32x2 mx[2][4];
#pragma unroll
        for (int r = 0; r < 2; ++r) { const int m = m0 + r * NGW; if (m < NT) {
#pragma unroll
                for (int j = 0; j < 4; ++j) { xv[r][j] = ((const f32x4*)(x + (size_t)m * D))[lane + 64 * j]; mx[r][j] = *(const u32x2*)(MIX + (size_t)m * D + 4 * lane + 256 * j); } } }
#pragma unroll
        for (int r = 0; r < 2; ++r) { const int m = m0 + r * NGW; if (m < NT) { const float* mb = MOD + (size_t)(m >> 12) * INC;
                f32x4 mv[4], x1[4]; float s = 0.f;
#pragma unroll
                for (int j = 0; j < 4; ++j) { mv[j] = (f32x4){pg8::bflo(mx[r][j].x), pg8::bfhi(mx[r][j].x), pg8::bflo(mx[r][j].y), pg8::bfhi(mx[r][j].y)}; s += (mv[j].x * mv[j].x + mv[j].y * mv[j].y) + (mv[j].z * mv[j].z + mv[j].w * mv[j].w); }
                const float r1 = rsqrtf(wave_sum(s) * (1.f / D) + EPS); float s2 = 0.f;
#pragma unroll
                for (int j = 0; j < 4; ++j) { const f32x4 w = ((const f32x4*)(norm_w + D))[lane + 64 * j], g = ((const f32x4*)(mb + 2 * D))[lane + 64 * j];
                    x1[j] = xv[r][j] + g * (mv[j] * r1 * w); s2 += (x1[j].x * x1[j].x + x1[j].y * x1[j].y) + (x1[j].z * x1[j].z + x1[j].w * x1[j].w); }
                const float r2 = rsqrtf(wave_sum(s2) * (1.f / D) + EPS);
                unsigned long long* o8 = (unsigned long long*)(HL + (size_t)m * D) + lane;
#pragma unroll
                for (int j = 0; j < 4; ++j) { const f32x4 w = ((const f32x4*)(norm_w + 2 * D))[lane + 64 * j], sc = ((const f32x4*)(mb + 3 * D))[lane + 64 * j], sh = ((const f32x4*)(mb + 4 * D))[lane + 64 * j];
                    const f32x4 o = x1[j] * r2 * w * (1.f + sc) + sh;
                    o8[64 * j] = (unsigned long long)cvtpk(o.x, o.y) | ((unsigned long long)cvtpk(o.z, o.w) << 32); } } }
    }
    SEAM(8);
    { pg8::Gemm g{HL, W1, D, D, D}; pg8::StaticOrder S; S.init(NT, FF, G, bx); pg8::EpiBf16<3> E{H1, FF}; pg8::gemm_phase(lds, g, S, E); }
    SEAM(9);
    { pg8::Gemm g{H1, W2, FF, FF, FF}; pg8::StaticOrder S; S.init(NT, D, G, bx); pg8::EpiBf16<0> E{MLP, D}; pg8::gemm_phase(lds, g, S, E); }
    SEAM(10);
    for (int m0 = gw; m0 < NT; m0 += 2 * NGW) {
        f32x4 xv[2][4]; u32x2 mx[2][4], ml[2][4];
#pragma unroll
        for (int r = 0; r < 2; ++r) { const int m = m0 + r * NGW; if (m < NT) {
#pragma unroll
                for (int j = 0; j < 4; ++j) { xv[r][j] = ((const f32x4*)(x + (size_t)m * D))[lane + 64 * j]; mx[r][j] = *(const u32x2*)(MIX + (size_t)m * D + 4 * lane + 256 * j);
                    ml[r][j] = *(const u32x2*)(MLP + (size_t)m * D + 4 * lane + 256 * j); } } }
#pragma unroll
        for (int r = 0; r < 2; ++r) { const int m = m0 + r * NGW; if (m < NT) { const float* mb = MOD + (size_t)(m >> 12) * INC;
                f32x4 mv[4], lv[4]; float s = 0.f, s3 = 0.f;
#pragma unroll
                for (int j = 0; j < 4; ++j) { mv[j] = (f32x4){pg8::bflo(mx[r][j].x), pg8::bfhi(mx[r][j].x), pg8::bflo(mx[r][j].y), pg8::bfhi(mx[r][j].y)}; s += (mv[j].x * mv[j].x + mv[j].y * mv[j].y) + (mv[j].z * mv[j].z + mv[j].w * mv[j].w);
                    lv[j] = (f32x4){pg8::bflo(ml[r][j].x), pg8::bfhi(ml[r][j].x), pg8::bflo(ml[r][j].y), pg8::bfhi(ml[r][j].y)}; s3 += (lv[j].x * lv[j].x + lv[j].y * lv[j].y) + (lv[j].z * lv[j].z + lv[j].w * lv[j].w); }
                const float r1 = rsqrtf(wave_sum(s) * (1.f / D) + EPS), r3 = rsqrtf(wave_sum(s3) * (1.f / D) + EPS);
#pragma unroll
                for (int j = 0; j < 4; ++j) { const f32x4 w1 = ((const f32x4*)(norm_w + D))[lane + 64 * j], g2 = ((const f32x4*)(mb + 2 * D))[lane + 64 * j];
                    const f32x4 w3 = ((const f32x4*)(norm_w + 3 * D))[lane + 64 * j], g5 = ((const f32x4*)(mb + 5 * D))[lane + 64 * j];
                    const f32x4 x1 = xv[r][j] + g2 * (mv[j] * r1 * w1);
                    ((f32x4*)(P.out + (size_t)m * D))[lane + 64 * j] = x1 + g5 * (lv[j] * r3 * w3); } } }
    }
#if PROBE_MASK
    { const unsigned long long _t = __builtin_amdgcn_s_memrealtime(); if ((PROBE_MASK >> 11) & 1) t_spin += _t - t_prev;
      if (bx == 0) { const unsigned long long t0 = __builtin_amdgcn_s_memrealtime(); while (__builtin_amdgcn_s_memrealtime() - t0 < t_spin) __builtin_amdgcn_s_sleep(8); } }
#endif
#if PROBE_XSYNC
    for (int i = 0; i < PROBE_XSYNC; ++i) grid.sync();
#endif
}
}

extern "C" void kernel_launch(void* const* d_in, const int* in_sizes, int n_in, void* d_out, int out_size, void* d_ws, size_t ws_size, hipStream_t stream) {
    static int grid = 0;
    if (grid == 0) {
        if (n_in != 24 || ws_size < WS_END) { fprintf(stderr, "kernel_launch: unexpected n_in %d / ws_size %zu\n", n_in, ws_size); grid = -1; return; }
        int dev = 0, cus = 0, per_cu = 0;
        hipGetDevice(&dev); hipDeviceGetAttribute(&cus, hipDeviceAttributeMultiprocessorCount, dev);
        hipFuncSetAttribute((const void*)mega, hipFuncAttributeMaxDynamicSharedMemorySize, LDS_BYTES);
        hipOccupancyMaxActiveBlocksPerMultiprocessor(&per_cu, (const void*)mega, 512, LDS_BYTES);
        if (per_cu < 1) { fprintf(stderr, "kernel_launch: occupancy query says %d blocks per CU\n", per_cu); grid = -1; return; }
        grid = cus;
        if (grid < 256) { fprintf(stderr, "kernel_launch: this kernel needs at least 256 compute units (found %d)\n", cus); grid = -1; return; }
    }
    if (grid < 0) return;
    if (hipMemsetAsync(d_ws, 0, 327680, stream) != hipSuccess) { fprintf(stderr, "kernel_launch: memset failed\n"); return; }
    Params p{};
    for (int i = 0; i < 24; ++i) p.in[i] = (const float*)d_in[i];
    p.out = (float*)d_out; p.ws = (unsigned char*)d_ws;
    void* args[] = {&p};
    hipError_t e = hipLaunchCooperativeKernel((const void*)mega, dim3(grid), dim3(512), args, LDS_BYTES, stream);
    if (e != hipSuccess) fprintf(stderr, "cooperative launch failed: %s (grid %d)\n", hipGetErrorString(e), grid);
}
```

```cpp
#include <hip/hip_runtime.h>
#include <hip/hip_cooperative_groups.h>
#include <cstdio>
#include <math.h>
namespace cg = cooperative_groups;
#ifndef USE_GRID_SYNC
#define USE_GRID_SYNC 0
#endif
#if !USE_GRID_SYNC
#define NO_GRID_SYNC 1
#endif
#ifndef PROBE_MASK
#define PROBE_MASK 0
#endif
#ifndef PROBE_XSYNC
#define PROBE_XSYNC 0
#endif
#ifndef PROBE_BUSY_PHASE
#define PROBE_BUSY_PHASE -1
#define PROBE_BUSY_BLOCK 0
#endif

namespace pg8 {
#define PG8_LAS __attribute__((address_space(3)))
typedef unsigned short bf16_t;
typedef short bf16x8 __attribute__((ext_vector_type(8)));
typedef float f32x4 __attribute__((ext_vector_type(4)));
typedef unsigned u32x4 __attribute__((ext_vector_type(4)));
typedef unsigned u32x2 __attribute__((ext_vector_type(2)));
constexpr int BM = 256, BK = 64, HALF = 128, HTB = HALF * BK * 2, STAGE_BYTES = 8 * HTB, NXCD = 8, WGM = 8;

__device__ __forceinline__ int lds_byte(int r, int c) { const int st = (r >> 4) * 2 + (c >> 5), rr = r & 15, cc = c & 31, ob = rr * 64 + cc * 2; return st * 1024 + (ob ^ (((ob >> 9) & 1) << 5)); }
__device__ __forceinline__ void stage_rc(int b, int& R, int& C) { const int st = b / 1024, sb = b % 1024, swz = sb ^ (((sb >> 9) & 1) << 5); R = (st >> 1) * 16 + swz / 64; C = (st & 1) * 32 + (swz % 64) / 2; }
__device__ __forceinline__ int perm32(int rho) { const int n = rho >> 4, i = rho & 15; return 8 * (i >> 2) + 4 * n + (i & 3); }

struct Unit { int pm, pn, kb, pass; };
struct Gemm { const bf16_t* A; const bf16_t* Bt; int lda, ldb, K; };

struct StaticOrder {
    int nM, nN, nwg, G, c;
    __device__ void init(int M, int N, int G_, int c_) { nM = M / BM; nN = N / BM; nwg = nM * nN; G = G_; c = c_; }
    __device__ bool next(int i, Unit& u) const {
        const long L = (long)i * G + c; if (L >= nwg) return false;
        int wgid = (int)L; { const int q = nwg / NXCD, r = nwg % NXCD, xcd = wgid % NXCD, off = wgid / NXCD; wgid = (xcd < r ? xcd * (q + 1) : r * (q + 1) + (xcd - r) * q) + off; }
        const int nig = WGM * nN, gid = wgid / nig, fm = gid * WGM, gsz = (nM - fm) < WGM ? (nM - fm) : WGM;
        u.pm = fm + ((wgid % nig) % gsz); u.pn = (wgid % nig) / gsz; u.kb = 0; u.pass = 0; return true;
    }
};

struct TwoPassOrder {
    StaticOrder base; int kbytes;
    __device__ bool next(int i, Unit& u) const { if (!base.next(i >> 1, u)) return false; u.pass = i & 1; u.kb = (i & 1) * kbytes; return true; }
};
__device__ __forceinline__ unsigned cvt_pk_bf16(float lo, float hi) { unsigned r; asm volatile("v_cvt_pk_bf16_f32 %0, %1, %2" : "=v"(r) : "v"(lo), "v"(hi)); return r; }
__device__ __forceinline__ float sigm(float x) { return __builtin_amdgcn_rcpf(1.0f + __builtin_amdgcn_exp2f(-1.4426950408889634f * x)); }
__device__ __forceinline__ float bflo(unsigned u) { return __uint_as_float(u << 16); }
__device__ __forceinline__ float bfhi(unsigned u) { return __uint_as_float(u & 0xffff0000u); }

template <int ACT  > struct EpiBf16 {
    static constexpr bool PERM = true;
    bf16_t* O; int ldc;
    __device__ __forceinline__ void operator()(const f32x4 (&acc)[2][2][4][2], const Unit& u, int wr, int wc, int fr, int fq) const {
        const int row0 = u.pm * BM + wr * 64 + fr, col0 = u.pn * BM + wc * 32 + 8 * fq;
#pragma unroll
        for (int ai = 0; ai < 2; ++ai)
#pragma unroll
            for (int m = 0; m < 4; ++m) { bf16_t* rowp = O + (size_t)(row0 + ai * HALF + m * 16) * ldc + col0;
#pragma unroll
                for (int bj = 0; bj < 2; ++bj) { f32x4 v0 = acc[ai][bj][m][0], v1 = acc[ai][bj][m][1];
                    if (ACT == 3) {
#pragma unroll
                        for (int j = 0; j < 4; ++j) { const float a = fmaxf(v0[j], 0.f), b = fmaxf(v1[j], 0.f); v0[j] = a * a; v1[j] = b * b; } }
                    u32x4 w; w.x = cvt_pk_bf16(v0[0], v0[1]); w.y = cvt_pk_bf16(v0[2], v0[3]); w.z = cvt_pk_bf16(v1[0], v1[1]); w.w = cvt_pk_bf16(v1[2], v1[3]);
                    *(u32x4*)(rowp + bj * HALF) = w; } }
    }
};
struct EpiG1 {
    static constexpr bool PERM = true;
    bf16_t *PI, *PZ, *PQ, *PG, *GATES; const float* LBv; int ctx;
    __device__ __forceinline__ void operator()(const f32x4 (&acc)[2][2][4][2], const Unit& u, int wr, int wc, int fr, int fq) const {
        const int pn = u.pn; bf16_t* base; int ld, cb, act;
        if (ctx) { base = PI; ld = 1536; cb = pn * 256; act = pn < 2 ? 0 : 3; }
        else if (pn < 2) { base = PI; ld = 512; cb = pn * 256; act = 0; }
        else if (pn < 6) { base = PZ; ld = 1024; cb = (pn - 2) * 256; act = 3; }
        else if (pn < 8) { base = PQ; ld = 512; cb = (pn - 6) * 256; act = 1; }
        else if (pn < 10) { base = PG; ld = 512; cb = (pn - 8) * 256; act = 1; }
        else { base = GATES; ld = 2048; cb = (pn - 10) * 128; act = 2; }
        const int row0 = u.pm * BM + wr * 64 + fr, col0 = cb + wc * 32 + 8 * fq;
        if (act == 2) {
#pragma unroll
            for (int ai = 0; ai < 2; ++ai)
#pragma unroll
                for (int m = 0; m < 4; ++m) { bf16_t* rowp = base + (size_t)(row0 + ai * HALF + m * 16) * ld + col0; f32x4 rh[2], gb[2];
#pragma unroll
                    for (int n = 0; n < 2; ++n)
#pragma unroll
                        for (int j = 0; j < 4; ++j) { const float eA = __builtin_amdgcn_exp2f(-1.4426950408889634f * acc[ai][0][m][n][j]), eB = __builtin_amdgcn_exp2f(-1.4426950408889634f * acc[ai][1][m][n][j]);
                            gb[n][j] = __builtin_amdgcn_rcpf(1.0f + eB); rh[n][j] = (1.0f + eB) * __builtin_amdgcn_rcpf(1.0f + eA); }
                    u32x4 w; w.x = cvt_pk_bf16(rh[0][0], rh[0][1]); w.y = cvt_pk_bf16(rh[0][2], rh[0][3]); w.z = cvt_pk_bf16(rh[1][0], rh[1][1]); w.w = cvt_pk_bf16(rh[1][2], rh[1][3]);
                    *(u32x4*)rowp = w;
                    w.x = cvt_pk_bf16(gb[0][0], gb[0][1]); w.y = cvt_pk_bf16(gb[0][2], gb[0][3]); w.z = cvt_pk_bf16(gb[1][0], gb[1][1]); w.w = cvt_pk_bf16(gb[1][2], gb[1][3]);
                    *(u32x4*)(rowp + 1024) = w; }
            return;
        }
        f32x4 om[2][2];
        if (act == 3) {
#pragma unroll
            for (int bj = 0; bj < 2; ++bj)
#pragma unroll
                for (int n = 0; n < 2; ++n) { const f32x4 l = *(const f32x4*)(LBv + ((col0 + bj * HALF + 4 * n) & 511)); om[bj][n] = (f32x4){1.f - l.x, 1.f - l.y, 1.f - l.z, 1.f - l.w}; } }
#pragma unroll
        for (int ai = 0; ai < 2; ++ai)
#pragma unroll
            for (int m = 0; m < 4; ++m) { bf16_t* rowp = base + (size_t)(row0 + ai * HALF + m * 16) * ld + col0;
#pragma unroll
                for (int bj = 0; bj < 2; ++bj) { f32x4 v0 = acc[ai][bj][m][0], v1 = acc[ai][bj][m][1];
                    if (act == 3) {
#pragma unroll
                        for (int j = 0; j < 4; ++j) { v0[j] = om[bj][0][j] * sigm(-v0[j]); v1[j] = om[bj][1][j] * sigm(-v1[j]); } }
                    else if (act != 0) {
#pragma unroll
                        for (int j = 0; j < 4; ++j) { const float s0 = sigm(v0[j]), s1 = sigm(v1[j]); v0[j] = act == 1 ? v0[j] * s0 : s0; v1[j] = act == 1 ? v1[j] * s1 : s1; } }
                    u32x4 w; w.x = cvt_pk_bf16(v0[0], v0[1]); w.y = cvt_pk_bf16(v0[2], v0[3]); w.z = cvt_pk_bf16(v1[0], v1[1]); w.w = cvt_pk_bf16(v1[2], v1[3]);
                    *(u32x4*)(rowp + bj * HALF) = w; } }
    }
};
struct EpiMerge2 {
    static constexpr bool PERM = true;
    bf16_t* O; const bf16_t* RG;
    __device__ __forceinline__ void operator()(f32x4 (&acc)[2][2][4][2], const Unit& u, int wr, int wc, int fr, int fq) const {
        const int row0 = u.pm * BM + wr * 64 + fr, col0 = u.pn * BM + wc * 32 + 8 * fq; const int goff = u.pass ? 1024 : 0;
#pragma unroll
        for (int ai = 0; ai < 2; ++ai)
#pragma unroll
            for (int m = 0; m < 4; ++m) { const size_t r = (size_t)(row0 + ai * HALF + m * 16);
#pragma unroll
                for (int bj = 0; bj < 2; ++bj) { f32x4 v0 = acc[ai][bj][m][0], v1 = acc[ai][bj][m][1];
                    const u32x4 g = *(const u32x4*)(RG + r * 2048 + goff + col0 + bj * HALF);
                    v0[0] *= bflo(g.x); v0[1] *= bfhi(g.x); v0[2] *= bflo(g.y); v0[3] *= bfhi(g.y); v1[0] *= bflo(g.z); v1[1] *= bfhi(g.z); v1[2] *= bflo(g.w); v1[3] *= bfhi(g.w);
                    if (u.pass == 0) { acc[ai][bj][m][0] = v0; acc[ai][bj][m][1] = v1; }
                    else { u32x4 w; w.x = cvt_pk_bf16(v0[0], v0[1]); w.y = cvt_pk_bf16(v0[2], v0[3]); w.z = cvt_pk_bf16(v1[0], v1[1]); w.w = cvt_pk_bf16(v1[2], v1[3]);
                        *(u32x4*)(O + r * 1024 + col0 + bj * HALF) = w; } } }
    }
};

#ifndef PG8_SP2
#define PG8_SP2 true
#endif
#ifndef PG8_ALIGN
#define PG8_ALIGN true
#endif
template <class Epi, class Sched, bool ALIGN_EPI = PG8_ALIGN, bool SP2 = PG8_SP2>
__device__ __forceinline__ void gemm_phase(PG8_LAS unsigned char* lds, const Gemm g, const Sched& S, const Epi& E) {
    const int tid = threadIdx.x, wid = __builtin_amdgcn_readfirstlane(tid >> 6), lane = tid & 63, wr = wid >> 2, wc = wid & 3, fr = lane & 15, fq = lane >> 4;
    const int nt = g.K / BK;
    unsigned voffA[2], voffB[2];
#pragma unroll
    for (int i = 0; i < 2; ++i) { int R, C; stage_rc(tid * 16 + i * 8192, R, C); const int Rb = Epi::PERM ? ((R & ~31) + perm32(R & 31)) : R;
        voffA[i] = (unsigned)(R * g.lda + C) * 2u; voffB[i] = (unsigned)(Rb * g.ldb + C) * 2u; }
    const size_t kstep = (size_t)(BK * 2);
    const size_t hstepA = (size_t)HALF * g.lda * 2, hstepB = (size_t)HALF * g.ldb * 2;
    const size_t tstepA = 2 * hstepA, tstepB = 2 * hstepB;
    const unsigned ldsw = (unsigned)wid * 1024u;
    const int aoff = lds_byte(wr * 64 + fr, fq * 8), boff = lds_byte(wc * 32 + fr, fq * 8);
#define PG8_SA(b, h) (((b) * 2 + (h)) * HTB)
#define PG8_SB(b, h) ((4 + (b) * 2 + (h)) * HTB)
#define PG8_STAGE(bufoff, gbase, voff) do { _Pragma("unroll") for (int _i = 0; _i < 2; ++_i) \
        __builtin_amdgcn_global_load_lds((const unsigned*)((const char*)(gbase) + (voff)[_i]), (PG8_LAS unsigned*)(lds + (bufoff) + ldsw + _i * 8192), 16, 0, 0); } while (0)
#define PG8_LDA(dst, b, h) do { _Pragma("unroll") for (int m = 0; m < 4; ++m) _Pragma("unroll") for (int k = 0; k < 2; ++k) dst[m][k] = *(const PG8_LAS bf16x8*)(lds + PG8_SA(b, h) + aoff + m * 2048 + k * 1024); } while (0)
#define PG8_LDB(dst, b, h) do { _Pragma("unroll") for (int n = 0; n < 2; ++n) _Pragma("unroll") for (int k = 0; k < 2; ++k) dst[n][k] = *(const PG8_LAS bf16x8*)(lds + PG8_SB(b, h) + boff + n * 2048 + k * 1024); } while (0)
#define PG8_MMA(ai, bj, At, Bt) do { __builtin_amdgcn_s_setprio(1); _Pragma("unroll") for (int m = 0; m < 4; ++m) _Pragma("unroll") for (int n = 0; n < 2; ++n) _Pragma("unroll") for (int k = 0; k < 2; ++k) \
        acc[ai][bj][m][n] = __builtin_amdgcn_mfma_f32_16x16x32_bf16(Bt[n][k], At[m][k], acc[ai][bj][m][n], 0, 0, 0); __builtin_amdgcn_s_setprio(0); } while (0)
#define PG8_WAIT_V(n) asm volatile("s_waitcnt vmcnt(" #n ")" ::: "memory")
#define PG8_WAIT_L(n) asm volatile("s_waitcnt lgkmcnt(" #n ")" ::: "memory")
#define PG8_BAR __builtin_amdgcn_s_barrier()
#define PG8_SCHED __builtin_amdgcn_sched_barrier(0)
    Unit cur, nxt; int ui = 0;
    if (!S.next(0, cur)) return;
    f32x4 acc[2][2][4][2];
#pragma unroll
    for (int a = 0; a < 2; ++a)
#pragma unroll
        for (int b = 0; b < 2; ++b)
#pragma unroll
            for (int m = 0; m < 4; ++m)
#pragma unroll
                for (int n = 0; n < 2; ++n) acc[a][b][m][n] = (f32x4){0.f, 0.f, 0.f, 0.f};
    bf16x8 At[4][2], B0[2][2], B1[2][2];
    const char* cA = (const char*)g.A + (size_t)cur.pm * tstepA + cur.kb; const char* cB = (const char*)g.Bt + (size_t)cur.pn * tstepB + cur.kb;
    if constexpr (SP2) {
        PG8_STAGE(PG8_SB(0, 0), cB, voffB); PG8_STAGE(PG8_SB(0, 1), cB + hstepB, voffB); PG8_STAGE(PG8_SA(0, 0), cA, voffA); PG8_STAGE(PG8_SA(0, 1), cA + hstepA, voffA);
        if (wr == 1) PG8_BAR;
        PG8_WAIT_V(2); PG8_BAR;
        PG8_STAGE(PG8_SB(1, 0), cB + kstep, voffB); PG8_STAGE(PG8_SA(1, 0), cA + kstep, voffA); PG8_STAGE(PG8_SB(1, 1), cB + hstepB + kstep, voffB);
        PG8_WAIT_V(6); PG8_BAR;
    } else {
        PG8_STAGE(PG8_SB(0, 0), cB, voffB); PG8_STAGE(PG8_SA(0, 0), cA, voffA); PG8_STAGE(PG8_SB(0, 1), cB + hstepB, voffB); PG8_STAGE(PG8_SA(0, 1), cA + hstepA, voffA);
        if (wr == 1) PG8_BAR;
        PG8_WAIT_V(4); PG8_BAR;
        PG8_STAGE(PG8_SB(1, 0), cB + kstep, voffB); PG8_STAGE(PG8_SA(1, 0), cA + kstep, voffA); PG8_STAGE(PG8_SB(1, 1), cB + hstepB + kstep, voffB);
        PG8_WAIT_V(6); PG8_BAR;
    }
    for (;;) {
        const bool has_next = S.next(ui + 1, nxt);
        const char* nA = has_next ? (const char*)g.A + (size_t)nxt.pm * tstepA + nxt.kb : cA; const char* nB = has_next ? (const char*)g.Bt + (size_t)nxt.pn * tstepB + nxt.kb : cB;
        for (int t = 0; t < nt; t += 2) {
            const bool last = (t == nt - 2);
            const char* a1 = cA + (size_t)(t + 1) * kstep;
            const char* a2 = last ? nA : cA + (size_t)(t + 2) * kstep; const char* b2 = last ? nB : cB + (size_t)(t + 2) * kstep;
            const char* a3 = a2 + kstep; const char* b3 = b2 + kstep;
            if constexpr (SP2) {
            PG8_LDB(B0, 0, 0); PG8_LDB(B1, 0, 1); PG8_SCHED; PG8_LDA(At, 0, 0); PG8_STAGE(PG8_SA(1, 1), a1 + hstepA, voffA);
            PG8_WAIT_V(8); PG8_WAIT_L(0); PG8_BAR; PG8_MMA(0, 0, At, B0); PG8_MMA(0, 1, At, B1); PG8_BAR; PG8_SCHED;
            PG8_LDA(At, 0, 1); PG8_STAGE(PG8_SB(0, 0), b2, voffB); PG8_STAGE(PG8_SB(0, 1), b2 + hstepB, voffB); PG8_STAGE(PG8_SA(0, 0), a2, voffA);
            PG8_WAIT_V(8); PG8_WAIT_L(0); PG8_BAR; PG8_MMA(1, 0, At, B0); PG8_MMA(1, 1, At, B1); PG8_BAR; PG8_SCHED;
            PG8_LDB(B0, 1, 0); PG8_LDB(B1, 1, 1); PG8_SCHED; PG8_LDA(At, 1, 0); PG8_STAGE(PG8_SA(0, 1), a2 + hstepA, voffA);
            PG8_WAIT_V(8); PG8_WAIT_L(0); PG8_BAR; PG8_MMA(0, 0, At, B0); PG8_MMA(0, 1, At, B1); PG8_BAR; PG8_SCHED;
            PG8_LDA(At, 1, 1); PG8_STAGE(PG8_SB(1, 0), b3, voffB); PG8_STAGE(PG8_SB(1, 1), b3 + hstepB, voffB); PG8_STAGE(PG8_SA(1, 0), a3, voffA);
            PG8_WAIT_V(8); PG8_WAIT_L(0); PG8_BAR; PG8_MMA(1, 0, At, B0); PG8_MMA(1, 1, At, B1); PG8_BAR; PG8_SCHED;
            } else {
            PG8_LDB(B0, 0, 0); PG8_SCHED; PG8_LDA(At, 0, 0); PG8_STAGE(PG8_SA(1, 1), a1 + hstepA, voffA);
            PG8_WAIT_L(8); PG8_BAR; PG8_WAIT_L(0); PG8_MMA(0, 0, At, B0); PG8_BAR; PG8_SCHED;
            PG8_LDB(B1, 0, 1); PG8_STAGE(PG8_SB(0, 0), b2, voffB);
            PG8_BAR; PG8_WAIT_L(0); PG8_MMA(0, 1, At, B1); PG8_BAR;
            PG8_LDA(At, 0, 1); PG8_STAGE(PG8_SA(0, 0), a2, voffA);
            PG8_BAR; PG8_WAIT_L(0); PG8_MMA(1, 0, At, B0); PG8_BAR; PG8_SCHED;
            PG8_STAGE(PG8_SB(0, 1), b2 + hstepB, voffB);
            PG8_WAIT_V(6); PG8_BAR; PG8_MMA(1, 1, At, B1); PG8_BAR;
            PG8_LDB(B0, 1, 0); PG8_SCHED; PG8_LDA(At, 1, 0); PG8_STAGE(PG8_SA(0, 1), a2 + hstepA, voffA);
            PG8_WAIT_L(8); PG8_BAR; PG8_WAIT_L(0); PG8_MMA(0, 0, At, B0); PG8_BAR; PG8_SCHED;
            PG8_LDB(B1, 1, 1); PG8_STAGE(PG8_SB(1, 0), b3, voffB);
            PG8_BAR; PG8_WAIT_L(0); PG8_MMA(0, 1, At, B1); PG8_BAR;
            PG8_LDA(At, 1, 1); PG8_STAGE(PG8_SA(1, 0), a3, voffA);
            PG8_BAR; PG8_WAIT_L(0); PG8_MMA(1, 0, At, B0); PG8_BAR; PG8_SCHED;
            PG8_STAGE(PG8_SB(1, 1), b3 + hstepB, voffB);
            PG8_WAIT_V(6); PG8_BAR; PG8_MMA(1, 1, At, B1); PG8_BAR;
                    }
        }
        if constexpr (ALIGN_EPI) { if (wr == 0) PG8_BAR; }
        E(acc, cur, wr, wc, fr, fq);
        if (!has_next) break;
        if (nxt.pass == 0) {
#pragma unroll
        for (int a = 0; a < 2; ++a)
#pragma unroll
            for (int b = 0; b < 2; ++b)
#pragma unroll
                for (int m = 0; m < 4; ++m)
#pragma unroll
                    for (int n = 0; n < 2; ++n) acc[a][b][m][n] = (f32x4){0.f, 0.f, 0.f, 0.f};
        }
        cur = nxt; cA = nA; cB = nB; ++ui;
        if constexpr (ALIGN_EPI) { if (wr == 1) PG8_BAR; }
    }
    PG8_WAIT_V(0);
    if constexpr (!ALIGN_EPI) { if (wr == 0) PG8_BAR; }
    PG8_BAR;
#undef PG8_SA
#undef PG8_SB
#undef PG8_STAGE
#undef PG8_LDA
#undef PG8_LDB
#undef PG8_MMA
#undef PG8_WAIT_V
#undef PG8_WAIT_L
#undef PG8_BAR
#undef PG8_SCHED
}
}

namespace {
using pg8::bf16_t; using pg8::f32x4; using pg8::u32x4; using pg8::u32x2;
#define LAS __attribute__((address_space(3)))
constexpr int D = 1024, NB = 8, L = 4096, LC = 256, INC = 6144, FF = 4096, HW = 512;
constexpr int NT = NB * L, NCX = NB * LC;
constexpr float EPS = 1e-6f;
constexpr size_t MiB = 1u << 20;
constexpr size_t WS_MOD = 64 * 1024, WS_LB = 512 * 1024, WS_GT = 2 * MiB  ;
constexpr size_t WS_WIN = 18 * MiB, WS_WPAB = 30 * MiB, WS_WOUT = 32 * MiB, WS_W1 = 34 * MiB, WS_W2 = 42 * MiB;
constexpr size_t WS_STATE = 10 * MiB  , WS_HCTX = 50 * MiB, WS_PCTX = 54 * MiB, WS_SCTX = 60 * MiB;
constexpr size_t WS_HLAT = 64 * MiB;
constexpr size_t WS_PI = 128 * MiB, WS_PZ = 160 * MiB, WS_PQ = 224 * MiB, WS_PG = 256 * MiB, WS_GATES = 288 * MiB, WS_PHYT = 416 * MiB;
constexpr size_t WS_AY = 160 * MiB;
constexpr size_t WS_AY2 = 64 * MiB;
constexpr size_t WS_MERGED = 128 * MiB;
constexpr size_t WS_MIX = 448 * MiB, WS_MLP = 384 * MiB, WS_H1 = 128 * MiB, WS_HL = 64 * MiB;
constexpr size_t WS_END = 512 * MiB;
constexpr int LDS_BYTES = 163840;

__device__ __forceinline__ float bf2f(bf16_t h) { return __uint_as_float(((unsigned)h) << 16); }
__device__ __forceinline__ unsigned f2bf(float f) { unsigned u = __float_as_uint(f); return (u + 0x7fffu + ((u >> 16) & 1u)) >> 16; }
__device__ __forceinline__ unsigned pk2(float lo, float hi) { return f2bf(lo) | (f2bf(hi) << 16); }
__device__ __forceinline__ float sigmoidf_(float x) { return 1.f / (1.f + expf(-x)); }
__device__ __forceinline__ float siluf_(float x) { return x / (1.f + expf(-x)); }
__device__ __forceinline__ float wave_sum(float v) {
#pragma unroll
    for (int o = 1; o < 64; o <<= 1) v += __shfl_xor(v, o);
    return v;
}
#define LDS_WAIT() asm volatile("s_waitcnt lgkmcnt(0)" ::: "memory")

struct Params { const float* in[24]; float* out; unsigned char* ws; };
__device__ __forceinline__ f32x4 ldmod(const float* mb, int i4) { return ((const f32x4*)mb)[i4] + ((const f32x4*)(mb + 9 * INC))[i4]; }

#define XB_TMO      128
#define XB_XCNT(j)  (256  + 64 * (j))
#define XB_XSUB(j)  (1280 + 64 * (j))
#define XB_XGEN(j)  (2304 + 64 * (j))
#define XB_TOP      3328
#define XB_TOPGEN   3392
#define XCD_BAR_WORDS 3456
#define XB_SPIN_CAP (1u << 18)

__device__ __forceinline__ unsigned xb_ld(unsigned* p)              { return __hip_atomic_load(p, __ATOMIC_RELAXED, __HIP_MEMORY_SCOPE_AGENT); }
__device__ __forceinline__ unsigned xb_add(unsigned* p, unsigned v) { return __hip_atomic_fetch_add(p, v, __ATOMIC_RELAXED, __HIP_MEMORY_SCOPE_AGENT); }
__device__ __forceinline__ unsigned xb_xcc_id() { return (unsigned)__builtin_amdgcn_s_getreg((3 << 11) | 20) & 0xFu; }
#define XB_SPIN(cond, bar) do { unsigned _sp = 0; while (cond) { __builtin_amdgcn_s_sleep(1); \
    if ((++_sp & 255u) == 0u) { if (xb_ld(&(bar)[XB_TMO])) break; if (_sp > XB_SPIN_CAP) { atomicAdd(&(bar)[XB_TMO], 1u); break; } } } } while (0)

struct XcdBarrier {
    unsigned* bar; unsigned x;
    volatile LAS unsigned* st;
};

__device__ __forceinline__ XcdBarrier xcd_barrier_post(unsigned* bar, volatile LAS unsigned* st) {
    XcdBarrier b; b.bar = bar; b.x = xb_xcc_id(); b.st = st;
    if (threadIdx.x == 0) (void)xb_add(&bar[XB_XCNT(b.x)], 1u);
    return b;
}
__device__ __forceinline__ void xcd_barrier_complete(unsigned* bar, unsigned x, unsigned& nloc, unsigned& nx) {
    const unsigned G = gridDim.x * gridDim.y * gridDim.z;
    unsigned sum, cnt, mine, sp = 0u;
    for (;;) {
        sum = 0u; cnt = 0u; mine = 0u;
#pragma unroll
        for (unsigned j = 0; j < 16; ++j) { const unsigned c = xb_ld(&bar[XB_XCNT(j)]); sum += c; cnt += (c > 0u) ? 1u : 0u; mine = (j == x) ? c : mine; }
        if (sum == G) break;
        __builtin_amdgcn_s_sleep(1);
        if ((++sp & 255u) == 0u) { if (xb_ld(&bar[XB_TMO])) break; if (sp > XB_SPIN_CAP) { atomicAdd(&bar[XB_TMO], 1u); break; } }
    }
    nloc = mine > 0u ? mine : 1u; nx = cnt > 0u ? cnt : 1u;
}

__device__ __forceinline__ void xcd_barrier(const XcdBarrier& b) {
    asm volatile("s_waitcnt vmcnt(0)" ::: "memory");
    __syncthreads();
    if (threadIdx.x == 0) {
        unsigned* bar = b.bar;
        __builtin_amdgcn_s_waitcnt(0);
        unsigned nloc = b.st[0], nx = b.st[1];
        if (nloc == 0u) { xcd_barrier_complete(bar, b.x, nloc, nx); b.st[0] = nloc; b.st[1] = nx; }
        const unsigned old = xb_add(&bar[XB_XSUB(b.x)], 1u);
        const unsigned gen = old / nloc;
        if (old + 1u == (gen + 1u) * nloc) {
            __builtin_amdgcn_fence(__ATOMIC_RELEASE, "agent");
            asm volatile("s_waitcnt vmcnt(0)" ::: "memory");
            const unsigned og = xb_add(&bar[XB_TOP], 1u);
            const unsigned tg = og / nx;
            if (og + 1u == (tg + 1u) * nx) xb_add(&bar[XB_TOPGEN], 1u);
            else XB_SPIN(xb_ld(&bar[XB_TOPGEN]) == tg, bar);
            __builtin_amdgcn_fence(__ATOMIC_ACQUIRE, "agent");
            xb_add(&bar[XB_XGEN(b.x)], 1u);
            asm volatile("s_waitcnt vmcnt(0)" ::: "memory");
        } else {
            XB_SPIN(xb_ld(&bar[XB_XGEN(b.x)]) == gen, bar);
            __builtin_amdgcn_fence(__ATOMIC_ACQUIRE, "agent");
            asm volatile("s_waitcnt vmcnt(0)" ::: "memory");
        }
    }
    __syncthreads();
}


__device__ __forceinline__ void transpose_item(const float* W, int N, bf16_t* WT, int ldk, int koff, int remap, LAS float* scr, int item, int lane) {
    const int nblk = N / 32, kb = item / nblk, nb = item % nblk, k0 = 64 * kb, n0 = 32 * nb;
    int rbase = n0;
    if (remap) { if (n0 < 2560) rbase = n0; else if (n0 < 4096) rbase = n0 + 2048;
        else { const int g = n0 - 4096, nn = g & 1023; rbase = 2560 + 256 * (nn >> 7) + (g >= 1024 ? 128 : 0) + (nn & 127); } }
#pragma unroll 8
    for (int i = 0; i < 32; ++i) { const int kk = 2 * i + (lane >> 5); scr[kk * 33 + (lane & 31)] = W[(size_t)(k0 + kk) * N + n0 + (lane & 31)]; }
    LDS_WAIT();
    const int c = lane & 7;
#pragma unroll
    for (int j = 0; j < 4; ++j) { const int n = (lane >> 3) + 8 * j; const LAS float* s = scr + (8 * c) * 33 + n;
        u32x4 o; o.x = pk2(s[0 * 33], s[1 * 33]); o.y = pk2(s[2 * 33], s[3 * 33]); o.z = pk2(s[4 * 33], s[5 * 33]); o.w = pk2(s[6 * 33], s[7 * 33]);
        *(u32x4*)(WT + (size_t)(rbase + n) * ldk + koff + k0 + 8 * c) = o; }
    LDS_WAIT();
}

__device__ __forceinline__ void row_norm_mod_bf16(const float* xrow, const float* nw, const float* scale, const float* shift, bf16_t* orow, int lane) {
    const f32x4* xr = (const f32x4*)xrow + lane; f32x4 v[4]; float s = 0.f;
#pragma unroll
    for (int j = 0; j < 4; ++j) { v[j] = xr[64 * j]; s += (v[j].x * v[j].x + v[j].y * v[j].y) + (v[j].z * v[j].z + v[j].w * v[j].w); }
    const float r = rsqrtf(wave_sum(s) * (1.f / D) + EPS);
    unsigned long long* o8 = (unsigned long long*)orow + lane;
#pragma unroll
    for (int j = 0; j < 4; ++j) { const f32x4 w = ((const f32x4*)nw)[lane + 64 * j], sc = ((const f32x4*)scale)[lane + 64 * j], sh = ((const f32x4*)shift)[lane + 64 * j];
        const f32x4 o = v[j] * r * w * (1.f + sc) + sh;
        o8[64 * j] = (unsigned long long)pk2(o.x, o.y) | ((unsigned long long)pk2(o.z, o.w) << 32); }
}
__device__ __forceinline__ f32x4 ld_bf4(const bf16_t* p) { const u32x2 u = *(const u32x2*)p; return (f32x4){pg8::bflo(u.x), pg8::bfhi(u.x), pg8::bflo(u.y), pg8::bfhi(u.y)}; }
__device__ __forceinline__ void row_x1(const float* xrow, const bf16_t* mixrow, const float* nw1, const float* g2, f32x4 (&x1)[4], int lane) {
    f32x4 mv[4]; float s = 0.f;
#pragma unroll
    for (int j = 0; j < 4; ++j) { mv[j] = ld_bf4(mixrow + 4 * lane + 256 * j); s += (mv[j].x * mv[j].x + mv[j].y * mv[j].y) + (mv[j].z * mv[j].z + mv[j].w * mv[j].w); }
    const float r = rsqrtf(wave_sum(s) * (1.f / D) + EPS);
#pragma unroll
    for (int j = 0; j < 4; ++j) { const f32x4 w = ((const f32x4*)nw1)[lane + 64 * j], g = ((const f32x4*)g2)[lane + 64 * j], xv = ((const f32x4*)xrow)[lane + 64 * j];
        x1[j] = xv + g * (mv[j] * r * w); }
}

typedef float f32x16 __attribute__((ext_vector_type(16)));
typedef float f32x2_t __attribute__((ext_vector_type(2)));
typedef __bf16 bf16x2_t __attribute__((ext_vector_type(2)));
__device__ __forceinline__ unsigned cvtpk(float lo, float hi) { const f32x2_t v = {lo, hi}; const bf16x2_t b = __builtin_convertvector(v, bf16x2_t); return __builtin_bit_cast(unsigned, b); }
constexpr int HY_PAD = 256, HY_PITCH = (HY_PAD + 4096 + HY_PAD) * 2 + 16;
constexpr int HY_TAB0 = 8 * HY_PITCH;
constexpr int HY_TAB1 = HY_TAB0 + 17408 + 64;
__device__ __forceinline__ void conv8(const u32x4 raw, float left, float right, float w0, float w1, float w2, float bias, float (&o)[8]) {
    float in[10]; in[0] = left; in[9] = right;
    in[1] = pg8::bflo(raw.x); in[2] = pg8::bfhi(raw.x); in[3] = pg8::bflo(raw.y); in[4] = pg8::bfhi(raw.y); in[5] = pg8::bflo(raw.z); in[6] = pg8::bfhi(raw.z); in[7] = pg8::bflo(raw.w); in[8] = pg8::bfhi(raw.w);
#pragma unroll
    for (int j = 0; j < 8; ++j) o[j] = bias + w0 * in[j] + w1 * in[j + 1] + w2 * in[j + 2];
}
__device__ __forceinline__ void hyena_channel(LAS unsigned char* lds, int c, bf16_t* PHYT, const bf16_t* GTB, const float* hy_sw, const float* hy_sb) {
    const int tid = threadIdx.x, lane = tid & 63, wave = __builtin_amdgcn_readfirstlane(tid >> 6);
    const bool hl = (tid & 7) != 0, hr = ((tid + 1) & 7) != 0;
    __syncthreads();
    for (int ci = tid; ci < 1088; ci += 512) { u32x4 v = (u32x4){0u, 0u, 0u, 0u};
        if (ci >= 32 && ci < 1056) v = *(const u32x4*)(GTB + (size_t)c * 8192 + (ci - 32) * 8);
        *(LAS u32x4*)(lds + HY_TAB0 + ci * 16) = v; }
    {
        const bf16_t* x1r = PHYT + (size_t)(512 + c) * NT + 8 * tid; const bf16_t* vr = PHYT + (size_t)(1024 + c) * NT + 8 * tid;
        const float xw0 = hy_sw[512 + c], xw1 = hy_sw[1536 + 512 + c], xw2 = hy_sw[3072 + 512 + c], xb = hy_sb[512 + c];
        const float vw0 = hy_sw[1024 + c], vw1 = hy_sw[1536 + 1024 + c], vw2 = hy_sw[3072 + 1024 + c], vb = hy_sb[1024 + c];
        u32x4 xa[8], va[8];
#pragma unroll
        for (int b = 0; b < 8; ++b) { xa[b] = *(const u32x4*)(x1r + (size_t)b * L); va[b] = *(const u32x4*)(vr + (size_t)b * L); }
#pragma unroll
        for (int b = 0; b < 8; ++b) {
            const unsigned xpw = __shfl_up(xa[b].w, 1), xnx = __shfl_down(xa[b].x, 1), vpw = __shfl_up(va[b].w, 1), vnx = __shfl_down(va[b].x, 1);
            const float xl = hl ? pg8::bfhi(xpw) : 0.f, xr = hr ? pg8::bflo(xnx) : 0.f, vl = hl ? pg8::bfhi(vpw) : 0.f, vrr = hr ? pg8::bflo(vnx) : 0.f;
            float cx[8], cv[8]; conv8(xa[b], xl, xr, xw0, xw1, xw2, xb, cx); conv8(va[b], vl, vrr, vw0, vw1, vw2, vb, cv);
            u32x4 w; w.x = cvtpk(cx[0] * cv[0], cx[1] * cv[1]); w.y = cvtpk(cx[2] * cv[2], cx[3] * cv[3]); w.z = cvtpk(cx[4] * cv[4], cx[5] * cv[5]); w.w = cvtpk(cx[6] * cv[6], cx[7] * cv[7]);
            *(LAS u32x4*)(lds + b * HY_PITCH + (HY_PAD + 8 * tid) * 2) = w; }
        { const int b = tid >> 6, side = (tid >> 5) & 1, k = tid & 31;
            *(LAS u32x4*)(lds + b * HY_PITCH + (side ? (HY_PAD + 4096) * 2 : 0) + k * 16) = (u32x4){0u, 0u, 0u, 0u}; }
    }
    __syncthreads();
    for (int ci = tid; ci < 1088; ci += 512) { const u32x4 d = *(const LAS u32x4*)(lds + HY_TAB0 + ci * 16); const unsigned d4 = ci < 1087 ? *(const LAS unsigned*)(lds + HY_TAB0 + ci * 16 + 16) : 0u;
        u32x4 o; o.x = __builtin_amdgcn_alignbit(d.y, d.x, 16); o.y = __builtin_amdgcn_alignbit(d.z, d.y, 16); o.z = __builtin_amdgcn_alignbit(d.w, d.z, 16); o.w = __builtin_amdgcn_alignbit(d4, d.w, 16);
        *(LAS u32x4*)(lds + HY_TAB1 + ci * 16) = o; }
    __syncthreads();
    const int T0 = 512 * wave, r = lane & 31, h = lane >> 5, bb = r & 7, tb = r >> 3;
    f32x16 acc[4];
#pragma unroll
    for (int i = 0; i < 4; ++i)
#pragma unroll
        for (int j = 0; j < 16; ++j) acc[i][j] = 0.f;
    {
        const int Dfirst = T0 - 4080;
        const int e0 = 4351 - Dfirst - r + 8 * h;
        const unsigned aaddr0 = (unsigned)((e0 & 1) ? HY_TAB1 : HY_TAB0) + (unsigned)(e0 & ~1) * 2u;
        const unsigned baddr0 = (unsigned)(bb * HY_PITCH + (HY_PAD + T0 + 64 * tb - Dfirst + 8 * h) * 2);
#define HY_LDA(dst, ad) do { u32x4 _t; _t.x = *(const LAS unsigned*)(lds + (ad)); _t.y = *(const LAS unsigned*)(lds + (ad) + 4); _t.z = *(const LAS unsigned*)(lds + (ad) + 8); _t.w = *(const LAS unsigned*)(lds + (ad) + 12); dst = __builtin_bit_cast(pg8::bf16x8, _t); } while (0)
#define HY_LDB(dst, ad) dst = *(const LAS pg8::bf16x8*)(lds + (ad))
#define HY_MMA(i, A, B) acc[i] = __builtin_amdgcn_mfma_f32_32x32x16_bf16(A, B, acc[i], 0, 0, 0)
#define HY_GENERIC(st_lo, st_hi) do { for (int st = (st_lo); st < (st_hi); ++st) { const unsigned aa = aaddr0 - 32u * (unsigned)st, ba = baddr0 - 32u * (unsigned)st; pg8::bf16x8 A; HY_LDA(A, aa); \
            if (st <= 267) { pg8::bf16x8 B; HY_LDB(B, ba); HY_MMA(0, A, B); } \
            if (st >= 2 && st <= 269) { pg8::bf16x8 B; HY_LDB(B, ba + 64); HY_MMA(1, A, B); } \
            if (st >= 16 && st <= 283) { pg8::bf16x8 B; HY_LDB(B, ba + 512); HY_MMA(2, A, B); } \
            if (st >= 18) { pg8::bf16x8 B; HY_LDB(B, ba + 576); HY_MMA(3, A, B); } } } while (0)
        HY_GENERIC(0, 18);
        {
            unsigned aa = aaddr0 - 32u * 18u, ba = baddr0 - 32u * 18u;
            pg8::bf16x8 Aa, Ab, X0, X1, X2, X3, Y0, Y1, Y2, Y3;
            HY_LDB(X0, ba + 64u); HY_LDB(Y0, ba + 64u + 512u);
            HY_LDB(X1, ba + 32u); HY_LDB(Y1, ba + 32u + 512u);
            HY_LDA(Aa, aa); HY_LDB(X2, ba); HY_LDB(Y2, ba + 512u);
#define HY_STEP(Acur, Anext, Xc, Xo, Xn, Yc, Yo, Yn, k) do { \
                HY_LDA(Anext, aa - 32u * ((k) + 1)); HY_LDB(Xn, ba - 32u * ((k) + 1)); HY_LDB(Yn, ba - 32u * ((k) + 1) + 512u); __builtin_amdgcn_sched_barrier(0); \
                HY_MMA(0, Acur, Xc); HY_MMA(1, Acur, Xo); HY_MMA(2, Acur, Yc); HY_MMA(3, Acur, Yo); __builtin_amdgcn_sched_barrier(0); } while (0)
#pragma unroll 1
            for (int it = 0; it < 62; ++it) {
                HY_STEP(Aa, Ab, X2, X0, X3, Y2, Y0, Y3, 0);
                HY_STEP(Ab, Aa, X3, X1, X0, Y3, Y1, Y0, 1);
                HY_STEP(Aa, Ab, X0, X2, X1, Y0, Y2, Y1, 2);
                HY_STEP(Ab, Aa, X1, X3, X2, Y1, Y3, Y2, 3);
                aa -= 128u; ba -= 128u;
            }
#undef HY_STEP
        }
        HY_GENERIC(266, 286);
#undef HY_LDA
#undef HY_LDB
#undef HY_MMA
#undef HY_GENERIC
    }
    __syncthreads();
    {
        const bf16_t* x0r = PHYT + (size_t)c * NT + 8 * tid; u32x4 xa[8];
#pragma unroll
        for (int b = 0; b < 8; ++b) xa[b] = *(const u32x4*)(x0r + (size_t)b * L);
#pragma unroll
        for (int i = 0; i < 4; ++i)
#pragma unroll
            for (int g = 0; g < 4; ++g) { const int t = T0 + 256 * (i >> 1) + 32 * (i & 1) + 64 * tb + 8 * g + 4 * h;
                pg8::u32x2 w; w.x = cvtpk(acc[i][4 * g], acc[i][4 * g + 1]); w.y = cvtpk(acc[i][4 * g + 2], acc[i][4 * g + 3]);
                *(LAS pg8::u32x2*)(lds + bb * HY_PITCH + (HY_PAD + t) * 2) = w; }
        __syncthreads();
        bf16_t* yr = PHYT + (size_t)(1024 + c) * NT + 8 * tid;
        const float w0 = hy_sw[c], w1 = hy_sw[1536 + c], w2 = hy_sw[3072 + c], bs = hy_sb[c];
#pragma unroll
        for (int b = 0; b < 8; ++b) {
            const unsigned xpw = __shfl_up(xa[b].w, 1), xnx = __shfl_down(xa[b].x, 1);
            const float xl = hl ? pg8::bfhi(xpw) : 0.f, xr = hr ? pg8::bflo(xnx) : 0.f;
            float cx[8]; conv8(xa[b], xl, xr, w0, w1, w2, bs, cx);
            const u32x4 y = *(const LAS u32x4*)(lds + b * HY_PITCH + (HY_PAD + 8 * tid) * 2);
            u32x4 w; w.x = cvtpk(cx[0] * pg8::bflo(y.x), cx[1] * pg8::bfhi(y.x)); w.y = cvtpk(cx[2] * pg8::bflo(y.y), cx[3] * pg8::bfhi(y.y));
            w.z = cvtpk(cx[4] * pg8::bflo(y.z), cx[5] * pg8::bfhi(y.z)); w.w = cvtpk(cx[6] * pg8::bflo(y.w), cx[7] * pg8::bfhi(y.w));
            *(u32x4*)(yr + (size_t)b * L) = w; }
    }
}

constexpr int HG_QE = 0, HG_KE = 17408, HG_KDT = 34816, HG_VT = 53248, HG_DEC = 71680, HG_BUF = 72192;

#define HG_RD2(ptr_a, ptr_b) __builtin_bit_cast(pg8::bf16x8, (u32x4){(*(const LAS u32x2*)(ptr_a)).x, (*(const LAS u32x2*)(ptr_a)).y, (*(const LAS u32x2*)(ptr_b)).x, (*(const LAS u32x2*)(ptr_b)).y})
typedef short v4i16_t __attribute__((ext_vector_type(4)));
#define HG_TR1(p) __builtin_amdgcn_ds_read_tr16_b64_v4i16((LAS v4i16_t*)(p))
#define HG_TR2(pa, pb) __builtin_bit_cast(pg8::bf16x8, __builtin_shufflevector(HG_TR1(pa), HG_TR1(pb), 0, 1, 2, 3, 4, 5, 6, 7))
#define HG_MFMA(a, b, c) __builtin_amdgcn_mfma_f32_16x16x32_bf16(a, b, c, 0, 0, 0)
#define HG_SB() __builtin_amdgcn_sched_barrier(0)
__device__ __forceinline__ pg8::bf16x8 hg_pack2(const f32x4& a, const f32x4& b) { u32x4 t; t.x = cvtpk(a[0], a[1]); t.y = cvtpk(a[2], a[3]); t.z = cvtpk(b[0], b[1]); t.w = cvtpk(b[2], b[3]); return __builtin_bit_cast(pg8::bf16x8, t); }
template <bool HAS_Q>
__device__ __forceinline__ void hgrn_consume(LAS unsigned char* Bf, f32x4 (&S)[2][8], int base, int dir, int h, int cw, int fr, int kg, float* o_out, int dbg) {
    const f32x4 z4 = (f32x4){0.f, 0.f, 0.f, 0.f};
    const int trq = fr >> 2, trp = fr & 3;
    pg8::bf16x8 Bv[2][2];
#pragma unroll
    for (int sl = 0; sl < 2; ++sl)
#pragma unroll
        for (int ks = 0; ks < 2; ++ks) { LAS unsigned char* const vp = Bf + HG_VT + (32 * ks + 4 * kg + trq) * 288 + (32 * cw + 16 * sl + 4 * trp) * 2; Bv[sl][ks] = HG_TR2(vp, vp + 16 * 288); }
    if (HAS_Q) {
        f32x4 st[10];
#pragma unroll
        for (int i = 0; i < 10; ++i) st[i] = z4;
        pg8::bf16x8 Kf[2][4], Qf[2][4];
        LAS unsigned char* const kbase = Bf + HG_KE + fr * 272 + 8 * kg * 2; LAS unsigned char* const qbase = Bf + HG_QE + fr * 272 + 8 * kg * 2;
#pragma unroll
        for (int b4 = 0; b4 < 4; ++b4) { Kf[0][b4] = *(const LAS pg8::bf16x8*)(kbase + b4 * 16 * 272); Qf[0][b4] = *(const LAS pg8::bf16x8*)(qbase + b4 * 16 * 272); }
#pragma unroll
        for (int ks = 0; ks < 4; ++ks) {
            if (ks < 3) {
#pragma unroll
                for (int b4 = 0; b4 < 4; ++b4) { Kf[(ks + 1) & 1][b4] = *(const LAS pg8::bf16x8*)(kbase + b4 * 16 * 272 + (ks + 1) * 64); Qf[(ks + 1) & 1][b4] = *(const LAS pg8::bf16x8*)(qbase + b4 * 16 * 272 + (ks + 1) * 64); } }
            HG_SB();
#pragma unroll
            for (int cb = 0; cb < 4; ++cb)
#pragma unroll
                for (int sb = 0; sb <= cb; ++sb) st[cb * (cb + 1) / 2 + sb] = HG_MFMA(Kf[ks & 1][sb], Qf[ks & 1][cb], st[cb * (cb + 1) / 2 + sb]);
            HG_SB();
        }
#pragma unroll
        for (int cb = 0; cb < 4; ++cb)
#pragma unroll
            for (int r = 0; r < 4; ++r) st[cb * (cb + 1) / 2 + cb][r] = (4 * kg + r <= fr) ? st[cb * (cb + 1) / 2 + cb][r] : 0.f;
        pg8::bf16x8 Af[4][2];
        Af[0][0] = hg_pack2(st[0], z4); Af[1][0] = hg_pack2(st[1], st[2]); Af[2][0] = hg_pack2(st[3], st[4]); Af[2][1] = hg_pack2(st[5], z4); Af[3][0] = hg_pack2(st[6], st[7]); Af[3][1] = hg_pack2(st[8], st[9]);
        pg8::bf16x8 Bs[2][4];
#pragma unroll
        for (int sl = 0; sl < 2; ++sl)
#pragma unroll
            for (int kp = 0; kp < 4; ++kp) Bs[sl][kp] = hg_pack2(S[sl][2 * kp], S[sl][2 * kp + 1]);
        pg8::bf16x8 Aq[2][4];
        LAS unsigned char* const qp0 = Bf + HG_QE + fr * 272 + 4 * kg * 2;
#pragma unroll
        for (int kp = 0; kp < 4; ++kp) Aq[0][kp] = HG_RD2(qp0 + kp * 64, qp0 + kp * 64 + 32);
#pragma unroll
        for (int cb = 0; cb < 4; ++cb) {
            if (cb < 3) {
#pragma unroll
                for (int kp = 0; kp < 4; ++kp) Aq[(cb + 1) & 1][kp] = HG_RD2(qp0 + (cb + 1) * 16 * 272 + kp * 64, qp0 + (cb + 1) * 16 * 272 + kp * 64 + 32); }
            HG_SB();
            f32x4 o0 = z4, o1 = z4;
            o0 = HG_MFMA(Bv[0][0], Af[cb][0], o0); o1 = HG_MFMA(Bv[1][0], Af[cb][0], o1);
            if (cb >= 2) { o0 = HG_MFMA(Bv[0][1], Af[cb][1], o0); o1 = HG_MFMA(Bv[1][1], Af[cb][1], o1); }
#pragma unroll
            for (int kp = 0; kp < 4; ++kp) { o0 = HG_MFMA(Bs[0][kp], Aq[cb & 1][kp], o0); o1 = HG_MFMA(Bs[1][kp], Aq[cb & 1][kp], o1); }
            HG_SB();
            { const int cp = 16 * cb + fr; const int t = base + (dir ? 63 - cp : cp); float* op = o_out + (size_t)t * 128 + 32 * cw + 4 * kg;
              if (!(dbg & 1)) { *(f32x4*)op = o0; *(f32x4*)(op + 16) = o1; } else asm volatile("" :: "v"(o0), "v"(o1)); }
        }
    }
    pg8::bf16x8 Ak[2][2][2]; f32x4 dc[2][2];
    LAS unsigned char* const kdp = Bf + HG_KDT + (4 * kg + trq) * 288 + 4 * trp * 2; LAS unsigned char* const dcp = Bf + HG_DEC + 4 * kg * 4;
#pragma unroll
    for (int u = 0; u < 2; ++u) { dc[0][u] = *(const LAS f32x4*)(dcp + u * 64);
#pragma unroll
        for (int ks = 0; ks < 2; ++ks) Ak[0][u][ks] = HG_TR2(kdp + u * 32 + ks * 32 * 288, kdp + u * 32 + ks * 32 * 288 + 16 * 288); }
#pragma unroll
    for (int bp = 0; bp < 4; ++bp) {
        if (bp < 3) {
#pragma unroll
            for (int u = 0; u < 2; ++u) { const int blk = 2 * (bp + 1) + u; dc[(bp + 1) & 1][u] = *(const LAS f32x4*)(dcp + blk * 64);
#pragma unroll
                for (int ks = 0; ks < 2; ++ks) Ak[(bp + 1) & 1][u][ks] = HG_TR2(kdp + blk * 32 + ks * 32 * 288, kdp + blk * 32 + ks * 32 * 288 + 16 * 288); } }
        HG_SB();
#pragma unroll
        for (int u = 0; u < 2; ++u) { const int blk = 2 * bp + u; f32x4 s0 = S[0][blk] * dc[bp & 1][u], s1 = S[1][blk] * dc[bp & 1][u];
#pragma unroll
            for (int ks = 0; ks < 2; ++ks) { s0 = HG_MFMA(Ak[bp & 1][u][ks], Bv[0][ks], s0); s1 = HG_MFMA(Ak[bp & 1][u][ks], Bv[1][ks], s1); }
            S[0][blk] = s0; S[1][blk] = s1; }
        HG_SB();
    }
}
#undef HG_RD2
#undef HG_TR1
#undef HG_TR2
#undef HG_MFMA
#undef HG_SB

template <bool HAS_Q>
__device__ __forceinline__ void hgrn_chain_mfma(LAS unsigned char* lds, const bf16_t* pi, int ldi, const bf16_t* pz, int ldz, const bf16_t* pq, int ldq, int Lseq, int h, int dir,
                                                const float* lb, const float* s_in, float* s_out, float* o_out, int n_begin, int nch  , int dbg = 0, unsigned char* dbgp = nullptr) {
    const int tid = threadIdx.x, lane = tid & 63, wave = __builtin_amdgcn_readfirstlane(tid >> 6);
    const bool producer = wave < 4;
#if PROBE_MASK
    unsigned long long bar_wait = 0ull;
#define HG_BAR() do { asm volatile("s_waitcnt lgkmcnt(0)" ::: "memory"); const unsigned long long _b0 = __builtin_amdgcn_s_memrealtime(); __builtin_amdgcn_s_barrier(); bar_wait += __builtin_amdgcn_s_memrealtime() - _b0; asm volatile("" ::: "memory"); } while (0)
#else
#define HG_BAR() do { asm volatile("s_waitcnt lgkmcnt(0)" ::: "memory"); __builtin_amdgcn_s_barrier(); asm volatile("" ::: "memory"); } while (0)
#endif
    const int pw = wave & 3, dp = lane & 15, rq = lane >> 4, ch0 = 32 * pw + 2 * dp;
    const int rowmin = dir ? 48 - 16 * rq : 16 * rq;
    const unsigned voZ = (unsigned)(rowmin * ldz + h * 128 + ch0) * 2u, voI = (unsigned)(rowmin * ldi + h * 128 + ch0) * 2u, voQ = (unsigned)(rowmin * (HAS_Q ? ldq : ldi) + h * 128 + ch0) * 2u;
    const __amdgpu_buffer_rsrc_t rsZ = __builtin_amdgcn_make_buffer_rsrc((void*)pz, 0, Lseq * ldz * 2, 0x00020000);
    const __amdgpu_buffer_rsrc_t rsI = __builtin_amdgcn_make_buffer_rsrc((void*)pi, 0, Lseq * ldi * 2, 0x00020000);
    const __amdgpu_buffer_rsrc_t rsQ = __builtin_amdgcn_make_buffer_rsrc((void*)(HAS_Q ? pq : pi), 0, Lseq * (HAS_Q ? ldq : ldi) * 2, 0x00020000);
#define HG_LOAD(n, Z, Q, V) do { const int _n = (dbg & 2) ? 0 : (n); const int _base = dir ? (Lseq - 64 * (_n + 1)) : 64 * _n; \
        _Pragma("unroll") for (int i = 0; i < 16; ++i) { const int _r = _base + (dir ? 15 - i : i); \
            Z[i] = __builtin_amdgcn_raw_buffer_load_b32(rsZ, voZ, _r * ldz * 2, 0); V[i] = __builtin_amdgcn_raw_buffer_load_b32(rsI, voI, _r * ldi * 2, 0); \
            if (HAS_Q) Q[i] = __builtin_amdgcn_raw_buffer_load_b32(rsQ, voQ, _r * ldq * 2, 0); } } while (0)
#define HG_PRODUCE(Z, Q, V, boff) do { LAS unsigned char* const Bf = lds + (boff); \
        float f0[16], f1[16]; float p0 = 1.f, p1 = 1.f; \
        _Pragma("unroll") for (int i = 0; i < 16; ++i) { f0[i] = 1.f - pg8::bflo(Z[i]); f1[i] = 1.f - pg8::bfhi(Z[i]); p0 *= f0[i]; p1 *= f1[i]; } \
        float run0 = 1.f, run1 = 1.f, fl0 = 1.f, fl1 = 1.f, suf0 = 1.f, suf1 = 1.f; \
        _Pragma("unroll") for (int qq = 0; qq < 4; ++qq) { const float t0 = __shfl(p0, dp + 16 * qq), t1 = __shfl(p1, dp + 16 * qq); fl0 *= t0; fl1 *= t1; if (qq < rq) { run0 *= t0; run1 *= t1; } if (qq > rq) { suf0 *= t0; suf1 *= t1; } } \
        if (HAS_Q) { \
            _Pragma("unroll") for (int i = 0; i < 16; ++i) { run0 *= f0[i]; run1 *= f1[i]; const float ia = __builtin_amdgcn_rcpf(run0), ib = __builtin_amdgcn_rcpf(run1); \
                const float kea = pg8::bflo(Z[i]) * ia, keb = pg8::bfhi(Z[i]) * ib; const int cp = 16 * rq + i; \
                *(LAS unsigned*)(Bf + HG_QE + cp * 272 + ch0 * 2) = cvtpk(pg8::bflo(Q[i]) * run0, pg8::bfhi(Q[i]) * run1); \
                *(LAS unsigned*)(Bf + HG_KE + cp * 272 + ch0 * 2) = cvtpk(kea, keb); \
                *(LAS unsigned*)(Bf + HG_KDT + cp * 288 + ch0 * 2) = cvtpk(kea * fl0, keb * fl1); } \
        } else { \
            _Pragma("unroll") for (int i = 15; i >= 0; --i) { const int cp = 16 * rq + i; \
                *(LAS unsigned*)(Bf + HG_KDT + cp * 288 + ch0 * 2) = cvtpk(pg8::bflo(Z[i]) * suf0, pg8::bfhi(Z[i]) * suf1); suf0 *= f0[i]; suf1 *= f1[i]; } \
        } \
        _Pragma("unroll") for (int i = 0; i < 16; ++i) *(LAS unsigned*)(Bf + HG_VT + (16 * rq + i) * 288 + ch0 * 2) = V[i]; \
        if (rq == 0) *(LAS f32x2_t*)(Bf + HG_DEC + ch0 * 4) = (f32x2_t){fl0, fl1}; } while (0)
#define HG_CONSUME(m, boff) hgrn_consume<HAS_Q>(lds + (boff), S, dir ? (Lseq - 64 * ((m) + 1)) : 64 * (m), dir, h, cw, fr, kg, o_out, dbg)

    __syncthreads();
    if (producer) {
        unsigned zA[16], qA[16], vA[16], zB[16], qB[16], vB[16];
        HG_LOAD(n_begin, zA, qA, vA);
        if (n_begin + 1 < nch) HG_LOAD(n_begin + 1, zB, qB, vB);
        for (int n = n_begin; n <= nch; n += 2) {
            if (n < nch && !(dbg & 4)) HG_PRODUCE(zA, qA, vA, 0);
            if (n + 2 < nch) HG_LOAD(n + 2, zA, qA, vA);
            HG_BAR();
            if (n + 1 < nch && !(dbg & 4)) HG_PRODUCE(zB, qB, vB, HG_BUF);
            if (n + 3 < nch) HG_LOAD(n + 3, zB, qB, vB);
            HG_BAR();
        }
    } else {
        const int cw = wave & 3, fr = lane & 15, kg = lane >> 4;
        __builtin_amdgcn_s_setprio(3);
        f32x4 S[2][8];
#pragma unroll
        for (int sl = 0; sl < 2; ++sl)
#pragma unroll
            for (int blk = 0; blk < 8; ++blk)
#pragma unroll
                for (int r = 0; r < 4; ++r) S[sl][blk][r] = s_in ? s_in[(size_t)(16 * blk + 4 * kg + r) * 128 + 32 * cw + 16 * sl + fr] : 0.f;
        for (int n = n_begin; n <= nch; n += 2) {
            if (n > n_begin && !(dbg & 8)) HG_CONSUME(n - 1, HG_BUF);
            HG_BAR();
            if (n < nch && !(dbg & 8)) HG_CONSUME(n, 0);
            HG_BAR();
        }
        if (dbg) {
#pragma unroll
            for (int sl = 0; sl < 2; ++sl)
#pragma unroll
                for (int blk = 0; blk < 8; ++blk) asm volatile("" :: "v"(S[sl][blk][0]), "v"(S[sl][blk][1]), "v"(S[sl][blk][2]), "v"(S[sl][blk][3]));
        }
        if (s_out) {
#pragma unroll
            for (int sl = 0; sl < 2; ++sl)
#pragma unroll
                for (int blk = 0; blk < 8; ++blk)
#pragma unroll
                    for (int r = 0; r < 4; ++r) s_out[(size_t)(16 * blk + 4 * kg + r) * 128 + 32 * cw + 16 * sl + fr] = S[sl][blk][r];
        }
        __builtin_amdgcn_s_setprio(0);
    }
#if PROBE_MASK
    if (HAS_Q && blockIdx.x == PROBE_BUSY_BLOCK && (tid == 0 || tid == 256) && dbg == 0) *(volatile unsigned long long*)(dbgp + (tid ? 8 : 0)) = bar_wait;
#endif
#undef HG_LOAD
#undef HG_PRODUCE
#undef HG_CONSUME
#undef HG_BAR
    __syncthreads();
}

__global__ void __launch_bounds__(512, 2) mega(Params P) {
    extern __shared__ __attribute__((aligned(16))) unsigned char lds_raw[];
    cg::grid_group grid = cg::this_grid();
    LAS unsigned char* lds = (LAS unsigned char*)lds_raw;
    const int tid = threadIdx.x, lane = tid & 63, wave = __builtin_amdgcn_readfirstlane(tid >> 6);
    const int G = gridDim.x, bx = blockIdx.x;
    const int vcu = (G % 8 == 0) ? (bx % 8) * (G / 8) + bx / 8 : bx;
    const int gw = vcu * 8 + wave, NGW = G * 8;
    unsigned char* ws = P.ws;
    const float* x = P.in[0]; const float* cvec = P.in[1]; const float* ctx = P.in[2]; const float* c_ctx = P.in[3];
    const float* w_ada = P.in[4]; const float* b_ada = P.in[5]; const float* norm_w = P.in[6]; const float* w_in = P.in[7];
    const float* lb_param = P.in[8]; const float* g_norm = P.in[9]; const float* hy_sw = P.in[10]; const float* hy_sb = P.in[11];
    const float* f_w1 = P.in[12]; const float* f_b1 = P.in[13]; const float* f_w2 = P.in[14]; const float* f_b2 = P.in[15];
    const float* f_w3 = P.in[16]; const float* f_freq = P.in[17]; const float* hy_d = P.in[18]; const float* w_pa = P.in[19];
    const float* w_pb = P.in[20]; const float* w_out = P.in[21]; const float* w_mlp1 = P.in[22]; const float* w_mlp2 = P.in[23];
    float* MOD = (float*)(ws + WS_MOD); float* LB = (float*)(ws + WS_LB); bf16_t* GTB = (bf16_t*)(ws + WS_GT);
    bf16_t* WIN = (bf16_t*)(ws + WS_WIN); bf16_t* WPAB = (bf16_t*)(ws + WS_WPAB); bf16_t* WOUT = (bf16_t*)(ws + WS_WOUT); bf16_t* W1 = (bf16_t*)(ws + WS_W1); bf16_t* W2 = (bf16_t*)(ws + WS_W2);
    bf16_t* HCTX = (bf16_t*)(ws + WS_HCTX); bf16_t* PCTX = (bf16_t*)(ws + WS_PCTX); float* SCTX = (float*)(ws + WS_SCTX);
    bf16_t* HLAT = (bf16_t*)(ws + WS_HLAT); bf16_t* PI = (bf16_t*)(ws + WS_PI); bf16_t* PZ = (bf16_t*)(ws + WS_PZ); bf16_t* PQ = (bf16_t*)(ws + WS_PQ);
    bf16_t* PG = (bf16_t*)(ws + WS_PG); bf16_t* GATES = (bf16_t*)(ws + WS_GATES); bf16_t* PHYT = (bf16_t*)(ws + WS_PHYT);
    bf16_t* AY = (bf16_t*)(ws + WS_AY2); bf16_t* MERGED = (bf16_t*)(ws + WS_MERGED); bf16_t* MIX = (bf16_t*)(ws + WS_MIX);
    bf16_t* MLP = (bf16_t*)(ws + WS_MLP); bf16_t* H1 = (bf16_t*)(ws + WS_H1); bf16_t* HL = (bf16_t*)(ws + WS_HL);
    float* O2 = P.out;

    volatile LAS unsigned* MISC = (volatile LAS unsigned*)(lds + LDS_BYTES - 128);
    if (tid < 16) MISC[tid] = 0u;
    __syncthreads();
    const XcdBarrier xbar = xcd_barrier_post((unsigned*)ws, MISC);
#ifdef NO_GRID_SYNC
#define SEAM_RAW(k) xcd_barrier(xbar)
#else
#define SEAM_RAW(k) do { if ((k) == 0) grid.sync(); else xcd_barrier(xbar); } while (0)
#endif
#if PROBE_MASK
    unsigned long long t_prev = __builtin_amdgcn_s_memrealtime(), t_spin = 0ull;
#define SEAM(k) do { if ((k) == PROBE_BUSY_PHASE && bx == PROBE_BUSY_BLOCK && tid == 0) *(volatile unsigned long long*)(ws + 32768) = __builtin_amdgcn_s_memrealtime() - t_prev; \
    SEAM_RAW(k); { const unsigned long long _t = __builtin_amdgcn_s_memrealtime(); if ((PROBE_MASK >> (k)) & 1) t_spin += _t - t_prev; \
    if ((k) == PROBE_BUSY_PHASE) t_spin += *(volatile unsigned long long*)(ws + 32768); t_prev = _t; } } while (0)
#else
#define SEAM(k) SEAM_RAW(k)
#endif
    {
        if (bx < 192) {
            const int cgp = bx % 96, kh = bx / 96;
            LAS float* sc = (LAS float*)lds;
            LAS float* ps = (LAS float*)(lds + 20480);
            for (int i = tid; i < 9 * 512; i += 512) { const int r = i >> 9, k = kh * 512 + (i & 511); sc[i] = siluf_(r < 8 ? cvec[r * D + k] : c_ctx[k]); }
            __syncthreads();
            const int j = cgp * 64 + lane; float a9[9];
#pragma unroll
            for (int r = 0; r < 9; ++r) a9[r] = 0.f;
            const float* wp = w_ada + (size_t)(kh * 512 + wave * 64) * INC + j;
#pragma unroll 1
            for (int kk = 0; kk < 64; kk += 16) { float w[16];
#pragma unroll
                for (int u = 0; u < 16; ++u) w[u] = wp[(size_t)(kk + u) * INC];
#pragma unroll
                for (int u = 0; u < 16; ++u)
#pragma unroll
                    for (int r = 0; r < 9; ++r) a9[r] += sc[r * 512 + wave * 64 + kk + u] * w[u]; }
#pragma unroll
            for (int r = 0; r < 9; ++r) ps[(wave * 9 + r) * 64 + lane] = a9[r];
            __syncthreads();
            for (int i = tid; i < 9 * 64; i += 512) { const int r = i >> 6, l = i & 63; float s = kh == 0 ? b_ada[cgp * 64 + l] : 0.f;
#pragma unroll
                for (int w = 0; w < 8; ++w) s += ps[(w * 9 + r) * 64 + l];
                MOD[(size_t)kh * (9 * INC) + r * INC + cgp * 64 + l] = s; }
            __syncthreads();
        }
        if (bx == G - 1) { const float a = lb_param[tid], b = lb_param[HW + tid], m = fmaxf(a, b); const float ea = expf(a - m), eb = expf(b - m); LB[tid] = ea / (ea + eb); }
        {   LAS float* scr = (LAS float*)(lds + wave * 16384);
            for (int it = gw; it < 16 * 192; it += NGW) transpose_item(w_in, INC, WIN, D, 0, 1, scr, it, lane); }
        for (int tb = bx; tb < 256; tb += G) {
            __syncthreads();
            LAS float* zf = (LAS float*)lds; LAS float* h1 = zf + 17 * 36; LAS float* h2 = h1 + 17 * 64;
            for (int i = tid; i < 17 * 33; i += 512) { const int p = i / 33, k = i - 33 * p, t = 16 * tb + p; float val;
                if (k == 0) val = (float)t / (float)(L - 1);
                else { const int bi = (k - 1) & 15; const float band = 1e-4f + (float)bi * ((15.f - 1e-4f) / 15.f);
                    const float w = 2.0f * 3.14159265358979323846f * (float)t / (float)L; const float ang = w * band;
                    val = (k <= 16) ? cosf(ang) : -sinf(ang); }
                zf[p * 36 + k] = val; }
            __syncthreads();
            for (int i = tid; i < 17 * 64; i += 512) { const int p = i >> 6, k = i & 63; float acc = f_b1[k];
#pragma unroll 11
                for (int q = 0; q < 33; ++q) acc += zf[p * 36 + q] * f_w1[q * 64 + k];
                h1[i] = sinf(f_freq[k] * acc); }
            __syncthreads();
            for (int i = tid; i < 17 * 64; i += 512) { const int p = i >> 6, k = i & 63; float acc = f_b2[k];
#pragma unroll 16
                for (int q = 0; q < 64; ++q) acc += h1[p * 64 + q] * f_w2[q * 64 + k];
                h2[i] = sinf(f_freq[k] * acc); }
            __syncthreads();
            const int c = tid; float af[16], ab[16];
#pragma unroll
            for (int p = 0; p < 16; ++p) { af[p] = 0.f; ab[p] = 0.f; }
#pragma unroll 4
            for (int k = 0; k < 64; ++k) { const float wf = f_w3[k * 1024 + c], wb = f_w3[k * 1024 + 512 + c]; float hv[17];
#pragma unroll
                for (int p = 0; p < 17; ++p) hv[p] = h2[p * 64 + k];
#pragma unroll
                for (int p = 0; p < 16; ++p) { af[p] += hv[p] * wf; ab[p] += hv[p + 1] * wb; } }
            const float mind = logf(1e-2f) / 1.5f, maxd = logf(1e-2f) / 0.3f;
            const float delta = fabsf(mind + (maxd - mind) * ((float)c / 511.f));
            unsigned short of[16], ob[16];
#pragma unroll
            for (int p = 0; p < 16; ++p) { const int tf = 16 * tb + p, tbk = tf + 1;
                float vf = af[p] * expf(-((float)tf / (float)(L - 1)) * delta); if (tf == 0) vf += hy_d[c];
                float vb = ab[p] * expf(-((float)tbk / (float)(L - 1)) * delta); if (tbk >= L) vb = 0.f;
                of[15 - p] = (unsigned short)f2bf(vf); ob[p] = (unsigned short)f2bf(vb); }
            bf16_t* gf = GTB + (size_t)c * 8192 + (4080 - 16 * tb); bf16_t* gb = GTB + (size_t)c * 8192 + (4096 + 16 * tb);
            u32x4 w0, w1;
            w0.x = of[0] | ((unsigned)of[1] << 16); w0.y = of[2] | ((unsigned)of[3] << 16); w0.z = of[4] | ((unsigned)of[5] << 16); w0.w = of[6] | ((unsigned)of[7] << 16);
            w1.x = of[8] | ((unsigned)of[9] << 16); w1.y = of[10] | ((unsigned)of[11] << 16); w1.z = of[12] | ((unsigned)of[13] << 16); w1.w = of[14] | ((unsigned)of[15] << 16);
            *(u32x4*)gf = w0; *(u32x4*)(gf + 8) = w1;
            w0.x = ob[0] | ((unsigned)ob[1] << 16); w0.y = ob[2] | ((unsigned)ob[3] << 16); w0.z = ob[4] | ((unsigned)ob[5] << 16); w0.w = ob[6] | ((unsigned)ob[7] << 16);
            w1.x = ob[8] | ((unsigned)ob[9] << 16); w1.y = ob[10] | ((unsigned)ob[11] << 16); w1.z = ob[12] | ((unsigned)ob[13] << 16); w1.w = ob[14] | ((unsigned)ob[15] << 16);
            *(u32x4*)gb = w0; *(u32x4*)(gb + 8) = w1;
        }
    }
    SEAM(0);
    for (int m0 = gw; m0 < NT + NCX; m0 += 4 * NGW) {
        f32x4 v[4][4];
#pragma unroll
        for (int r = 0; r < 4; ++r) { const int m = m0 + r * NGW; if (m < NT + NCX) { const f32x4* xr = (const f32x4*)(m < NT ? x + (size_t)m * D : ctx + (size_t)(m - NT) * D) + lane;
#pragma unroll
                for (int j = 0; j < 4; ++j) v[r][j] = xr[64 * j]; } }
#pragma unroll
        for (int r = 0; r < 4; ++r) { const int m = m0 + r * NGW; if (m < NT + NCX) {
                const float* mb = MOD + (size_t)(m < NT ? (m >> 12) : 8) * INC; bf16_t* orow = m < NT ? HLAT + (size_t)m * D : HCTX + (size_t)(m - NT) * D;
                float s = 0.f;
#pragma unroll
                for (int j = 0; j < 4; ++j) s += (v[r][j].x * v[r][j].x + v[r][j].y * v[r][j].y) + (v[r][j].z * v[r][j].z + v[r][j].w * v[r][j].w);
                const float rs = rsqrtf(wave_sum(s) * (1.f / D) + EPS);
                unsigned long long* o8 = (unsigned long long*)orow + lane;
#pragma unroll
                for (int j = 0; j < 4; ++j) { const f32x4 w = ((const f32x4*)norm_w)[lane + 64 * j], sc = ldmod(mb, lane + 64 * j), sh = ldmod(mb + D, lane + 64 * j);
                    const f32x4 o = v[r][j] * rs * w * (1.f + sc) + sh;
                    o8[64 * j] = (unsigned long long)cvtpk(o.x, o.y) | ((unsigned long long)cvtpk(o.z, o.w) << 32); } } }
    }
    SEAM(1);
    {
        { pg8::Gemm g{HLAT, WIN, D, D, D}; pg8::StaticOrder S; S.init(NT, 4608, G, bx); pg8::EpiG1 E{PI, PZ, PQ, PG, GATES, LB, 0};
          pg8::gemm_phase(lds, g, S, E); }
        { pg8::Gemm g{WIN + (size_t)4608 * D, HLAT, D, D, D}; pg8::StaticOrder S; S.init(1536, NT, G, bx); pg8::EpiBf16<0> E{PHYT, NT};
          pg8::gemm_phase(lds, g, S, E); }
        { pg8::Gemm g{HCTX, WIN, D, D, D}; pg8::StaticOrder S; S.init(NCX, 1536, G, bx); pg8::EpiG1 E{PCTX, nullptr, nullptr, nullptr, nullptr, LB, 1};
          pg8::gemm_phase(lds, g, S, E); }
        if (bx >= 48) {
            LAS float* scr = (LAS float*)(lds + wave * 16384);
            constexpr int I_PA = 8 * 32, I_OUT = 16 * 32, I_1 = 16 * 128, I_2 = 64 * 32;
            __syncthreads();
            for (int it = (bx - 48) * 8 + wave; it < 2 * I_PA + I_OUT + I_1 + I_2; it += (G - 48) * 8) {
                int r = it;
                if (r < I_PA) { transpose_item(w_pa, D, WPAB, D, 0, 0, scr, r, lane); continue; } r -= I_PA;
                if (r < I_PA) { transpose_item(w_pb, D, WPAB, D, 512, 0, scr, r, lane); continue; } r -= I_PA;
                if (r < I_OUT) { transpose_item(w_out, D, WOUT, D, 0, 0, scr, r, lane); continue; } r -= I_OUT;
                if (r < I_1) { transpose_item(w_mlp1, FF, W1, D, 0, 0, scr, r, lane); continue; } r -= I_1;
                transpose_item(w_mlp2, D, W2, FF, 0, 0, scr, r, lane);
            }
        }

    }
    SEAM(2);
    {
        float* STATE = (float*)(ws + WS_HLAT);
        constexpr int NSEG = 4, SEGC = 64 / NSEG;
        if (bx < 64 * NSEG) { const int item = bx;
            const int chain = item / NSEG, seg = item % NSEG, b = chain >> 3, h = (chain >> 1) & 3, dir = chain & 1, n0 = SEGC * seg; float* st = STATE + (size_t)(item & 255) * 16384;
            const bf16_t* pzc = PZ + (size_t)b * L * 1024 + (dir ? 512 : 0);
            int n_start = n0; bool decayed = false;
            if (seg > 0) {
                LAS float* red = (LAS float*)lds;
                float r0 = 1.f, r1 = 1.f;
                while (n_start > 0 && !decayed) {
                    n_start -= 4;
                    const int basec = dir ? (L - 64 * (n_start + 4)) : 64 * n_start;
                    float p0 = 1.f, p1 = 1.f;
#pragma unroll 8
                    for (int i = 0; i < 32; ++i) { const unsigned kk = *(const unsigned*)(pzc + (size_t)(basec + 32 * wave + i) * 1024 + h * 128 + 2 * lane); p0 *= 1.f - pg8::bflo(kk); p1 *= 1.f - pg8::bfhi(kk); }
                    __syncthreads();
                    *(LAS f32x2_t*)(red + wave * 128 + 2 * lane) = (f32x2_t){p0, p1};
                    __syncthreads();
                    if (wave == 0) {
#pragma unroll
                        for (int w = 0; w < 8; ++w) { const f32x2_t t = *(const LAS f32x2_t*)(red + w * 128 + 2 * lane); r0 *= t.x; r1 *= t.y; }
                        float mx = fmaxf(r0, r1);
#pragma unroll
                        for (int o = 1; o < 64; o <<= 1) mx = fmaxf(mx, __shfl_xor(mx, o));
                        if (lane == 0) red[1024] = mx;
                    }
                    __syncthreads();
                    decayed = __builtin_amdgcn_readfirstlane(red[1024] < 1e-10f ? 1 : 0) != 0;
                }
            }
            if (seg == 0 || !decayed)
                hgrn_chain_mfma<false>(lds, PCTX + (size_t)b * LC * 1536, 1536, PCTX + (size_t)b * LC * 1536 + (dir ? 1024 : 512), 1536, nullptr, 0, LC, h, dir, LB, nullptr, st, nullptr, 0, LC / 64);
            if (seg > 0) hgrn_chain_mfma<false>(lds, PI + (size_t)b * L * 512, 512, pzc, 1024, nullptr, 0, L, h, dir, LB, decayed ? nullptr : st, st, nullptr, n_start, n0);
            hgrn_chain_mfma<true>(lds, PI + (size_t)b * L * 512, 512, pzc, 1024, PQ + (size_t)b * L * 512, 512, L, h, dir, LB,
                                  st, nullptr, O2 + (size_t)chain * L * 128, n0, n0 + SEGC, 0, ws + 32768 + 128);
#if PROBE_MASK
            if (PROBE_BUSY_PHASE == 20 && bx == PROBE_BUSY_BLOCK && tid == 0) *(volatile unsigned long long*)(ws + 32768 + 64) = __builtin_amdgcn_s_memrealtime() - t_prev;
#endif
        }
        unsigned* hctr = (unsigned*)(ws + 36864);
        for (;;) {
            __syncthreads();
            if (tid == 0) MISC[4] = atomicAdd(hctr, 1u);
            __syncthreads();
            const int c = (int)MISC[4];
            if (c >= HW) break;
            hyena_channel(lds, c, PHYT, GTB, hy_sw, hy_sb);
        }
    }
    SEAM(4);
#if PROBE_MASK
    if (PROBE_BUSY_PHASE == 20) t_spin += *(volatile unsigned long long*)(ws + 32768 + 64);
    if (PROBE_BUSY_PHASE == 21) t_spin += *(volatile unsigned long long*)(ws + 32768 + 128);
    if (PROBE_BUSY_PHASE == 22) t_spin += *(volatile unsigned long long*)(ws + 32768 + 136);
#endif
    {
        const f32x4 gn0 = ((const f32x4*)g_norm)[(2 * lane) & 31], gn1 = ((const f32x4*)g_norm)[(2 * lane + 1) & 31];
        for (int t0 = gw; t0 < NT; t0 += 2 * NGW) {
            f32x4 of[2][2], ob[2][2]; u32x4 pg[2];
#pragma unroll
            for (int r = 0; r < 2; ++r) { const int t = t0 + r * NGW; if (t < NT) {
                    { const int bb = t >> 12, hh = lane >> 4; const float* pf = O2 + ((size_t)((bb * 4 + hh) * 2) * L + (t & 4095)) * 128 + 8 * (lane & 15); const float* pb = pf + (size_t)L * 128;
                      of[r][0] = *(const f32x4*)pf; of[r][1] = *(const f32x4*)(pf + 4); ob[r][0] = *(const f32x4*)pb; ob[r][1] = *(const f32x4*)(pb + 4); }
                    pg[r] = ((const u32x4*)(PG + (size_t)t * 512))[lane]; } }
#pragma unroll
            for (int r = 0; r < 2; ++r) { const int t = t0 + r * NGW; if (t < NT) {
                    const f32x4 a0 = of[r][0] + ob[r][0], a1 = of[r][1] + ob[r][1];
                    float s = (a0.x * a0.x + a0.y * a0.y) + (a0.z * a0.z + a0.w * a0.w) + (a1.x * a1.x + a1.y * a1.y) + (a1.z * a1.z + a1.w * a1.w);
                    s += __shfl_xor(s, 1); s += __shfl_xor(s, 2); s += __shfl_xor(s, 4); s += __shfl_xor(s, 8);
                    const float rs = rsqrtf(s * (1.f / 128.f) + EPS);
                    u32x4 o;
                    o.x = cvtpk(a0.x * rs * gn0.x * pg8::bflo(pg[r].x), a0.y * rs * gn0.y * pg8::bfhi(pg[r].x)); o.y = cvtpk(a0.z * rs * gn0.z * pg8::bflo(pg[r].y), a0.w * rs * gn0.w * pg8::bfhi(pg[r].y));
                    o.z = cvtpk(a1.x * rs * gn1.x * pg8::bflo(pg[r].z), a1.y * rs * gn1.y * pg8::bfhi(pg[r].z)); o.w = cvtpk(a1.z * rs * gn1.z * pg8::bflo(pg[r].w), a1.w * rs * gn1.w * pg8::bfhi(pg[r].w));
                    *(u32x4*)(AY + (size_t)t * 1024 + 8 * lane) = o; } }
        }
    }
    {
        LAS bf16_t* tl = (LAS bf16_t*)(lds + wave * 16384);
        for (int it = gw; it < 8 * 512; it += NGW) { const int c0 = (it & 7) * 64, tok0 = (it >> 3) * 64;
#pragma unroll
            for (int i = 0; i < 8; ++i) { const int ch = lane + 64 * i, rr = ch >> 3, cc = (ch & 7) * 8;
                const u32x4 v = *(const u32x4*)(PHYT + (size_t)(1024 + c0 + rr) * NT + tok0 + cc);
                LAS unsigned* d = (LAS unsigned*)(tl + rr * 66 + cc); d[0] = v.x; d[1] = v.y; d[2] = v.z; d[3] = v.w; }
            LDS_WAIT();
#pragma unroll
            for (int i = 0; i < 8; ++i) { const int ch = lane + 64 * i, tt = ch >> 3, cc = (ch & 7) * 8; unsigned o[4];
#pragma unroll
                for (int q = 0; q < 4; ++q) o[q] = (unsigned)tl[(cc + 2 * q) * 66 + tt] | ((unsigned)tl[(cc + 2 * q + 1) * 66 + tt] << 16);
                *(u32x4*)(AY + (size_t)(tok0 + tt) * 1024 + 512 + c0 + cc) = (u32x4){o[0], o[1], o[2], o[3]}; }
            LDS_WAIT();
        }
    }
    SEAM(5);
    { pg8::Gemm g{AY, WPAB, D, D, 512}; pg8::TwoPassOrder S; S.base.init(NT, D, G, bx); S.kbytes = 1024; pg8::EpiMerge2 E{MERGED, GATES}; pg8::gemm_phase(lds, g, S, E); }
    SEAM(6);
    { pg8::Gemm g{MERGED, WOUT, D, D, D}; pg8::StaticOrder S; S.init(NT, D, G, bx); pg8::EpiBf16<0> E{MIX, D}; pg8::gemm_phase(lds, g, S, E); }
    SEAM(7);
    for (int m0 = gw; m0 < NT; m0 += 2 * NGW) {
        f32x4 xv[2][4]; u32x2 mx[2][4];
#pragma unroll
        for (int r = 0; r < 2; ++r) { const int m = m0 + r * NGW; if (m < NT) {
#pragma unroll
                for (int j = 0; j < 4; ++j) { xv[r][j] = ((const f32x4*)(x + (size_t)m * D))[lane + 64 * j]; mx[r][j] = *(const u32x2*)(MIX + (size_t)m * D + 4 * lane + 256 * j); } } }
#pragma unroll
        for (int r = 0; r < 2; ++r) { const int m = m0 + r * NGW; if (m < NT) { const float* mb = MOD + (size_t)(m >> 12) * INC;
                f32x4 mv[4], x1[4]; float s = 0.f;
#pragma unroll
                for (int j = 0; j < 4; ++j) { mv[j] = (f32x4){pg8::bflo(mx[r][j].x), pg8::bfhi(mx[r][j].x), pg8::bflo(mx[r][j].y), pg8::bfhi(mx[r][j].y)}; s += (mv[j].x * mv[j].x + mv[j].y * mv[j].y) + (mv[j].z * mv[j].z + mv[j].w * mv[j].w); }
                const float r1 = rsqrtf(wave_sum(s) * (1.f / D) + EPS); float s2 = 0.f;
#pragma unroll
                for (int j = 0; j < 4; ++j) { const f32x4 w = ((const f32x4*)(norm_w + D))[lane + 64 * j], g = ldmod(mb + 2 * D, lane + 64 * j);
                    x1[j] = xv[r][j] + g * (mv[j] * r1 * w); s2 += (x1[j].x * x1[j].x + x1[j].y * x1[j].y) + (x1[j].z * x1[j].z + x1[j].w * x1[j].w); }
                const float r2 = rsqrtf(wave_sum(s2) * (1.f / D) + EPS);
                unsigned long long* o8 = (unsigned long long*)(HL + (size_t)m * D) + lane;
#pragma unroll
                for (int j = 0; j < 4; ++j) { const f32x4 w = ((const f32x4*)(norm_w + 2 * D))[lane + 64 * j], sc = ldmod(mb + 3 * D, lane + 64 * j), sh = ldmod(mb + 4 * D, lane + 64 * j);
                    const f32x4 o = x1[j] * r2 * w * (1.f + sc) + sh;
                    o8[64 * j] = (unsigned long long)cvtpk(o.x, o.y) | ((unsigned long long)cvtpk(o.z, o.w) << 32); } } }
    }
    SEAM(8);
    { pg8::Gemm g{HL, W1, D, D, D}; pg8::StaticOrder S; S.init(NT, FF, G, bx); pg8::EpiBf16<3> E{H1, FF}; pg8::gemm_phase(lds, g, S, E); }
    SEAM(9);
    { pg8::Gemm g{H1, W2, FF, FF, FF}; pg8::StaticOrder S; S.init(NT, D, G, bx); pg8::EpiBf16<0> E{MLP, D}; pg8::gemm_phase(lds, g, S, E); }
    SEAM(10);
    for (int m0 = gw; m0 < NT; m0 += 2 * NGW) {
        f32x4 xv[2][4]; u32x2 mx[2][4], ml[2][4];
#pragma unroll
        for (int r = 0; r < 2; ++r) { const int m = m0 + r * NGW; if (m < NT) {
#pragma unroll
                for (int j = 0; j < 4; ++j) { xv[r][j] = ((const f32x4*)(x + (size_t)m * D))[lane + 64 * j]; mx[r][j] = *(const u32x2*)(MIX + (size_t)m * D + 4 * lane + 256 * j);
                    ml[r][j] = *(const u32x2*)(MLP + (size_t)m * D + 4 * lane + 256 * j); } } }
#pragma unroll
        for (int r = 0; r < 2; ++r) { const int m = m0 + r * NGW; if (m < NT) { const float* mb = MOD + (size_t)(m >> 12) * INC;
                f32x4 mv[4], lv[4]; float s = 0.f, s3 = 0.f;
#pragma unroll
                for (int j = 0; j < 4; ++j) { mv[j] = (f32x4){pg8::bflo(mx[r][j].x), pg8::bfhi(mx[r][j].x), pg8::bflo(mx[r][j].y), pg8::bfhi(mx[r][j].y)}; s += (mv[j].x * mv[j].x + mv[j].y * mv[j].y) + (mv[j].z * mv[j].z + mv[j].w * mv[j].w);
                    lv[j] = (f32x4){pg8::bflo(ml[r][j].x), pg8::bfhi(ml[r][j].x), pg8::bflo(ml[r][j].y), pg8::bfhi(ml[r][j].y)}; s3 += (lv[j].x * lv[j].x + lv[j].y * lv[j].y) + (lv[j].z * lv[j].z + lv[j].w * lv[j].w); }
                const float r1 = rsqrtf(wave_sum(s) * (1.f / D) + EPS), r3 = rsqrtf(wave_sum(s3) * (1.f / D) + EPS);
#pragma unroll
                for (int j = 0; j < 4; ++j) { const f32x4 w1 = ((const f32x4*)(norm_w + D))[lane + 64 * j], g2 = ldmod(mb + 2 * D, lane + 64 * j);
                    const f32x4 w3 = ((const f32x4*)(norm_w + 3 * D))[lane + 64 * j], g5 = ldmod(mb + 5 * D, lane + 64 * j);
                    const f32x4 x1 = xv[r][j] + g2 * (mv[j] * r1 * w1);
                    ((f32x4*)(P.out + (size_t)m * D))[lane + 64 * j] = x1 + g5 * (lv[j] * r3 * w3); } } }
    }
#if PROBE_MASK
    { const unsigned long long _t = __builtin_amdgcn_s_memrealtime(); if ((PROBE_MASK >> 11) & 1) t_spin += _t - t_prev;
      if (bx == 0) { const unsigned long long t0 = __builtin_amdgcn_s_memrealtime(); while (__builtin_amdgcn_s_memrealtime() - t0 < t_spin) __builtin_amdgcn_s_sleep(8); } }
#endif
#if PROBE_XSYNC
    for (int i = 0; i < PROBE_XSYNC; ++i) grid.sync();
#endif
}
}

extern "C" void kernel_launch(void* const* d_in, const int* in_sizes, int n_in, void* d_out, int out_size, void* d_ws, size_t ws_size, hipStream_t stream) {
    static int grid = 0;
    if (grid == 0) {
        if (n_in != 24 || ws_size < WS_END) { fprintf(stderr, "kernel_launch: unexpected n_in %d / ws_size %zu\n", n_in, ws_size); grid = -1; return; }
        int dev = 0, cus = 0, per_cu = 0;
        hipGetDevice(&dev); hipDeviceGetAttribute(&cus, hipDeviceAttributeMultiprocessorCount, dev);
        hipFuncSetAttribute((const void*)mega, hipFuncAttributeMaxDynamicSharedMemorySize, LDS_BYTES);
        hipOccupancyMaxActiveBlocksPerMultiprocessor(&per_cu, (const void*)mega, 512, LDS_BYTES);
        if (per_cu < 1) { fprintf(stderr, "kernel_launch: occupancy query says %d blocks per CU\n", per_cu); grid = -1; return; }
        grid = cus;
        if (grid < 256) { fprintf(stderr, "kernel_launch: this kernel needs at least 256 compute units (found %d)\n", cus); grid = -1; return; }
    }
    if (grid < 0) return;
    if (hipMemsetAsync(d_ws, 0, 65536, stream) != hipSuccess) { fprintf(stderr, "kernel_launch: memset failed\n"); return; }
    Params p{};
    for (int i = 0; i < 24; ++i) p.in[i] = (const float*)d_in[i];
    p.out = (float*)d_out; p.ws = (unsigned char*)d_ws;
    void* args[] = {&p};
    hipError_t e = hipLaunchCooperativeKernel((const void*)mega, dim3(grid), dim3(512), args, LDS_BYTES, stream);
    if (e != hipSuccess) fprintf(stderr, "cooperative launch failed: %s (grid %d)\n", hipGetErrorString(e), grid);
}
```

```cpp
#include <hip/hip_runtime.h>
#include <hip/hip_cooperative_groups.h>
#include <cstdio>
#include <math.h>
namespace cg = cooperative_groups;
#ifndef USE_GRID_SYNC
#define USE_GRID_SYNC 0
#endif
#if !USE_GRID_SYNC
#define NO_GRID_SYNC 1
#endif
#ifndef PROBE_MASK
#define PROBE_MASK 0
#endif
#ifndef PROBE_XSYNC
#define PROBE_XSYNC 0
#endif
#ifndef PROBE_BUSY_PHASE
#define PROBE_BUSY_PHASE -1
#define PROBE_BUSY_BLOCK 0
#endif

namespace pg8 {
#define PG8_LAS __attribute__((address_space(3)))
typedef unsigned short bf16_t;
typedef short bf16x8 __attribute__((ext_vector_type(8)));
typedef float f32x4 __attribute__((ext_vector_type(4)));
typedef unsigned u32x4 __attribute__((ext_vector_type(4)));
typedef unsigned u32x2 __attribute__((ext_vector_type(2)));
constexpr int BM = 256, BK = 64, HALF = 128, HTB = HALF * BK * 2, STAGE_BYTES = 8 * HTB, NXCD = 8, WGM = 8;

__device__ __forceinline__ int lds_byte(int r, int c) { const int st = (r >> 4) * 2 + (c >> 5), rr = r & 15, cc = c & 31, ob = rr * 64 + cc * 2; return st * 1024 + (ob ^ (((ob >> 9) & 1) << 5)); }
__device__ __forceinline__ void stage_rc(int b, int& R, int& C) { const int st = b / 1024, sb = b % 1024, swz = sb ^ (((sb >> 9) & 1) << 5); R = (st >> 1) * 16 + swz / 64; C = (st & 1) * 32 + (swz % 64) / 2; }
__device__ __forceinline__ int perm32(int rho) { const int n = rho >> 4, i = rho & 15; return 8 * (i >> 2) + 4 * n + (i & 3); }

struct Unit { int pm, pn, kb, pass; };
struct Gemm { const bf16_t* A; const bf16_t* Bt; int lda, ldb, K; };

struct StaticOrder {
    int nM, nN, nwg, G, c;
    __device__ void init(int M, int N, int G_, int c_) { nM = M / BM; nN = N / BM; nwg = nM * nN; G = G_; c = c_; }
    __device__ bool next(int i, Unit& u) const {
        const long L = (long)i * G + c; if (L >= nwg) return false;
        int wgid = (int)L; { const int q = nwg / NXCD, r = nwg % NXCD, xcd = wgid % NXCD, off = wgid / NXCD; wgid = (xcd < r ? xcd * (q + 1) : r * (q + 1) + (xcd - r) * q) + off; }
        const int nig = WGM * nN, gid = wgid / nig, fm = gid * WGM, gsz = (nM - fm) < WGM ? (nM - fm) : WGM;
        u.pm = fm + ((wgid % nig) % gsz); u.pn = (wgid % nig) / gsz; u.kb = 0; u.pass = 0; return true;
    }
};

struct TwoPassOrder {
    StaticOrder base; int kbytes;
    __device__ bool next(int i, Unit& u) const { if (!base.next(i >> 1, u)) return false; u.pass = i & 1; u.kb = (i & 1) * kbytes; return true; }
};
__device__ __forceinline__ unsigned cvt_pk_bf16(float lo, float hi) { unsigned r; asm volatile("v_cvt_pk_bf16_f32 %0, %1, %2" : "=v"(r) : "v"(lo), "v"(hi)); return r; }
__device__ __forceinline__ float sigm(float x) { return __builtin_amdgcn_rcpf(1.0f + __builtin_amdgcn_exp2f(-1.4426950408889634f * x)); }
__device__ __forceinline__ float bflo(unsigned u) { return __uint_as_float(u << 16); }
__device__ __forceinline__ float bfhi(unsigned u) { return __uint_as_float(u & 0xffff0000u); }

template <int ACT  > struct EpiBf16 {
    static constexpr bool PERM = true;
    bf16_t* O; int ldc;
    __device__ __forceinline__ void operator()(const f32x4 (&acc)[2][2][4][2], const Unit& u, int wr, int wc, int fr, int fq) const {
        const int row0 = u.pm * BM + wr * 64 + fr, col0 = u.pn * BM + wc * 32 + 8 * fq;
#pragma unroll
        for (int ai = 0; ai < 2; ++ai)
#pragma unroll
            for (int m = 0; m < 4; ++m) { bf16_t* rowp = O + (size_t)(row0 + ai * HALF + m * 16) * ldc + col0;
#pragma unroll
                for (int bj = 0; bj < 2; ++bj) { f32x4 v0 = acc[ai][bj][m][0], v1 = acc[ai][bj][m][1];
                    if (ACT == 3) {
#pragma unroll
                        for (int j = 0; j < 4; ++j) { const float a = fmaxf(v0[j], 0.f), b = fmaxf(v1[j], 0.f); v0[j] = a * a; v1[j] = b * b; } }
                    u32x4 w; w.x = cvt_pk_bf16(v0[0], v0[1]); w.y = cvt_pk_bf16(v0[2], v0[3]); w.z = cvt_pk_bf16(v1[0], v1[1]); w.w = cvt_pk_bf16(v1[2], v1[3]);
                    *(u32x4*)(rowp + bj * HALF) = w; } }
    }
};
struct EpiG1 {
    static constexpr bool PERM = true;
    bf16_t *PI, *PZ, *PQ, *PG, *GATES; const float* LBv; int ctx;
    __device__ __forceinline__ void operator()(const f32x4 (&acc)[2][2][4][2], const Unit& u, int wr, int wc, int fr, int fq) const {
        const int pn = u.pn; bf16_t* base; int ld, cb, act;
        if (ctx) { base = PI; ld = 1536; cb = pn * 256; act = pn < 2 ? 0 : 3; }
        else if (pn < 2) { base = PI; ld = 512; cb = pn * 256; act = 0; }
        else if (pn < 6) { base = PZ; ld = 1024; cb = (pn - 2) * 256; act = 3; }
        else if (pn < 8) { base = PQ; ld = 512; cb = (pn - 6) * 256; act = 1; }
        else if (pn < 10) { base = PG; ld = 512; cb = (pn - 8) * 256; act = 1; }
        else { base = GATES; ld = 2048; cb = (pn - 10) * 128; act = 2; }
        const int row0 = u.pm * BM + wr * 64 + fr, col0 = cb + wc * 32 + 8 * fq;
        if (act == 2) {
#pragma unroll
            for (int ai = 0; ai < 2; ++ai)
#pragma unroll
                for (int m = 0; m < 4; ++m) { bf16_t* rowp = base + (size_t)(row0 + ai * HALF + m * 16) * ld + col0; f32x4 rh[2], gb[2];
#pragma unroll
                    for (int n = 0; n < 2; ++n)
#pragma unroll
                        for (int j = 0; j < 4; ++j) { const float eA = __builtin_amdgcn_exp2f(-1.4426950408889634f * acc[ai][0][m][n][j]), eB = __builtin_amdgcn_exp2f(-1.4426950408889634f * acc[ai][1][m][n][j]);
                            gb[n][j] = __builtin_amdgcn_rcpf(1.0f + eB); rh[n][j] = (1.0f + eB) * __builtin_amdgcn_rcpf(1.0f + eA); }
                    u32x4 w; w.x = cvt_pk_bf16(rh[0][0], rh[0][1]); w.y = cvt_pk_bf16(rh[0][2], rh[0][3]); w.z = cvt_pk_bf16(rh[1][0], rh[1][1]); w.w = cvt_pk_bf16(rh[1][2], rh[1][3]);
                    *(u32x4*)rowp = w;
                    w.x = cvt_pk_bf16(gb[0][0], gb[0][1]); w.y = cvt_pk_bf16(gb[0][2], gb[0][3]); w.z = cvt_pk_bf16(gb[1][0], gb[1][1]); w.w = cvt_pk_bf16(gb[1][2], gb[1][3]);
                    *(u32x4*)(rowp + 1024) = w; }
            return;
        }
        f32x4 om[2][2];
        if (act == 3) {
#pragma unroll
            for (int bj = 0; bj < 2; ++bj)
#pragma unroll
                for (int n = 0; n < 2; ++n) { const f32x4 l = *(const f32x4*)(LBv + ((col0 + bj * HALF + 4 * n) & 511)); om[bj][n] = (f32x4){1.f - l.x, 1.f - l.y, 1.f - l.z, 1.f - l.w}; } }
#pragma unroll
        for (int ai = 0; ai < 2; ++ai)
#pragma unroll
            for (int m = 0; m < 4; ++m) { bf16_t* rowp = base + (size_t)(row0 + ai * HALF + m * 16) * ld + col0;
#pragma unroll
                for (int bj = 0; bj < 2; ++bj) { f32x4 v0 = acc[ai][bj][m][0], v1 = acc[ai][bj][m][1];
                    if (act == 3) {
#pragma unroll
                        for (int j = 0; j < 4; ++j) { v0[j] = om[bj][0][j] * sigm(-v0[j]); v1[j] = om[bj][1][j] * sigm(-v1[j]); } }
                    else if (act != 0) {
#pragma unroll
                        for (int j = 0; j < 4; ++j) { const float s0 = sigm(v0[j]), s1 = sigm(v1[j]); v0[j] = act == 1 ? v0[j] * s0 : s0; v1[j] = act == 1 ? v1[j] * s1 : s1; } }
                    u32x4 w; w.x = cvt_pk_bf16(v0[0], v0[1]); w.y = cvt_pk_bf16(v0[2], v0[3]); w.z = cvt_pk_bf16(v1[0], v1[1]); w.w = cvt_pk_bf16(v1[2], v1[3]);
                    *(u32x4*)(rowp + bj * HALF) = w; } }
    }
};
struct EpiMerge2 {
    static constexpr bool PERM = true;
    bf16_t* O; const bf16_t* RG;
    __device__ __forceinline__ void operator()(f32x4 (&acc)[2][2][4][2], const Unit& u, int wr, int wc, int fr, int fq) const {
        const int row0 = u.pm * BM + wr * 64 + fr, col0 = u.pn * BM + wc * 32 + 8 * fq; const int goff = u.pass ? 1024 : 0;
#pragma unroll
        for (int ai = 0; ai < 2; ++ai)
#pragma unroll
            for (int m = 0; m < 4; ++m) { const size_t r = (size_t)(row0 + ai * HALF + m * 16);
#pragma unroll
                for (int bj = 0; bj < 2; ++bj) { f32x4 v0 = acc[ai][bj][m][0], v1 = acc[ai][bj][m][1];
                    const u32x4 g = *(const u32x4*)(RG + r * 2048 + goff + col0 + bj * HALF);
                    v0[0] *= bflo(g.x); v0[1] *= bfhi(g.x); v0[2] *= bflo(g.y); v0[3] *= bfhi(g.y); v1[0] *= bflo(g.z); v1[1] *= bfhi(g.z); v1[2] *= bflo(g.w); v1[3] *= bfhi(g.w);
                    if (u.pass == 0) { acc[ai][bj][m][0] = v0; acc[ai][bj][m][1] = v1; }
                    else { u32x4 w; w.x = cvt_pk_bf16(v0[0], v0[1]); w.y = cvt_pk_bf16(v0[2], v0[3]); w.z = cvt_pk_bf16(v1[0], v1[1]); w.w = cvt_pk_bf16(v1[2], v1[3]);
                        *(u32x4*)(O + r * 1024 + col0 + bj * HALF) = w; } } }
    }
};

#ifndef PG8_SP2
#define PG8_SP2 true
#endif
#ifndef PG8_ALIGN
#define PG8_ALIGN true
#endif
template <class Epi, class Sched, bool ALIGN_EPI = PG8_ALIGN, bool SP2 = PG8_SP2>
__device__ __forceinline__ void gemm_phase(PG8_LAS unsigned char* lds, const Gemm g, const Sched& S, const Epi& E) {
    const int tid = threadIdx.x, wid = __builtin_amdgcn_readfirstlane(tid >> 6), lane = tid & 63, wr = wid >> 2, wc = wid & 3, fr = lane & 15, fq = lane >> 4;
    const int nt = g.K / BK;
    unsigned voffA[2], voffB[2];
#pragma unroll
    for (int i = 0; i < 2; ++i) { int R, C; stage_rc(tid * 16 + i * 8192, R, C); const int Rb = Epi::PERM ? ((R & ~31) + perm32(R & 31)) : R;
        voffA[i] = (unsigned)(R * g.lda + C) * 2u; voffB[i] = (unsigned)(Rb * g.ldb + C) * 2u; }
    const size_t kstep = (size_t)(BK * 2);
    const size_t hstepA = (size_t)HALF * g.lda * 2, hstepB = (size_t)HALF * g.ldb * 2;
    const size_t tstepA = 2 * hstepA, tstepB = 2 * hstepB;
    const unsigned ldsw = (unsigned)wid * 1024u;
    const int aoff = lds_byte(wr * 64 + fr, fq * 8), boff = lds_byte(wc * 32 + fr, fq * 8);
#define PG8_SA(b, h) (((b) * 2 + (h)) * HTB)
#define PG8_SB(b, h) ((4 + (b) * 2 + (h)) * HTB)
#define PG8_STAGE(bufoff, gbase, voff) do { _Pragma("unroll") for (int _i = 0; _i < 2; ++_i) \
        __builtin_amdgcn_global_load_lds((const unsigned*)((const char*)(gbase) + (voff)[_i]), (PG8_LAS unsigned*)(lds + (bufoff) + ldsw + _i * 8192), 16, 0, 0); } while (0)
#define PG8_LDA(dst, b, h) do { _Pragma("unroll") for (int m = 0; m < 4; ++m) _Pragma("unroll") for (int k = 0; k < 2; ++k) dst[m][k] = *(const PG8_LAS bf16x8*)(lds + PG8_SA(b, h) + aoff + m * 2048 + k * 1024); } while (0)
#define PG8_LDB(dst, b, h) do { _Pragma("unroll") for (int n = 0; n < 2; ++n) _Pragma("unroll") for (int k = 0; k < 2; ++k) dst[n][k] = *(const PG8_LAS bf16x8*)(lds + PG8_SB(b, h) + boff + n * 2048 + k * 1024); } while (0)
#define PG8_MMA(ai, bj, At, Bt) do { __builtin_amdgcn_s_setprio(1); _Pragma("unroll") for (int m = 0; m < 4; ++m) _Pragma("unroll") for (int n = 0; n < 2; ++n) _Pragma("unroll") for (int k = 0; k < 2; ++k) \
        acc[ai][bj][m][n] = __builtin_amdgcn_mfma_f32_16x16x32_bf16(Bt[n][k], At[m][k], acc[ai][bj][m][n], 0, 0, 0); __builtin_amdgcn_s_setprio(0); } while (0)
#define PG8_WAIT_V(n) asm volatile("s_waitcnt vmcnt(" #n ")" ::: "memory")
#define PG8_WAIT_L(n) asm volatile("s_waitcnt lgkmcnt(" #n ")" ::: "memory")
#define PG8_BAR __builtin_amdgcn_s_barrier()
#define PG8_SCHED __builtin_amdgcn_sched_barrier(0)
    Unit cur, nxt; int ui = 0;
    if (!S.next(0, cur)) return;
    f32x4 acc[2][2][4][2];
#pragma unroll
    for (int a = 0; a < 2; ++a)
#pragma unroll
        for (int b = 0; b < 2; ++b)
#pragma unroll
            for (int m = 0; m < 4; ++m)
#pragma unroll
                for (int n = 0; n < 2; ++n) acc[a][b][m][n] = (f32x4){0.f, 0.f, 0.f, 0.f};
    bf16x8 At[4][2], B0[2][2], B1[2][2];
    const char* cA = (const char*)g.A + (size_t)cur.pm * tstepA + cur.kb; const char* cB = (const char*)g.Bt + (size_t)cur.pn * tstepB + cur.kb;
    if constexpr (SP2) {
        PG8_STAGE(PG8_SB(0, 0), cB, voffB); PG8_STAGE(PG8_SB(0, 1), cB + hstepB, voffB); PG8_STAGE(PG8_SA(0, 0), cA, voffA); PG8_STAGE(PG8_SA(0, 1), cA + hstepA, voffA);
        if (wr == 1) PG8_BAR;
        PG8_WAIT_V(2); PG8_BAR;
        PG8_STAGE(PG8_SB(1, 0), cB + kstep, voffB); PG8_STAGE(PG8_SA(1, 0), cA + kstep, voffA); PG8_STAGE(PG8_SB(1, 1), cB + hstepB + kstep, voffB);
        PG8_WAIT_V(6); PG8_BAR;
    } else {
        PG8_STAGE(PG8_SB(0, 0), cB, voffB); PG8_STAGE(PG8_SA(0, 0), cA, voffA); PG8_STAGE(PG8_SB(0, 1), cB + hstepB, voffB); PG8_STAGE(PG8_SA(0, 1), cA + hstepA, voffA);
        if (wr == 1) PG8_BAR;
        PG8_WAIT_V(4); PG8_BAR;
        PG8_STAGE(PG8_SB(1, 0), cB + kstep, voffB); PG8_STAGE(PG8_SA(1, 0), cA + kstep, voffA); PG8_STAGE(PG8_SB(1, 1), cB + hstepB + kstep, voffB);
        PG8_WAIT_V(6); PG8_BAR;
    }
    for (;;) {
        const bool has_next = S.next(ui + 1, nxt);
        const char* nA = has_next ? (const char*)g.A + (size_t)nxt.pm * tstepA + nxt.kb : cA; const char* nB = has_next ? (const char*)g.Bt + (size_t)nxt.pn * tstepB + nxt.kb : cB;
        for (int t = 0; t < nt; t += 2) {
            const bool last = (t == nt - 2);
            const char* a1 = cA + (size_t)(t + 1) * kstep;
            const char* a2 = last ? nA : cA + (size_t)(t + 2) * kstep; const char* b2 = last ? nB : cB + (size_t)(t + 2) * kstep;
            const char* a3 = a2 + kstep; const char* b3 = b2 + kstep;
            if constexpr (SP2) {
            PG8_LDB(B0, 0, 0); PG8_LDB(B1, 0, 1); PG8_SCHED; PG8_LDA(At, 0, 0); PG8_STAGE(PG8_SA(1, 1), a1 + hstepA, voffA);
            PG8_WAIT_V(8); PG8_WAIT_L(0); PG8_BAR; PG8_MMA(0, 0, At, B0); PG8_MMA(0, 1, At, B1); PG8_BAR; PG8_SCHED;
            PG8_LDA(At, 0, 1); PG8_STAGE(PG8_SB(0, 0), b2, voffB); PG8_STAGE(PG8_SB(0, 1), b2 + hstepB, voffB); PG8_STAGE(PG8_SA(0, 0), a2, voffA);
            PG8_WAIT_V(8); PG8_WAIT_L(0); PG8_BAR; PG8_MMA(1, 0, At, B0); PG8_MMA(1, 1, At, B1); PG8_BAR; PG8_SCHED;
            PG8_LDB(B0, 1, 0); PG8_LDB(B1, 1, 1); PG8_SCHED; PG8_LDA(At, 1, 0); PG8_STAGE(PG8_SA(0, 1), a2 + hstepA, voffA);
            PG8_WAIT_V(8); PG8_WAIT_L(0); PG8_BAR; PG8_MMA(0, 0, At, B0); PG8_MMA(0, 1, At, B1); PG8_BAR; PG8_SCHED;
            PG8_LDA(At, 1, 1); PG8_STAGE(PG8_SB(1, 0), b3, voffB); PG8_STAGE(PG8_SB(1, 1), b3 + hstepB, voffB); PG8_STAGE(PG8_SA(1, 0), a3, voffA);
            PG8_WAIT_V(8); PG8_WAIT_L(0); PG8_BAR; PG8_MMA(1, 0, At, B0); PG8_MMA(1, 1, At, B1); PG8_BAR; PG8_SCHED;
            } else {
            PG8_LDB(B0, 0, 0); PG8_SCHED; PG8_LDA(At, 0, 0); PG8_STAGE(PG8_SA(1, 1), a1 + hstepA, voffA);
            PG8_WAIT_L(8); PG8_BAR; PG8_WAIT_L(0); PG8_MMA(0, 0, At, B0); PG8_BAR; PG8_SCHED;
            PG8_LDB(B1, 0, 1); PG8_STAGE(PG8_SB(0, 0), b2, voffB);
            PG8_BAR; PG8_WAIT_L(0); PG8_MMA(0, 1, At, B1); PG8_BAR;
            PG8_LDA(At, 0, 1); PG8_STAGE(PG8_SA(0, 0), a2, voffA);
            PG8_BAR; PG8_WAIT_L(0); PG8_MMA(1, 0, At, B0); PG8_BAR; PG8_SCHED;
            PG8_STAGE(PG8_SB(0, 1), b2 + hstepB, voffB);
            PG8_WAIT_V(6); PG8_BAR; PG8_MMA(1, 1, At, B1); PG8_BAR;
            PG8_LDB(B0, 1, 0); PG8_SCHED; PG8_LDA(At, 1, 0); PG8_STAGE(PG8_SA(0, 1), a2 + hstepA, voffA);
            PG8_WAIT_L(8); PG8_BAR; PG8_WAIT_L(0); PG8_MMA(0, 0, At, B0); PG8_BAR; PG8_SCHED;
            PG8_LDB(B1, 1, 1); PG8_STAGE(PG8_SB(1, 0), b3, voffB);
            PG8_BAR; PG8_WAIT_L(0); PG8_MMA(0, 1, At, B1); PG8_BAR;
            PG8_LDA(At, 1, 1); PG8_STAGE(PG8_SA(1, 0), a3, voffA);
            PG8_BAR; PG8_WAIT_L(0); PG8_MMA(1, 0, At, B0); PG8_BAR; PG8_SCHED;
            PG8_STAGE(PG8_SB(1, 1), b3 + hstepB, voffB);
            PG8_WAIT_V(6); PG8_BAR; PG8_MMA(1, 1, At, B1); PG8_BAR;
                    }
        }
        if constexpr (ALIGN_EPI) { if (wr == 0) PG8_BAR; }
        E(acc, cur, wr, wc, fr, fq);
        if (!has_next) break;
        if (nxt.pass == 0) {
#pragma unroll
        for (int a = 0; a < 2; ++a)
#pragma unroll
            for (int b = 0; b < 2; ++b)
#pragma unroll
                for (int m = 0; m < 4; ++m)
#pragma unroll
                    for (int n = 0; n < 2; ++n) acc[a][b][m][n] = (f32x4){0.f, 0.f, 0.f, 0.f};
        }
        cur = nxt; cA = nA; cB = nB; ++ui;
        if constexpr (ALIGN_EPI) { if (wr == 1) PG8_BAR; }
    }
    PG8_WAIT_V(0);
    if constexpr (!ALIGN_EPI) { if (wr == 0) PG8_BAR; }
    PG8_BAR;
#undef PG8_SA
#undef PG8_SB
#undef PG8_STAGE
#undef PG8_LDA
#undef PG8_LDB
#undef PG8_MMA
#undef PG8_WAIT_V
#undef PG8_WAIT_L
#undef PG8_BAR
#undef PG8_SCHED
}
}

namespace {
using pg8::bf16_t; using pg8::f32x4; using pg8::u32x4; using pg8::u32x2;
#define LAS __attribute__((address_space(3)))
constexpr int D = 1024, NB = 8, L = 4096, LC = 256, INC = 6144, FF = 4096, HW = 512;
constexpr int NT = NB * L, NCX = NB * LC;
constexpr float EPS = 1e-6f;
constexpr size_t MiB = 1u << 20;
constexpr size_t WS_MOD = 64 * 1024, WS_LB = 512 * 1024, WS_GT = 2 * MiB  ;
constexpr size_t WS_WIN = 18 * MiB, WS_WPAB = 30 * MiB, WS_WOUT = 32 * MiB, WS_W1 = 34 * MiB, WS_W2 = 42 * MiB;
constexpr size_t WS_STATE = 10 * MiB  , WS_HCTX = 50 * MiB, WS_PCTX = 54 * MiB, WS_SCTX = 60 * MiB;
constexpr size_t WS_HLAT = 64 * MiB;
constexpr size_t WS_PI = 128 * MiB, WS_PZ = 160 * MiB, WS_PQ = 224 * MiB, WS_PG = 256 * MiB, WS_GATES = 288 * MiB, WS_PHYT = 416 * MiB;
constexpr size_t WS_AY = 160 * MiB;
constexpr size_t WS_AY2 = 64 * MiB;
constexpr size_t WS_MERGED = 128 * MiB;
constexpr size_t WS_MIX = 448 * MiB, WS_MLP = 384 * MiB, WS_H1 = 128 * MiB, WS_HL = 64 * MiB;
constexpr size_t WS_END = 512 * MiB;
constexpr int LDS_BYTES = 163840;

__device__ __forceinline__ float bf2f(bf16_t h) { return __uint_as_float(((unsigned)h) << 16); }
__device__ __forceinline__ unsigned f2bf(float f) { unsigned u = __float_as_uint(f); return (u + 0x7fffu + ((u >> 16) & 1u)) >> 16; }
__device__ __forceinline__ unsigned pk2(float lo, float hi) { return f2bf(lo) | (f2bf(hi) << 16); }
__device__ __forceinline__ float sigmoidf_(float x) { return 1.f / (1.f + expf(-x)); }
__device__ __forceinline__ float siluf_(float x) { return x / (1.f + expf(-x)); }
__device__ __forceinline__ float wave_sum(float v) {
#pragma unroll
    for (int o = 1; o < 64; o <<= 1) v += __shfl_xor(v, o);
    return v;
}
#define LDS_WAIT() asm volatile("s_waitcnt lgkmcnt(0)" ::: "memory")

struct Params { const float* in[24]; float* out; unsigned char* ws; };
__device__ __forceinline__ f32x4 ldmod(const float* mb, int i4) { return ((const f32x4*)mb)[i4]; }

#define XB_TMO      128
#define XB_XCNT(j)  (256  + 64 * (j))
#define XB_XSUB(j)  (1280 + 64 * (j))
#define XB_XGEN(j)  (2304 + 64 * (j))
#define XB_TOP      3328
#define XB_TOPGEN   3392
#define XCD_BAR_WORDS 3456
#define XB_SPIN_CAP (1u << 18)

__device__ __forceinline__ unsigned xb_ld(unsigned* p)              { return __hip_atomic_load(p, __ATOMIC_RELAXED, __HIP_MEMORY_SCOPE_AGENT); }
__device__ __forceinline__ unsigned xb_add(unsigned* p, unsigned v) { return __hip_atomic_fetch_add(p, v, __ATOMIC_RELAXED, __HIP_MEMORY_SCOPE_AGENT); }
__device__ __forceinline__ unsigned xb_xcc_id() { return (unsigned)__builtin_amdgcn_s_getreg((3 << 11) | 20) & 0xFu; }
#define XB_SPIN(cond, bar) do { unsigned _sp = 0; while (cond) { __builtin_amdgcn_s_sleep(1); \
    if ((++_sp & 255u) == 0u) { if (xb_ld(&(bar)[XB_TMO])) break; if (_sp > XB_SPIN_CAP) { atomicAdd(&(bar)[XB_TMO], 1u); break; } } } } while (0)

struct XcdBarrier {
    unsigned* bar; unsigned x;
    volatile LAS unsigned* st;
};

__device__ __forceinline__ XcdBarrier xcd_barrier_post(unsigned* bar, volatile LAS unsigned* st) {
    XcdBarrier b; b.bar = bar; b.x = xb_xcc_id(); b.st = st;
    if (threadIdx.x == 0) (void)xb_add(&bar[XB_XCNT(b.x)], 1u);
    return b;
}
__device__ __forceinline__ void xcd_barrier_complete(unsigned* bar, unsigned x, unsigned& nloc, unsigned& nx) {
    const unsigned G = gridDim.x * gridDim.y * gridDim.z;
    unsigned sum, cnt, mine, sp = 0u;
    for (;;) {
        sum = 0u; cnt = 0u; mine = 0u;
#pragma unroll
        for (unsigned j = 0; j < 16; ++j) { const unsigned c = xb_ld(&bar[XB_XCNT(j)]); sum += c; cnt += (c > 0u) ? 1u : 0u; mine = (j == x) ? c : mine; }
        if (sum == G) break;
        __builtin_amdgcn_s_sleep(1);
        if ((++sp & 255u) == 0u) { if (xb_ld(&bar[XB_TMO])) break; if (sp > XB_SPIN_CAP) { atomicAdd(&bar[XB_TMO], 1u); break; } }
    }
    nloc = mine > 0u ? mine : 1u; nx = cnt > 0u ? cnt : 1u;
}

__device__ __forceinline__ void xcd_barrier(const XcdBarrier& b) {
    asm volatile("s_waitcnt vmcnt(0)" ::: "memory");
    __syncthreads();
    if (threadIdx.x == 0) {
        unsigned* bar = b.bar;
        __builtin_amdgcn_s_waitcnt(0);
        unsigned nloc = b.st[0], nx = b.st[1];
        if (nloc == 0u) { xcd_barrier_complete(bar, b.x, nloc, nx); b.st[0] = nloc; b.st[1] = nx; }
        const unsigned old = xb_add(&bar[XB_XSUB(b.x)], 1u);
        const unsigned gen = old / nloc;
        if (old + 1u == (gen + 1u) * nloc) {
            __builtin_amdgcn_fence(__ATOMIC_RELEASE, "agent");
            asm volatile("s_waitcnt vmcnt(0)" ::: "memory");
            const unsigned og = xb_add(&bar[XB_TOP], 1u);
            const unsigned tg = og / nx;
            if (og + 1u == (tg + 1u) * nx) xb_add(&bar[XB_TOPGEN], 1u);
            else XB_SPIN(xb_ld(&bar[XB_TOPGEN]) == tg, bar);
            __builtin_amdgcn_fence(__ATOMIC_ACQUIRE, "agent");
            xb_add(&bar[XB_XGEN(b.x)], 1u);
            asm volatile("s_waitcnt vmcnt(0)" ::: "memory");
        } else {
            XB_SPIN(xb_ld(&bar[XB_XGEN(b.x)]) == gen, bar);
            __builtin_amdgcn_fence(__ATOMIC_ACQUIRE, "agent");
            asm volatile("s_waitcnt vmcnt(0)" ::: "memory");
        }
    }
    __syncthreads();
}


__device__ __forceinline__ void transpose_item(const float* W, int N, bf16_t* WT, int ldk, int koff, int remap, LAS float* scr, int item, int lane) {
    const int nblk = N / 32, kb = item / nblk, nb = item % nblk, k0 = 64 * kb, n0 = 32 * nb;
    int rbase = n0;
    if (remap) { if (n0 < 2560) rbase = n0; else if (n0 < 4096) rbase = n0 + 2048;
        else { const int g = n0 - 4096, nn = g & 1023; rbase = 2560 + 256 * (nn >> 7) + (g >= 1024 ? 128 : 0) + (nn & 127); } }
#pragma unroll 8
    for (int i = 0; i < 32; ++i) { const int kk = 2 * i + (lane >> 5); scr[kk * 33 + (lane & 31)] = W[(size_t)(k0 + kk) * N + n0 + (lane & 31)]; }
    LDS_WAIT();
    const int c = lane & 7;
#pragma unroll
    for (int j = 0; j < 4; ++j) { const int n = (lane >> 3) + 8 * j; const LAS float* s = scr + (8 * c) * 33 + n;
        u32x4 o; o.x = pk2(s[0 * 33], s[1 * 33]); o.y = pk2(s[2 * 33], s[3 * 33]); o.z = pk2(s[4 * 33], s[5 * 33]); o.w = pk2(s[6 * 33], s[7 * 33]);
        *(u32x4*)(WT + (size_t)(rbase + n) * ldk + koff + k0 + 8 * c) = o; }
    LDS_WAIT();
}

__device__ __forceinline__ void row_norm_mod_bf16(const float* xrow, const float* nw, const float* scale, const float* shift, bf16_t* orow, int lane) {
    const f32x4* xr = (const f32x4*)xrow + lane; f32x4 v[4]; float s = 0.f;
#pragma unroll
    for (int j = 0; j < 4; ++j) { v[j] = xr[64 * j]; s += (v[j].x * v[j].x + v[j].y * v[j].y) + (v[j].z * v[j].z + v[j].w * v[j].w); }
    const float r = rsqrtf(wave_sum(s) * (1.f / D) + EPS);
    unsigned long long* o8 = (unsigned long long*)orow + lane;
#pragma unroll
    for (int j = 0; j < 4; ++j) { const f32x4 w = ((const f32x4*)nw)[lane + 64 * j], sc = ((const f32x4*)scale)[lane + 64 * j], sh = ((const f32x4*)shift)[lane + 64 * j];
        const f32x4 o = v[j] * r * w * (1.f + sc) + sh;
        o8[64 * j] = (unsigned long long)pk2(o.x, o.y) | ((unsigned long long)pk2(o.z, o.w) << 32); }
}
__device__ __forceinline__ f32x4 ld_bf4(const bf16_t* p) { const u32x2 u = *(const u32x2*)p; return (f32x4){pg8::bflo(u.x), pg8::bfhi(u.x), pg8::bflo(u.y), pg8::bfhi(u.y)}; }
__device__ __forceinline__ void row_x1(const float* xrow, const bf16_t* mixrow, const float* nw1, const float* g2, f32x4 (&x1)[4], int lane) {
    f32x4 mv[4]; float s = 0.f;
#pragma unroll
    for (int j = 0; j < 4; ++j) { mv[j] = ld_bf4(mixrow + 4 * lane + 256 * j); s += (mv[j].x * mv[j].x + mv[j].y * mv[j].y) + (mv[j].z * mv[j].z + mv[j].w * mv[j].w); }
    const float r = rsqrtf(wave_sum(s) * (1.f / D) + EPS);
#pragma unroll
    for (int j = 0; j < 4; ++j) { const f32x4 w = ((const f32x4*)nw1)[lane + 64 * j], g = ((const f32x4*)g2)[lane + 64 * j], xv = ((const f32x4*)xrow)[lane + 64 * j];
        x1[j] = xv + g * (mv[j] * r * w); }
}

typedef float f32x16 __attribute__((ext_vector_type(16)));
typedef float f32x2_t __attribute__((ext_vector_type(2)));
typedef __bf16 bf16x2_t __attribute__((ext_vector_type(2)));
__device__ __forceinline__ unsigned cvtpk(float lo, float hi) { const f32x2_t v = {lo, hi}; const bf16x2_t b = __builtin_convertvector(v, bf16x2_t); return __builtin_bit_cast(unsigned, b); }
constexpr int HY_PAD = 256, HY_PITCH = (HY_PAD + 4096 + HY_PAD) * 2 + 16;
constexpr int HY_TAB0 = 8 * HY_PITCH;
constexpr int HY_TAB1 = HY_TAB0 + 17408 + 64;
__device__ __forceinline__ void conv8(const u32x4 raw, float left, float right, float w0, float w1, float w2, float bias, float (&o)[8]) {
    float in[10]; in[0] = left; in[9] = right;
    in[1] = pg8::bflo(raw.x); in[2] = pg8::bfhi(raw.x); in[3] = pg8::bflo(raw.y); in[4] = pg8::bfhi(raw.y); in[5] = pg8::bflo(raw.z); in[6] = pg8::bfhi(raw.z); in[7] = pg8::bflo(raw.w); in[8] = pg8::bfhi(raw.w);
#pragma unroll
    for (int j = 0; j < 8; ++j) o[j] = bias + w0 * in[j] + w1 * in[j + 1] + w2 * in[j + 2];
}
__device__ __forceinline__ void hyena_channel(LAS unsigned char* lds, int c, bf16_t* PHYT, const bf16_t* GTB, const float* hy_sw, const float* hy_sb) {
    const int tid = threadIdx.x, lane = tid & 63, wave = __builtin_amdgcn_readfirstlane(tid >> 6);
    const bool hl = (tid & 7) != 0, hr = ((tid + 1) & 7) != 0;
    __syncthreads();
    for (int ci = tid; ci < 1088; ci += 512) { u32x4 v = (u32x4){0u, 0u, 0u, 0u};
        if (ci >= 32 && ci < 1056) v = *(const u32x4*)(GTB + (size_t)c * 8192 + (ci - 32) * 8);
        *(LAS u32x4*)(lds + HY_TAB0 + ci * 16) = v; }
    {
        const bf16_t* x1r = PHYT + (size_t)(512 + c) * NT + 8 * tid; const bf16_t* vr = PHYT + (size_t)(1024 + c) * NT + 8 * tid;
        const float xw0 = hy_sw[512 + c], xw1 = hy_sw[1536 + 512 + c], xw2 = hy_sw[3072 + 512 + c], xb = hy_sb[512 + c];
        const float vw0 = hy_sw[1024 + c], vw1 = hy_sw[1536 + 1024 + c], vw2 = hy_sw[3072 + 1024 + c], vb = hy_sb[1024 + c];
        u32x4 xa[8], va[8];
#pragma unroll
        for (int b = 0; b < 8; ++b) { xa[b] = *(const u32x4*)(x1r + (size_t)b * L); va[b] = *(const u32x4*)(vr + (size_t)b * L); }
#pragma unroll
        for (int b = 0; b < 8; ++b) {
            const unsigned xpw = __shfl_up(xa[b].w, 1), xnx = __shfl_down(xa[b].x, 1), vpw = __shfl_up(va[b].w, 1), vnx = __shfl_down(va[b].x, 1);
            const float xl = hl ? pg8::bfhi(xpw) : 0.f, xr = hr ? pg8::bflo(xnx) : 0.f, vl = hl ? pg8::bfhi(vpw) : 0.f, vrr = hr ? pg8::bflo(vnx) : 0.f;
            float cx[8], cv[8]; conv8(xa[b], xl, xr, xw0, xw1, xw2, xb, cx); conv8(va[b], vl, vrr, vw0, vw1, vw2, vb, cv);
            u32x4 w; w.x = cvtpk(cx[0] * cv[0], cx[1] * cv[1]); w.y = cvtpk(cx[2] * cv[2], cx[3] * cv[3]); w.z = cvtpk(cx[4] * cv[4], cx[5] * cv[5]); w.w = cvtpk(cx[6] * cv[6], cx[7] * cv[7]);
            *(LAS u32x4*)(lds + b * HY_PITCH + (HY_PAD + 8 * tid) * 2) = w; }
        { const int b = tid >> 6, side = (tid >> 5) & 1, k = tid & 31;
            *(LAS u32x4*)(lds + b * HY_PITCH + (side ? (HY_PAD + 4096) * 2 : 0) + k * 16) = (u32x4){0u, 0u, 0u, 0u}; }
    }
    __syncthreads();
    for (int ci = tid; ci < 1088; ci += 512) { const u32x4 d = *(const LAS u32x4*)(lds + HY_TAB0 + ci * 16); const unsigned d4 = ci < 1087 ? *(const LAS unsigned*)(lds + HY_TAB0 + ci * 16 + 16) : 0u;
        u32x4 o; o.x = __builtin_amdgcn_alignbit(d.y, d.x, 16); o.y = __builtin_amdgcn_alignbit(d.z, d.y, 16); o.z = __builtin_amdgcn_alignbit(d.w, d.z, 16); o.w = __builtin_amdgcn_alignbit(d4, d.w, 16);
        *(LAS u32x4*)(lds + HY_TAB1 + ci * 16) = o; }
    __syncthreads();
    const int T0 = 512 * wave, r = lane & 31, h = lane >> 5, bb = r & 7, tb = r >> 3;
    f32x16 acc[4];
#pragma unroll
    for (int i = 0; i < 4; ++i)
#pragma unroll
        for (int j = 0; j < 16; ++j) acc[i][j] = 0.f;
    {
        const int Dfirst = T0 - 4080;
        const int e0 = 4351 - Dfirst - r + 8 * h;
        const unsigned aaddr0 = (unsigned)((e0 & 1) ? HY_TAB1 : HY_TAB0) + (unsigned)(e0 & ~1) * 2u;
        const unsigned baddr0 = (unsigned)(bb * HY_PITCH + (HY_PAD + T0 + 64 * tb - Dfirst + 8 * h) * 2);
#define HY_LDA(dst, ad) do { u32x4 _t; _t.x = *(const LAS unsigned*)(lds + (ad)); _t.y = *(const LAS unsigned*)(lds + (ad) + 4); _t.z = *(const LAS unsigned*)(lds + (ad) + 8); _t.w = *(const LAS unsigned*)(lds + (ad) + 12); dst = __builtin_bit_cast(pg8::bf16x8, _t); } while (0)
#define HY_LDB(dst, ad) dst = *(const LAS pg8::bf16x8*)(lds + (ad))
#define HY_MMA(i, A, B) acc[i] = __builtin_amdgcn_mfma_f32_32x32x16_bf16(A, B, acc[i], 0, 0, 0)
#define HY_GENERIC(st_lo, st_hi) do { for (int st = (st_lo); st < (st_hi); ++st) { const unsigned aa = aaddr0 - 32u * (unsigned)st, ba = baddr0 - 32u * (unsigned)st; pg8::bf16x8 A; HY_LDA(A, aa); \
            if (st <= 267) { pg8::bf16x8 B; HY_LDB(B, ba); HY_MMA(0, A, B); } \
            if (st >= 2 && st <= 269) { pg8::bf16x8 B; HY_LDB(B, ba + 64); HY_MMA(1, A, B); } \
            if (st >= 16 && st <= 283) { pg8::bf16x8 B; HY_LDB(B, ba + 512); HY_MMA(2, A, B); } \
            if (st >= 18) { pg8::bf16x8 B; HY_LDB(B, ba + 576); HY_MMA(3, A, B); } } } while (0)
        HY_GENERIC(0, 18);
        {
            unsigned aa = aaddr0 - 32u * 18u, ba = baddr0 - 32u * 18u;
            pg8::bf16x8 Aa, Ab, X0, X1, X2, X3, Y0, Y1, Y2, Y3;
            HY_LDB(X0, ba + 64u); HY_LDB(Y0, ba + 64u + 512u);
            HY_LDB(X1, ba + 32u); HY_LDB(Y1, ba + 32u + 512u);
            HY_LDA(Aa, aa); HY_LDB(X2, ba); HY_LDB(Y2, ba + 512u);
#define HY_STEP(Acur, Anext, Xc, Xo, Xn, Yc, Yo, Yn, k) do { \
                HY_LDA(Anext, aa - 32u * ((k) + 1)); HY_LDB(Xn, ba - 32u * ((k) + 1)); HY_LDB(Yn, ba - 32u * ((k) + 1) + 512u); __builtin_amdgcn_sched_barrier(0); \
                HY_MMA(0, Acur, Xc); HY_MMA(1, Acur, Xo); HY_MMA(2, Acur, Yc); HY_MMA(3, Acur, Yo); __builtin_amdgcn_sched_barrier(0); } while (0)
#pragma unroll 1
            for (int it = 0; it < 62; ++it) {
                HY_STEP(Aa, Ab, X2, X0, X3, Y2, Y0, Y3, 0);
                HY_STEP(Ab, Aa, X3, X1, X0, Y3, Y1, Y0, 1);
                HY_STEP(Aa, Ab, X0, X2, X1, Y0, Y2, Y1, 2);
                HY_STEP(Ab, Aa, X1, X3, X2, Y1, Y3, Y2, 3);
                aa -= 128u; ba -= 128u;
            }
#undef HY_STEP
        }
        HY_GENERIC(266, 286);
#undef HY_LDA
#undef HY_LDB
#undef HY_MMA
#undef HY_GENERIC
    }
    __syncthreads();
    {
        const bf16_t* x0r = PHYT + (size_t)c * NT + 8 * tid; u32x4 xa[8];
#pragma unroll
        for (int b = 0; b < 8; ++b) xa[b] = *(const u32x4*)(x0r + (size_t)b * L);
#pragma unroll
        for (int i = 0; i < 4; ++i)
#pragma unroll
            for (int g = 0; g < 4; ++g) { const int t = T0 + 256 * (i >> 1) + 32 * (i & 1) + 64 * tb + 8 * g + 4 * h;
                pg8::u32x2 w; w.x = cvtpk(acc[i][4 * g], acc[i][4 * g + 1]); w.y = cvtpk(acc[i][4 * g + 2], acc[i][4 * g + 3]);
                *(LAS pg8::u32x2*)(lds + bb * HY_PITCH + (HY_PAD + t) * 2) = w; }
        __syncthreads();
        bf16_t* yr = PHYT + (size_t)(1024 + c) * NT + 8 * tid;
        const float w0 = hy_sw[c], w1 = hy_sw[1536 + c], w2 = hy_sw[3072 + c], bs = hy_sb[c];
#pragma unroll
        for (int b = 0; b < 8; ++b) {
            const unsigned xpw = __shfl_up(xa[b].w, 1), xnx = __shfl_down(xa[b].x, 1);
            const float xl = hl ? pg8::bfhi(xpw) : 0.f, xr = hr ? pg8::bflo(xnx) : 0.f;
            float cx[8]; conv8(xa[b], xl, xr, w0, w1, w2, bs, cx);
            const u32x4 y = *(const LAS u32x4*)(lds + b * HY_PITCH + (HY_PAD + 8 * tid) * 2);
            u32x4 w; w.x = cvtpk(cx[0] * pg8::bflo(y.x), cx[1] * pg8::bfhi(y.x)); w.y = cvtpk(cx[2] * pg8::bflo(y.y), cx[3] * pg8::bfhi(y.y));
            w.z = cvtpk(cx[4] * pg8::bflo(y.z), cx[5] * pg8::bfhi(y.z)); w.w = cvtpk(cx[6] * pg8::bflo(y.w), cx[7] * pg8::bfhi(y.w));
            *(u32x4*)(yr + (size_t)b * L) = w; }
    }
}

constexpr int HG_QE = 0, HG_KE = 17408, HG_KDT = 34816, HG_VT = 53248, HG_DEC = 71680, HG_BUF = 72192;

#define HG_RD2(ptr_a, ptr_b) __builtin_bit_cast(pg8::bf16x8, (u32x4){(*(const LAS u32x2*)(ptr_a)).x, (*(const LAS u32x2*)(ptr_a)).y, (*(const LAS u32x2*)(ptr_b)).x, (*(const LAS u32x2*)(ptr_b)).y})
typedef short v4i16_t __attribute__((ext_vector_type(4)));
#define HG_TR1(p) __builtin_amdgcn_ds_read_tr16_b64_v4i16((LAS v4i16_t*)(p))
#define HG_TR2(pa, pb) __builtin_bit_cast(pg8::bf16x8, __builtin_shufflevector(HG_TR1(pa), HG_TR1(pb), 0, 1, 2, 3, 4, 5, 6, 7))
#define HG_MFMA(a, b, c) __builtin_amdgcn_mfma_f32_16x16x32_bf16(a, b, c, 0, 0, 0)
#define HG_SB() __builtin_amdgcn_sched_barrier(0)
__device__ __forceinline__ pg8::bf16x8 hg_pack2(const f32x4& a, const f32x4& b) { u32x4 t; t.x = cvtpk(a[0], a[1]); t.y = cvtpk(a[2], a[3]); t.z = cvtpk(b[0], b[1]); t.w = cvtpk(b[2], b[3]); return __builtin_bit_cast(pg8::bf16x8, t); }
template <bool HAS_Q>
__device__ __forceinline__ void hgrn_consume(LAS unsigned char* Bf, f32x4 (&S)[2][8], int base, int dir, int h, int cw, int fr, int kg, float* o_out, int dbg) {
    const f32x4 z4 = (f32x4){0.f, 0.f, 0.f, 0.f};
    const int trq = fr >> 2, trp = fr & 3;
    pg8::bf16x8 Bv[2][2];
#pragma unroll
    for (int sl = 0; sl < 2; ++sl)
#pragma unroll
        for (int ks = 0; ks < 2; ++ks) { LAS unsigned char* const vp = Bf + HG_VT + (32 * ks + 4 * kg + trq) * 288 + (32 * cw + 16 * sl + 4 * trp) * 2; Bv[sl][ks] = HG_TR2(vp, vp + 16 * 288); }
    if (HAS_Q) {
        f32x4 st[10];
#pragma unroll
        for (int i = 0; i < 10; ++i) st[i] = z4;
        pg8::bf16x8 Kf[2][4], Qf[2][4];
        LAS unsigned char* const kbase = Bf + HG_KE + fr * 272 + 8 * kg * 2; LAS unsigned char* const qbase = Bf + HG_QE + fr * 272 + 8 * kg * 2;
#pragma unroll
        for (int b4 = 0; b4 < 4; ++b4) { Kf[0][b4] = *(const LAS pg8::bf16x8*)(kbase + b4 * 16 * 272); Qf[0][b4] = *(const LAS pg8::bf16x8*)(qbase + b4 * 16 * 272); }
#pragma unroll
        for (int ks = 0; ks < 4; ++ks) {
            if (ks < 3) {
#pragma unroll
                for (int b4 = 0; b4 < 4; ++b4) { Kf[(ks + 1) & 1][b4] = *(const LAS pg8::bf16x8*)(kbase + b4 * 16 * 272 + (ks + 1) * 64); Qf[(ks + 1) & 1][b4] = *(const LAS pg8::bf16x8*)(qbase + b4 * 16 * 272 + (ks + 1) * 64); } }
            HG_SB();
#pragma unroll
            for (int cb = 0; cb < 4; ++cb)
#pragma unroll
                for (int sb = 0; sb <= cb; ++sb) st[cb * (cb + 1) / 2 + sb] = HG_MFMA(Kf[ks & 1][sb], Qf[ks & 1][cb], st[cb * (cb + 1) / 2 + sb]);
            HG_SB();
        }
#pragma unroll
        for (int cb = 0; cb < 4; ++cb)
#pragma unroll
            for (int r = 0; r < 4; ++r) st[cb * (cb + 1) / 2 + cb][r] = (4 * kg + r <= fr) ? st[cb * (cb + 1) / 2 + cb][r] : 0.f;
        pg8::bf16x8 Af[4][2];
        Af[0][0] = hg_pack2(st[0], z4); Af[1][0] = hg_pack2(st[1], st[2]); Af[2][0] = hg_pack2(st[3], st[4]); Af[2][1] = hg_pack2(st[5], z4); Af[3][0] = hg_pack2(st[6], st[7]); Af[3][1] = hg_pack2(st[8], st[9]);
        pg8::bf16x8 Bs[2][4];
#pragma unroll
        for (int sl = 0; sl < 2; ++sl)
#pragma unroll
            for (int kp = 0; kp < 4; ++kp) Bs[sl][kp] = hg_pack2(S[sl][2 * kp], S[sl][2 * kp + 1]);
        pg8::bf16x8 Aq[2][4];
        LAS unsigned char* const qp0 = Bf + HG_QE + fr * 272 + 4 * kg * 2;
#pragma unroll
        for (int kp = 0; kp < 4; ++kp) Aq[0][kp] = HG_RD2(qp0 + kp * 64, qp0 + kp * 64 + 32);
#pragma unroll
        for (int cb = 0; cb < 4; ++cb) {
            if (cb < 3) {
#pragma unroll
                for (int kp = 0; kp < 4; ++kp) Aq[(cb + 1) & 1][kp] = HG_RD2(qp0 + (cb + 1) * 16 * 272 + kp * 64, qp0 + (cb + 1) * 16 * 272 + kp * 64 + 32); }
            HG_SB();
            f32x4 o0 = z4, o1 = z4;
            o0 = HG_MFMA(Bv[0][0], Af[cb][0], o0); o1 = HG_MFMA(Bv[1][0], Af[cb][0], o1);
            if (cb >= 2) { o0 = HG_MFMA(Bv[0][1], Af[cb][1], o0); o1 = HG_MFMA(Bv[1][1], Af[cb][1], o1); }
#pragma unroll
            for (int kp = 0; kp < 4; ++kp) { o0 = HG_MFMA(Bs[0][kp], Aq[cb & 1][kp], o0); o1 = HG_MFMA(Bs[1][kp], Aq[cb & 1][kp], o1); }
            HG_SB();
            { const int cp = 16 * cb + fr; const int t = base + (dir ? 63 - cp : cp); float* op = o_out + (size_t)t * 128 + 32 * cw + 4 * kg;
              if (!(dbg & 1)) { *(f32x4*)op = o0; *(f32x4*)(op + 16) = o1; } else asm volatile("" :: "v"(o0), "v"(o1)); }
        }
    }
    pg8::bf16x8 Ak[2][2][2]; f32x4 dc[2][2];
    LAS unsigned char* const kdp = Bf + HG_KDT + (4 * kg + trq) * 288 + 4 * trp * 2; LAS unsigned char* const dcp = Bf + HG_DEC + 4 * kg * 4;
#pragma unroll
    for (int u = 0; u < 2; ++u) { dc[0][u] = *(const LAS f32x4*)(dcp + u * 64);
#pragma unroll
        for (int ks = 0; ks < 2; ++ks) Ak[0][u][ks] = HG_TR2(kdp + u * 32 + ks * 32 * 288, kdp + u * 32 + ks * 32 * 288 + 16 * 288); }
#pragma unroll
    for (int bp = 0; bp < 4; ++bp) {
        if (bp < 3) {
#pragma unroll
            for (int u = 0; u < 2; ++u) { const int blk = 2 * (bp + 1) + u; dc[(bp + 1) & 1][u] = *(const LAS f32x4*)(dcp + blk * 64);
#pragma unroll
                for (int ks = 0; ks < 2; ++ks) Ak[(bp + 1) & 1][u][ks] = HG_TR2(kdp + blk * 32 + ks * 32 * 288, kdp + blk * 32 + ks * 32 * 288 + 16 * 288); } }
        HG_SB();
#pragma unroll
        for (int u = 0; u < 2; ++u) { const int blk = 2 * bp + u; f32x4 s0 = S[0][blk] * dc[bp & 1][u], s1 = S[1][blk] * dc[bp & 1][u];
#pragma unroll
            for (int ks = 0; ks < 2; ++ks) { s0 = HG_MFMA(Ak[bp & 1][u][ks], Bv[0][ks], s0); s1 = HG_MFMA(Ak[bp & 1][u][ks], Bv[1][ks], s1); }
            S[0][blk] = s0; S[1][blk] = s1; }
        HG_SB();
    }
}
#undef HG_RD2
#undef HG_TR1
#undef HG_TR2
#undef HG_MFMA
#undef HG_SB

template <bool HAS_Q>
__device__ __forceinline__ void hgrn_chain_mfma(LAS unsigned char* lds, const bf16_t* pi, int ldi, const bf16_t* pz, int ldz, const bf16_t* pq, int ldq, int Lseq, int h, int dir,
                                                const float* lb, const float* s_in, float* s_out, float* o_out, int n_begin, int nch  , int dbg = 0, unsigned char* dbgp = nullptr) {
    const int tid = threadIdx.x, lane = tid & 63, wave = __builtin_amdgcn_readfirstlane(tid >> 6);
    const bool producer = wave < 4;
#if PROBE_MASK
    unsigned long long bar_wait = 0ull;
#define HG_BAR() do { asm volatile("s_waitcnt lgkmcnt(0)" ::: "memory"); const unsigned long long _b0 = __builtin_amdgcn_s_memrealtime(); __builtin_amdgcn_s_barrier(); bar_wait += __builtin_amdgcn_s_memrealtime() - _b0; asm volatile("" ::: "memory"); } while (0)
#else
#define HG_BAR() do { asm volatile("s_waitcnt lgkmcnt(0)" ::: "memory"); __builtin_amdgcn_s_barrier(); asm volatile("" ::: "memory"); } while (0)
#endif
    const int pw = wave & 3, dp = lane & 15, rq = lane >> 4, ch0 = 32 * pw + 2 * dp;
    const int rowmin = dir ? 48 - 16 * rq : 16 * rq;
    const unsigned voZ = (unsigned)(rowmin * ldz + h * 128 + ch0) * 2u, voI = (unsigned)(rowmin * ldi + h * 128 + ch0) * 2u, voQ = (unsigned)(rowmin * (HAS_Q ? ldq : ldi) + h * 128 + ch0) * 2u;
    const __amdgpu_buffer_rsrc_t rsZ = __builtin_amdgcn_make_buffer_rsrc((void*)pz, 0, Lseq * ldz * 2, 0x00020000);
    const __amdgpu_buffer_rsrc_t rsI = __builtin_amdgcn_make_buffer_rsrc((void*)pi, 0, Lseq * ldi * 2, 0x00020000);
    const __amdgpu_buffer_rsrc_t rsQ = __builtin_amdgcn_make_buffer_rsrc((void*)(HAS_Q ? pq : pi), 0, Lseq * (HAS_Q ? ldq : ldi) * 2, 0x00020000);
#define HG_LOAD(n, Z, Q, V) do { const int _n = (dbg & 2) ? 0 : (n); const int _base = dir ? (Lseq - 64 * (_n + 1)) : 64 * _n; \
        _Pragma("unroll") for (int i = 0; i < 16; ++i) { const int _r = _base + (dir ? 15 - i : i); \
            Z[i] = __builtin_amdgcn_raw_buffer_load_b32(rsZ, voZ, _r * ldz * 2, 0); V[i] = __builtin_amdgcn_raw_buffer_load_b32(rsI, voI, _r * ldi * 2, 0); \
            if (HAS_Q) Q[i] = __builtin_amdgcn_raw_buffer_load_b32(rsQ, voQ, _r * ldq * 2, 0); } } while (0)
#define HG_PRODUCE(Z, Q, V, boff) do { LAS unsigned char* const Bf = lds + (boff); \
        float f0[16], f1[16]; float p0 = 1.f, p1 = 1.f; \
        _Pragma("unroll") for (int i = 0; i < 16; ++i) { f0[i] = 1.f - pg8::bflo(Z[i]); f1[i] = 1.f - pg8::bfhi(Z[i]); p0 *= f0[i]; p1 *= f1[i]; } \
        float run0 = 1.f, run1 = 1.f, fl0 = 1.f, fl1 = 1.f, suf0 = 1.f, suf1 = 1.f; \
        _Pragma("unroll") for (int qq = 0; qq < 4; ++qq) { const float t0 = __shfl(p0, dp + 16 * qq), t1 = __shfl(p1, dp + 16 * qq); fl0 *= t0; fl1 *= t1; if (qq < rq) { run0 *= t0; run1 *= t1; } if (qq > rq) { suf0 *= t0; suf1 *= t1; } } \
        if (HAS_Q) { \
            _Pragma("unroll") for (int i = 0; i < 16; ++i) { run0 *= f0[i]; run1 *= f1[i]; const float ia = __builtin_amdgcn_rcpf(run0), ib = __builtin_amdgcn_rcpf(run1); \
                const float kea = pg8::bflo(Z[i]) * ia, keb = pg8::bfhi(Z[i]) * ib; const int cp = 16 * rq + i; \
                *(LAS unsigned*)(Bf + HG_QE + cp * 272 + ch0 * 2) = cvtpk(pg8::bflo(Q[i]) * run0, pg8::bfhi(Q[i]) * run1); \
                *(LAS unsigned*)(Bf + HG_KE + cp * 272 + ch0 * 2) = cvtpk(kea, keb); \
                *(LAS unsigned*)(Bf + HG_KDT + cp * 288 + ch0 * 2) = cvtpk(kea * fl0, keb * fl1); } \
        } else { \
            _Pragma("unroll") for (int i = 15; i >= 0; --i) { const int cp = 16 * rq + i; \
                *(LAS unsigned*)(Bf + HG_KDT + cp * 288 + ch0 * 2) = cvtpk(pg8::bflo(Z[i]) * suf0, pg8::bfhi(Z[i]) * suf1); suf0 *= f0[i]; suf1 *= f1[i]; } \
        } \
        _Pragma("unroll") for (int i = 0; i < 16; ++i) *(LAS unsigned*)(Bf + HG_VT + (16 * rq + i) * 288 + ch0 * 2) = V[i]; \
        if (rq == 0) *(LAS f32x2_t*)(Bf + HG_DEC + ch0 * 4) = (f32x2_t){fl0, fl1}; } while (0)
#define HG_CONSUME(m, boff) hgrn_consume<HAS_Q>(lds + (boff), S, dir ? (Lseq - 64 * ((m) + 1)) : 64 * (m), dir, h, cw, fr, kg, o_out, dbg)

    __syncthreads();
    if (producer) {
        unsigned zA[16], qA[16], vA[16], zB[16], qB[16], vB[16];
        HG_LOAD(n_begin, zA, qA, vA);
        if (n_begin + 1 < nch) HG_LOAD(n_begin + 1, zB, qB, vB);
        for (int n = n_begin; n <= nch; n += 2) {
            if (n < nch && !(dbg & 4)) HG_PRODUCE(zA, qA, vA, 0);
            if (n + 2 < nch) HG_LOAD(n + 2, zA, qA, vA);
            HG_BAR();
            if (n + 1 < nch && !(dbg & 4)) HG_PRODUCE(zB, qB, vB, HG_BUF);
            if (n + 3 < nch) HG_LOAD(n + 3, zB, qB, vB);
            HG_BAR();
        }
    } else {
        const int cw = wave & 3, fr = lane & 15, kg = lane >> 4;
        __builtin_amdgcn_s_setprio(3);
        f32x4 S[2][8];
#pragma unroll
        for (int sl = 0; sl < 2; ++sl)
#pragma unroll
            for (int blk = 0; blk < 8; ++blk)
#pragma unroll
                for (int r = 0; r < 4; ++r) S[sl][blk][r] = s_in ? s_in[(size_t)(16 * blk + 4 * kg + r) * 128 + 32 * cw + 16 * sl + fr] : 0.f;
        for (int n = n_begin; n <= nch; n += 2) {
            if (n > n_begin && !(dbg & 8)) HG_CONSUME(n - 1, HG_BUF);
            HG_BAR();
            if (n < nch && !(dbg & 8)) HG_CONSUME(n, 0);
            HG_BAR();
        }
        if (dbg) {
#pragma unroll
            for (int sl = 0; sl < 2; ++sl)
#pragma unroll
                for (int blk = 0; blk < 8; ++blk) asm volatile("" :: "v"(S[sl][blk][0]), "v"(S[sl][blk][1]), "v"(S[sl][blk][2]), "v"(S[sl][blk][3]));
        }
        if (s_out) {
#pragma unroll
            for (int sl = 0; sl < 2; ++sl)
#pragma unroll
                for (int blk = 0; blk < 8; ++blk)
#pragma unroll
                    for (int r = 0; r < 4; ++r) s_out[(size_t)(16 * blk + 4 * kg + r) * 128 + 32 * cw + 16 * sl + fr] = S[sl][blk][r];
        }
        __builtin_amdgcn_s_setprio(0);
    }
#if PROBE_MASK
    if (HAS_Q && blockIdx.x == PROBE_BUSY_BLOCK && (tid == 0 || tid == 256) && dbg == 0) *(volatile unsigned long long*)(dbgp + (tid ? 8 : 0)) = bar_wait;
#endif
#undef HG_LOAD
#undef HG_PRODUCE
#undef HG_CONSUME
#undef HG_BAR
    __syncthreads();
}

__global__ void __launch_bounds__(512, 2) mega(Params P) {
    extern __shared__ __attribute__((aligned(16))) unsigned char lds_raw[];
    cg::grid_group grid = cg::this_grid();
    LAS unsigned char* lds = (LAS unsigned char*)lds_raw;
    const int tid = threadIdx.x, lane = tid & 63, wave = __builtin_amdgcn_readfirstlane(tid >> 6);
    const int G = gridDim.x, bx = blockIdx.x;
    const int vcu = (G % 8 == 0) ? (bx % 8) * (G / 8) + bx / 8 : bx;
    const int gw = vcu * 8 + wave, NGW = G * 8;
    unsigned char* ws = P.ws;
    const float* x = P.in[0]; const float* cvec = P.in[1]; const float* ctx = P.in[2]; const float* c_ctx = P.in[3];
    const float* w_ada = P.in[4]; const float* b_ada = P.in[5]; const float* norm_w = P.in[6]; const float* w_in = P.in[7];
    const float* lb_param = P.in[8]; const float* g_norm = P.in[9]; const float* hy_sw = P.in[10]; const float* hy_sb = P.in[11];
    const float* f_w1 = P.in[12]; const float* f_b1 = P.in[13]; const float* f_w2 = P.in[14]; const float* f_b2 = P.in[15];
    const float* f_w3 = P.in[16]; const float* f_freq = P.in[17]; const float* hy_d = P.in[18]; const float* w_pa = P.in[19];
    const float* w_pb = P.in[20]; const float* w_out = P.in[21]; const float* w_mlp1 = P.in[22]; const float* w_mlp2 = P.in[23];
    float* MOD = (float*)(ws + WS_MOD); float* LB = (float*)(ws + WS_LB); bf16_t* GTB = (bf16_t*)(ws + WS_GT);
    bf16_t* WIN = (bf16_t*)(ws + WS_WIN); bf16_t* WPAB = (bf16_t*)(ws + WS_WPAB); bf16_t* WOUT = (bf16_t*)(ws + WS_WOUT); bf16_t* W1 = (bf16_t*)(ws + WS_W1); bf16_t* W2 = (bf16_t*)(ws + WS_W2);
    bf16_t* HCTX = (bf16_t*)(ws + WS_HCTX); bf16_t* PCTX = (bf16_t*)(ws + WS_PCTX); float* SCTX = (float*)(ws + WS_SCTX);
    bf16_t* HLAT = (bf16_t*)(ws + WS_HLAT); bf16_t* PI = (bf16_t*)(ws + WS_PI); bf16_t* PZ = (bf16_t*)(ws + WS_PZ); bf16_t* PQ = (bf16_t*)(ws + WS_PQ);
    bf16_t* PG = (bf16_t*)(ws + WS_PG); bf16_t* GATES = (bf16_t*)(ws + WS_GATES); bf16_t* PHYT = (bf16_t*)(ws + WS_PHYT);
    bf16_t* AY = (bf16_t*)(ws + WS_AY2); bf16_t* MERGED = (bf16_t*)(ws + WS_MERGED); bf16_t* MIX = (bf16_t*)(ws + WS_MIX);
    bf16_t* MLP = (bf16_t*)(ws + WS_MLP); bf16_t* H1 = (bf16_t*)(ws + WS_H1); bf16_t* HL = (bf16_t*)(ws + WS_HL);
    float* O2 = P.out;

    volatile LAS unsigned* MISC = (volatile LAS unsigned*)(lds + LDS_BYTES - 128);
    if (tid < 16) MISC[tid] = 0u;
    __syncthreads();
    const XcdBarrier xbar = xcd_barrier_post((unsigned*)ws, MISC);
#ifdef NO_GRID_SYNC
#define SEAM_RAW(k) xcd_barrier(xbar)
#else
#define SEAM_RAW(k) do { if ((k) == 0) grid.sync(); else xcd_barrier(xbar); } while (0)
#endif
#if PROBE_MASK
    unsigned long long t_prev = __builtin_amdgcn_s_memrealtime(), t_spin = 0ull;
#define SEAM(k) do { if ((k) == PROBE_BUSY_PHASE && bx == PROBE_BUSY_BLOCK && tid == 0) *(volatile unsigned long long*)(ws + 32768) = __builtin_amdgcn_s_memrealtime() - t_prev; \
    SEAM_RAW(k); { const unsigned long long _t = __builtin_amdgcn_s_memrealtime(); if ((PROBE_MASK >> (k)) & 1) t_spin += _t - t_prev; \
    if ((k) == PROBE_BUSY_PHASE) t_spin += *(volatile unsigned long long*)(ws + 32768); t_prev = _t; } } while (0)
#else
#define SEAM(k) SEAM_RAW(k)
#endif
    {
        if (bx < 192) {
            LAS float* sc = (LAS float*)lds;
            LAS float* ps = (LAS float*)(lds + 40960);
            for (int i = tid; i < 9 * D; i += 512) { const int r = i >> 10, k = i & 1023; sc[i] = siluf_(r < 8 ? cvec[r * D + k] : c_ctx[k]); }
            __syncthreads();
            const int jl = lane & 31, kk = lane >> 5, j = bx * 32 + jl; float a9[9];
#pragma unroll
            for (int r = 0; r < 9; ++r) a9[r] = 0.f;
            const float* wp = w_ada + (size_t)(wave * 128 + kk) * INC + j;
#pragma unroll 1
            for (int i0 = 0; i0 < 64; i0 += 16) { float w[16];
#pragma unroll
                for (int u = 0; u < 16; ++u) w[u] = wp[(size_t)(2 * (i0 + u)) * INC];
#pragma unroll
                for (int u = 0; u < 16; ++u)
#pragma unroll
                    for (int r = 0; r < 9; ++r) a9[r] += sc[r * D + wave * 128 + 2 * (i0 + u) + kk] * w[u]; }
#pragma unroll
            for (int r = 0; r < 9; ++r) { a9[r] += __shfl_xor(a9[r], 32); if (lane < 32) ps[(wave * 9 + r) * 32 + jl] = a9[r]; }
            __syncthreads();
            for (int i = tid; i < 9 * 32; i += 512) { const int r = i >> 5, l = i & 31; float s = b_ada[bx * 32 + l];
#pragma unroll
                for (int w = 0; w < 8; ++w) s += ps[(w * 9 + r) * 32 + l];
                MOD[r * INC + bx * 32 + l] = s; }
            __syncthreads();
        }
        if (bx == G - 1) { const float a = lb_param[tid], b = lb_param[HW + tid], m = fmaxf(a, b); const float ea = expf(a - m), eb = expf(b - m); LB[tid] = ea / (ea + eb); }
        {   LAS float* scr = (LAS float*)(lds + wave * 16384);
            for (int it = gw; it < 16 * 192; it += NGW) transpose_item(w_in, INC, WIN, D, 0, 1, scr, it, lane); }
        for (int tb = bx; tb < 256; tb += G) {
            __syncthreads();
            LAS float* zf = (LAS float*)lds; LAS float* h1 = zf + 17 * 36; LAS float* h2 = h1 + 17 * 64;
            for (int i = tid; i < 17 * 33; i += 512) { const int p = i / 33, k = i - 33 * p, t = 16 * tb + p; float val;
                if (k == 0) val = (float)t / (float)(L - 1);
                else { const int bi = (k - 1) & 15; const float band = 1e-4f + (float)bi * ((15.f - 1e-4f) / 15.f);
                    const float w = 2.0f * 3.14159265358979323846f * (float)t / (float)L; const float ang = w * band;
                    val = (k <= 16) ? cosf(ang) : -sinf(ang); }
                zf[p * 36 + k] = val; }
            __syncthreads();
            for (int i = tid; i < 17 * 64; i += 512) { const int p = i >> 6, k = i & 63; float acc = f_b1[k];
#pragma unroll 11
                for (int q = 0; q < 33; ++q) acc += zf[p * 36 + q] * f_w1[q * 64 + k];
                h1[i] = sinf(f_freq[k] * acc); }
            __syncthreads();
            for (int i = tid; i < 17 * 64; i += 512) { const int p = i >> 6, k = i & 63; float acc = f_b2[k];
#pragma unroll 16
                for (int q = 0; q < 64; ++q) acc += h1[p * 64 + q] * f_w2[q * 64 + k];
                h2[i] = sinf(f_freq[k] * acc); }
            __syncthreads();
            const int c = tid; float af[16], ab[16];
#pragma unroll
            for (int p = 0; p < 16; ++p) { af[p] = 0.f; ab[p] = 0.f; }
#pragma unroll 4
            for (int k = 0; k < 64; ++k) { const float wf = f_w3[k * 1024 + c], wb = f_w3[k * 1024 + 512 + c]; float hv[17];
#pragma unroll
                for (int p = 0; p < 17; ++p) hv[p] = h2[p * 64 + k];
#pragma unroll
                for (int p = 0; p < 16; ++p) { af[p] += hv[p] * wf; ab[p] += hv[p + 1] * wb; } }
            const float mind = logf(1e-2f) / 1.5f, maxd = logf(1e-2f) / 0.3f;
            const float delta = fabsf(mind + (maxd - mind) * ((float)c / 511.f));
            unsigned short of[16], ob[16];
#pragma unroll
            for (int p = 0; p < 16; ++p) { const int tf = 16 * tb + p, tbk = tf + 1;
                float vf = af[p] * expf(-((float)tf / (float)(L - 1)) * delta); if (tf == 0) vf += hy_d[c];
                float vb = ab[p] * expf(-((float)tbk / (float)(L - 1)) * delta); if (tbk >= L) vb = 0.f;
                of[15 - p] = (unsigned short)f2bf(vf); ob[p] = (unsigned short)f2bf(vb); }
            bf16_t* gf = GTB + (size_t)c * 8192 + (4080 - 16 * tb); bf16_t* gb = GTB + (size_t)c * 8192 + (4096 + 16 * tb);
            u32x4 w0, w1;
            w0.x = of[0] | ((unsigned)of[1] << 16); w0.y = of[2] | ((unsigned)of[3] << 16); w0.z = of[4] | ((unsigned)of[5] << 16); w0.w = of[6] | ((unsigned)of[7] << 16);
            w1.x = of[8] | ((unsigned)of[9] << 16); w1.y = of[10] | ((unsigned)of[11] << 16); w1.z = of[12] | ((unsigned)of[13] << 16); w1.w = of[14] | ((unsigned)of[15] << 16);
            *(u32x4*)gf = w0; *(u32x4*)(gf + 8) = w1;
            w0.x = ob[0] | ((unsigned)ob[1] << 16); w0.y = ob[2] | ((unsigned)ob[3] << 16); w0.z = ob[4] | ((unsigned)ob[5] << 16); w0.w = ob[6] | ((unsigned)ob[7] << 16);
            w1.x = ob[8] | ((unsigned)ob[9] << 16); w1.y = ob[10] | ((unsigned)ob[11] << 16); w1.z = ob[12] | ((unsigned)ob[13] << 16); w1.w = ob[14] | ((unsigned)ob[15] << 16);
            *(u32x4*)gb = w0; *(u32x4*)(gb + 8) = w1;
        }
    }
    SEAM(0);
    for (int m0 = gw; m0 < NT + NCX; m0 += 4 * NGW) {
        f32x4 v[4][4];
#pragma unroll
        for (int r = 0; r < 4; ++r) { const int m = m0 + r * NGW; if (m < NT + NCX) { const f32x4* xr = (const f32x4*)(m < NT ? x + (size_t)m * D : ctx + (size_t)(m - NT) * D) + lane;
#pragma unroll
                for (int j = 0; j < 4; ++j) v[r][j] = xr[64 * j]; } }
#pragma unroll
        for (int r = 0; r < 4; ++r) { const int m = m0 + r * NGW; if (m < NT + NCX) {
                const float* mb = MOD + (size_t)(m < NT ? (m >> 12) : 8) * INC; bf16_t* orow = m < NT ? HLAT + (size_t)m * D : HCTX + (size_t)(m - NT) * D;
                float s = 0.f;
#pragma unroll
                for (int j = 0; j < 4; ++j) s += (v[r][j].x * v[r][j].x + v[r][j].y * v[r][j].y) + (v[r][j].z * v[r][j].z + v[r][j].w * v[r][j].w);
                const float rs = rsqrtf(wave_sum(s) * (1.f / D) + EPS);
                unsigned long long* o8 = (unsigned long long*)orow + lane;
#pragma unroll
                for (int j = 0; j < 4; ++j) { const f32x4 w = ((const f32x4*)norm_w)[lane + 64 * j], sc = ldmod(mb, lane + 64 * j), sh = ldmod(mb + D, lane + 64 * j);
                    const f32x4 o = v[r][j] * rs * w * (1.f + sc) + sh;
                    o8[64 * j] = (unsigned long long)cvtpk(o.x, o.y) | ((unsigned long long)cvtpk(o.z, o.w) << 32); } } }
    }
    SEAM(1);
    {
        { pg8::Gemm g{HLAT, WIN, D, D, D}; pg8::StaticOrder S; S.init(NT, 4608, G, bx); pg8::EpiG1 E{PI, PZ, PQ, PG, GATES, LB, 0};
          pg8::gemm_phase(lds, g, S, E); }
        { pg8::Gemm g{WIN + (size_t)4608 * D, HLAT, D, D, D}; pg8::StaticOrder S; S.init(1536, NT, G, bx); pg8::EpiBf16<0> E{PHYT, NT};
          pg8::gemm_phase(lds, g, S, E); }
        { pg8::Gemm g{HCTX, WIN, D, D, D}; pg8::StaticOrder S; S.init(NCX, 1536, G, bx); pg8::EpiG1 E{PCTX, nullptr, nullptr, nullptr, nullptr, LB, 1};
          pg8::gemm_phase(lds, g, S, E); }
        if (bx >= 48) {
            LAS float* scr = (LAS float*)(lds + wave * 16384);
            constexpr int I_PA = 8 * 32, I_OUT = 16 * 32, I_1 = 16 * 128, I_2 = 64 * 32;
            __syncthreads();
            for (int it = (bx - 48) * 8 + wave; it < 2 * I_PA + I_OUT + I_1 + I_2; it += (G - 48) * 8) {
                int r = it;
                if (r < I_PA) { transpose_item(w_pa, D, WPAB, D, 0, 0, scr, r, lane); continue; } r -= I_PA;
                if (r < I_PA) { transpose_item(w_pb, D, WPAB, D, 512, 0, scr, r, lane); continue; } r -= I_PA;
                if (r < I_OUT) { transpose_item(w_out, D, WOUT, D, 0, 0, scr, r, lane); continue; } r -= I_OUT;
                if (r < I_1) { transpose_item(w_mlp1, FF, W1, D, 0, 0, scr, r, lane); continue; } r -= I_1;
                transpose_item(w_mlp2, D, W2, FF, 0, 0, scr, r, lane);
            }
        }

    }
    SEAM(2);
    {
        float* STATE = (float*)(ws + WS_HLAT);
        constexpr int NSEG = 4, SEGC = 64 / NSEG;
        if (bx < 64 * NSEG) { const int item = bx;
            const int chain = item / NSEG, seg = item % NSEG, b = chain >> 3, h = (chain >> 1) & 3, dir = chain & 1, n0 = SEGC * seg; float* st = STATE + (size_t)(item & 255) * 16384;
            const bf16_t* pzc = PZ + (size_t)b * L * 1024 + (dir ? 512 : 0);
            int n_start = n0; bool decayed = false;
            if (seg > 0) {
                LAS float* red = (LAS float*)lds;
                float r0 = 1.f, r1 = 1.f;
                while (n_start > 0 && !decayed) {
                    n_start -= 4;
                    const int basec = dir ? (L - 64 * (n_start + 4)) : 64 * n_start;
                    float p0 = 1.f, p1 = 1.f;
#pragma unroll 8
                    for (int i = 0; i < 32; ++i) { const unsigned kk = *(const unsigned*)(pzc + (size_t)(basec + 32 * wave + i) * 1024 + h * 128 + 2 * lane); p0 *= 1.f - pg8::bflo(kk); p1 *= 1.f - pg8::bfhi(kk); }
                    __syncthreads();
                    *(LAS f32x2_t*)(red + wave * 128 + 2 * lane) = (f32x2_t){p0, p1};
                    __syncthreads();
                    if (wave == 0) {
#pragma unroll
                        for (int w = 0; w < 8; ++w) { const f32x2_t t = *(const LAS f32x2_t*)(red + w * 128 + 2 * lane); r0 *= t.x; r1 *= t.y; }
                        float mx = fmaxf(r0, r1);
#pragma unroll
                        for (int o = 1; o < 64; o <<= 1) mx = fmaxf(mx, __shfl_xor(mx, o));
                        if (lane == 0) red[1024] = mx;
                    }
                    __syncthreads();
                    decayed = __builtin_amdgcn_readfirstlane(red[1024] < 1e-10f ? 1 : 0) != 0;
                }
            }
            if (seg == 0 || !decayed)
                hgrn_chain_mfma<false>(lds, PCTX + (size_t)b * LC * 1536, 1536, PCTX + (size_t)b * LC * 1536 + (dir ? 1024 : 512), 1536, nullptr, 0, LC, h, dir, LB, nullptr, st, nullptr, 0, LC / 64);
            if (seg > 0) hgrn_chain_mfma<false>(lds, PI + (size_t)b * L * 512, 512, pzc, 1024, nullptr, 0, L, h, dir, LB, decayed ? nullptr : st, st, nullptr, n_start, n0);
            hgrn_chain_mfma<true>(lds, PI + (size_t)b * L * 512, 512, pzc, 1024, PQ + (size_t)b * L * 512, 512, L, h, dir, LB,
                                  st, nullptr, O2 + (size_t)chain * L * 128, n0, n0 + SEGC, 0, ws + 32768 + 128);
#if PROBE_MASK
            if (PROBE_BUSY_PHASE == 20 && bx == PROBE_BUSY_BLOCK && tid == 0) *(volatile unsigned long long*)(ws + 32768 + 64) = __builtin_amdgcn_s_memrealtime() - t_prev;
#endif
        }
        unsigned* hctr = (unsigned*)(ws + 36864);
        for (;;) {
            __syncthreads();
            if (tid == 0) MISC[4] = atomicAdd(hctr, 1u);
            __syncthreads();
            const int c = (int)MISC[4];
            if (c >= HW) break;
            hyena_channel(lds, c, PHYT, GTB, hy_sw, hy_sb);
        }
    }
    SEAM(4);
#if PROBE_MASK
    if (PROBE_BUSY_PHASE == 20) t_spin += *(volatile unsigned long long*)(ws + 32768 + 64);
    if (PROBE_BUSY_PHASE == 21) t_spin += *(volatile unsigned long long*)(ws + 32768 + 128);
    if (PROBE_BUSY_PHASE == 22) t_spin += *(volatile unsigned long long*)(ws + 32768 + 136);
#endif
    {
        const f32x4 gn0 = ((const f32x4*)g_norm)[(2 * lane) & 31], gn1 = ((const f32x4*)g_norm)[(2 * lane + 1) & 31];
        for (int t0 = gw; t0 < NT; t0 += 2 * NGW) {
            f32x4 of[2][2], ob[2][2]; u32x4 pg[2];
#pragma unroll
            for (int r = 0; r < 2; ++r) { const int t = t0 + r * NGW; if (t < NT) {
                    { const int bb = t >> 12, hh = lane >> 4; const float* pf = O2 + ((size_t)((bb * 4 + hh) * 2) * L + (t & 4095)) * 128 + 8 * (lane & 15); const float* pb = pf + (size_t)L * 128;
                      of[r][0] = *(const f32x4*)pf; of[r][1] = *(const f32x4*)(pf + 4); ob[r][0] = *(const f32x4*)pb; ob[r][1] = *(const f32x4*)(pb + 4); }
                    pg[r] = ((const u32x4*)(PG + (size_t)t * 512))[lane]; } }
#pragma unroll
            for (int r = 0; r < 2; ++r) { const int t = t0 + r * NGW; if (t < NT) {
                    const f32x4 a0 = of[r][0] + ob[r][0], a1 = of[r][1] + ob[r][1];
                    float s = (a0.x * a0.x + a0.y * a0.y) + (a0.z * a0.z + a0.w * a0.w) + (a1.x * a1.x + a1.y * a1.y) + (a1.z * a1.z + a1.w * a1.w);
                    s += __shfl_xor(s, 1); s += __shfl_xor(s, 2); s += __shfl_xor(s, 4); s += __shfl_xor(s, 8);
                    const float rs = rsqrtf(s * (1.f / 128.f) + EPS);
                    u32x4 o;
                    o.x = cvtpk(a0.x * rs * gn0.x * pg8::bflo(pg[r].x), a0.y * rs * gn0.y * pg8::bfhi(pg[r].x)); o.y = cvtpk(a0.z * rs * gn0.z * pg8::bflo(pg[r].y), a0.w * rs * gn0.w * pg8::bfhi(pg[r].y));
                    o.z = cvtpk(a1.x * rs * gn1.x * pg8::bflo(pg[r].z), a1.y * rs * gn1.y * pg8::bfhi(pg[r].z)); o.w = cvtpk(a1.z * rs * gn1.z * pg8::bflo(pg[r].w), a1.w * rs * gn1.w * pg8::bfhi(pg[r].w));
                    *(u32x4*)(AY + (size_t)t * 1024 + 8 * lane) = o; } }
        }
    }
    {
        LAS bf16_t* tl = (LAS bf16_t*)(lds + wave * 16384);
        for (int it = gw; it < 8 * 512; it += NGW) { const int c0 = (it & 7) * 64, tok0 = (it >> 3) * 64;
#pragma unroll
            for (int i = 0; i < 8; ++i) { const int ch = lane + 64 * i, rr = ch >> 3, cc = (ch & 7) * 8;
                const u32x4 v = *(const u32x4*)(PHYT + (size_t)(1024 + c0 + rr) * NT + tok0 + cc);
                LAS unsigned* d = (LAS unsigned*)(tl + rr * 66 + cc); d[0] = v.x; d[1] = v.y; d[2] = v.z; d[3] = v.w; }
            LDS_WAIT();
#pragma unroll
            for (int i = 0; i < 8; ++i) { const int ch = lane + 64 * i, tt = ch >> 3, cc = (ch & 7) * 8; unsigned o[4];
#pragma unroll
                for (int q = 0; q < 4; ++q) o[q] = (unsigned)tl[(cc + 2 * q) * 66 + tt] | ((unsigned)tl[(cc + 2 * q + 1) * 66 + tt] << 16);
                *(u32x4*)(AY + (size_t)(tok0 + tt) * 1024 + 512 + c0 + cc) = (u32x4){o[0], o[1], o[2], o[3]}; }
            LDS_WAIT();
        }
    }
    SEAM(5);
    { pg8::Gemm g{AY, WPAB, D, D, 512}; pg8::TwoPassOrder S; S.base.init(NT, D, G, bx); S.kbytes = 1024; pg8::EpiMerge2 E{MERGED, GATES}; pg8::gemm_phase(lds, g, S, E); }
    SEAM(6);
    { pg8::Gemm g{MERGED, WOUT, D, D, D}; pg8::StaticOrder S; S.init(NT, D, G, bx); pg8::EpiBf16<0> E{MIX, D}; pg8::gemm_phase(lds, g, S, E); }
    SEAM(7);
    for (int m0 = gw; m0 < NT; m0 += 2 * NGW) {
        f32x4 xv[2][4]; u32x2 mx[2][4];
#pragma unroll
        for (int r = 0; r < 2; ++r) { const int m = m0 + r * NGW; if (m < NT) {
#pragma unroll
                for (int j = 0; j < 4; ++j) { xv[r][j] = ((const f32x4*)(x + (size_t)m * D))[lane + 64 * j]; mx[r][j] = *(const u32x2*)(MIX + (size_t)m * D + 4 * lane + 256 * j); } } }
#pragma unroll
        for (int r = 0; r < 2; ++r) { const int m = m0 + r * NGW; if (m < NT) { const float* mb = MOD + (size_t)(m >> 12) * INC;
                f32x4 mv[4], x1[4]; float s = 0.f;
#pragma unroll
                for (int j = 0; j < 4; ++j) { mv[j] = (f32x4){pg8::bflo(mx[r][j].x), pg8::bfhi(mx[r][j].x), pg8::bflo(mx[r][j].y), pg8::bfhi(mx[r][j].y)}; s += (mv[j].x * mv[j].x + mv[j].y * mv[j].y) + (mv[j].z * mv[j].z + mv[j].w * mv[j].w); }
                const float r1 = rsqrtf(wave_sum(s) * (1.f / D) + EPS); float s2 = 0.f;
#pragma unroll
                for (int j = 0; j < 4; ++j) { const f32x4 w = ((const f32x4*)(norm_w + D))[lane + 64 * j], g = ldmod(mb + 2 * D, lane + 64 * j);
                    x1[j] = xv[r][j] + g * (mv[j] * r1 * w); s2 += (x1[j].x * x1[j].x + x1[j].y * x1[j].y) + (x1[j].z * x1[j].z + x1[j].w * x1[j].w); }
                const float r2 = rsqrtf(wave_sum(s2) * (1.f / D) + EPS);
                unsigned long long* o8 = (unsigned long long*)(HL + (size_t)m * D) + lane;
#pragma unroll
                for (int j = 0; j < 4; ++j) { const f32x4 w = ((const f32x4*)(norm_w + 2 * D))[lane + 64 * j], sc = ldmod(mb + 3 * D, lane + 64 * j), sh = ldmod(mb + 4 * D, lane + 64 * j);
                    const f32x4 o = x1[j] * r2 * w * (1.f + sc) + sh;
                    o8[64 * j] = (unsigned long long)cvtpk(o.x, o.y) | ((unsigned long long)cvtpk(o.z, o.w) << 32); } } }
    }
    SEAM(8);
    { pg8::Gemm g{HL, W1, D, D, D}; pg8::StaticOrder S; S.init(NT, FF, G, bx); pg8::EpiBf16<3> E{H1, FF}; pg8::gemm_phase(lds, g, S, E); }
    SEAM(9);
    { pg8::Gemm g{H1, W2, FF, FF, FF}; pg8::StaticOrder S; S.init(NT, D, G, bx); pg8::EpiBf16<0> E{MLP, D}; pg8::gemm_phase(lds, g, S, E); }
    SEAM(10);
    for (int m0 = gw; m0 < NT; m0 += 2 * NGW) {
        f32x4 xv[2][4]; u32x2 mx[2][4], ml[2][4];
#pragma unroll
        for (int r = 0; r < 2; ++r) { const int m = m0 + r * NGW; if (m < NT) {
#pragma unroll
                for (int j = 0; j < 4; ++j) { xv[r][j] = ((const f32x4*)(x + (size_t)m * D))[lane + 64 * j]; mx[r][j] = *(const u32x2*)(MIX + (size_t)m * D + 4 * lane + 256 * j);
                    ml[r][j] = *(const u32x2*)(MLP + (size_t)m * D + 4 * lane + 256 * j); } } }
#pragma unroll
        for (int r = 0; r < 2; ++r) { const int m = m0 + r * NGW; if (m < NT) { const float* mb = MOD + (size_t)(m >> 12) * INC;
                f32x4 mv[4], lv[4]; float s = 0.f, s3 = 0.f;
#pragma unroll
                for (int j = 0; j < 4; ++j) { mv[j] = (f32x4){pg8::bflo(mx[r][j].x), pg8::bfhi(mx[r][j].x), pg8::bflo(mx[r][j].y), pg8::bfhi(mx[r][j].y)}; s += (mv[j].x * mv[j].x + mv[j].y * mv[j].y) + (mv[j].z * mv[j].z + mv[j].w * mv[j].w);
                    lv[j] = (f32x4){pg8::bflo(ml[r][j].x), pg8::bfhi(ml[r][j].x), pg8::bflo(ml[r][j].y), pg8::bfhi(ml[r][j].y)}; s3 += (lv[j].x * lv[j].x + lv[j].y * lv[j].y) + (lv[j].z * lv[j].z + lv[j].w * lv[j].w); }
                const float r1 = rsqrtf(wave_sum(s) * (1.f / D) + EPS), r3 = rsqrtf(wave_sum(s3) * (1.f / D) + EPS);
#pragma unroll
                for (int j = 0; j < 4; ++j) { const f32x4 w1 = ((const f32x4*)(norm_w + D))[lane + 64 * j], g2 = ldmod(mb + 2 * D, lane + 64 * j);
                    const f32x4 w3 = ((const f32x4*)(norm_w + 3 * D))[lane + 64 * j], g5 = ldmod(mb + 5 * D, lane + 64 * j);
                    const f32x4 x1 = xv[r][j] + g2 * (mv[j] * r1 * w1);
                    ((f32x4*)(P.out + (size_t)m * D))[lane + 64 * j] = x1 + g5 * (lv[j] * r3 * w3); } } }
    }
#if PROBE_MASK
    { const unsigned long long _t = __builtin_amdgcn_s_memrealtime(); if ((PROBE_MASK >> 11) & 1) t_spin += _t - t_prev;
      if (bx == 0) { const unsigned long long t0 = __builtin_amdgcn_s_memrealtime(); while (__builtin_amdgcn_s_memrealtime() - t0 < t_spin) __builtin_amdgcn_s_sleep(8); } }
#endif
#if PROBE_XSYNC
    for (int i = 0; i < PROBE_XSYNC; ++i) grid.sync();
#endif
}
}

extern "C" void kernel_launch(void* const* d_in, const int* in_sizes, int n_in, void* d_out, int out_size, void* d_ws, size_t ws_size, hipStream_t stream) {
    static int grid = 0;
    if (grid == 0) {
        if (n_in != 24 || ws_size < WS_END) { fprintf(stderr, "kernel_launch: unexpected n_in %d / ws_size %zu\n", n_in, ws_size); grid = -1; return; }
        int dev = 0, cus = 0, per_cu = 0;
        hipGetDevice(&dev); hipDeviceGetAttribute(&cus, hipDeviceAttributeMultiprocessorCount, dev);
        hipFuncSetAttribute((const void*)mega, hipFuncAttributeMaxDynamicSharedMemorySize, LDS_BYTES);
        hipOccupancyMaxActiveBlocksPerMultiprocessor(&per_cu, (const void*)mega, 512, LDS_BYTES);
        if (per_cu < 1) { fprintf(stderr, "kernel_launch: occupancy query says %d blocks per CU\n", per_cu); grid = -1; return; }
        grid = cus;
        if (grid < 256) { fprintf(stderr, "kernel_launch: this kernel needs at least 256 compute units (found %d)\n", cus); grid = -1; return; }
    }
    if (grid < 0) return;
    if (hipMemsetAsync(d_ws, 0, 65536, stream) != hipSuccess) { fprintf(stderr, "kernel_launch: memset failed\n"); return; }
    Params p{};
    for (int i = 0; i < 24; ++i) p.in[i] = (const float*)d_in[i];
    p.out = (float*)d_out; p.ws = (unsigned char*)d_ws;
    void* args[] = {&p};
    hipError_t e = hipLaunchCooperativeKernel((const void*)mega, dim3(grid), dim3(512), args, LDS_BYTES, stream);
    if (e != hipSuccess) fprintf(stderr, "cooperative launch failed: %s (grid %d)\n", hipGetErrorString(e), grid);
}
```

```cpp
#include <hip/hip_runtime.h>
#include <hip/hip_cooperative_groups.h>
#include <cstdio>
#include <math.h>
namespace cg = cooperative_groups;
#ifndef USE_GRID_SYNC
#define USE_GRID_SYNC 0
#endif
#if !USE_GRID_SYNC
#define NO_GRID_SYNC 1
#endif
#ifndef PROBE_MASK
#define PROBE_MASK 0
#endif
#ifndef P1_ROWS
#define P1_ROWS 4
#endif
#ifndef PROBE_XSYNC
#define PROBE_XSYNC 0
#endif
#ifndef PROBE_BUSY_PHASE
#define PROBE_BUSY_PHASE -1
#define PROBE_BUSY_BLOCK 0
#endif

namespace pg8 {
#define PG8_LAS __attribute__((address_space(3)))
typedef unsigned short bf16_t;
typedef short bf16x8 __attribute__((ext_vector_type(8)));
typedef float f32x4 __attribute__((ext_vector_type(4)));
typedef unsigned u32x4 __attribute__((ext_vector_type(4)));
typedef unsigned u32x2 __attribute__((ext_vector_type(2)));
#ifndef PG8_WGM
#define PG8_WGM 8
#endif
constexpr int BM = 256, BK = 64, HALF = 128, HTB = HALF * BK * 2, STAGE_BYTES = 8 * HTB, NXCD = 8, WGM = PG8_WGM;

__device__ __forceinline__ int lds_byte(int r, int c) { const int st = (r >> 4) * 2 + (c >> 5), rr = r & 15, cc = c & 31, ob = rr * 64 + cc * 2; return st * 1024 + (ob ^ (((ob >> 9) & 1) << 5)); }
__device__ __forceinline__ void stage_rc(int b, int& R, int& C) { const int st = b / 1024, sb = b % 1024, swz = sb ^ (((sb >> 9) & 1) << 5); R = (st >> 1) * 16 + swz / 64; C = (st & 1) * 32 + (swz % 64) / 2; }
__device__ __forceinline__ int perm32(int rho) { const int n = rho >> 4, i = rho & 15; return 8 * (i >> 2) + 4 * n + (i & 3); }

struct Unit { int pm, pn, kb, pass; };
struct Gemm { const bf16_t* A; const bf16_t* Bt; int lda, ldb, K; };

struct StaticOrder {
    int nM, nN, nwg, G, c;
    __device__ void init(int M, int N, int G_, int c_) { nM = M / BM; nN = N / BM; nwg = nM * nN; G = G_; c = c_; }
    __device__ bool next(int i, Unit& u) const {
        const long L = (long)i * G + c; if (L >= nwg) return false;
        int wgid = (int)L; { const int q = nwg / NXCD, r = nwg % NXCD, xcd = wgid % NXCD, off = wgid / NXCD; wgid = (xcd < r ? xcd * (q + 1) : r * (q + 1) + (xcd - r) * q) + off; }
        const int nig = WGM * nN, gid = wgid / nig, fm = gid * WGM, gsz = (nM - fm) < WGM ? (nM - fm) : WGM;
        u.pm = fm + ((wgid % nig) % gsz); u.pn = (wgid % nig) / gsz; u.kb = 0; u.pass = 0; return true;
    }
};

struct TwoPassOrder {
    StaticOrder base; int kbytes;
    __device__ bool next(int i, Unit& u) const { if (!base.next(i >> 1, u)) return false; u.pass = i & 1; u.kb = (i & 1) * kbytes; return true; }
};
__device__ __forceinline__ unsigned cvt_pk_bf16(float lo, float hi) { unsigned r; asm volatile("v_cvt_pk_bf16_f32 %0, %1, %2" : "=v"(r) : "v"(lo), "v"(hi)); return r; }
__device__ __forceinline__ float sigm(float x) { return __builtin_amdgcn_rcpf(1.0f + __builtin_amdgcn_exp2f(-1.4426950408889634f * x)); }
__device__ __forceinline__ float bflo(unsigned u) { return __uint_as_float(u << 16); }
__device__ __forceinline__ float bfhi(unsigned u) { return __uint_as_float(u & 0xffff0000u); }

template <int ACT  > struct EpiBf16 {
    static constexpr bool PERM = true;
    bf16_t* O; int ldc;
    __device__ __forceinline__ void operator()(const f32x4 (&acc)[2][2][4][2], const Unit& u, int wr, int wc, int fr, int fq) const {
        const int row0 = u.pm * BM + wr * 64 + fr, col0 = u.pn * BM + wc * 32 + 8 * fq;
#pragma unroll
        for (int ai = 0; ai < 2; ++ai)
#pragma unroll
            for (int m = 0; m < 4; ++m) { bf16_t* rowp = O + (size_t)(row0 + ai * HALF + m * 16) * ldc + col0;
#pragma unroll
                for (int bj = 0; bj < 2; ++bj) { f32x4 v0 = acc[ai][bj][m][0], v1 = acc[ai][bj][m][1];
                    if (ACT == 3) {
#pragma unroll
                        for (int j = 0; j < 4; ++j) { const float a = fmaxf(v0[j], 0.f), b = fmaxf(v1[j], 0.f); v0[j] = a * a; v1[j] = b * b; } }
                    u32x4 w; w.x = cvt_pk_bf16(v0[0], v0[1]); w.y = cvt_pk_bf16(v0[2], v0[3]); w.z = cvt_pk_bf16(v1[0], v1[1]); w.w = cvt_pk_bf16(v1[2], v1[3]);
                    *(u32x4*)(rowp + bj * HALF) = w; } }
    }
};
struct EpiG1 {
    static constexpr bool PERM = true;
    bf16_t *PI, *PZ, *PQ, *PG, *GATES; const float* LBv; int ctx;
    __device__ __forceinline__ void operator()(const f32x4 (&acc)[2][2][4][2], const Unit& u, int wr, int wc, int fr, int fq) const {
        const int pn = u.pn; bf16_t* base; int ld, cb, act;
        if (ctx) { base = PI; ld = 1536; cb = pn * 256; act = pn < 2 ? 0 : 3; }
        else if (pn < 2) { base = PI; ld = 512; cb = pn * 256; act = 0; }
        else if (pn < 6) { base = PZ; ld = 1024; cb = (pn - 2) * 256; act = 3; }
        else if (pn < 8) { base = PQ; ld = 512; cb = (pn - 6) * 256; act = 1; }
        else if (pn < 10) { base = PG; ld = 512; cb = (pn - 8) * 256; act = 1; }
        else { base = GATES; ld = 2048; cb = (pn - 10) * 128; act = 2; }
        const int row0 = u.pm * BM + wr * 64 + fr, col0 = cb + wc * 32 + 8 * fq;
        if (act == 2) {
#pragma unroll
            for (int ai = 0; ai < 2; ++ai)
#pragma unroll
                for (int m = 0; m < 4; ++m) { bf16_t* rowp = base + (size_t)(row0 + ai * HALF + m * 16) * ld + col0; f32x4 rh[2], gb[2];
#pragma unroll
                    for (int n = 0; n < 2; ++n)
#pragma unroll
                        for (int j = 0; j < 4; ++j) { const float eA = __builtin_amdgcn_exp2f(-1.4426950408889634f * acc[ai][0][m][n][j]), eB = __builtin_amdgcn_exp2f(-1.4426950408889634f * acc[ai][1][m][n][j]);
                            gb[n][j] = __builtin_amdgcn_rcpf(1.0f + eB); rh[n][j] = (1.0f + eB) * __builtin_amdgcn_rcpf(1.0f + eA); }
                    u32x4 w; w.x = cvt_pk_bf16(rh[0][0], rh[0][1]); w.y = cvt_pk_bf16(rh[0][2], rh[0][3]); w.z = cvt_pk_bf16(rh[1][0], rh[1][1]); w.w = cvt_pk_bf16(rh[1][2], rh[1][3]);
                    *(u32x4*)rowp = w;
                    w.x = cvt_pk_bf16(gb[0][0], gb[0][1]); w.y = cvt_pk_bf16(gb[0][2], gb[0][3]); w.z = cvt_pk_bf16(gb[1][0], gb[1][1]); w.w = cvt_pk_bf16(gb[1][2], gb[1][3]);
                    *(u32x4*)(rowp + 1024) = w; }
            return;
        }
        f32x4 om[2][2];
        if (act == 3) {
#pragma unroll
            for (int bj = 0; bj < 2; ++bj)
#pragma unroll
                for (int n = 0; n < 2; ++n) { const f32x4 l = *(const f32x4*)(LBv + ((col0 + bj * HALF + 4 * n) & 511)); om[bj][n] = (f32x4){1.f - l.x, 1.f - l.y, 1.f - l.z, 1.f - l.w}; } }
#pragma unroll
        for (int ai = 0; ai < 2; ++ai)
#pragma unroll
            for (int m = 0; m < 4; ++m) { bf16_t* rowp = base + (size_t)(row0 + ai * HALF + m * 16) * ld + col0;
#pragma unroll
                for (int bj = 0; bj < 2; ++bj) { f32x4 v0 = acc[ai][bj][m][0], v1 = acc[ai][bj][m][1];
                    if (act == 3) {
#pragma unroll
                        for (int j = 0; j < 4; ++j) { v0[j] = om[bj][0][j] * sigm(-v0[j]); v1[j] = om[bj][1][j] * sigm(-v1[j]); } }
                    else if (act != 0) {
#pragma unroll
                        for (int j = 0; j < 4; ++j) { const float s0 = sigm(v0[j]), s1 = sigm(v1[j]); v0[j] = act == 1 ? v0[j] * s0 : s0; v1[j] = act == 1 ? v1[j] * s1 : s1; } }
                    u32x4 w; w.x = cvt_pk_bf16(v0[0], v0[1]); w.y = cvt_pk_bf16(v0[2], v0[3]); w.z = cvt_pk_bf16(v1[0], v1[1]); w.w = cvt_pk_bf16(v1[2], v1[3]);
                    *(u32x4*)(rowp + bj * HALF) = w; } }
    }
};
struct EpiMerge2 {
    static constexpr bool PERM = true;
    bf16_t* O; const bf16_t* RG;
    __device__ __forceinline__ void operator()(f32x4 (&acc)[2][2][4][2], const Unit& u, int wr, int wc, int fr, int fq) const {
        const int row0 = u.pm * BM + wr * 64 + fr, col0 = u.pn * BM + wc * 32 + 8 * fq; const int goff = u.pass ? 1024 : 0;
#pragma unroll
        for (int ai = 0; ai < 2; ++ai)
#pragma unroll
            for (int m = 0; m < 4; ++m) { const size_t r = (size_t)(row0 + ai * HALF + m * 16);
#pragma unroll
                for (int bj = 0; bj < 2; ++bj) { f32x4 v0 = acc[ai][bj][m][0], v1 = acc[ai][bj][m][1];
                    const u32x4 g = *(const u32x4*)(RG + r * 2048 + goff + col0 + bj * HALF);
                    v0[0] *= bflo(g.x); v0[1] *= bfhi(g.x); v0[2] *= bflo(g.y); v0[3] *= bfhi(g.y); v1[0] *= bflo(g.z); v1[1] *= bfhi(g.z); v1[2] *= bflo(g.w); v1[3] *= bfhi(g.w);
                    if (u.pass == 0) { acc[ai][bj][m][0] = v0; acc[ai][bj][m][1] = v1; }
                    else { u32x4 w; w.x = cvt_pk_bf16(v0[0], v0[1]); w.y = cvt_pk_bf16(v0[2], v0[3]); w.z = cvt_pk_bf16(v1[0], v1[1]); w.w = cvt_pk_bf16(v1[2], v1[3]);
                        *(u32x4*)(O + r * 1024 + col0 + bj * HALF) = w; } } }
    }
};

#ifndef PG8_SP2
#define PG8_SP2 true
#endif
#ifndef PG8_ALIGN
#define PG8_ALIGN true
#endif
template <class Epi, class Sched, bool ALIGN_EPI = PG8_ALIGN, bool SP2 = PG8_SP2>
__device__ __forceinline__ void gemm_phase(PG8_LAS unsigned char* lds, const Gemm g, const Sched& S, const Epi& E) {
    const int tid = threadIdx.x, wid = __builtin_amdgcn_readfirstlane(tid >> 6), lane = tid & 63, wr = wid >> 2, wc = wid & 3, fr = lane & 15, fq = lane >> 4;
    const int nt = g.K / BK;
    unsigned voffA[2], voffB[2];
#pragma unroll
    for (int i = 0; i < 2; ++i) { int R, C; stage_rc(tid * 16 + i * 8192, R, C); const int Rb = Epi::PERM ? ((R & ~31) + perm32(R & 31)) : R;
        voffA[i] = (unsigned)(R * g.lda + C) * 2u; voffB[i] = (unsigned)(Rb * g.ldb + C) * 2u; }
    const size_t kstep = (size_t)(BK * 2);
    const size_t hstepA = (size_t)HALF * g.lda * 2, hstepB = (size_t)HALF * g.ldb * 2;
    const size_t tstepA = 2 * hstepA, tstepB = 2 * hstepB;
    const unsigned ldsw = (unsigned)wid * 1024u;
    const int aoff = lds_byte(wr * 64 + fr, fq * 8), boff = lds_byte(wc * 32 + fr, fq * 8);
#define PG8_SA(b, h) (((b) * 2 + (h)) * HTB)
#define PG8_SB(b, h) ((4 + (b) * 2 + (h)) * HTB)
#define PG8_STAGE(bufoff, gbase, voff) do { _Pragma("unroll") for (int _i = 0; _i < 2; ++_i) \
        __builtin_amdgcn_global_load_lds((const unsigned*)((const char*)(gbase) + (voff)[_i]), (PG8_LAS unsigned*)(lds + (bufoff) + ldsw + _i * 8192), 16, 0, 0); } while (0)
#define PG8_LDA(dst, b, h) do { _Pragma("unroll") for (int m = 0; m < 4; ++m) _Pragma("unroll") for (int k = 0; k < 2; ++k) dst[m][k] = *(const PG8_LAS bf16x8*)(lds + PG8_SA(b, h) + aoff + m * 2048 + k * 1024); } while (0)
#define PG8_LDB(dst, b, h) do { _Pragma("unroll") for (int n = 0; n < 2; ++n) _Pragma("unroll") for (int k = 0; k < 2; ++k) dst[n][k] = *(const PG8_LAS bf16x8*)(lds + PG8_SB(b, h) + boff + n * 2048 + k * 1024); } while (0)
#define PG8_MMA(ai, bj, At, Bt) do { __builtin_amdgcn_s_setprio(1); _Pragma("unroll") for (int m = 0; m < 4; ++m) _Pragma("unroll") for (int n = 0; n < 2; ++n) _Pragma("unroll") for (int k = 0; k < 2; ++k) \
        acc[ai][bj][m][n] = __builtin_amdgcn_mfma_f32_16x16x32_bf16(Bt[n][k], At[m][k], acc[ai][bj][m][n], 0, 0, 0); __builtin_amdgcn_s_setprio(0); } while (0)
#define PG8_WAIT_V(n) asm volatile("s_waitcnt vmcnt(" #n ")" ::: "memory")
#define PG8_WAIT_L(n) asm volatile("s_waitcnt lgkmcnt(" #n ")" ::: "memory")
#define PG8_BAR __builtin_amdgcn_s_barrier()
#define PG8_SCHED __builtin_amdgcn_sched_barrier(0)
    Unit cur, nxt; int ui = 0;
    if (!S.next(0, cur)) return;
    f32x4 acc[2][2][4][2];
#pragma unroll
    for (int a = 0; a < 2; ++a)
#pragma unroll
        for (int b = 0; b < 2; ++b)
#pragma unroll
            for (int m = 0; m < 4; ++m)
#pragma unroll
                for (int n = 0; n < 2; ++n) acc[a][b][m][n] = (f32x4){0.f, 0.f, 0.f, 0.f};
    bf16x8 At[4][2], B0[2][2], B1[2][2];
    const char* cA = (const char*)g.A + (size_t)cur.pm * tstepA + cur.kb; const char* cB = (const char*)g.Bt + (size_t)cur.pn * tstepB + cur.kb;
    if constexpr (SP2) {
        PG8_STAGE(PG8_SB(0, 0), cB, voffB); PG8_STAGE(PG8_SB(0, 1), cB + hstepB, voffB); PG8_STAGE(PG8_SA(0, 0), cA, voffA); PG8_STAGE(PG8_SA(0, 1), cA + hstepA, voffA);
        if (wr == 1) PG8_BAR;
        PG8_WAIT_V(2); PG8_BAR;
        PG8_STAGE(PG8_SB(1, 0), cB + kstep, voffB); PG8_STAGE(PG8_SA(1, 0), cA + kstep, voffA); PG8_STAGE(PG8_SB(1, 1), cB + hstepB + kstep, voffB);
        PG8_WAIT_V(6); PG8_BAR;
    } else {
        PG8_STAGE(PG8_SB(0, 0), cB, voffB); PG8_STAGE(PG8_SA(0, 0), cA, voffA); PG8_STAGE(PG8_SB(0, 1), cB + hstepB, voffB); PG8_STAGE(PG8_SA(0, 1), cA + hstepA, voffA);
        if (wr == 1) PG8_BAR;
        PG8_WAIT_V(4); PG8_BAR;
        PG8_STAGE(PG8_SB(1, 0), cB + kstep, voffB); PG8_STAGE(PG8_SA(1, 0), cA + kstep, voffA); PG8_STAGE(PG8_SB(1, 1), cB + hstepB + kstep, voffB);
        PG8_WAIT_V(6); PG8_BAR;
    }
    for (;;) {
        const bool has_next = S.next(ui + 1, nxt);
        const char* nA = has_next ? (const char*)g.A + (size_t)nxt.pm * tstepA + nxt.kb : cA; const char* nB = has_next ? (const char*)g.Bt + (size_t)nxt.pn * tstepB + nxt.kb : cB;
        for (int t = 0; t < nt; t += 2) {
            const bool last = (t == nt - 2);
            const char* a1 = cA + (size_t)(t + 1) * kstep;
            const char* a2 = last ? nA : cA + (size_t)(t + 2) * kstep; const char* b2 = last ? nB : cB + (size_t)(t + 2) * kstep;
            const char* a3 = a2 + kstep; const char* b3 = b2 + kstep;
            if constexpr (SP2) {
            PG8_LDB(B0, 0, 0); PG8_LDB(B1, 0, 1); PG8_SCHED; PG8_LDA(At, 0, 0); PG8_STAGE(PG8_SA(1, 1), a1 + hstepA, voffA);
            PG8_WAIT_V(8); PG8_WAIT_L(0); PG8_BAR; PG8_MMA(0, 0, At, B0); PG8_MMA(0, 1, At, B1); PG8_BAR; PG8_SCHED;
            PG8_LDA(At, 0, 1); PG8_STAGE(PG8_SB(0, 0), b2, voffB); PG8_STAGE(PG8_SB(0, 1), b2 + hstepB, voffB); PG8_STAGE(PG8_SA(0, 0), a2, voffA);
            PG8_WAIT_V(8); PG8_WAIT_L(0); PG8_BAR; PG8_MMA(1, 0, At, B0); PG8_MMA(1, 1, At, B1); PG8_BAR; PG8_SCHED;
            PG8_LDB(B0, 1, 0); PG8_LDB(B1, 1, 1); PG8_SCHED; PG8_LDA(At, 1, 0); PG8_STAGE(PG8_SA(0, 1), a2 + hstepA, voffA);
            PG8_WAIT_V(8); PG8_WAIT_L(0); PG8_BAR; PG8_MMA(0, 0, At, B0); PG8_MMA(0, 1, At, B1); PG8_BAR; PG8_SCHED;
            PG8_LDA(At, 1, 1); PG8_STAGE(PG8_SB(1, 0), b3, voffB); PG8_STAGE(PG8_SB(1, 1), b3 + hstepB, voffB); PG8_STAGE(PG8_SA(1, 0), a3, voffA);
            PG8_WAIT_V(8); PG8_WAIT_L(0); PG8_BAR; PG8_MMA(1, 0, At, B0); PG8_MMA(1, 1, At, B1); PG8_BAR; PG8_SCHED;
            } else {
            PG8_LDB(B0, 0, 0); PG8_SCHED; PG8_LDA(At, 0, 0); PG8_STAGE(PG8_SA(1, 1), a1 + hstepA, voffA);
            PG8_WAIT_L(8); PG8_BAR; PG8_WAIT_L(0); PG8_MMA(0, 0, At, B0); PG8_BAR; PG8_SCHED;
            PG8_LDB(B1, 0, 1); PG8_STAGE(PG8_SB(0, 0), b2, voffB);
            PG8_BAR; PG8_WAIT_L(0); PG8_MMA(0, 1, At, B1); PG8_BAR;
            PG8_LDA(At, 0, 1); PG8_STAGE(PG8_SA(0, 0), a2, voffA);
            PG8_BAR; PG8_WAIT_L(0); PG8_MMA(1, 0, At, B0); PG8_BAR; PG8_SCHED;
            PG8_STAGE(PG8_SB(0, 1), b2 + hstepB, voffB);
            PG8_WAIT_V(6); PG8_BAR; PG8_MMA(1, 1, At, B1); PG8_BAR;
            PG8_LDB(B0, 1, 0); PG8_SCHED; PG8_LDA(At, 1, 0); PG8_STAGE(PG8_SA(0, 1), a2 + hstepA, voffA);
            PG8_WAIT_L(8); PG8_BAR; PG8_WAIT_L(0); PG8_MMA(0, 0, At, B0); PG8_BAR; PG8_SCHED;
            PG8_LDB(B1, 1, 1); PG8_STAGE(PG8_SB(1, 0), b3, voffB);
            PG8_BAR; PG8_WAIT_L(0); PG8_MMA(0, 1, At, B1); PG8_BAR;
            PG8_LDA(At, 1, 1); PG8_STAGE(PG8_SA(1, 0), a3, voffA);
            PG8_BAR; PG8_WAIT_L(0); PG8_MMA(1, 0, At, B0); PG8_BAR; PG8_SCHED;
            PG8_STAGE(PG8_SB(1, 1), b3 + hstepB, voffB);
            PG8_WAIT_V(6); PG8_BAR; PG8_MMA(1, 1, At, B1); PG8_BAR;
                    }
        }
        if constexpr (ALIGN_EPI) { if (wr == 0) PG8_BAR; }
        E(acc, cur, wr, wc, fr, fq);
        if (!has_next) break;
        if (nxt.pass == 0) {
#pragma unroll
        for (int a = 0; a < 2; ++a)
#pragma unroll
            for (int b = 0; b < 2; ++b)
#pragma unroll
                for (int m = 0; m < 4; ++m)
#pragma unroll
                    for (int n = 0; n < 2; ++n) acc[a][b][m][n] = (f32x4){0.f, 0.f, 0.f, 0.f};
        }
        cur = nxt; cA = nA; cB = nB; ++ui;
        if constexpr (ALIGN_EPI) { if (wr == 1) PG8_BAR; }
    }
    PG8_WAIT_V(0);
    if constexpr (!ALIGN_EPI) { if (wr == 0) PG8_BAR; }
    PG8_BAR;
#undef PG8_SA
#undef PG8_SB
#undef PG8_STAGE
#undef PG8_LDA
#undef PG8_LDB
#undef PG8_MMA
#undef PG8_WAIT_V
#undef PG8_WAIT_L
#undef PG8_BAR
#undef PG8_SCHED
}
}

namespace {
using pg8::bf16_t; using pg8::f32x4; using pg8::u32x4; using pg8::u32x2;
#define LAS __attribute__((address_space(3)))
constexpr int D = 1024, NB = 8, L = 4096, LC = 256, INC = 6144, FF = 4096, HW = 512;
constexpr int NT = NB * L, NCX = NB * LC;
constexpr float EPS = 1e-6f;
constexpr size_t MiB = 1u << 20;
constexpr size_t WS_MOD = 64 * 1024, WS_LB = 512 * 1024, WS_GT = 2 * MiB  ;
constexpr size_t WS_WIN = 18 * MiB, WS_WPAB = 30 * MiB, WS_WOUT = 32 * MiB, WS_W1 = 34 * MiB, WS_W2 = 42 * MiB;
constexpr size_t WS_STATE = 10 * MiB  , WS_HCTX = 50 * MiB, WS_PCTX = 54 * MiB, WS_SCTX = 60 * MiB;
constexpr size_t WS_HLAT = 64 * MiB;
constexpr size_t WS_PI = 128 * MiB, WS_PZ = 160 * MiB, WS_PQ = 224 * MiB, WS_PG = 256 * MiB, WS_GATES = 288 * MiB, WS_PHYT = 416 * MiB;
constexpr size_t WS_AY = 160 * MiB;
constexpr size_t WS_AY2 = 64 * MiB;
constexpr size_t WS_MERGED = 128 * MiB;
constexpr size_t WS_MIX = 448 * MiB, WS_MLP = 384 * MiB, WS_H1 = 128 * MiB, WS_HL = 64 * MiB;
constexpr size_t WS_END = 512 * MiB;
constexpr int LDS_BYTES = 163840;

__device__ __forceinline__ float bf2f(bf16_t h) { return __uint_as_float(((unsigned)h) << 16); }
__device__ __forceinline__ unsigned f2bf(float f) { unsigned u = __float_as_uint(f); return (u + 0x7fffu + ((u >> 16) & 1u)) >> 16; }
__device__ __forceinline__ unsigned pk2(float lo, float hi) { return f2bf(lo) | (f2bf(hi) << 16); }
__device__ __forceinline__ float sigmoidf_(float x) { return 1.f / (1.f + expf(-x)); }
__device__ __forceinline__ float siluf_(float x) { return x / (1.f + expf(-x)); }
__device__ __forceinline__ float wave_sum(float v) {
#pragma unroll
    for (int o = 1; o < 64; o <<= 1) v += __shfl_xor(v, o);
    return v;
}
#define LDS_WAIT() asm volatile("s_waitcnt lgkmcnt(0)" ::: "memory")

struct Params { const float* in[24]; float* out; unsigned char* ws; };
__device__ __forceinline__ f32x4 ldmod(const float* mb, int i4) { return ((const f32x4*)mb)[i4]; }

#define XB_TMO      128
#define XB_XCNT(j)  (256  + 64 * (j))
#define XB_XSUB(j)  (1280 + 64 * (j))
#define XB_XGEN(j)  (2304 + 64 * (j))
#define XB_TOP      3328
#define XB_TOPGEN   3392
#define XCD_BAR_WORDS 3456
#define XB_SPIN_CAP (1u << 18)

__device__ __forceinline__ unsigned xb_ld(unsigned* p)              { return __hip_atomic_load(p, __ATOMIC_RELAXED, __HIP_MEMORY_SCOPE_AGENT); }
__device__ __forceinline__ unsigned xb_add(unsigned* p, unsigned v) { return __hip_atomic_fetch_add(p, v, __ATOMIC_RELAXED, __HIP_MEMORY_SCOPE_AGENT); }
__device__ __forceinline__ unsigned xb_xcc_id() { return (unsigned)__builtin_amdgcn_s_getreg((3 << 11) | 20) & 0xFu; }
#define XB_SPIN(cond, bar) do { unsigned _sp = 0; while (cond) { __builtin_amdgcn_s_sleep(1); \
    if ((++_sp & 255u) == 0u) { if (xb_ld(&(bar)[XB_TMO])) break; if (_sp > XB_SPIN_CAP) { atomicAdd(&(bar)[XB_TMO], 1u); break; } } } } while (0)

struct XcdBarrier {
    unsigned* bar; unsigned x;
    volatile LAS unsigned* st;
};

__device__ __forceinline__ XcdBarrier xcd_barrier_post(unsigned* bar, volatile LAS unsigned* st) {
    XcdBarrier b; b.bar = bar; b.x = xb_xcc_id(); b.st = st;
    if (threadIdx.x == 0) (void)xb_add(&bar[XB_XCNT(b.x)], 1u);
    return b;
}
__device__ __forceinline__ void xcd_barrier_complete(unsigned* bar, unsigned x, unsigned& nloc, unsigned& nx) {
    const unsigned G = gridDim.x * gridDim.y * gridDim.z;
    unsigned sum, cnt, mine, sp = 0u;
    for (;;) {
        sum = 0u; cnt = 0u; mine = 0u;
#pragma unroll
        for (unsigned j = 0; j < 16; ++j) { const unsigned c = xb_ld(&bar[XB_XCNT(j)]); sum += c; cnt += (c > 0u) ? 1u : 0u; mine = (j == x) ? c : mine; }
        if (sum == G) break;
        __builtin_amdgcn_s_sleep(1);
        if ((++sp & 255u) == 0u) { if (xb_ld(&bar[XB_TMO])) break; if (sp > XB_SPIN_CAP) { atomicAdd(&bar[XB_TMO], 1u); break; } }
    }
    nloc = mine > 0u ? mine : 1u; nx = cnt > 0u ? cnt : 1u;
}

__device__ __forceinline__ void xcd_barrier(const XcdBarrier& b) {
    asm volatile("s_waitcnt vmcnt(0)" ::: "memory");
    __syncthreads();
    if (threadIdx.x == 0) {
        unsigned* bar = b.bar;
        __builtin_amdgcn_s_waitcnt(0);
        unsigned nloc = b.st[0], nx = b.st[1];
        if (nloc == 0u) { xcd_barrier_complete(bar, b.x, nloc, nx); b.st[0] = nloc; b.st[1] = nx; }
        const unsigned old = xb_add(&bar[XB_XSUB(b.x)], 1u);
        const unsigned gen = old / nloc;
        if (old + 1u == (gen + 1u) * nloc) {
            __builtin_amdgcn_fence(__ATOMIC_RELEASE, "agent");
            asm volatile("s_waitcnt vmcnt(0)" ::: "memory");
            const unsigned og = xb_add(&bar[XB_TOP], 1u);
            const unsigned tg = og / nx;
            if (og + 1u == (tg + 1u) * nx) xb_add(&bar[XB_TOPGEN], 1u);
            else XB_SPIN(xb_ld(&bar[XB_TOPGEN]) == tg, bar);
            __builtin_amdgcn_fence(__ATOMIC_ACQUIRE, "agent");
            xb_add(&bar[XB_XGEN(b.x)], 1u);
            asm volatile("s_waitcnt vmcnt(0)" ::: "memory");
        } else {
            XB_SPIN(xb_ld(&bar[XB_XGEN(b.x)]) == gen, bar);
            __builtin_amdgcn_fence(__ATOMIC_ACQUIRE, "agent");
            asm volatile("s_waitcnt vmcnt(0)" ::: "memory");
        }
    }
    __syncthreads();
}


__device__ __forceinline__ void transpose_item(const float* W, int N, bf16_t* WT, int ldk, int koff, int remap, LAS float* scr, int item, int lane) {
    const int nblk = N / 32, kb = item / nblk, nb = item % nblk, k0 = 64 * kb, n0 = 32 * nb;
    int rbase = n0;
    if (remap) { if (n0 < 2560) rbase = n0; else if (n0 < 4096) rbase = n0 + 2048;
        else { const int g = n0 - 4096, nn = g & 1023; rbase = 2560 + 256 * (nn >> 7) + (g >= 1024 ? 128 : 0) + (nn & 127); } }
#pragma unroll 8
    for (int i = 0; i < 32; ++i) { const int kk = 2 * i + (lane >> 5); scr[kk * 33 + (lane & 31)] = W[(size_t)(k0 + kk) * N + n0 + (lane & 31)]; }
    LDS_WAIT();
    const int c = lane & 7;
#pragma unroll
    for (int j = 0; j < 4; ++j) { const int n = (lane >> 3) + 8 * j; const LAS float* s = scr + (8 * c) * 33 + n;
        u32x4 o; o.x = pk2(s[0 * 33], s[1 * 33]); o.y = pk2(s[2 * 33], s[3 * 33]); o.z = pk2(s[4 * 33], s[5 * 33]); o.w = pk2(s[6 * 33], s[7 * 33]);
        *(u32x4*)(WT + (size_t)(rbase + n) * ldk + koff + k0 + 8 * c) = o; }
    LDS_WAIT();
}

__device__ __forceinline__ void row_norm_mod_bf16(const float* xrow, const float* nw, const float* scale, const float* shift, bf16_t* orow, int lane) {
    const f32x4* xr = (const f32x4*)xrow + lane; f32x4 v[4]; float s = 0.f;
#pragma unroll
    for (int j = 0; j < 4; ++j) { v[j] = xr[64 * j]; s += (v[j].x * v[j].x + v[j].y * v[j].y) + (v[j].z * v[j].z + v[j].w * v[j].w); }
    const float r = rsqrtf(wave_sum(s) * (1.f / D) + EPS);
    unsigned long long* o8 = (unsigned long long*)orow + lane;
#pragma unroll
    for (int j = 0; j < 4; ++j) { const f32x4 w = ((const f32x4*)nw)[lane + 64 * j], sc = ((const f32x4*)scale)[lane + 64 * j], sh = ((const f32x4*)shift)[lane + 64 * j];
        const f32x4 o = v[j] * r * w * (1.f + sc) + sh;
        o8[64 * j] = (unsigned long long)pk2(o.x, o.y) | ((unsigned long long)pk2(o.z, o.w) << 32); }
}
__device__ __forceinline__ f32x4 ld_bf4(const bf16_t* p) { const u32x2 u = *(const u32x2*)p; return (f32x4){pg8::bflo(u.x), pg8::bfhi(u.x), pg8::bflo(u.y), pg8::bfhi(u.y)}; }
__device__ __forceinline__ void row_x1(const float* xrow, const bf16_t* mixrow, const float* nw1, const float* g2, f32x4 (&x1)[4], int lane) {
    f32x4 mv[4]; float s = 0.f;
#pragma unroll
    for (int j = 0; j < 4; ++j) { mv[j] = ld_bf4(mixrow + 4 * lane + 256 * j); s += (mv[j].x * mv[j].x + mv[j].y * mv[j].y) + (mv[j].z * mv[j].z + mv[j].w * mv[j].w); }
    const float r = rsqrtf(wave_sum(s) * (1.f / D) + EPS);
#pragma unroll
    for (int j = 0; j < 4; ++j) { const f32x4 w = ((const f32x4*)nw1)[lane + 64 * j], g = ((const f32x4*)g2)[lane + 64 * j], xv = ((const f32x4*)xrow)[lane + 64 * j];
        x1[j] = xv + g * (mv[j] * r * w); }
}

typedef float f32x16 __attribute__((ext_vector_type(16)));
typedef float f32x2_t __attribute__((ext_vector_type(2)));
typedef __bf16 bf16x2_t __attribute__((ext_vector_type(2)));
__device__ __forceinline__ unsigned cvtpk(float lo, float hi) { const f32x2_t v = {lo, hi}; const bf16x2_t b = __builtin_convertvector(v, bf16x2_t); return __builtin_bit_cast(unsigned, b); }
constexpr int HY_PAD = 256, HY_PITCH = (HY_PAD + 4096 + HY_PAD) * 2 + 16;
constexpr int HY_TAB0 = 8 * HY_PITCH;
constexpr int HY_TAB1 = HY_TAB0 + 17408 + 64;
__device__ __forceinline__ void conv8(const u32x4 raw, float left, float right, float w0, float w1, float w2, float bias, float (&o)[8]) {
    float in[10]; in[0] = left; in[9] = right;
    in[1] = pg8::bflo(raw.x); in[2] = pg8::bfhi(raw.x); in[3] = pg8::bflo(raw.y); in[4] = pg8::bfhi(raw.y); in[5] = pg8::bflo(raw.z); in[6] = pg8::bfhi(raw.z); in[7] = pg8::bflo(raw.w); in[8] = pg8::bfhi(raw.w);
#pragma unroll
    for (int j = 0; j < 8; ++j) o[j] = bias + w0 * in[j] + w1 * in[j + 1] + w2 * in[j + 2];
}
__device__ __forceinline__ void hyena_channel(LAS unsigned char* lds, int c, bf16_t* PHYT, const bf16_t* GTB, const float* hy_sw, const float* hy_sb) {
    const int tid = threadIdx.x, lane = tid & 63, wave = __builtin_amdgcn_readfirstlane(tid >> 6);
    const bool hl = (tid & 7) != 0, hr = ((tid + 1) & 7) != 0;
    __syncthreads();
    for (int ci = tid; ci < 1088; ci += 512) { u32x4 v = (u32x4){0u, 0u, 0u, 0u};
        if (ci >= 32 && ci < 1056) v = *(const u32x4*)(GTB + (size_t)c * 8192 + (ci - 32) * 8);
        *(LAS u32x4*)(lds + HY_TAB0 + ci * 16) = v; }
    {
        const bf16_t* x1r = PHYT + (size_t)(512 + c) * NT + 8 * tid; const bf16_t* vr = PHYT + (size_t)(1024 + c) * NT + 8 * tid;
        const float xw0 = hy_sw[512 + c], xw1 = hy_sw[1536 + 512 + c], xw2 = hy_sw[3072 + 512 + c], xb = hy_sb[512 + c];
        const float vw0 = hy_sw[1024 + c], vw1 = hy_sw[1536 + 1024 + c], vw2 = hy_sw[3072 + 1024 + c], vb = hy_sb[1024 + c];
        u32x4 xa[8], va[8];
#pragma unroll
        for (int b = 0; b < 8; ++b) { xa[b] = *(const u32x4*)(x1r + (size_t)b * L); va[b] = *(const u32x4*)(vr + (size_t)b * L); }
#pragma unroll
        for (int b = 0; b < 8; ++b) {
            const unsigned xpw = __shfl_up(xa[b].w, 1), xnx = __shfl_down(xa[b].x, 1), vpw = __shfl_up(va[b].w, 1), vnx = __shfl_down(va[b].x, 1);
            const float xl = hl ? pg8::bfhi(xpw) : 0.f, xr = hr ? pg8::bflo(xnx) : 0.f, vl = hl ? pg8::bfhi(vpw) : 0.f, vrr = hr ? pg8::bflo(vnx) : 0.f;
            float cx[8], cv[8]; conv8(xa[b], xl, xr, xw0, xw1, xw2, xb, cx); conv8(va[b], vl, vrr, vw0, vw1, vw2, vb, cv);
            u32x4 w; w.x = cvtpk(cx[0] * cv[0], cx[1] * cv[1]); w.y = cvtpk(cx[2] * cv[2], cx[3] * cv[3]); w.z = cvtpk(cx[4] * cv[4], cx[5] * cv[5]); w.w = cvtpk(cx[6] * cv[6], cx[7] * cv[7]);
            *(LAS u32x4*)(lds + b * HY_PITCH + (HY_PAD + 8 * tid) * 2) = w; }
        { const int b = tid >> 6, side = (tid >> 5) & 1, k = tid & 31;
            *(LAS u32x4*)(lds + b * HY_PITCH + (side ? (HY_PAD + 4096) * 2 : 0) + k * 16) = (u32x4){0u, 0u, 0u, 0u}; }
    }
    __syncthreads();
    for (int ci = tid; ci < 1088; ci += 512) { const u32x4 d = *(const LAS u32x4*)(lds + HY_TAB0 + ci * 16); const unsigned d4 = ci < 1087 ? *(const LAS unsigned*)(lds + HY_TAB0 + ci * 16 + 16) : 0u;
        u32x4 o; o.x = __builtin_amdgcn_alignbit(d.y, d.x, 16); o.y = __builtin_amdgcn_alignbit(d.z, d.y, 16); o.z = __builtin_amdgcn_alignbit(d.w, d.z, 16); o.w = __builtin_amdgcn_alignbit(d4, d.w, 16);
        *(LAS u32x4*)(lds + HY_TAB1 + ci * 16) = o; }
    __syncthreads();
    const int T0 = 512 * wave, r = lane & 31, h = lane >> 5, bb = r & 7, tb = r >> 3;
    f32x16 acc[4];
#pragma unroll
    for (int i = 0; i < 4; ++i)
#pragma unroll
        for (int j = 0; j < 16; ++j) acc[i][j] = 0.f;
    {
        const int Dfirst = T0 - 4080;
        const int e0 = 4351 - Dfirst - r + 8 * h;
        const unsigned aaddr0 = (unsigned)((e0 & 1) ? HY_TAB1 : HY_TAB0) + (unsigned)(e0 & ~1) * 2u;
        const unsigned baddr0 = (unsigned)(bb * HY_PITCH + (HY_PAD + T0 + 64 * tb - Dfirst + 8 * h) * 2);
#define HY_LDA(dst, ad) do { u32x4 _t; _t.x = *(const LAS unsigned*)(lds + (ad)); _t.y = *(const LAS unsigned*)(lds + (ad) + 4); _t.z = *(const LAS unsigned*)(lds + (ad) + 8); _t.w = *(const LAS unsigned*)(lds + (ad) + 12); dst = __builtin_bit_cast(pg8::bf16x8, _t); } while (0)
#define HY_LDB(dst, ad) dst = *(const LAS pg8::bf16x8*)(lds + (ad))
#define HY_MMA(i, A, B) acc[i] = __builtin_amdgcn_mfma_f32_32x32x16_bf16(A, B, acc[i], 0, 0, 0)
#define HY_GENERIC(st_lo, st_hi) do { for (int st = (st_lo); st < (st_hi); ++st) { const unsigned aa = aaddr0 - 32u * (unsigned)st, ba = baddr0 - 32u * (unsigned)st; pg8::bf16x8 A; HY_LDA(A, aa); \
            if (st <= 267) { pg8::bf16x8 B; HY_LDB(B, ba); HY_MMA(0, A, B); } \
            if (st >= 2 && st <= 269) { pg8::bf16x8 B; HY_LDB(B, ba + 64); HY_MMA(1, A, B); } \
            if (st >= 16 && st <= 283) { pg8::bf16x8 B; HY_LDB(B, ba + 512); HY_MMA(2, A, B); } \
            if (st >= 18) { pg8::bf16x8 B; HY_LDB(B, ba + 576); HY_MMA(3, A, B); } } } while (0)
        HY_GENERIC(0, 18);
        {
            unsigned aa = aaddr0 - 32u * 18u, ba = baddr0 - 32u * 18u;
            pg8::bf16x8 Aa, Ab, X0, X1, X2, X3, Y0, Y1, Y2, Y3;
            HY_LDB(X0, ba + 64u); HY_LDB(Y0, ba + 64u + 512u);
            HY_LDB(X1, ba + 32u); HY_LDB(Y1, ba + 32u + 512u);
            HY_LDA(Aa, aa); HY_LDB(X2, ba); HY_LDB(Y2, ba + 512u);
#define HY_STEP(Acur, Anext, Xc, Xo, Xn, Yc, Yo, Yn, k) do { \
                HY_LDA(Anext, aa - 32u * ((k) + 1)); HY_LDB(Xn, ba - 32u * ((k) + 1)); HY_LDB(Yn, ba - 32u * ((k) + 1) + 512u); __builtin_amdgcn_sched_barrier(0); \
                HY_MMA(0, Acur, Xc); HY_MMA(1, Acur, Xo); HY_MMA(2, Acur, Yc); HY_MMA(3, Acur, Yo); __builtin_amdgcn_sched_barrier(0); } while (0)
#pragma unroll 1
            for (int it = 0; it < 62; ++it) {
                HY_STEP(Aa, Ab, X2, X0, X3, Y2, Y0, Y3, 0);
                HY_STEP(Ab, Aa, X3, X1, X0, Y3, Y1, Y0, 1);
                HY_STEP(Aa, Ab, X0, X2, X1, Y0, Y2, Y1, 2);
                HY_STEP(Ab, Aa, X1, X3, X2, Y1, Y3, Y2, 3);
                aa -= 128u; ba -= 128u;
            }
#undef HY_STEP
        }
        HY_GENERIC(266, 286);
#undef HY_LDA
#undef HY_LDB
#undef HY_MMA
#undef HY_GENERIC
    }
    __syncthreads();
    {
        const bf16_t* x0r = PHYT + (size_t)c * NT + 8 * tid; u32x4 xa[8];
#pragma unroll
        for (int b = 0; b < 8; ++b) xa[b] = *(const u32x4*)(x0r + (size_t)b * L);
#pragma unroll
        for (int i = 0; i < 4; ++i)
#pragma unroll
            for (int g = 0; g < 4; ++g) { const int t = T0 + 256 * (i >> 1) + 32 * (i & 1) + 64 * tb + 8 * g + 4 * h;
                pg8::u32x2 w; w.x = cvtpk(acc[i][4 * g], acc[i][4 * g + 1]); w.y = cvtpk(acc[i][4 * g + 2], acc[i][4 * g + 3]);
                *(LAS pg8::u32x2*)(lds + bb * HY_PITCH + (HY_PAD + t) * 2) = w; }
        __syncthreads();
        bf16_t* yr = PHYT + (size_t)(1024 + c) * NT + 8 * tid;
        const float w0 = hy_sw[c], w1 = hy_sw[1536 + c], w2 = hy_sw[3072 + c], bs = hy_sb[c];
#pragma unroll
        for (int b = 0; b < 8; ++b) {
            const unsigned xpw = __shfl_up(xa[b].w, 1), xnx = __shfl_down(xa[b].x, 1);
            const float xl = hl ? pg8::bfhi(xpw) : 0.f, xr = hr ? pg8::bflo(xnx) : 0.f;
            float cx[8]; conv8(xa[b], xl, xr, w0, w1, w2, bs, cx);
            const u32x4 y = *(const LAS u32x4*)(lds + b * HY_PITCH + (HY_PAD + 8 * tid) * 2);
            u32x4 w; w.x = cvtpk(cx[0] * pg8::bflo(y.x), cx[1] * pg8::bfhi(y.x)); w.y = cvtpk(cx[2] * pg8::bflo(y.y), cx[3] * pg8::bfhi(y.y));
            w.z = cvtpk(cx[4] * pg8::bflo(y.z), cx[5] * pg8::bfhi(y.z)); w.w = cvtpk(cx[6] * pg8::bflo(y.w), cx[7] * pg8::bfhi(y.w));
            *(u32x4*)(yr + (size_t)b * L) = w; }
    }
}

constexpr int HG_QE = 0, HG_KE = 17408, HG_KDT = 34816, HG_VT = 53248, HG_DEC = 71680, HG_BUF = 72192;

#define HG_RD2(ptr_a, ptr_b) __builtin_bit_cast(pg8::bf16x8, (u32x4){(*(const LAS u32x2*)(ptr_a)).x, (*(const LAS u32x2*)(ptr_a)).y, (*(const LAS u32x2*)(ptr_b)).x, (*(const LAS u32x2*)(ptr_b)).y})
typedef short v4i16_t __attribute__((ext_vector_type(4)));
#define HG_TR1(p) __builtin_amdgcn_ds_read_tr16_b64_v4i16((LAS v4i16_t*)(p))
#define HG_TR2(pa, pb) __builtin_bit_cast(pg8::bf16x8, __builtin_shufflevector(HG_TR1(pa), HG_TR1(pb), 0, 1, 2, 3, 4, 5, 6, 7))
#define HG_MFMA(a, b, c) __builtin_amdgcn_mfma_f32_16x16x32_bf16(a, b, c, 0, 0, 0)
#define HG_SB() __builtin_amdgcn_sched_barrier(0)
__device__ __forceinline__ pg8::bf16x8 hg_pack2(const f32x4& a, const f32x4& b) { u32x4 t; t.x = cvtpk(a[0], a[1]); t.y = cvtpk(a[2], a[3]); t.z = cvtpk(b[0], b[1]); t.w = cvtpk(b[2], b[3]); return __builtin_bit_cast(pg8::bf16x8, t); }
template <bool HAS_Q>
__device__ __forceinline__ void hgrn_consume(LAS unsigned char* Bf, f32x4 (&S)[2][8], int base, int dir, int h, int cw, int fr, int kg, float* o_out, int dbg) {
    const f32x4 z4 = (f32x4){0.f, 0.f, 0.f, 0.f};
    const int trq = fr >> 2, trp = fr & 3;
    pg8::bf16x8 Bv[2][2];
#pragma unroll
    for (int sl = 0; sl < 2; ++sl)
#pragma unroll
        for (int ks = 0; ks < 2; ++ks) { LAS unsigned char* const vp = Bf + HG_VT + (32 * ks + 4 * kg + trq) * 288 + (32 * cw + 16 * sl + 4 * trp) * 2; Bv[sl][ks] = HG_TR2(vp, vp + 16 * 288); }
    if (HAS_Q) {
        f32x4 st[10];
#pragma unroll
        for (int i = 0; i < 10; ++i) st[i] = z4;
        pg8::bf16x8 Kf[2][4], Qf[2][4];
        LAS unsigned char* const kbase = Bf + HG_KE + fr * 272 + 8 * kg * 2; LAS unsigned char* const qbase = Bf + HG_QE + fr * 272 + 8 * kg * 2;
#pragma unroll
        for (int b4 = 0; b4 < 4; ++b4) { Kf[0][b4] = *(const LAS pg8::bf16x8*)(kbase + b4 * 16 * 272); Qf[0][b4] = *(const LAS pg8::bf16x8*)(qbase + b4 * 16 * 272); }
#pragma unroll
        for (int ks = 0; ks < 4; ++ks) {
            if (ks < 3) {
#pragma unroll
                for (int b4 = 0; b4 < 4; ++b4) { Kf[(ks + 1) & 1][b4] = *(const LAS pg8::bf16x8*)(kbase + b4 * 16 * 272 + (ks + 1) * 64); Qf[(ks + 1) & 1][b4] = *(const LAS pg8::bf16x8*)(qbase + b4 * 16 * 272 + (ks + 1) * 64); } }
            HG_SB();
#pragma unroll
            for (int cb = 0; cb < 4; ++cb)
#pragma unroll
                for (int sb = 0; sb <= cb; ++sb) st[cb * (cb + 1) / 2 + sb] = HG_MFMA(Kf[ks & 1][sb], Qf[ks & 1][cb], st[cb * (cb + 1) / 2 + sb]);
            HG_SB();
        }
#pragma unroll
        for (int cb = 0; cb < 4; ++cb)
#pragma unroll
            for (int r = 0; r < 4; ++r) st[cb * (cb + 1) / 2 + cb][r] = (4 * kg + r <= fr) ? st[cb * (cb + 1) / 2 + cb][r] : 0.f;
        pg8::bf16x8 Af[4][2];
        Af[0][0] = hg_pack2(st[0], z4); Af[1][0] = hg_pack2(st[1], st[2]); Af[2][0] = hg_pack2(st[3], st[4]); Af[2][1] = hg_pack2(st[5], z4); Af[3][0] = hg_pack2(st[6], st[7]); Af[3][1] = hg_pack2(st[8], st[9]);
        pg8::bf16x8 Bs[2][4];
#pragma unroll
        for (int sl = 0; sl < 2; ++sl)
#pragma unroll
            for (int kp = 0; kp < 4; ++kp) Bs[sl][kp] = hg_pack2(S[sl][2 * kp], S[sl][2 * kp + 1]);
        pg8::bf16x8 Aq[2][4];
        LAS unsigned char* const qp0 = Bf + HG_QE + fr * 272 + 4 * kg * 2;
#pragma unroll
        for (int kp = 0; kp < 4; ++kp) Aq[0][kp] = HG_RD2(qp0 + kp * 64, qp0 + kp * 64 + 32);
#pragma unroll
        for (int cb = 0; cb < 4; ++cb) {
            if (cb < 3) {
#pragma unroll
                for (int kp = 0; kp < 4; ++kp) Aq[(cb + 1) & 1][kp] = HG_RD2(qp0 + (cb + 1) * 16 * 272 + kp * 64, qp0 + (cb + 1) * 16 * 272 + kp * 64 + 32); }
            HG_SB();
            f32x4 o0 = z4, o1 = z4;
            o0 = HG_MFMA(Bv[0][0], Af[cb][0], o0); o1 = HG_MFMA(Bv[1][0], Af[cb][0], o1);
            if (cb >= 2) { o0 = HG_MFMA(Bv[0][1], Af[cb][1], o0); o1 = HG_MFMA(Bv[1][1], Af[cb][1], o1); }
#pragma unroll
            for (int kp = 0; kp < 4; ++kp) { o0 = HG_MFMA(Bs[0][kp], Aq[cb & 1][kp], o0); o1 = HG_MFMA(Bs[1][kp], Aq[cb & 1][kp], o1); }
            HG_SB();
            { const int cp = 16 * cb + fr; const int t = base + (dir ? 63 - cp : cp); bf16_t* op = (bf16_t*)o_out + (size_t)t * 128 + 32 * cw + 4 * kg;
              if (!(dbg & 1)) { *(u32x2*)op = (u32x2){cvtpk(o0[0], o0[1]), cvtpk(o0[2], o0[3])}; *(u32x2*)(op + 16) = (u32x2){cvtpk(o1[0], o1[1]), cvtpk(o1[2], o1[3])}; } else asm volatile("" :: "v"(o0), "v"(o1)); }
        }
    }
    pg8::bf16x8 Ak[2][2][2]; f32x4 dc[2][2];
    LAS unsigned char* const kdp = Bf + HG_KDT + (4 * kg + trq) * 288 + 4 * trp * 2; LAS unsigned char* const dcp = Bf + HG_DEC + 4 * kg * 4;
#pragma unroll
    for (int u = 0; u < 2; ++u) { dc[0][u] = *(const LAS f32x4*)(dcp + u * 64);
#pragma unroll
        for (int ks = 0; ks < 2; ++ks) Ak[0][u][ks] = HG_TR2(kdp + u * 32 + ks * 32 * 288, kdp + u * 32 + ks * 32 * 288 + 16 * 288); }
#pragma unroll
    for (int bp = 0; bp < 4; ++bp) {
        if (bp < 3) {
#pragma unroll
            for (int u = 0; u < 2; ++u) { const int blk = 2 * (bp + 1) + u; dc[(bp + 1) & 1][u] = *(const LAS f32x4*)(dcp + blk * 64);
#pragma unroll
                for (int ks = 0; ks < 2; ++ks) Ak[(bp + 1) & 1][u][ks] = HG_TR2(kdp + blk * 32 + ks * 32 * 288, kdp + blk * 32 + ks * 32 * 288 + 16 * 288); } }
        HG_SB();
#pragma unroll
        for (int u = 0; u < 2; ++u) { const int blk = 2 * bp + u; f32x4 s0 = S[0][blk] * dc[bp & 1][u], s1 = S[1][blk] * dc[bp & 1][u];
#pragma unroll
            for (int ks = 0; ks < 2; ++ks) { s0 = HG_MFMA(Ak[bp & 1][u][ks], Bv[0][ks], s0); s1 = HG_MFMA(Ak[bp & 1][u][ks], Bv[1][ks], s1); }
            S[0][blk] = s0; S[1][blk] = s1; }
        HG_SB();
    }
}
#undef HG_RD2
#undef HG_TR1
#undef HG_TR2
#undef HG_MFMA
#undef HG_SB

template <bool HAS_Q>
__device__ __forceinline__ void hgrn_chain_mfma(LAS unsigned char* lds, const bf16_t* pi, int ldi, const bf16_t* pz, int ldz, const bf16_t* pq, int ldq, int Lseq, int h, int dir,
                                                const float* lb, const float* s_in, float* s_out, float* o_out, int n_begin, int nch  , int dbg = 0, unsigned char* dbgp = nullptr) {
    const int tid = threadIdx.x, lane = tid & 63, wave = __builtin_amdgcn_readfirstlane(tid >> 6);
    const bool producer = wave < 4;
#if PROBE_MASK
    unsigned long long bar_wait = 0ull;
#define HG_BAR() do { asm volatile("s_waitcnt lgkmcnt(0)" ::: "memory"); const unsigned long long _b0 = __builtin_amdgcn_s_memrealtime(); __builtin_amdgcn_s_barrier(); bar_wait += __builtin_amdgcn_s_memrealtime() - _b0; asm volatile("" ::: "memory"); } while (0)
#else
#define HG_BAR() do { asm volatile("s_waitcnt lgkmcnt(0)" ::: "memory"); __builtin_amdgcn_s_barrier(); asm volatile("" ::: "memory"); } while (0)
#endif
    const int pw = wave & 3, dp = lane & 15, rq = lane >> 4, ch0 = 32 * pw + 2 * dp;
    const int rowmin = dir ? 48 - 16 * rq : 16 * rq;
    const unsigned voZ = (unsigned)(rowmin * ldz + h * 128 + ch0) * 2u, voI = (unsigned)(rowmin * ldi + h * 128 + ch0) * 2u, voQ = (unsigned)(rowmin * (HAS_Q ? ldq : ldi) + h * 128 + ch0) * 2u;
    const __amdgpu_buffer_rsrc_t rsZ = __builtin_amdgcn_make_buffer_rsrc((void*)pz, 0, Lseq * ldz * 2, 0x00020000);
    const __amdgpu_buffer_rsrc_t rsI = __builtin_amdgcn_make_buffer_rsrc((void*)pi, 0, Lseq * ldi * 2, 0x00020000);
    const __amdgpu_buffer_rsrc_t rsQ = __builtin_amdgcn_make_buffer_rsrc((void*)(HAS_Q ? pq : pi), 0, Lseq * (HAS_Q ? ldq : ldi) * 2, 0x00020000);
#define HG_LOAD(n, Z, Q, V) do { const int _n = (dbg & 2) ? 0 : (n); const int _base = dir ? (Lseq - 64 * (_n + 1)) : 64 * _n; \
        _Pragma("unroll") for (int i = 0; i < 16; ++i) { const int _r = _base + (dir ? 15 - i : i); \
            Z[i] = __builtin_amdgcn_raw_buffer_load_b32(rsZ, voZ, _r * ldz * 2, 0); V[i] = __builtin_amdgcn_raw_buffer_load_b32(rsI, voI, _r * ldi * 2, 0); \
            if (HAS_Q) Q[i] = __builtin_amdgcn_raw_buffer_load_b32(rsQ, voQ, _r * ldq * 2, 0); } } while (0)
#define HG_PRODUCE(Z, Q, V, boff) do { LAS unsigned char* const Bf = lds + (boff); \
        float f0[16], f1[16]; float p0 = 1.f, p1 = 1.f; \
        _Pragma("unroll") for (int i = 0; i < 16; ++i) { f0[i] = 1.f - pg8::bflo(Z[i]); f1[i] = 1.f - pg8::bfhi(Z[i]); p0 *= f0[i]; p1 *= f1[i]; } \
        float run0 = 1.f, run1 = 1.f, fl0 = 1.f, fl1 = 1.f, suf0 = 1.f, suf1 = 1.f; \
        _Pragma("unroll") for (int qq = 0; qq < 4; ++qq) { const float t0 = __shfl(p0, dp + 16 * qq), t1 = __shfl(p1, dp + 16 * qq); fl0 *= t0; fl1 *= t1; if (qq < rq) { run0 *= t0; run1 *= t1; } if (qq > rq) { suf0 *= t0; suf1 *= t1; } } \
        if (HAS_Q) { \
            _Pragma("unroll") for (int i = 0; i < 16; ++i) { run0 *= f0[i]; run1 *= f1[i]; const float ia = __builtin_amdgcn_rcpf(run0), ib = __builtin_amdgcn_rcpf(run1); \
                const float kea = pg8::bflo(Z[i]) * ia, keb = pg8::bfhi(Z[i]) * ib; const int cp = 16 * rq + i; \
                *(LAS unsigned*)(Bf + HG_QE + cp * 272 + ch0 * 2) = cvtpk(pg8::bflo(Q[i]) * run0, pg8::bfhi(Q[i]) * run1); \
                *(LAS unsigned*)(Bf + HG_KE + cp * 272 + ch0 * 2) = cvtpk(kea, keb); \
                *(LAS unsigned*)(Bf + HG_KDT + cp * 288 + ch0 * 2) = cvtpk(kea * fl0, keb * fl1); } \
        } else { \
            _Pragma("unroll") for (int i = 15; i >= 0; --i) { const int cp = 16 * rq + i; \
                *(LAS unsigned*)(Bf + HG_KDT + cp * 288 + ch0 * 2) = cvtpk(pg8::bflo(Z[i]) * suf0, pg8::bfhi(Z[i]) * suf1); suf0 *= f0[i]; suf1 *= f1[i]; } \
        } \
        _Pragma("unroll") for (int i = 0; i < 16; ++i) *(LAS unsigned*)(Bf + HG_VT + (16 * rq + i) * 288 + ch0 * 2) = V[i]; \
        if (rq == 0) *(LAS f32x2_t*)(Bf + HG_DEC + ch0 * 4) = (f32x2_t){fl0, fl1}; } while (0)
#define HG_CONSUME(m, boff) hgrn_consume<HAS_Q>(lds + (boff), S, dir ? (Lseq - 64 * ((m) + 1)) : 64 * (m), dir, h, cw, fr, kg, o_out, dbg)

    __syncthreads();
    if (producer) {
        unsigned zA[16], qA[16], vA[16], zB[16], qB[16], vB[16];
        HG_LOAD(n_begin, zA, qA, vA);
        if (n_begin + 1 < nch) HG_LOAD(n_begin + 1, zB, qB, vB);
        for (int n = n_begin; n <= nch; n += 2) {
            if (n < nch && !(dbg & 4)) HG_PRODUCE(zA, qA, vA, 0);
            if (n + 2 < nch) HG_LOAD(n + 2, zA, qA, vA);
            HG_BAR();
            if (n + 1 < nch && !(dbg & 4)) HG_PRODUCE(zB, qB, vB, HG_BUF);
            if (n + 3 < nch) HG_LOAD(n + 3, zB, qB, vB);
            HG_BAR();
        }
    } else {
        const int cw = wave & 3, fr = lane & 15, kg = lane >> 4;
        __builtin_amdgcn_s_setprio(3);
        f32x4 S[2][8];
#pragma unroll
        for (int sl = 0; sl < 2; ++sl)
#pragma unroll
            for (int blk = 0; blk < 8; ++blk)
#pragma unroll
                for (int r = 0; r < 4; ++r) S[sl][blk][r] = s_in ? s_in[(size_t)(16 * blk + 4 * kg + r) * 128 + 32 * cw + 16 * sl + fr] : 0.f;
        for (int n = n_begin; n <= nch; n += 2) {
            if (n > n_begin && !(dbg & 8)) HG_CONSUME(n - 1, HG_BUF);
            HG_BAR();
            if (n < nch && !(dbg & 8)) HG_CONSUME(n, 0);
            HG_BAR();
        }
        if (dbg) {
#pragma unroll
            for (int sl = 0; sl < 2; ++sl)
#pragma unroll
                for (int blk = 0; blk < 8; ++blk) asm volatile("" :: "v"(S[sl][blk][0]), "v"(S[sl][blk][1]), "v"(S[sl][blk][2]), "v"(S[sl][blk][3]));
        }
        if (s_out) {
#pragma unroll
            for (int sl = 0; sl < 2; ++sl)
#pragma unroll
                for (int blk = 0; blk < 8; ++blk)
#pragma unroll
                    for (int r = 0; r < 4; ++r) s_out[(size_t)(16 * blk + 4 * kg + r) * 128 + 32 * cw + 16 * sl + fr] = S[sl][blk][r];
        }
        __builtin_amdgcn_s_setprio(0);
    }
#if PROBE_MASK
    if (HAS_Q && blockIdx.x == PROBE_BUSY_BLOCK && (tid == 0 || tid == 256) && dbg == 0) *(volatile unsigned long long*)(dbgp + (tid ? 8 : 0)) = bar_wait;
#endif
#undef HG_LOAD
#undef HG_PRODUCE
#undef HG_CONSUME
#undef HG_BAR
    __syncthreads();
}

__global__ void __launch_bounds__(512, 2) mega(Params P) {
    extern __shared__ __attribute__((aligned(16))) unsigned char lds_raw[];
    cg::grid_group grid = cg::this_grid();
    LAS unsigned char* lds = (LAS unsigned char*)lds_raw;
    const int tid = threadIdx.x, lane = tid & 63, wave = __builtin_amdgcn_readfirstlane(tid >> 6);
    const int G = gridDim.x, bx = blockIdx.x;
    const int vcu = (G % 8 == 0) ? (bx % 8) * (G / 8) + bx / 8 : bx;
    const int gw = vcu * 8 + wave, NGW = G * 8;
    unsigned char* ws = P.ws;
    const float* x = P.in[0]; const float* cvec = P.in[1]; const float* ctx = P.in[2]; const float* c_ctx = P.in[3];
    const float* w_ada = P.in[4]; const float* b_ada = P.in[5]; const float* norm_w = P.in[6]; const float* w_in = P.in[7];
    const float* lb_param = P.in[8]; const float* g_norm = P.in[9]; const float* hy_sw = P.in[10]; const float* hy_sb = P.in[11];
    const float* f_w1 = P.in[12]; const float* f_b1 = P.in[13]; const float* f_w2 = P.in[14]; const float* f_b2 = P.in[15];
    const float* f_w3 = P.in[16]; const float* f_freq = P.in[17]; const float* hy_d = P.in[18]; const float* w_pa = P.in[19];
    const float* w_pb = P.in[20]; const float* w_out = P.in[21]; const float* w_mlp1 = P.in[22]; const float* w_mlp2 = P.in[23];
    float* MOD = (float*)(ws + WS_MOD); float* LB = (float*)(ws + WS_LB); bf16_t* GTB = (bf16_t*)(ws + WS_GT);
    bf16_t* WIN = (bf16_t*)(ws + WS_WIN); bf16_t* WPAB = (bf16_t*)(ws + WS_WPAB); bf16_t* WOUT = (bf16_t*)(ws + WS_WOUT); bf16_t* W1 = (bf16_t*)(ws + WS_W1); bf16_t* W2 = (bf16_t*)(ws + WS_W2);
    bf16_t* HCTX = (bf16_t*)(ws + WS_HCTX); bf16_t* PCTX = (bf16_t*)(ws + WS_PCTX); float* SCTX = (float*)(ws + WS_SCTX);
    bf16_t* HLAT = (bf16_t*)(ws + WS_HLAT); bf16_t* PI = (bf16_t*)(ws + WS_PI); bf16_t* PZ = (bf16_t*)(ws + WS_PZ); bf16_t* PQ = (bf16_t*)(ws + WS_PQ);
    bf16_t* PG = (bf16_t*)(ws + WS_PG); bf16_t* GATES = (bf16_t*)(ws + WS_GATES); bf16_t* PHYT = (bf16_t*)(ws + WS_PHYT);
    bf16_t* AY = (bf16_t*)(ws + WS_AY2); bf16_t* MERGED = (bf16_t*)(ws + WS_MERGED); bf16_t* MIX = (bf16_t*)(ws + WS_MIX);
    bf16_t* MLP = (bf16_t*)(ws + WS_MLP); bf16_t* H1 = (bf16_t*)(ws + WS_H1); bf16_t* HL = (bf16_t*)(ws + WS_HL);
    float* O2 = P.out;

    volatile LAS unsigned* MISC = (volatile LAS unsigned*)(lds + LDS_BYTES - 128);
    if (tid < 16) MISC[tid] = 0u;
    __syncthreads();
    const XcdBarrier xbar = xcd_barrier_post((unsigned*)ws, MISC);
#ifdef NO_GRID_SYNC
#define SEAM_RAW(k) xcd_barrier(xbar)
#else
#define SEAM_RAW(k) do { if ((k) == 0) grid.sync(); else xcd_barrier(xbar); } while (0)
#endif
#if PROBE_MASK
    unsigned long long t_prev = __builtin_amdgcn_s_memrealtime(), t_spin = 0ull;
#define SEAM(k) do { if ((k) == PROBE_BUSY_PHASE && bx == PROBE_BUSY_BLOCK && tid == 0) *(volatile unsigned long long*)(ws + 32768) = __builtin_amdgcn_s_memrealtime() - t_prev; \
    SEAM_RAW(k); { const unsigned long long _t = __builtin_amdgcn_s_memrealtime(); if ((PROBE_MASK >> (k)) & 1) t_spin += _t - t_prev; \
    if ((k) == PROBE_BUSY_PHASE) t_spin += *(volatile unsigned long long*)(ws + 32768); t_prev = _t; } } while (0)
#else
#define SEAM(k) SEAM_RAW(k)
#endif
    {
        if (bx < 192) {
            LAS float* sc = (LAS float*)lds;
            LAS float* ps = (LAS float*)(lds + 40960);
            for (int i = tid; i < 9 * D; i += 512) { const int r = i >> 10, k = i & 1023; sc[i] = siluf_(r < 8 ? cvec[r * D + k] : c_ctx[k]); }
            __syncthreads();
            const int jl = lane & 31, kk = lane >> 5, j = bx * 32 + jl; float a9[9];
#pragma unroll
            for (int r = 0; r < 9; ++r) a9[r] = 0.f;
            const float* wp = w_ada + (size_t)(wave * 128 + kk) * INC + j;
#pragma unroll 1
            for (int i0 = 0; i0 < 64; i0 += 16) { float w[16];
#pragma unroll
                for (int u = 0; u < 16; ++u) w[u] = wp[(size_t)(2 * (i0 + u)) * INC];
#pragma unroll
                for (int u = 0; u < 16; ++u)
#pragma unroll
                    for (int r = 0; r < 9; ++r) a9[r] += sc[r * D + wave * 128 + 2 * (i0 + u) + kk] * w[u]; }
#pragma unroll
            for (int r = 0; r < 9; ++r) { a9[r] += __shfl_xor(a9[r], 32); if (lane < 32) ps[(wave * 9 + r) * 32 + jl] = a9[r]; }
            __syncthreads();
            for (int i = tid; i < 9 * 32; i += 512) { const int r = i >> 5, l = i & 31; float s = b_ada[bx * 32 + l];
#pragma unroll
                for (int w = 0; w < 8; ++w) s += ps[(w * 9 + r) * 32 + l];
                MOD[r * INC + bx * 32 + l] = s; }
            __syncthreads();
        }
        if (bx == G - 1) { const float a = lb_param[tid], b = lb_param[HW + tid], m = fmaxf(a, b); const float ea = expf(a - m), eb = expf(b - m); LB[tid] = ea / (ea + eb); }
        {   LAS float* scr = (LAS float*)(lds + wave * 16384);
            for (int it = gw; it < 16 * 192; it += NGW) transpose_item(w_in, INC, WIN, D, 0, 1, scr, it, lane); }
        for (int tb = bx; tb < 256; tb += G) {
            __syncthreads();
            LAS float* zf = (LAS float*)lds; LAS float* h1 = zf + 17 * 36; LAS float* h2 = h1 + 17 * 64;
            for (int i = tid; i < 17 * 33; i += 512) { const int p = i / 33, k = i - 33 * p, t = 16 * tb + p; float val;
                if (k == 0) val = (float)t / (float)(L - 1);
                else { const int bi = (k - 1) & 15; const float band = 1e-4f + (float)bi * ((15.f - 1e-4f) / 15.f);
                    const float w = 2.0f * 3.14159265358979323846f * (float)t / (float)L; const float ang = w * band;
                    val = (k <= 16) ? cosf(ang) : -sinf(ang); }
                zf[p * 36 + k] = val; }
            __syncthreads();
            for (int i = tid; i < 17 * 64; i += 512) { const int p = i >> 6, k = i & 63; float acc = f_b1[k];
#pragma unroll 11
                for (int q = 0; q < 33; ++q) acc += zf[p * 36 + q] * f_w1[q * 64 + k];
                h1[i] = sinf(f_freq[k] * acc); }
            __syncthreads();
            for (int i = tid; i < 17 * 64; i += 512) { const int p = i >> 6, k = i & 63; float acc = f_b2[k];
#pragma unroll 16
                for (int q = 0; q < 64; ++q) acc += h1[p * 64 + q] * f_w2[q * 64 + k];
                h2[i] = sinf(f_freq[k] * acc); }
            __syncthreads();
            const int c = tid; float af[16], ab[16];
#pragma unroll
            for (int p = 0; p < 16; ++p) { af[p] = 0.f; ab[p] = 0.f; }
#pragma unroll 4
            for (int k = 0; k < 64; ++k) { const float wf = f_w3[k * 1024 + c], wb = f_w3[k * 1024 + 512 + c]; float hv[17];
#pragma unroll
                for (int p = 0; p < 17; ++p) hv[p] = h2[p * 64 + k];
#pragma unroll
                for (int p = 0; p < 16; ++p) { af[p] += hv[p] * wf; ab[p] += hv[p + 1] * wb; } }
            const float mind = logf(1e-2f) / 1.5f, maxd = logf(1e-2f) / 0.3f;
            const float delta = fabsf(mind + (maxd - mind) * ((float)c / 511.f));
            unsigned short of[16], ob[16];
#pragma unroll
            for (int p = 0; p < 16; ++p) { const int tf = 16 * tb + p, tbk = tf + 1;
                float vf = af[p] * expf(-((float)tf / (float)(L - 1)) * delta); if (tf == 0) vf += hy_d[c];
                float vb = ab[p] * expf(-((float)tbk / (float)(L - 1)) * delta); if (tbk >= L) vb = 0.f;
                of[15 - p] = (unsigned short)f2bf(vf); ob[p] = (unsigned short)f2bf(vb); }
            bf16_t* gf = GTB + (size_t)c * 8192 + (4080 - 16 * tb); bf16_t* gb = GTB + (size_t)c * 8192 + (4096 + 16 * tb);
            u32x4 w0, w1;
            w0.x = of[0] | ((unsigned)of[1] << 16); w0.y = of[2] | ((unsigned)of[3] << 16); w0.z = of[4] | ((unsigned)of[5] << 16); w0.w = of[6] | ((unsigned)of[7] << 16);
            w1.x = of[8] | ((unsigned)of[9] << 16); w1.y = of[10] | ((unsigned)of[11] << 16); w1.z = of[12] | ((unsigned)of[13] << 16); w1.w = of[14] | ((unsigned)of[15] << 16);
            *(u32x4*)gf = w0; *(u32x4*)(gf + 8) = w1;
            w0.x = ob[0] | ((unsigned)ob[1] << 16); w0.y = ob[2] | ((unsigned)ob[3] << 16); w0.z = ob[4] | ((unsigned)ob[5] << 16); w0.w = ob[6] | ((unsigned)ob[7] << 16);
            w1.x = ob[8] | ((unsigned)ob[9] << 16); w1.y = ob[10] | ((unsigned)ob[11] << 16); w1.z = ob[12] | ((unsigned)ob[13] << 16); w1.w = ob[14] | ((unsigned)ob[15] << 16);
            *(u32x4*)gb = w0; *(u32x4*)(gb + 8) = w1;
        }
    }
    SEAM(0);
    for (int m0 = gw; m0 < NT + NCX; m0 += P1_ROWS * NGW) {
        f32x4 v[P1_ROWS][4];
#pragma unroll
        for (int r = 0; r < P1_ROWS; ++r) { const int m = m0 + r * NGW; if (m < NT + NCX) { const f32x4* xr = (const f32x4*)(m < NT ? x + (size_t)m * D : ctx + (size_t)(m - NT) * D) + lane;
#pragma unroll
                for (int j = 0; j < 4; ++j) v[r][j] = xr[64 * j]; } }
#pragma unroll
        for (int r = 0; r < P1_ROWS; ++r) { const int m = m0 + r * NGW; if (m < NT + NCX) {
                const float* mb = MOD + (size_t)(m < NT ? (m >> 12) : 8) * INC; bf16_t* orow = m < NT ? HLAT + (size_t)m * D : HCTX + (size_t)(m - NT) * D;
                float s = 0.f;
#pragma unroll
                for (int j = 0; j < 4; ++j) s += (v[r][j].x * v[r][j].x + v[r][j].y * v[r][j].y) + (v[r][j].z * v[r][j].z + v[r][j].w * v[r][j].w);
                const float rs = rsqrtf(wave_sum(s) * (1.f / D) + EPS);
                unsigned long long* o8 = (unsigned long long*)orow + lane;
#pragma unroll
                for (int j = 0; j < 4; ++j) { const f32x4 w = ((const f32x4*)norm_w)[lane + 64 * j], sc = ldmod(mb, lane + 64 * j), sh = ldmod(mb + D, lane + 64 * j);
                    const f32x4 o = v[r][j] * rs * w * (1.f + sc) + sh;
                    o8[64 * j] = (unsigned long long)cvtpk(o.x, o.y) | ((unsigned long long)cvtpk(o.z, o.w) << 32); } } }
    }
    SEAM(1);
    {
        { pg8::Gemm g{HLAT, WIN, D, D, D}; pg8::StaticOrder S; S.init(NT, 4608, G, bx); pg8::EpiG1 E{PI, PZ, PQ, PG, GATES, LB, 0};
          pg8::gemm_phase(lds, g, S, E); }
        { pg8::Gemm g{WIN + (size_t)4608 * D, HLAT, D, D, D}; pg8::StaticOrder S; S.init(1536, NT, G, bx); pg8::EpiBf16<0> E{PHYT, NT};
          pg8::gemm_phase(lds, g, S, E); }
        { pg8::Gemm g{HCTX, WIN, D, D, D}; pg8::StaticOrder S; S.init(NCX, 1536, G, bx); pg8::EpiG1 E{PCTX, nullptr, nullptr, nullptr, nullptr, LB, 1};
          pg8::gemm_phase(lds, g, S, E); }
        if (bx >= 48) {
            LAS float* scr = (LAS float*)(lds + wave * 16384);
            constexpr int I_PA = 8 * 32, I_OUT = 16 * 32, I_1 = 16 * 128, I_2 = 64 * 32;
            __syncthreads();
            for (int it = (bx - 48) * 8 + wave; it < 2 * I_PA + I_OUT + I_1 + I_2; it += (G - 48) * 8) {
                int r = it;
                if (r < I_PA) { transpose_item(w_pa, D, WPAB, D, 0, 0, scr, r, lane); continue; } r -= I_PA;
                if (r < I_PA) { transpose_item(w_pb, D, WPAB, D, 512, 0, scr, r, lane); continue; } r -= I_PA;
                if (r < I_OUT) { transpose_item(w_out, D, WOUT, D, 0, 0, scr, r, lane); continue; } r -= I_OUT;
                if (r < I_1) { transpose_item(w_mlp1, FF, W1, D, 0, 0, scr, r, lane); continue; } r -= I_1;
                transpose_item(w_mlp2, D, W2, FF, 0, 0, scr, r, lane);
            }
        }

    }
    SEAM(2);
    {
        float* STATE = (float*)(ws + WS_HLAT);
        constexpr int NSEG = 4, SEGC = 64 / NSEG;
        if (bx < 64 * NSEG) { const int item = bx;
            const int chain = item / NSEG, seg = item % NSEG, b = chain >> 3, h = (chain >> 1) & 3, dir = chain & 1, n0 = SEGC * seg; float* st = STATE + (size_t)(item & 255) * 16384;
            const bf16_t* pzc = PZ + (size_t)b * L * 1024 + (dir ? 512 : 0);
            int n_start = n0; bool decayed = false;
            if (seg > 0) {
                LAS float* red = (LAS float*)lds;
                float r0 = 1.f, r1 = 1.f;
                while (n_start > 0 && !decayed) {
                    n_start -= 4;
                    const int basec = dir ? (L - 64 * (n_start + 4)) : 64 * n_start;
                    float p0 = 1.f, p1 = 1.f;
#pragma unroll 8
                    for (int i = 0; i < 32; ++i) { const unsigned kk = *(const unsigned*)(pzc + (size_t)(basec + 32 * wave + i) * 1024 + h * 128 + 2 * lane); p0 *= 1.f - pg8::bflo(kk); p1 *= 1.f - pg8::bfhi(kk); }
                    __syncthreads();
                    *(LAS f32x2_t*)(red + wave * 128 + 2 * lane) = (f32x2_t){p0, p1};
                    __syncthreads();
                    if (wave == 0) {
#pragma unroll
                        for (int w = 0; w < 8; ++w) { const f32x2_t t = *(const LAS f32x2_t*)(red + w * 128 + 2 * lane); r0 *= t.x; r1 *= t.y; }
                        float mx = fmaxf(r0, r1);
#pragma unroll
                        for (int o = 1; o < 64; o <<= 1) mx = fmaxf(mx, __shfl_xor(mx, o));
                        if (lane == 0) red[1024] = mx;
                    }
                    __syncthreads();
                    decayed = __builtin_amdgcn_readfirstlane(red[1024] < 1e-10f ? 1 : 0) != 0;
                }
            }
            if (seg == 0 || !decayed)
                hgrn_chain_mfma<false>(lds, PCTX + (size_t)b * LC * 1536, 1536, PCTX + (size_t)b * LC * 1536 + (dir ? 1024 : 512), 1536, nullptr, 0, LC, h, dir, LB, nullptr, st, nullptr, 0, LC / 64);
            if (seg > 0) hgrn_chain_mfma<false>(lds, PI + (size_t)b * L * 512, 512, pzc, 1024, nullptr, 0, L, h, dir, LB, decayed ? nullptr : st, st, nullptr, n_start, n0);
            hgrn_chain_mfma<true>(lds, PI + (size_t)b * L * 512, 512, pzc, 1024, PQ + (size_t)b * L * 512, 512, L, h, dir, LB,
                                  st, nullptr, O2 + (size_t)chain * L * 64, n0, n0 + SEGC, 0, ws + 32768 + 128);
#if PROBE_MASK
            if (PROBE_BUSY_PHASE == 20 && bx == PROBE_BUSY_BLOCK && tid == 0) *(volatile unsigned long long*)(ws + 32768 + 64) = __builtin_amdgcn_s_memrealtime() - t_prev;
#endif
        }
        unsigned* hctr = (unsigned*)(ws + 36864);
        for (;;) {
            __syncthreads();
            if (tid == 0) MISC[4] = atomicAdd(hctr, 1u);
            __syncthreads();
            const int c = (int)MISC[4];
            if (c >= HW) break;
            hyena_channel(lds, c, PHYT, GTB, hy_sw, hy_sb);
        }
    }
    SEAM(4);
#if PROBE_MASK
    if (PROBE_BUSY_PHASE == 20) t_spin += *(volatile unsigned long long*)(ws + 32768 + 64);
    if (PROBE_BUSY_PHASE == 21) t_spin += *(volatile unsigned long long*)(ws + 32768 + 128);
    if (PROBE_BUSY_PHASE == 22) t_spin += *(volatile unsigned long long*)(ws + 32768 + 136);
#endif
    {
        const f32x4 gn0 = ((const f32x4*)g_norm)[(2 * lane) & 31], gn1 = ((const f32x4*)g_norm)[(2 * lane + 1) & 31];
        for (int t0 = gw; t0 < NT; t0 += 2 * NGW) {
            f32x4 of[2][2], ob[2][2]; u32x4 pg[2];
#pragma unroll
            for (int r = 0; r < 2; ++r) { const int t = t0 + r * NGW; if (t < NT) {
                    { const int bb = t >> 12, hh = lane >> 4; const bf16_t* pf = (const bf16_t*)O2 + ((size_t)((bb * 4 + hh) * 2) * L + (t & 4095)) * 128 + 8 * (lane & 15); const bf16_t* pb = pf + (size_t)L * 128;
                      const u32x4 uf = *(const u32x4*)pf, ub = *(const u32x4*)pb;
                      of[r][0] = (f32x4){pg8::bflo(uf.x), pg8::bfhi(uf.x), pg8::bflo(uf.y), pg8::bfhi(uf.y)}; of[r][1] = (f32x4){pg8::bflo(uf.z), pg8::bfhi(uf.z), pg8::bflo(uf.w), pg8::bfhi(uf.w)};
                      ob[r][0] = (f32x4){pg8::bflo(ub.x), pg8::bfhi(ub.x), pg8::bflo(ub.y), pg8::bfhi(ub.y)}; ob[r][1] = (f32x4){pg8::bflo(ub.z), pg8::bfhi(ub.z), pg8::bflo(ub.w), pg8::bfhi(ub.w)}; }
                    pg[r] = ((const u32x4*)(PG + (size_t)t * 512))[lane]; } }
#pragma unroll
            for (int r = 0; r < 2; ++r) { const int t = t0 + r * NGW; if (t < NT) {
                    const f32x4 a0 = of[r][0] + ob[r][0], a1 = of[r][1] + ob[r][1];
                    float s = (a0.x * a0.x + a0.y * a0.y) + (a0.z * a0.z + a0.w * a0.w) + (a1.x * a1.x + a1.y * a1.y) + (a1.z * a1.z + a1.w * a1.w);
                    s += __shfl_xor(s, 1); s += __shfl_xor(s, 2); s += __shfl_xor(s, 4); s += __shfl_xor(s, 8);
                    const float rs = rsqrtf(s * (1.f / 128.f) + EPS);
                    u32x4 o;
                    o.x = cvtpk(a0.x * rs * gn0.x * pg8::bflo(pg[r].x), a0.y * rs * gn0.y * pg8::bfhi(pg[r].x)); o.y = cvtpk(a0.z * rs * gn0.z * pg8::bflo(pg[r].y), a0.w * rs * gn0.w * pg8::bfhi(pg[r].y));
                    o.z = cvtpk(a1.x * rs * gn1.x * pg8::bflo(pg[r].z), a1.y * rs * gn1.y * pg8::bfhi(pg[r].z)); o.w = cvtpk(a1.z * rs * gn1.z * pg8::bflo(pg[r].w), a1.w * rs * gn1.w * pg8::bfhi(pg[r].w));
                    *(u32x4*)(AY + (size_t)t * 1024 + 8 * lane) = o; } }
        }
    }
    {
        LAS bf16_t* tl = (LAS bf16_t*)(lds + wave * 16384);
        for (int it = gw; it < 8 * 512; it += NGW) { const int c0 = (it & 7) * 64, tok0 = (it >> 3) * 64;
#pragma unroll
            for (int i = 0; i < 8; ++i) { const int ch = lane + 64 * i, rr = ch >> 3, cc = (ch & 7) * 8;
                const u32x4 v = *(const u32x4*)(PHYT + (size_t)(1024 + c0 + rr) * NT + tok0 + cc);
                LAS unsigned* d = (LAS unsigned*)(tl + rr * 66 + cc); d[0] = v.x; d[1] = v.y; d[2] = v.z; d[3] = v.w; }
            LDS_WAIT();
#pragma unroll
            for (int i = 0; i < 8; ++i) { const int ch = lane + 64 * i, tt = ch >> 3, cc = (ch & 7) * 8; unsigned o[4];
#pragma unroll
                for (int q = 0; q < 4; ++q) o[q] = (unsigned)tl[(cc + 2 * q) * 66 + tt] | ((unsigned)tl[(cc + 2 * q + 1) * 66 + tt] << 16);
                *(u32x4*)(AY + (size_t)(tok0 + tt) * 1024 + 512 + c0 + cc) = (u32x4){o[0], o[1], o[2], o[3]}; }
            LDS_WAIT();
        }
    }
    SEAM(5);
    { pg8::Gemm g{AY, WPAB, D, D, 512}; pg8::TwoPassOrder S; S.base.init(NT, D, G, bx); S.kbytes = 1024; pg8::EpiMerge2 E{MERGED, GATES}; pg8::gemm_phase(lds, g, S, E); }
    SEAM(6);
    { pg8::Gemm g{MERGED, WOUT, D, D, D}; pg8::StaticOrder S; S.init(NT, D, G, bx); pg8::EpiBf16<0> E{MIX, D}; pg8::gemm_phase(lds, g, S, E); }
    SEAM(7);
    for (int m0 = gw; m0 < NT; m0 += 2 * NGW) {
        f32x4 xv[2][4]; u32x2 mx[2][4];
#pragma unroll
        for (int r = 0; r < 2; ++r) { const int m = m0 + r * NGW; if (m < NT) {
#pragma unroll
                for (int j = 0; j < 4; ++j) { xv[r][j] = ((const f32x4*)(x + (size_t)m * D))[lane + 64 * j]; mx[r][j] = *(const u32x2*)(MIX + (size_t)m * D + 4 * lane + 256 * j); } } }
#pragma unroll
        for (int r = 0; r < 2; ++r) { const int m = m0 + r * NGW; if (m < NT) { const float* mb = MOD + (size_t)(m >> 12) * INC;
                f32x4 mv[4], x1[4]; float s = 0.f;
#pragma unroll
                for (int j = 0; j < 4; ++j) { mv[j] = (f32x4){pg8::bflo(mx[r][j].x), pg8::bfhi(mx[r][j].x), pg8::bflo(mx[r][j].y), pg8::bfhi(mx[r][j].y)}; s += (mv[j].x * mv[j].x + mv[j].y * mv[j].y) + (mv[j].z * mv[j].z + mv[j].w * mv[j].w); }
                const float r1 = rsqrtf(wave_sum(s) * (1.f / D) + EPS); float s2 = 0.f;
                unsigned long long* x8 = (unsigned long long*)(MIX + (size_t)m * D) + lane;
#pragma unroll
                for (int j = 0; j < 4; ++j) { const f32x4 w = ((const f32x4*)(norm_w + D))[lane + 64 * j], g = ldmod(mb + 2 * D, lane + 64 * j);
                    x1[j] = xv[r][j] + g * (mv[j] * r1 * w); s2 += (x1[j].x * x1[j].x + x1[j].y * x1[j].y) + (x1[j].z * x1[j].z + x1[j].w * x1[j].w);
                    x8[64 * j] = (unsigned long long)cvtpk(x1[j].x, x1[j].y) | ((unsigned long long)cvtpk(x1[j].z, x1[j].w) << 32); }
                const float r2 = rsqrtf(wave_sum(s2) * (1.f / D) + EPS);
                unsigned long long* o8 = (unsigned long long*)(HL + (size_t)m * D) + lane;
#pragma unroll
                for (int j = 0; j < 4; ++j) { const f32x4 w = ((const f32x4*)(norm_w + 2 * D))[lane + 64 * j], sc = ldmod(mb + 3 * D, lane + 64 * j), sh = ldmod(mb + 4 * D, lane + 64 * j);
                    const f32x4 o = x1[j] * r2 * w * (1.f + sc) + sh;
                    o8[64 * j] = (unsigned long long)cvtpk(o.x, o.y) | ((unsigned long long)cvtpk(o.z, o.w) << 32); } } }
    }
    SEAM(8);
    { pg8::Gemm g{HL, W1, D, D, D}; pg8::StaticOrder S; S.init(NT, FF, G, bx); pg8::EpiBf16<3> E{H1, FF}; pg8::gemm_phase(lds, g, S, E); }
    SEAM(9);
    { pg8::Gemm g{H1, W2, FF, FF, FF}; pg8::StaticOrder S; S.init(NT, D, G, bx); pg8::EpiBf16<0> E{MLP, D}; pg8::gemm_phase(lds, g, S, E); }
    SEAM(10);
    for (int m0 = gw; m0 < NT; m0 += 4 * NGW) {
        u32x2 xq[4][4], ml[4][4];
#pragma unroll
        for (int r = 0; r < 4; ++r) { const int m = m0 + r * NGW; if (m < NT) {
#pragma unroll
                for (int j = 0; j < 4; ++j) { xq[r][j] = *(const u32x2*)(MIX + (size_t)m * D + 4 * lane + 256 * j); ml[r][j] = *(const u32x2*)(MLP + (size_t)m * D + 4 * lane + 256 * j); } } }
#pragma unroll
        for (int r = 0; r < 4; ++r) { const int m = m0 + r * NGW; if (m < NT) { const float* mb = MOD + (size_t)(m >> 12) * INC;
                f32x4 lv[4]; float s3 = 0.f;
#pragma unroll
                for (int j = 0; j < 4; ++j) { lv[j] = (f32x4){pg8::bflo(ml[r][j].x), pg8::bfhi(ml[r][j].x), pg8::bflo(ml[r][j].y), pg8::bfhi(ml[r][j].y)}; s3 += (lv[j].x * lv[j].x + lv[j].y * lv[j].y) + (lv[j].z * lv[j].z + lv[j].w * lv[j].w); }
                const float r3 = rsqrtf(wave_sum(s3) * (1.f / D) + EPS);
#pragma unroll
                for (int j = 0; j < 4; ++j) { const f32x4 w3 = ((const f32x4*)(norm_w + 3 * D))[lane + 64 * j], g5 = ldmod(mb + 5 * D, lane + 64 * j);
                    const f32x4 x1 = (f32x4){pg8::bflo(xq[r][j].x), pg8::bfhi(xq[r][j].x), pg8::bflo(xq[r][j].y), pg8::bfhi(xq[r][j].y)};
                    ((f32x4*)(P.out + (size_t)m * D))[lane + 64 * j] = x1 + g5 * (lv[j] * r3 * w3); } } }
    }
#if PROBE_MASK
    { const unsigned long long _t = __builtin_amdgcn_s_memrealtime(); if ((PROBE_MASK >> 11) & 1) t_spin += _t - t_prev;
      if (bx == 0) { const unsigned long long t0 = __builtin_amdgcn_s_memrealtime(); while (__builtin_amdgcn_s_memrealtime() - t0 < t_spin) __builtin_amdgcn_s_sleep(8); } }
#endif
#if PROBE_XSYNC
    for (int i = 0; i < PROBE_XSYNC; ++i) grid.sync();
#endif
}
}

extern "C" void kernel_launch(void* const* d_in, const int* in_sizes, int n_in, void* d_out, int out_size, void* d_ws, size_t ws_size, hipStream_t stream) {
    static int grid = 0;
    if (grid == 0) {
        if (n_in != 24 || ws_size < WS_END) { fprintf(stderr, "kernel_launch: unexpected n_in %d / ws_size %zu\n", n_in, ws_size); grid = -1; return; }
        int dev = 0, cus = 0, per_cu = 0;
        hipGetDevice(&dev); hipDeviceGetAttribute(&cus, hipDeviceAttributeMultiprocessorCount, dev);
        hipFuncSetAttribute((const void*)mega, hipFuncAttributeMaxDynamicSharedMemorySize, LDS_BYTES);
        hipOccupancyMaxActiveBlocksPerMultiprocessor(&per_cu, (const void*)mega, 512, LDS_BYTES);
        if (per_cu < 1) { fprintf(stderr, "kernel_launch: occupancy query says %d blocks per CU\n", per_cu); grid = -1; return; }
        grid = cus;
        if (grid < 256) { fprintf(stderr, "kernel_launch: this kernel needs at least 256 compute units (found %d)\n", cus); grid = -1; return; }
    }
    if (grid < 0) return;
    if (hipMemsetAsync(d_ws, 0, 65536, stream) != hipSuccess) { fprintf(stderr, "kernel_launch: memset failed\n"); return; }
    Params p{};
    for (int i = 0; i < 24; ++i) p.in[i] = (const float*)d_in[i];
    p.out = (float*)d_out; p.ws = (unsigned char*)d_ws;
    void* args[] = {&p};
    hipError_t e = hipLaunchCooperativeKernel((const void*)mega, dim3(grid), dim3(512), args, LDS_BYTES, stream);
    if (e != hipSuccess) fprintf(stderr, "cooperative launch failed: %s (grid %d)\n", hipGetErrorString(e), grid);
}
```
